# Optimizing an MI355X kernel written in HIP

```python
import jax
import jax.numpy as jnp
from jax import lax
import numpy as np


D_MODEL = 1024
BATCH = 16
SEQ = 2048
DEPTH = 4

HEAD_DIM = 64
ATTN_Q_HEADS = 8
ATTN_KV_HEADS = 2
ATTN_GROUP = ATTN_Q_HEADS // ATTN_KV_HEADS
ATTN_WIDTH = ATTN_Q_HEADS * HEAD_DIM
ATTN_KV_WIDTH = ATTN_KV_HEADS * HEAD_DIM
WINDOW = 128
ATTN_BLOCK = 128
RWKV_HEADS = 8
RWKV_WIDTH = RWKV_HEADS * HEAD_DIM
DECAY_LORA = 64
ICLR_LORA = 64
GATE_LORA = 128
RWKV_SIZES = (RWKV_WIDTH, RWKV_WIDTH, RWKV_WIDTH, DECAY_LORA, ICLR_LORA, GATE_LORA)
RWKV_COLS = sum(RWKV_SIZES)
RWKV_LN_EPS = 64e-5
RET_HEADS = 8
RET_WIDTH = RET_HEADS * HEAD_DIM
RET_CHUNK = 128
ROPE_BASE = 10000.0
N_BRANCH = 3
IN_SIZES = (ATTN_WIDTH, ATTN_KV_WIDTH, ATTN_KV_WIDTH, RWKV_COLS,
            RET_WIDTH, RET_WIDTH, RET_WIDTH, RET_WIDTH, N_BRANCH * D_MODEL)
IN_WIDTH = sum(IN_SIZES)
D_FF = -((-8 * D_MODEL) // (3 * 256)) * 256
NORM_EPS = 1e-6

kernel_name = 'hybrid_swa_rwkv7_retention_block'


def _split(t, sizes):
    out, start = [], 0
    for s in sizes:
        out.append(t[..., start:start + s])
        start += s
    return out


def _rms(x, eps=NORM_EPS):
    xf = x.astype(jnp.float32)
    return (xf * lax.rsqrt(jnp.mean(xf * xf, axis=-1, keepdims=True) + eps)).astype(x.dtype)


def sliding_window_attention(q, k, v, sinks):
    B, T = q.shape[0], q.shape[1]
    C = ATTN_BLOCK
    NB = T // C
    qb = q.reshape(B, NB, C, ATTN_KV_HEADS, ATTN_GROUP, HEAD_DIM)

    def band(t):
        tb = t.reshape(B, NB, C, ATTN_KV_HEADS, HEAD_DIM)
        prev = jnp.concatenate([jnp.zeros_like(tb[:, :1]), tb[:, :-1]], axis=1)
        return jnp.concatenate([prev, tb], axis=2)

    kb, vb = band(k), band(v)
    s = jnp.einsum('bnqhgd,bnshd->bnhgqs', qb, kb).astype(jnp.float32) * (HEAD_DIM ** -0.5)
    qi = jnp.arange(C)[:, None]
    si = jnp.arange(2 * C)[None, :]
    rel = qi + C - si
    key_pos = jnp.arange(NB)[:, None, None] * C + si[None] - C
    mask = (rel >= 0) & (rel < WINDOW) & (key_pos >= 0)
    s = jnp.where(mask[None, :, None, None], s, -jnp.inf)
    sink = sinks.astype(jnp.float32).reshape(ATTN_KV_HEADS, ATTN_GROUP)[None, None, :, :, None, None]
    m = jnp.maximum(jnp.max(s, axis=-1, keepdims=True), sink)
    p = jnp.exp(s - m)
    p = p / (jnp.sum(p, axis=-1, keepdims=True) + jnp.exp(sink - m))
    o = jnp.einsum('bnhgqs,bnshd->bnqhgd', p.astype(v.dtype), vb)
    return o.reshape(B, T, ATTN_WIDTH)


def rwkv7_time_mix(h, shift_mu, w0, w2, a0, a2, g2, k_k, k_a, r_k, lnx_g, lnx_b):
    B, T = h.shape[0], h.shape[1]
    H, N = RWKV_HEADS, HEAD_DIM
    h_prev = jnp.pad(h, ((0, 0), (1, 0), (0, 0)))[:, :-1]
    z = h + shift_mu * (h_prev - h)
    r, k, v, wd, ad, gd = _split(z, RWKV_SIZES)
    w_log = -jax.nn.softplus(-(w0 + jnp.tanh(wd) @ w2)) - 0.5
    decay = jnp.exp(-jnp.exp(w_log.astype(jnp.float32)))
    a = jax.nn.sigmoid(a0 + ad @ a2)
    g = jax.nn.sigmoid(gd) @ g2
    kk = (k * k_k).reshape(B, T, H, N).astype(jnp.float32)
    kk = kk / jnp.maximum(jnp.linalg.norm(kk, axis=-1, keepdims=True), 1e-12)
    k = k * (1.0 + (a - 1.0) * k_a)

    def heads(t):
        return t.reshape(B, T, H, N).astype(jnp.float32)

    r_h, k_h, v_h, a_h, w_h = heads(r), heads(k), heads(v), heads(a), heads(decay)
    xs = tuple(t.transpose(1, 0, 2, 3) for t in (r_h, w_h, k_h, v_h, -kk, kk * a_h))

    def step(S, inp):
        r_t, w_t, k_t, v_t, a_t, b_t = inp
        Sa = jnp.einsum('bhvk,bhk->bhv', S, a_t)
        S = S * w_t[:, :, None, :] + Sa[..., None] * b_t[:, :, None, :] + v_t[..., None] * k_t[:, :, None, :]
        return S, jnp.einsum('bhvk,bhk->bhv', S, r_t)

    S0 = jnp.zeros((B, H, N, N), jnp.float32)
    _, y = lax.scan(step, S0, xs)
    y = y.transpose(1, 0, 2, 3)
    mu = jnp.mean(y, axis=-1, keepdims=True)
    var = jnp.mean(jnp.square(y - mu), axis=-1, keepdims=True)
    y = ((y - mu) * lax.rsqrt(var + RWKV_LN_EPS)).reshape(B, T, RWKV_WIDTH)
    y = y * lnx_g.astype(jnp.float32) + lnx_b.astype(jnp.float32)
    bonus = jnp.sum(r_h * k_h * r_k.astype(jnp.float32), axis=-1, keepdims=True) * v_h
    y = (y + bonus.reshape(B, T, RWKV_WIDTH)) * g.astype(jnp.float32)
    return y.astype(h.dtype)


def _rotary(x, pos):
    half = HEAD_DIM // 2
    inv_freq = 1.0 / (ROPE_BASE ** (jnp.arange(half, dtype=jnp.float32) * 2.0 / HEAD_DIM))
    ang = pos.astype(jnp.float32)[:, None] * inv_freq[None, :]
    cos, sin = jnp.cos(ang)[:, None, :], jnp.sin(ang)[:, None, :]
    x1, x2 = x[..., :half], x[..., half:]
    return jnp.concatenate([x1 * cos - x2 * sin, x2 * cos + x1 * sin], axis=-1)


def retention(q, k, v, gate):
    B, T = q.shape[0], q.shape[1]
    H, d, C = RET_HEADS, HEAD_DIM, RET_CHUNK
    NC = T // C
    pos = jnp.arange(T)
    qh = _rotary(q.reshape(B, T, H, d).astype(jnp.float32), pos)
    kh = _rotary(k.reshape(B, T, H, d).astype(jnp.float32), pos) * (d ** -0.5)
    vh = v.reshape(B, T, H, d).astype(jnp.float32)
    log_gamma = jnp.log1p(-jnp.power(2.0, -5.0 - jnp.arange(H, dtype=jnp.float32)))
    idx = jnp.arange(C, dtype=jnp.float32)
    diff = idx[:, None] - idx[None, :]
    dmat = jnp.where(diff >= 0, jnp.exp(log_gamma[:, None, None] * jnp.maximum(diff, 0.0)), 0.0)
    xi = jnp.exp(log_gamma[:, None] * (idx[None, :] + 1.0))
    zeta = jnp.exp(log_gamma[:, None] * (C - 1.0 - idx[None, :]))
    chunk_decay = jnp.exp(log_gamma * C)
    qc = qh.reshape(B, NC, C, H, d)
    kc = kh.reshape(B, NC, C, H, d)
    vc = vh.reshape(B, NC, C, H, d)
    s = jnp.einsum('bnihd,bnjhd->bnhij', qc, kc) * dmat
    inner = jnp.einsum('bnhij,bnjhe->bnihe', s, vc)
    kv = jnp.einsum('bnjhd,bnjhe,hj->nbhde', kc, vc, zeta)

    def step(R, kv_n):
        return R * chunk_decay[None, :, None, None] + kv_n, R

    _, r_prev = lax.scan(step, jnp.zeros((B, H, d, d), jnp.float32), kv)
    cross = jnp.einsum('bnihd,nbhde,hi->bnihe', qc, r_prev, xi)
    o = _rms((inner + cross).reshape(B, T, H, d)).reshape(B, T, RET_WIDTH)
    o = o * jax.nn.silu(gate.astype(jnp.float32))
    return o.astype(q.dtype)


def hybrid_layer(x, norm1_g, w_in, attn_q_norm_g, attn_k_norm_g, attn_sinks, w_attn_o,
                 rwkv_shift_mu, rwkv_w0, rwkv_w2, rwkv_a0, rwkv_a2, rwkv_g2, rwkv_k_k, rwkv_k_a,
                 rwkv_r_k, rwkv_lnx_g, rwkv_lnx_b, w_rwkv_o, w_ret_o, w_out,
                 norm2_g, w_ffn_gate, w_ffn_up, w_ffn_down):
    B, T, D = x.shape
    h = _rms(x) * norm1_g
    proj = h @ w_in
    aq, ak, av, rw, rq, rk, rv, rg, gates = _split(proj, IN_SIZES)
    aq = _rms(aq.reshape(B, T, ATTN_Q_HEADS, HEAD_DIM)) * attn_q_norm_g
    ak = _rms(ak.reshape(B, T, ATTN_KV_HEADS, HEAD_DIM)) * attn_k_norm_g
    av = av.reshape(B, T, ATTN_KV_HEADS, HEAD_DIM)
    o_a = sliding_window_attention(aq, ak, av, attn_sinks) @ w_attn_o
    o_b = rwkv7_time_mix(rw, rwkv_shift_mu, rwkv_w0, rwkv_w2, rwkv_a0, rwkv_a2, rwkv_g2,
                         rwkv_k_k, rwkv_k_a, rwkv_r_k, rwkv_lnx_g, rwkv_lnx_b) @ w_rwkv_o
    o_c = retention(rq, rk, rv, rg) @ w_ret_o
    g = jax.nn.sigmoid(gates).reshape(B, T, N_BRANCH, D)
    mixed = g[:, :, 0] * o_a + g[:, :, 1] * o_b + g[:, :, 2] * o_c
    x = x + mixed @ w_out
    h2 = _rms(x) * norm2_g
    x = x + (jax.nn.silu(h2 @ w_ffn_gate) * (h2 @ w_ffn_up)) @ w_ffn_down
    return x


def setup_inputs(seed: int = 0) -> dict:
    key = jax.random.key(seed)
    ks = jax.random.split(key, 25)
    L = DEPTH

    def nrm(k, shape, scale):
        return jax.random.normal(k, shape, jnp.float32) * scale

    return {
        'x': nrm(ks[0], (BATCH, SEQ, D_MODEL), 1.0),
        'norm1_g': 1.0 + nrm(ks[1], (L, D_MODEL), 0.02),
        'w_in': nrm(ks[2], (L, D_MODEL, IN_WIDTH), D_MODEL ** -0.5),
        'attn_q_norm_g': 1.0 + nrm(ks[3], (L, HEAD_DIM), 0.02),
        'attn_k_norm_g': 1.0 + nrm(ks[4], (L, HEAD_DIM), 0.02),
        'attn_sinks': nrm(ks[5], (L, ATTN_Q_HEADS), 0.5),
        'w_attn_o': nrm(ks[6], (L, ATTN_WIDTH, D_MODEL), ATTN_WIDTH ** -0.5),
        'rwkv_shift_mu': jax.random.uniform(ks[7], (L, RWKV_COLS), jnp.float32),
        'rwkv_w0': jax.random.uniform(ks[8], (L, RWKV_WIDTH), jnp.float32, minval=-6.0, maxval=1.0),
        'rwkv_w2': nrm(ks[9], (L, DECAY_LORA, RWKV_WIDTH), 0.1 * DECAY_LORA ** -0.5),
        'rwkv_a0': nrm(ks[10], (L, RWKV_WIDTH), 0.1),
        'rwkv_a2': nrm(ks[11], (L, ICLR_LORA, RWKV_WIDTH), ICLR_LORA ** -0.5),
        'rwkv_g2': nrm(ks[12], (L, GATE_LORA, RWKV_WIDTH), GATE_LORA ** -0.5),
        'rwkv_k_k': 0.85 + nrm(ks[13], (L, RWKV_WIDTH), 0.02),
        'rwkv_k_a': 1.0 + nrm(ks[14], (L, RWKV_WIDTH), 0.02),
        'rwkv_r_k': nrm(ks[15], (L, RWKV_HEADS, HEAD_DIM), 0.1),
        'rwkv_lnx_g': 1.0 + nrm(ks[16], (L, RWKV_WIDTH), 0.02),
        'rwkv_lnx_b': nrm(ks[17], (L, RWKV_WIDTH), 0.02),
        'w_rwkv_o': nrm(ks[18], (L, RWKV_WIDTH, D_MODEL), RWKV_WIDTH ** -0.5),
        'w_ret_o': nrm(ks[19], (L, RET_WIDTH, D_MODEL), RET_WIDTH ** -0.5),
        'w_out': nrm(ks[20], (L, D_MODEL, D_MODEL), D_MODEL ** -0.5),
        'norm2_g': 1.0 + nrm(ks[21], (L, D_MODEL), 0.02),
        'w_ffn_gate': nrm(ks[22], (L, D_MODEL, D_FF), D_MODEL ** -0.5),
        'w_ffn_up': nrm(ks[23], (L, D_MODEL, D_FF), D_MODEL ** -0.5),
        'w_ffn_down': nrm(ks[24], (L, D_FF, D_MODEL), D_FF ** -0.5),
    }


def reference(x, norm1_g, w_in, attn_q_norm_g, attn_k_norm_g, attn_sinks, w_attn_o,
              rwkv_shift_mu, rwkv_w0, rwkv_w2, rwkv_a0, rwkv_a2, rwkv_g2, rwkv_k_k, rwkv_k_a,
              rwkv_r_k, rwkv_lnx_g, rwkv_lnx_b, w_rwkv_o, w_ret_o, w_out,
              norm2_g, w_ffn_gate, w_ffn_up, w_ffn_down):
    for l in range(DEPTH):
        x = hybrid_layer(x, norm1_g[l], w_in[l], attn_q_norm_g[l], attn_k_norm_g[l], attn_sinks[l],
                         w_attn_o[l], rwkv_shift_mu[l], rwkv_w0[l], rwkv_w2[l], rwkv_a0[l], rwkv_a2[l],
                         rwkv_g2[l], rwkv_k_k[l], rwkv_k_a[l], rwkv_r_k[l], rwkv_lnx_g[l], rwkv_lnx_b[l],
                         w_rwkv_o[l], w_ret_o[l], w_out[l], norm2_g[l], w_ffn_gate[l], w_ffn_up[l],
                         w_ffn_down[l])
    return x
```

```cpp
#include <hip/hip_runtime.h>
#include <cstdio>
#include <cstdint>
#include <cstring>

constexpr int D = 1024, BATCH = 16, T = 2048, DEPTH = 4, M = BATCH * T;
constexpr int HD = 64;
constexpr int NA = 4608;
constexpr int NG = 3072;
constexpr int INW = NA + NG;
constexpr int C_AQ = 0, C_AK = 512, C_AV = 640, C_RW = 768, C_RQ = 2560, C_RK = 3072, C_RV = 3584, C_RG = 4096;
constexpr int RWC = 1792;
constexpr int FF = 2816, FF2 = 2 * FF;
constexpr int NMIX = 1536;

constexpr size_t MiB = 1u << 20;
constexpr size_t WS_CTL = 0, CTL_BYTES = 1 * MiB;
constexpr size_t WS_WIN = 1 * MiB;
constexpr size_t WS_WMIX = WS_WIN + (size_t)INW * D * 2;
constexpr size_t WS_WOUT = WS_WMIX + (size_t)D * NMIX * 2;
constexpr size_t WS_WGU = WS_WOUT + (size_t)D * D * 2;
constexpr size_t WS_WDN = WS_WGU + (size_t)FF2 * D * 2;
constexpr size_t WS_XB = 38 * MiB;
constexpr size_t WS_MIXO = 102 * MiB;
constexpr size_t WS_BIG = 198 * MiB;
constexpr size_t WS_MIXED = WS_BIG + 192 * MiB;
constexpr size_t WS_RSS = 486 * MiB;
constexpr size_t WS_ROPE = 488 * MiB;
constexpr size_t WS_END = 489 * MiB;
static_assert(WS_WDN + (size_t)D * FF * 2 <= WS_XB, "weights fit");
static_assert(WS_BIG + (size_t)M * NA * 2 <= WS_RSS, "big region fits");

#define GAS __attribute__((address_space(1)))
#define LAS __attribute__((address_space(3)))
typedef unsigned short bf16;
typedef unsigned v4u __attribute__((ext_vector_type(4)));
typedef unsigned v2u __attribute__((ext_vector_type(2)));
typedef float v4f __attribute__((ext_vector_type(4)));
__device__ __forceinline__ unsigned f2bf(float f) { unsigned u = __builtin_bit_cast(unsigned, f); return (u + 0x7fffu + ((u >> 16) & 1u)) >> 16; }
__device__ __forceinline__ unsigned pk2(float lo, float hi) { return f2bf(lo) | (f2bf(hi) << 16); }
__device__ __forceinline__ float bf2f(unsigned short b) { return __builtin_bit_cast(float, (unsigned)b << 16); }
__device__ __forceinline__ float bflo(unsigned w) { return __builtin_bit_cast(float, w << 16); }
__device__ __forceinline__ float bfhi(unsigned w) { return __builtin_bit_cast(float, w & 0xffff0000u); }
__device__ __forceinline__ float wave_sum(float v) {
#pragma unroll
    for (int o = 1; o < 64; o <<= 1) v += __shfl_xor(v, o);
    return v;
}
__device__ __forceinline__ float wave_max(float v) {
#pragma unroll
    for (int o = 1; o < 64; o <<= 1) v = fmaxf(v, __shfl_xor(v, o));
    return v;
}
__device__ __forceinline__ float sigmoidf_(float x) { return 1.f / (1.f + __expf(-x)); }

struct Params {
    const float* in[25];
    float* out;
    unsigned char* ws;
    int layer; int pad;
};
enum { I_X = 0, I_N1G, I_WIN, I_QNG, I_KNG, I_SINK, I_WAO, I_MU, I_W0, I_W2, I_A0, I_A2, I_G2, I_KK, I_KA, I_RK, I_LNG, I_LNB, I_WRO, I_WTO, I_WOUT, I_N2G, I_WG, I_WU, I_WD };


namespace pg8 {
#define PG8_LAS __attribute__((address_space(3)))
typedef unsigned short bf16_t;
typedef short bf16x8 __attribute__((ext_vector_type(8)));
typedef float f32x4 __attribute__((ext_vector_type(4)));
typedef unsigned u32x4 __attribute__((ext_vector_type(4)));
constexpr int BM = 256, BK = 64, HALF = 128, HTB = HALF * BK * 2  , STAGE_BYTES = 8 * HTB, NXCD = 8, WGM = 8;

__host__ __device__ __forceinline__ int lds_byte(int r, int c) { const int st = (r >> 4) * 2 + (c >> 5), rr = r & 15, cc = c & 31, ob = rr * 64 + cc * 2; return st * 1024 + (ob ^ (((ob >> 9) & 1) << 5)); }
__host__ __device__ __forceinline__ void stage_rc(int b, int& R, int& C) { const int st = b / 1024, sb = b % 1024, swz = sb ^ (((sb >> 9) & 1) << 5); R = (st >> 1) * 16 + swz / 64; C = (st & 1) * 32 + (swz % 64) / 2; }
__host__ __device__ __forceinline__ int perm32(int rho) { const int n = rho >> 4, i = rho & 15; return 8 * (i >> 2) + 4 * n + (i & 3); }

struct Unit { int pm, pn; };
struct Gemm { const bf16_t* A; const bf16_t* Bt; int M, N, K; };

struct StaticOrder {
    int nM, nN, nwg, G, c;
    __host__ __device__ void init(int M, int N, int G_, int c_) { nM = M / BM; nN = N / BM; nwg = nM * nN; G = G_; c = c_; }
    __host__ __device__ bool next(int i, Unit& u) const {
        const long L = (long)i * G + c; if (L >= nwg) return false;
        int wgid = (int)L; { const int q = nwg / NXCD, r = nwg % NXCD, xcd = wgid % NXCD, off = wgid / NXCD; wgid = (xcd < r ? xcd * (q + 1) : r * (q + 1) + (xcd - r) * q) + off; }
        const int nig = WGM * nN, gid = wgid / nig, fm = gid * WGM, gsz = (nM - fm) < WGM ? (nM - fm) : WGM;
        u.pm = fm + ((wgid % nig) % gsz); u.pn = (wgid % nig) / gsz; return true;
    }
    __device__ __forceinline__ void a_ready(const Unit&) const {}
    __device__ __forceinline__ void done(const Unit&) const {}
};


__device__ __forceinline__ unsigned cvt_pk_bf16(float lo, float hi) { unsigned r; asm volatile("v_cvt_pk_bf16_f32 %0, %1, %2" : "=v"(r) : "v"(lo), "v"(hi)); return r; }
__device__ __forceinline__ float clampg(float x) { return __builtin_amdgcn_fmed3f(x, -30.0f, 30.0f); }
__device__ __forceinline__ float row_rstd(const float* rss, int row) {
    const f32x4* p = (const f32x4*)(rss + (size_t)row * 16);
    const f32x4 a = p[0], b = p[1], c = p[2], d = p[3];
    const float s = (((a.x + a.y) + (a.z + a.w)) + ((b.x + b.y) + (b.z + b.w))) + (((c.x + c.y) + (c.z + c.w)) + ((d.x + d.y) + (d.z + d.w)));
    return rsqrtf(s * (1.0f / 1024.0f) + 1e-6f);
}
struct EpiRowScale {
    static constexpr bool PERM = true, AFTER_DRAIN = false; static constexpr int KSEG = 0;
    bf16_t* O; int ldc; const float* rss;
    __device__ __forceinline__ void operator()(const f32x4 (&acc)[2][2][4][2], const Unit& u, int wr, int wc, int fr, int fq) const {
        const int row0 = u.pm * BM + wr * 64 + fr, col0 = u.pn * BM + wc * 32 + 8 * fq;
#pragma unroll
        for (int ai = 0; ai < 2; ++ai)
#pragma unroll
            for (int m = 0; m < 4; ++m) { const int row = row0 + ai * HALF + m * 16; const float rs = row_rstd(rss, row); bf16_t* rowp = O + (size_t)row * ldc + col0;
#pragma unroll
                for (int bj = 0; bj < 2; ++bj) { const f32x4 v0 = acc[ai][bj][m][0] * rs, v1 = acc[ai][bj][m][1] * rs;
                    u32x4 w; w.x = cvt_pk_bf16(v0[0], v0[1]); w.y = cvt_pk_bf16(v0[2], v0[3]); w.z = cvt_pk_bf16(v1[0], v1[1]); w.w = cvt_pk_bf16(v1[2], v1[3]);
                    *(u32x4*)(rowp + bj * HALF) = w; } }
    }
};
struct EpiSwiglu {
    static constexpr bool PERM = true, AFTER_DRAIN = false; static constexpr int KSEG = 0;
    bf16_t* O; int ldc; const float* rss;
    __device__ __forceinline__ void operator()(const f32x4 (&acc)[2][2][4][2], const Unit& u, int wr, int wc, int fr, int fq) const {
        const int row0 = u.pm * BM + wr * 64 + fr, col0 = u.pn * HALF + wc * 32 + 8 * fq;
#pragma unroll
        for (int ai = 0; ai < 2; ++ai)
#pragma unroll
            for (int m = 0; m < 4; ++m) { const int row = row0 + ai * HALF + m * 16; const float rs = row_rstd(rss, row); bf16_t* rowp = O + (size_t)row * ldc + col0;
                float o[8];
#pragma unroll
                for (int n = 0; n < 2; ++n)
#pragma unroll
                    for (int j = 0; j < 4; ++j) { const float g = acc[ai][0][m][n][j] * rs, up = acc[ai][1][m][n][j] * rs; o[4 * n + j] = g * up * __builtin_amdgcn_rcpf(1.0f + __expf(-g)); }
                u32x4 w; w.x = cvt_pk_bf16(o[0], o[1]); w.y = cvt_pk_bf16(o[2], o[3]); w.z = cvt_pk_bf16(o[4], o[5]); w.w = cvt_pk_bf16(o[6], o[7]);
                *(u32x4*)rowp = w; }
    }
};
struct EpiResid {
    static constexpr bool PERM = false, AFTER_DRAIN = false; static constexpr int KSEG = 0;
    float* X; bf16_t* XB; float* rss;
    __device__ __forceinline__ void operator()(const f32x4 (&acc)[2][2][4][2], const Unit& u, int wr, int wc, int fr, int fq) const {
        const int row0 = u.pm * BM + wr * 64 + fr, col0 = u.pn * BM + wc * 32 + 4 * fq;
#pragma unroll
        for (int ai = 0; ai < 2; ++ai)
#pragma unroll
            for (int m = 0; m < 4; ++m) { const int row = row0 + ai * HALF + m * 16; const size_t off = (size_t)row * 1024 + col0; float ss = 0.f;
#pragma unroll
                for (int bj = 0; bj < 2; ++bj)
#pragma unroll
                    for (int n = 0; n < 2; ++n) { const size_t o2 = off + bj * HALF + n * 16; const f32x4 x = *(const f32x4*)(X + o2) + acc[ai][bj][m][n];
                        *(f32x4*)(X + o2) = x; ss += (x[0] * x[0] + x[1] * x[1]) + (x[2] * x[2] + x[3] * x[3]);
                        unsigned long long w = (unsigned long long)cvt_pk_bf16(x[0], x[1]) | ((unsigned long long)cvt_pk_bf16(x[2], x[3]) << 32);
                        *(unsigned long long*)(XB + o2) = w; }
                ss += __shfl_xor(ss, 16); ss += __shfl_xor(ss, 32);
                if (fq == 0) rss[(size_t)row * 16 + u.pn * 4 + wc] = ss; }
    }
};
struct EpiGateMix {
    static constexpr bool PERM = true, AFTER_DRAIN = false; static constexpr int KSEG = 8;
    const bf16_t* Gt; bf16_t* O;
    __device__ __forceinline__ void seg(f32x4 (&acc)[2][2][4][2], const Unit& u, int s, int wr, int wc, int fr, int fq) const {
        const int row0 = u.pm * BM + wr * 64 + fr, col0 = u.pn * BM + wc * 32 + 8 * fq;
#pragma unroll
        for (int ai = 0; ai < 2; ++ai)
#pragma unroll
            for (int m = 0; m < 4; ++m) { const bf16_t* gp = Gt + (size_t)(row0 + ai * HALF + m * 16) * 3072 + (s - 1) * 1024 + col0;
#pragma unroll
                for (int bj = 0; bj < 2; ++bj) { const u32x4 lo = *(const u32x4*)(gp + bj * HALF), hi = *(const u32x4*)(gp + 1024 + bj * HALF);
#pragma unroll
                    for (int q = 0; q < 4; ++q) { const unsigned wl = lo[q], wh = hi[q];
                        const float l0 = clampg(__builtin_bit_cast(float, wl << 16)), l1 = clampg(__builtin_bit_cast(float, wl & 0xffff0000u)), h0 = clampg(__builtin_bit_cast(float, wh << 16)), h1 = clampg(__builtin_bit_cast(float, wh & 0xffff0000u));
                        const float r0 = (1.0f + __expf(-h0)) * __builtin_amdgcn_rcpf(1.0f + __expf(-l0)), r1 = (1.0f + __expf(-h1)) * __builtin_amdgcn_rcpf(1.0f + __expf(-l1));
                        acc[ai][bj][m][q >> 1][(q & 1) * 2] *= r0; acc[ai][bj][m][q >> 1][(q & 1) * 2 + 1] *= r1; } } }
    }
    __device__ __forceinline__ void operator()(const f32x4 (&acc)[2][2][4][2], const Unit& u, int wr, int wc, int fr, int fq) const {
        const int row0 = u.pm * BM + wr * 64 + fr, col0 = u.pn * BM + wc * 32 + 8 * fq;
#pragma unroll
        for (int ai = 0; ai < 2; ++ai)
#pragma unroll
            for (int m = 0; m < 4; ++m) { const int row = row0 + ai * HALF + m * 16; const bf16_t* gp = Gt + (size_t)row * 3072 + 2048 + col0; bf16_t* rowp = O + (size_t)row * 1024 + col0;
#pragma unroll
                for (int bj = 0; bj < 2; ++bj) { const u32x4 g = *(const u32x4*)(gp + bj * HALF); float o[8];
#pragma unroll
                    for (int q = 0; q < 4; ++q) { const unsigned w = g[q]; const float g0 = clampg(__builtin_bit_cast(float, w << 16)), g1 = clampg(__builtin_bit_cast(float, w & 0xffff0000u));
                        o[2 * q] = acc[ai][bj][m][q >> 1][(q & 1) * 2] * __builtin_amdgcn_rcpf(1.0f + __expf(-g0)); o[2 * q + 1] = acc[ai][bj][m][q >> 1][(q & 1) * 2 + 1] * __builtin_amdgcn_rcpf(1.0f + __expf(-g1)); }
                    u32x4 w; w.x = cvt_pk_bf16(o[0], o[1]); w.y = cvt_pk_bf16(o[2], o[3]); w.z = cvt_pk_bf16(o[4], o[5]); w.w = cvt_pk_bf16(o[6], o[7]);
                    *(u32x4*)(rowp + bj * HALF) = w; } }
    }
};


template <class Epi, class Sched, bool ALIGN_EPI = false, bool SP2 = false>
__device__ __forceinline__ void gemm_phase(PG8_LAS unsigned char* lds, const Gemm g, const Sched& S, const Epi& E) {
    const int tid = threadIdx.x, wid = __builtin_amdgcn_readfirstlane(tid >> 6), lane = tid & 63, wr = wid >> 2, wc = wid & 3, fr = lane & 15, fq = lane >> 4;
    const int K = g.K, nt = K / BK;
    unsigned voffA[2], voffB[2];
#pragma unroll
    for (int i = 0; i < 2; ++i) { int R, C; stage_rc(tid * 16 + i * 8192, R, C); const int Rb = Epi::PERM ? ((R & ~31) + perm32(R & 31)) : R;
        voffA[i] = (unsigned)(R * K + C) * 2u; voffB[i] = (unsigned)(Rb * K + C) * 2u; }
    const size_t kstep = (size_t)(BK * 2);
    const size_t hstep = (size_t)HALF * K * 2;
    const size_t tstep = 2 * hstep;
    const unsigned ldsw = (unsigned)wid * 1024u;
    const int aoff = lds_byte(wr * 64 + fr, fq * 8), boff = lds_byte(wc * 32 + fr, fq * 8);
#define PG8_SA(b, h) (((b) * 2 + (h)) * HTB)
#define PG8_SB(b, h) ((4 + (b) * 2 + (h)) * HTB)
#define PG8_STAGE(bufoff, gbase, voff) do { _Pragma("unroll") for (int _i = 0; _i < 2; ++_i) \
        __builtin_amdgcn_global_load_lds((const unsigned*)((const char*)(gbase) + (voff)[_i]), (PG8_LAS unsigned*)(lds + (bufoff) + ldsw + _i * 8192), 16, 0, 0); } while (0)
#define PG8_LDA(dst, b, h) do { _Pragma("unroll") for (int m = 0; m < 4; ++m) _Pragma("unroll") for (int k = 0; k < 2; ++k) dst[m][k] = *(const PG8_LAS bf16x8*)(lds + PG8_SA(b, h) + aoff + m * 2048 + k * 1024); } while (0)
#define PG8_LDB(dst, b, h) do { _Pragma("unroll") for (int n = 0; n < 2; ++n) _Pragma("unroll") for (int k = 0; k < 2; ++k) dst[n][k] = *(const PG8_LAS bf16x8*)(lds + PG8_SB(b, h) + boff + n * 2048 + k * 1024); } while (0)
#define PG8_MMA(ai, bj, At, Bt) do { __builtin_amdgcn_s_setprio(1); _Pragma("unroll") for (int m = 0; m < 4; ++m) _Pragma("unroll") for (int n = 0; n < 2; ++n) _Pragma("unroll") for (int k = 0; k < 2; ++k) \
        acc[ai][bj][m][n] = __builtin_amdgcn_mfma_f32_16x16x32_bf16(Bt[n][k], At[m][k], acc[ai][bj][m][n], 0, 0, 0); __builtin_amdgcn_s_setprio(0); } while (0)
#define PG8_WAIT_V(n) asm volatile("s_waitcnt vmcnt(" #n ")" ::: "memory")
#define PG8_WAIT_L(n) asm volatile("s_waitcnt lgkmcnt(" #n ")" ::: "memory")
#define PG8_BAR __builtin_amdgcn_s_barrier()
#define PG8_SCHED __builtin_amdgcn_sched_barrier(0)
    Unit cur, nxt; int ui = 0;
    if (!S.next(0, cur)) return;
    f32x4 acc[2][2][4][2];
#pragma unroll
    for (int a = 0; a < 2; ++a)
#pragma unroll
        for (int b = 0; b < 2; ++b)
#pragma unroll
            for (int m = 0; m < 4; ++m)
#pragma unroll
                for (int n = 0; n < 2; ++n) acc[a][b][m][n] = (f32x4){0.f, 0.f, 0.f, 0.f};
    bf16x8 At[4][2], B0[2][2], B1[2][2];
    const char* cA = (const char*)g.A + (size_t)cur.pm * tstep; const char* cB = (const char*)g.Bt + (size_t)cur.pn * tstep;
    S.a_ready(cur);
    if constexpr (SP2) {
        PG8_STAGE(PG8_SB(0, 0), cB, voffB); PG8_STAGE(PG8_SB(0, 1), cB + hstep, voffB); PG8_STAGE(PG8_SA(0, 0), cA, voffA); PG8_STAGE(PG8_SA(0, 1), cA + hstep, voffA);
        if (wr == 1) PG8_BAR;
        PG8_WAIT_V(2); PG8_BAR;
        PG8_STAGE(PG8_SB(1, 0), cB + kstep, voffB); PG8_STAGE(PG8_SA(1, 0), cA + kstep, voffA); PG8_STAGE(PG8_SB(1, 1), cB + hstep + kstep, voffB);
        PG8_WAIT_V(6); PG8_BAR;
    } else {
        PG8_STAGE(PG8_SB(0, 0), cB, voffB); PG8_STAGE(PG8_SA(0, 0), cA, voffA); PG8_STAGE(PG8_SB(0, 1), cB + hstep, voffB); PG8_STAGE(PG8_SA(0, 1), cA + hstep, voffA);
        if (wr == 1) PG8_BAR;
        PG8_WAIT_V(4); PG8_BAR;
        PG8_STAGE(PG8_SB(1, 0), cB + kstep, voffB); PG8_STAGE(PG8_SA(1, 0), cA + kstep, voffA); PG8_STAGE(PG8_SB(1, 1), cB + hstep + kstep, voffB);
        PG8_WAIT_V(6); PG8_BAR;
    }
    for (;;) {
        const bool has_next = S.next(ui + 1, nxt);
        const char* nA = has_next ? (const char*)g.A + (size_t)nxt.pm * tstep : cA; const char* nB = has_next ? (const char*)g.Bt + (size_t)nxt.pn * tstep : cB;
        for (int t = 0; t < nt; t += 2) {
            const bool last = (t == nt - 2);
            const char* a1 = cA + (size_t)(t + 1) * kstep;
            const char* a2 = last ? nA : cA + (size_t)(t + 2) * kstep; const char* b2 = last ? nB : cB + (size_t)(t + 2) * kstep;
            const char* a3 = a2 + kstep; const char* b3 = b2 + kstep;
            if (last && has_next) S.a_ready(nxt);
            if constexpr (Epi::KSEG > 0) { if (t != 0 && (t % Epi::KSEG) == 0) E.seg(acc, cur, t / Epi::KSEG, wr, wc, fr, fq); }
            if constexpr (SP2) {
            PG8_LDB(B0, 0, 0); PG8_LDB(B1, 0, 1); PG8_SCHED; PG8_LDA(At, 0, 0); PG8_STAGE(PG8_SA(1, 1), a1 + hstep, voffA);
            PG8_WAIT_V(8); PG8_WAIT_L(0); PG8_BAR; PG8_MMA(0, 0, At, B0); PG8_MMA(0, 1, At, B1); PG8_BAR; PG8_SCHED;
            PG8_LDA(At, 0, 1); PG8_STAGE(PG8_SB(0, 0), b2, voffB); PG8_STAGE(PG8_SB(0, 1), b2 + hstep, voffB); PG8_STAGE(PG8_SA(0, 0), a2, voffA);
            PG8_WAIT_V(8); PG8_WAIT_L(0); PG8_BAR; PG8_MMA(1, 0, At, B0); PG8_MMA(1, 1, At, B1); PG8_BAR; PG8_SCHED;
            PG8_LDB(B0, 1, 0); PG8_LDB(B1, 1, 1); PG8_SCHED; PG8_LDA(At, 1, 0); PG8_STAGE(PG8_SA(0, 1), a2 + hstep, voffA);
            PG8_WAIT_V(8); PG8_WAIT_L(0); PG8_BAR; PG8_MMA(0, 0, At, B0); PG8_MMA(0, 1, At, B1); PG8_BAR; PG8_SCHED;
            PG8_LDA(At, 1, 1); PG8_STAGE(PG8_SB(1, 0), b3, voffB); PG8_STAGE(PG8_SB(1, 1), b3 + hstep, voffB); PG8_STAGE(PG8_SA(1, 0), a3, voffA);
            PG8_WAIT_V(8); PG8_WAIT_L(0); PG8_BAR; PG8_MMA(1, 0, At, B0); PG8_MMA(1, 1, At, B1); PG8_BAR; PG8_SCHED;
            } else {
            PG8_LDB(B0, 0, 0); PG8_SCHED; PG8_LDA(At, 0, 0); PG8_STAGE(PG8_SA(1, 1), a1 + hstep, voffA);
            PG8_WAIT_L(8); PG8_BAR; PG8_WAIT_L(0); PG8_MMA(0, 0, At, B0); PG8_BAR; PG8_SCHED;
            PG8_LDB(B1, 0, 1); PG8_STAGE(PG8_SB(0, 0), b2, voffB);
            PG8_BAR; PG8_WAIT_L(0); PG8_MMA(0, 1, At, B1); PG8_BAR;
            PG8_LDA(At, 0, 1); PG8_STAGE(PG8_SA(0, 0), a2, voffA);
            PG8_BAR; PG8_WAIT_L(0); PG8_MMA(1, 0, At, B0); PG8_BAR; PG8_SCHED;
            PG8_STAGE(PG8_SB(0, 1), b2 + hstep, voffB);
            PG8_WAIT_V(6); PG8_BAR; PG8_MMA(1, 1, At, B1); PG8_BAR;
            PG8_LDB(B0, 1, 0); PG8_SCHED; PG8_LDA(At, 1, 0); PG8_STAGE(PG8_SA(0, 1), a2 + hstep, voffA);
            PG8_WAIT_L(8); PG8_BAR; PG8_WAIT_L(0); PG8_MMA(0, 0, At, B0); PG8_BAR; PG8_SCHED;
            PG8_LDB(B1, 1, 1); PG8_STAGE(PG8_SB(1, 0), b3, voffB);
            PG8_BAR; PG8_WAIT_L(0); PG8_MMA(0, 1, At, B1); PG8_BAR;
            PG8_LDA(At, 1, 1); PG8_STAGE(PG8_SA(1, 0), a3, voffA);
            PG8_BAR; PG8_WAIT_L(0); PG8_MMA(1, 0, At, B0); PG8_BAR; PG8_SCHED;
            PG8_STAGE(PG8_SB(1, 1), b3 + hstep, voffB);
            PG8_WAIT_V(6); PG8_BAR; PG8_MMA(1, 1, At, B1); PG8_BAR;
            }
        }
        if constexpr (ALIGN_EPI) { if (wr == 0) PG8_BAR; }
        if constexpr (!Epi::AFTER_DRAIN) { E(acc, cur, wr, wc, fr, fq); S.done(cur); }
        if (!has_next) break;
#pragma unroll
        for (int a = 0; a < 2; ++a)
#pragma unroll
            for (int b = 0; b < 2; ++b)
#pragma unroll
                for (int m = 0; m < 4; ++m)
#pragma unroll
                    for (int n = 0; n < 2; ++n) acc[a][b][m][n] = (f32x4){0.f, 0.f, 0.f, 0.f};
        cur = nxt; cA = nA; cB = nB; ++ui;
        if constexpr (ALIGN_EPI) { if (wr == 1) PG8_BAR; }
    }
    PG8_WAIT_V(0);
    if constexpr (!ALIGN_EPI) { if (wr == 0) PG8_BAR; }
    PG8_BAR;
    if constexpr (Epi::AFTER_DRAIN) { E.fused(acc, cur, wr, wc, fr, fq, lds, wid, lane); S.done(cur); }
#undef PG8_SA
#undef PG8_SB
#undef PG8_STAGE
#undef PG8_LDA
#undef PG8_LDB
#undef PG8_MMA
#undef PG8_WAIT_V
#undef PG8_WAIT_L
#undef PG8_BAR
#undef PG8_SCHED
}
}


#define LDS_WAIT() asm volatile("s_waitcnt lgkmcnt(0)" ::: "memory")
constexpr int NWAVES = 8;
constexpr int LDS_BYTES = 147456;

__device__ __forceinline__ void tr_item(const float* W, int ldw, int k0, int n0, const float* scale, bf16* WT, int ldt, int drow0, int dcol0, LAS float* scr, int lane) {
#pragma unroll 8
    for (int i = 0; i < 32; ++i) { const int kk = 2 * i + (lane >> 5); float v = W[(size_t)(k0 + kk) * ldw + n0 + (lane & 31)]; if (scale) v *= scale[k0 + kk]; scr[kk * 33 + (lane & 31)] = v; }
    LDS_WAIT(); asm volatile("" ::: "memory");
    const int c = lane & 7;
#pragma unroll
    for (int j = 0; j < 4; ++j) { const int n = (lane >> 3) + 8 * j; const LAS float* s = scr + (8 * c) * 33 + n;
        v4u o; o.x = pk2(s[0 * 33], s[1 * 33]); o.y = pk2(s[2 * 33], s[3 * 33]); o.z = pk2(s[4 * 33], s[5 * 33]); o.w = pk2(s[6 * 33], s[7 * 33]);
        *(v4u*)(WT + (size_t)(drow0 + n) * ldt + dcol0 + 8 * c) = o; }
    LDS_WAIT(); asm volatile("" ::: "memory");
}
constexpr int WI_IN = 16 * 240, WI_MIX = 3 * 8 * 32, WI_OUT = 16 * 32, WI_G = 16 * 88, WI_DN = 44 * 32;
constexpr int WI_TOTAL = WI_IN + WI_MIX + WI_OUT + 2 * WI_G + WI_DN;
__device__ __forceinline__ void wconv_item(const Params& P, int l, int it, LAS float* scr, int lane) {
    unsigned char* ws = P.ws;
    if (it < WI_IN) { const int kb = it / 240, nb = it % 240; tr_item(P.in[I_WIN] + (size_t)l * D * INW, INW, 64 * kb, 32 * nb, P.in[I_N1G] + l * D, (bf16*)(ws + WS_WIN), D, 32 * nb, 64 * kb, scr, lane); return; }
    it -= WI_IN;
    if (it < WI_MIX) { const int br = it / 256, r = it % 256, kb = r / 32, nb = r % 32; const float* W = P.in[br == 0 ? I_WAO : (br == 1 ? I_WRO : I_WTO)] + (size_t)l * 512 * D;
        tr_item(W, D, 64 * kb, 32 * nb, nullptr, (bf16*)(ws + WS_WMIX), NMIX, 32 * nb, br * 512 + 64 * kb, scr, lane); return; }
    it -= WI_MIX;
    if (it < WI_OUT) { const int kb = it / 32, nb = it % 32; tr_item(P.in[I_WOUT] + (size_t)l * D * D, D, 64 * kb, 32 * nb, nullptr, (bf16*)(ws + WS_WOUT), D, 32 * nb, 64 * kb, scr, lane); return; }
    it -= WI_OUT;
    if (it < 2 * WI_G) { const int up = it / WI_G, r = it % WI_G, kb = r / 88, nb = r % 88, n0 = 32 * nb;
        tr_item(P.in[up ? I_WU : I_WG] + (size_t)l * D * FF, FF, 64 * kb, n0, P.in[I_N2G] + l * D, (bf16*)(ws + WS_WGU), D, (n0 / 128) * 256 + up * 128 + (n0 % 128), 64 * kb, scr, lane); return; }
    it -= 2 * WI_G;
    { const int kb = it / 32, nb = it % 32; tr_item(P.in[I_WD] + (size_t)l * FF * D, D, 64 * kb, 32 * nb, nullptr, (bf16*)(ws + WS_WDN), FF, 32 * nb, 64 * kb, scr, lane); }
}
__device__ __forceinline__ void phase_wconv(const Params& P, int l, LAS unsigned char* lds, int vcu, int G) {
    const int wave = __builtin_amdgcn_readfirstlane(threadIdx.x >> 6), lane = threadIdx.x & 63;
    LAS float* scr = (LAS float*)(lds + wave * 16384);
    for (int it = vcu * NWAVES + wave; it < WI_TOTAL; it += G * NWAVES) wconv_item(P, l, it, scr, lane);
}
__device__ __forceinline__ void phase_x0(const Params& P, int vcu, int G) {
    const int wave = __builtin_amdgcn_readfirstlane(threadIdx.x >> 6), lane = threadIdx.x & 63;
    const float* x = P.in[I_X]; float* out = P.out; bf16* xb = (bf16*)(P.ws + WS_XB); float* rss = (float*)(P.ws + WS_RSS);
    for (int m = vcu * NWAVES + wave; m < M; m += G * NWAVES) {
        const v4f* xr = (const v4f*)(x + (size_t)m * D) + lane; v4f* orow = (v4f*)(out + (size_t)m * D) + lane; unsigned long long* o8 = (unsigned long long*)(xb + (size_t)m * D) + lane;
        v4f v[4]; float s = 0.f;
#pragma unroll
        for (int j = 0; j < 4; ++j) { v[j] = xr[64 * j]; s += (v[j].x * v[j].x + v[j].y * v[j].y) + (v[j].z * v[j].z + v[j].w * v[j].w); }
        s = wave_sum(s);
#pragma unroll
        for (int j = 0; j < 4; ++j) { orow[64 * j] = v[j]; o8[64 * j] = (unsigned long long)pk2(v[j].x, v[j].y) | ((unsigned long long)pk2(v[j].z, v[j].w) << 32); }
        if (lane < 16) rss[(size_t)m * 16 + lane] = lane == 0 ? s : 0.f;
    }
    float* rope = (float*)(P.ws + WS_ROPE);
    for (int i = (vcu * NWAVES + wave) * 64 + lane; i < T * 32; i += G * NWAVES * 64) {
        const int t = i >> 5, j = i & 31; const float inv_freq = (float)exp(-((double)j / 32.0) * 9.210340371976184); const float ang = (float)t * inv_freq;
        const double xa = (double)ang, qd = rint(xa * 0.6366197723675814), fd = xa - qd * 1.5707963267948966; const int qi = (int)qd & 3;
        const float ff = (float)fd, f2 = ff * ff;
        const float sf = ff * (1.0f + f2 * (-1.6666667e-1f + f2 * (8.3333333e-3f + f2 * (-1.9841270e-4f + f2 * 2.7557319e-6f))));
        const float cf = 1.0f + f2 * (-0.5f + f2 * (4.1666667e-2f + f2 * (-1.3888889e-3f + f2 * (2.4801587e-5f + f2 * -2.7557319e-7f))));
        const float sn = (qi == 0) ? sf : (qi == 1) ? cf : (qi == 2) ? -sf : -cf, cs = (qi == 0) ? cf : (qi == 1) ? -sf : (qi == 2) ? -cf : sf;
        rope[2 * i] = cs; rope[2 * i + 1] = sn;
    }
}

__global__ void __launch_bounds__(256) k_attn_naive(Params P) {
    __shared__ float sq[4][64]; __shared__ float sp[4][128];
    const int w = threadIdx.x >> 6, lane = threadIdx.x & 63, l = P.layer;
    const bf16* proj = (const bf16*)(P.ws + WS_BIG); bf16* mixo = (bf16*)(P.ws + WS_MIXO);
    const float* gq = P.in[I_QNG] + l * 64; const float* gk = P.in[I_KNG] + l * 64; const float* sinks = P.in[I_SINK] + l * 8;
    const int task = blockIdx.x * 4 + w, qh = task & 7, tok = task >> 3, t = tok & (T - 1), kvh = qh >> 2;
    const float q = bf2f(proj[(size_t)tok * NA + C_AQ + qh * 64 + lane]);
    const float ssq = wave_sum(q * q);
    sq[w][lane] = q * rsqrtf(ssq * (1.f / 64.f) + 1e-6f) * gq[lane] * 0.125f * gk[lane];
    __syncthreads();
    float s[2];
#pragma unroll
    for (int jj = 0; jj < 2; ++jj) { const int j = lane + 64 * jj, kp = t - 127 + j; s[jj] = -INFINITY;
        if (kp >= 0) { const v4u* kr = (const v4u*)(proj + (size_t)(tok - 127 + j) * NA + C_AK + kvh * 64); float ss = 0.f, dot = 0.f;
#pragma unroll
            for (int c = 0; c < 8; ++c) { const v4u kv = kr[c];
#pragma unroll
                for (int e = 0; e < 4; ++e) { const float k0 = bflo(kv[e]), k1 = bfhi(kv[e]); ss += k0 * k0 + k1 * k1; dot += sq[w][8 * c + 2 * e] * k0 + sq[w][8 * c + 2 * e + 1] * k1; } }
            s[jj] = dot * rsqrtf(ss * (1.f / 64.f) + 1e-6f); } }
    const float sink = sinks[qh]; const float mx = fmaxf(wave_max(fmaxf(s[0], s[1])), sink);
    const float p0 = __expf(s[0] - mx), p1 = __expf(s[1] - mx);
    const float den = wave_sum(p0 + p1) + __expf(sink - mx);
    sp[w][lane] = p0 / den; sp[w][lane + 64] = p1 / den;
    __syncthreads();
    float o = 0.f; const int j0 = (t >= 127) ? 0 : 127 - t;
    for (int j = j0; j < 128; ++j) o += sp[w][j] * bf2f(proj[(size_t)(tok - 127 + j) * NA + C_AV + kvh * 64 + lane]);
    mixo[(size_t)tok * NMIX + qh * 64 + lane] = (bf16)f2bf(o);
}
__global__ void __launch_bounds__(256) k_ret_naive(Params P) {
    __shared__ float sq[32][64], sk[32][64], sv[32][64], so[32][64];
    const int tid = threadIdx.x, b = blockIdx.x >> 3, h = blockIdx.x & 7;
    const bf16* proj = (const bf16*)(P.ws + WS_BIG); bf16* mixo = (bf16*)(P.ws + WS_MIXO); const float* rope = (const float*)(P.ws + WS_ROPE);
    const float gamma = 1.0f - exp2f(-5.0f - (float)h);
    const int e = tid >> 2, dq = tid & 3;
    float R[16];
#pragma unroll
    for (int i = 0; i < 16; ++i) R[i] = 0.f;
    for (int t0 = 0; t0 < T; t0 += 32) {
        __syncthreads();
        for (int idx = tid; idx < 32 * 32; idx += 256) { const int tt = idx >> 5, j = idx & 31, pos = t0 + tt; const size_t row = (size_t)(b * T + pos) * NA;
            const float cs = rope[(pos * 32 + j) * 2], sn = rope[(pos * 32 + j) * 2 + 1];
            const float q1 = bf2f(proj[row + C_RQ + h * 64 + j]), q2 = bf2f(proj[row + C_RQ + h * 64 + 32 + j]);
            const float k1 = bf2f(proj[row + C_RK + h * 64 + j]), k2 = bf2f(proj[row + C_RK + h * 64 + 32 + j]);
            sq[tt][j] = q1 * cs - q2 * sn; sq[tt][j + 32] = q2 * cs + q1 * sn;
            sk[tt][j] = (k1 * cs - k2 * sn) * 0.125f; sk[tt][j + 32] = (k2 * cs + k1 * sn) * 0.125f; }
        for (int idx = tid; idx < 32 * 64; idx += 256) { const int tt = idx >> 6, c = idx & 63; sv[tt][c] = bf2f(proj[(size_t)(b * T + t0 + tt) * NA + C_RV + h * 64 + c]); }
        __syncthreads();
        for (int tt = 0; tt < 32; ++tt) { const float ve = sv[tt][e]; float o = 0.f;
#pragma unroll
            for (int i = 0; i < 16; ++i) { const int d = dq * 16 + i; R[i] = gamma * R[i] + sk[tt][d] * ve; o += sq[tt][d] * R[i]; }
            o += __shfl_xor(o, 1); o += __shfl_xor(o, 2);
            if (dq == 0) so[tt][e] = o; }
        __syncthreads();
        { const int tt = tid >> 3, e0 = (tid & 7) * 8; float ss = 0.f;
#pragma unroll
          for (int i = 0; i < 8; ++i) ss += so[tt][e0 + i] * so[tt][e0 + i];
          ss += __shfl_xor(ss, 1); ss += __shfl_xor(ss, 2); ss += __shfl_xor(ss, 4);
          const float rstd = rsqrtf(ss * (1.f / 64.f) + 1e-6f); const size_t row = (size_t)(b * T + t0 + tt);
#pragma unroll
          for (int i = 0; i < 8; ++i) { const float g = bf2f(proj[row * NA + C_RG + h * 64 + e0 + i]); mixo[row * NMIX + 1024 + h * 64 + e0 + i] = (bf16)f2bf(so[tt][e0 + i] * rstd * g / (1.0f + __expf(-g))); } }
    }
}
constexpr int RW_TT = 16;
constexpr int RW_LDS = (64 * 64 * 2 + 128 * 64) * 4 + RW_TT * (64 * 10 + 128) * 4 + RW_TT * 4;
__global__ void __launch_bounds__(256) k_rwkv_naive(Params P) {
    extern __shared__ __attribute__((aligned(16))) unsigned char dyn[];
    float* W2s = (float*)dyn; float* A2s = W2s + 64 * 64; float* G2s = A2s + 64 * 64;
    float* zr = G2s + 128 * 64; float* zk = zr + RW_TT * 64; float* zv = zk + RW_TT * 64; float* zwd = zv + RW_TT * 64; float* zad = zwd + RW_TT * 64;
    float* zgd = zad + RW_TT * 64; float* dec = zgd + RW_TT * 128; float* av = dec + RW_TT * 64; float* bv = av + RW_TT * 64; float* gg = bv + RW_TT * 64; float* ys = gg + RW_TT * 64; float* bs = ys + RW_TT * 64;
    const int tid = threadIdx.x, lane = tid & 63, b = blockIdx.x >> 3, h = blockIdx.x & 7, l = P.layer;
    const bf16* proj = (const bf16*)(P.ws + WS_BIG); bf16* mixo = (bf16*)(P.ws + WS_MIXO);
    const float* mu = P.in[I_MU] + l * RWC; const float* w0 = P.in[I_W0] + l * 512 + h * 64; const float* a0 = P.in[I_A0] + l * 512 + h * 64;
    const float* kkw = P.in[I_KK] + l * 512 + h * 64; const float* kaw = P.in[I_KA] + l * 512 + h * 64; const float* rkw = P.in[I_RK] + l * 512 + h * 64;
    const float* lng = P.in[I_LNG] + l * 512 + h * 64; const float* lnb = P.in[I_LNB] + l * 512 + h * 64;
    for (int i = tid; i < 64 * 64; i += 256) { const int c = i >> 6, j = i & 63; W2s[i] = P.in[I_W2][(size_t)l * 64 * 512 + c * 512 + h * 64 + j]; A2s[i] = P.in[I_A2][(size_t)l * 64 * 512 + c * 512 + h * 64 + j]; }
    for (int i = tid; i < 128 * 64; i += 256) { const int c = i >> 6, j = i & 63; G2s[i] = P.in[I_G2][(size_t)l * 128 * 512 + c * 512 + h * 64 + j]; }
    const int v_ = tid >> 2, kq = tid & 3;
    float S[16];
#pragma unroll
    for (int i = 0; i < 16; ++i) S[i] = 0.f;
    for (int t0 = 0; t0 < T; t0 += RW_TT) {
        __syncthreads();
        for (int idx = tid; idx < RW_TT * 448; idx += 256) { const int tt = idx / 448, c = idx % 448, t = t0 + tt;
            int col; if (c < 192) col = (c >> 6) * 512 + h * 64 + (c & 63); else col = 1536 + (c - 192);
            const size_t row = (size_t)(b * T + t) * NA + C_RW + col;
            const float hc = bf2f(proj[row]), hp = t > 0 ? bf2f(proj[row - NA]) : 0.f; const float z = hc + mu[col] * (hp - hc);
            if (c < 64) zr[tt * 64 + c] = z; else if (c < 128) zk[tt * 64 + c - 64] = z; else if (c < 192) zv[tt * 64 + c - 128] = z;
            else if (c < 256) zwd[tt * 64 + c - 192] = tanhf(z); else if (c < 320) zad[tt * 64 + c - 256] = z; else zgd[tt * 128 + c - 320] = sigmoidf_(z); }
        __syncthreads();
        for (int i = 0; i < RW_TT / 4; ++i) { const int tt = (tid >> 6) + 4 * i, j = lane;
            float wl = w0[j], al = a0[j], gl = 0.f;
            for (int c = 0; c < 64; ++c) { wl += zwd[tt * 64 + c] * W2s[c * 64 + j]; al += zad[tt * 64 + c] * A2s[c * 64 + j]; }
            for (int c = 0; c < 128; ++c) gl += zgd[tt * 128 + c] * G2s[c * 64 + j];
            const float x = -wl; const float sp = fmaxf(x, 0.f) + log1pf(__expf(-fabsf(x)));
            const float wlog = -sp - 0.5f; const float dcy = __expf(-__expf(wlog));
            const float a = sigmoidf_(al);
            const float kraw = zk[tt * 64 + j]; const float kk0 = kraw * kkw[j]; const float nrm = sqrtf(wave_sum(kk0 * kk0)); const float kk = kk0 / fmaxf(nrm, 1e-12f);
            const float kmod = kraw * (1.0f + (a - 1.0f) * kaw[j]); const float r = zr[tt * 64 + j];
            const float bsum = wave_sum(r * kmod * rkw[j]);
            __syncthreads();
            dec[tt * 64 + j] = dcy; av[tt * 64 + j] = -kk; bv[tt * 64 + j] = kk * a; zk[tt * 64 + j] = kmod; gg[tt * 64 + j] = gl; if (j == 0) bs[tt] = bsum; }
        __syncthreads();
        for (int tt = 0; tt < RW_TT; ++tt) { float sa = 0.f;
#pragma unroll
            for (int i = 0; i < 16; ++i) sa += S[i] * av[tt * 64 + kq * 16 + i];
            sa += __shfl_xor(sa, 1); sa += __shfl_xor(sa, 2);
            const float vv = zv[tt * 64 + v_]; float y = 0.f;
#pragma unroll
            for (int i = 0; i < 16; ++i) { const int k = kq * 16 + i; S[i] = S[i] * dec[tt * 64 + k] + sa * bv[tt * 64 + k] + vv * zk[tt * 64 + k]; y += S[i] * zr[tt * 64 + k]; }
            y += __shfl_xor(y, 1); y += __shfl_xor(y, 2);
            if (kq == 0) ys[tt * 64 + v_] = y; }
        __syncthreads();
        { const int tt = tid >> 4, v0 = (tid & 15) * 4; float s = 0.f;
#pragma unroll
          for (int i = 0; i < 4; ++i) s += ys[tt * 64 + v0 + i];
          s += __shfl_xor(s, 1); s += __shfl_xor(s, 2); s += __shfl_xor(s, 4); s += __shfl_xor(s, 8);
          const float mean = s * (1.f / 64.f); float q = 0.f;
#pragma unroll
          for (int i = 0; i < 4; ++i) { const float d = ys[tt * 64 + v0 + i] - mean; q += d * d; }
          q += __shfl_xor(q, 1); q += __shfl_xor(q, 2); q += __shfl_xor(q, 4); q += __shfl_xor(q, 8);
          const float rstd = rsqrtf(q * (1.f / 64.f) + 64e-5f); const size_t row = (size_t)(b * T + t0 + tt);
#pragma unroll
          for (int i = 0; i < 4; ++i) { const int v = v0 + i; const float yn = (ys[tt * 64 + v] - mean) * rstd * lng[v] + lnb[v];
              mixo[row * NMIX + 512 + h * 64 + v] = (bf16)f2bf((yn + bs[tt] * zv[tt * 64 + v]) * gg[tt * 64 + v]); } }
    }
}

__global__ void __launch_bounds__(512, 2) k_pre(Params P) {
    const int G = gridDim.x, bx = blockIdx.x, vcu = (G % 8 == 0) ? (bx % 8) * (G / 8) + bx / 8 : bx;
    phase_x0(P, vcu, G);
}
__global__ void __launch_bounds__(512, 2) k_wconv(Params P) {
    extern __shared__ __attribute__((aligned(16))) unsigned char lds[];
    const int G = gridDim.x, bx = blockIdx.x, vcu = (G % 8 == 0) ? (bx % 8) * (G / 8) + bx / 8 : bx;
    phase_wconv(P, P.layer, (LAS unsigned char*)lds, vcu, G);
}
template <int PH> __device__ __forceinline__ void gemm_phase_of(const Params& P, LAS unsigned char* lds, int G, int c) {
    unsigned char* ws = P.ws; const pg8::bf16_t* xb = (const pg8::bf16_t*)(ws + WS_XB); float* rss = (float*)(ws + WS_RSS);
    pg8::StaticOrder S;
    if constexpr (PH == 0) { pg8::Gemm g{xb, (const pg8::bf16_t*)(ws + WS_WIN), M, NA, D}; S.init(M, NA, G, c); pg8::EpiRowScale E{(pg8::bf16_t*)(ws + WS_BIG), NA, rss};
        pg8::gemm_phase<pg8::EpiRowScale, pg8::StaticOrder, true, true>(lds, g, S, E); }
    if constexpr (PH == 1) { pg8::Gemm g{xb, (const pg8::bf16_t*)(ws + WS_WIN) + (size_t)NA * D, M, NG, D}; S.init(M, NG, G, c); pg8::EpiRowScale E{(pg8::bf16_t*)(ws + WS_BIG), NG, rss};
        pg8::gemm_phase<pg8::EpiRowScale, pg8::StaticOrder, true, true>(lds, g, S, E); }
    if constexpr (PH == 2) { pg8::Gemm g{(const pg8::bf16_t*)(ws + WS_MIXO), (const pg8::bf16_t*)(ws + WS_WMIX), M, D, NMIX}; S.init(M, D, G, c); pg8::EpiGateMix E{(const pg8::bf16_t*)(ws + WS_BIG), (pg8::bf16_t*)(ws + WS_MIXED)};
        pg8::gemm_phase<pg8::EpiGateMix, pg8::StaticOrder, true, true>(lds, g, S, E); }
    if constexpr (PH == 3) { pg8::Gemm g{(const pg8::bf16_t*)(ws + WS_MIXED), (const pg8::bf16_t*)(ws + WS_WOUT), M, D, D}; S.init(M, D, G, c); pg8::EpiResid E{P.out, (pg8::bf16_t*)(ws + WS_XB), rss};
        pg8::gemm_phase<pg8::EpiResid, pg8::StaticOrder, true, true>(lds, g, S, E); }
    if constexpr (PH == 4) { pg8::Gemm g{xb, (const pg8::bf16_t*)(ws + WS_WGU), M, FF2, D}; S.init(M, FF2, G, c); pg8::EpiSwiglu E{(pg8::bf16_t*)(ws + WS_BIG), FF, rss};
        pg8::gemm_phase<pg8::EpiSwiglu, pg8::StaticOrder, true, true>(lds, g, S, E); }
    if constexpr (PH == 5) { pg8::Gemm g{(const pg8::bf16_t*)(ws + WS_BIG), (const pg8::bf16_t*)(ws + WS_WDN), M, D, FF}; S.init(M, D, G, c); pg8::EpiResid E{P.out, (pg8::bf16_t*)(ws + WS_XB), rss};
        pg8::gemm_phase<pg8::EpiResid, pg8::StaticOrder, true, true>(lds, g, S, E); }
}
template <int PH> __global__ void __launch_bounds__(512, 2) k_gemm(Params P) {
    extern __shared__ __attribute__((aligned(16))) unsigned char lds[];
    gemm_phase_of<PH>(P, (LAS unsigned char*)lds, (int)gridDim.x, (int)blockIdx.x);
}

template <int PH> static void launch_gemm(const Params& p, int grid, hipStream_t stream) {
    static bool attr = false; if (!attr) { (void)hipFuncSetAttribute((const void*)k_gemm<PH>, hipFuncAttributeMaxDynamicSharedMemorySize, LDS_BYTES); attr = true; }
    hipLaunchKernelGGL(k_gemm<PH>, dim3(grid), dim3(512), LDS_BYTES, stream, p);
}
extern "C" void kernel_launch(void* const* d_in, const int* in_sizes, int n_in, void* d_out, int out_size, void* d_ws, size_t ws_size, hipStream_t stream) {
    static int grid = 0;
    if (grid == 0) {
        if (n_in != 25 || out_size != M * D || ws_size < WS_END) { fprintf(stderr, "kernel_launch: unexpected shapes (n_in %d, out %d, ws %zu)\n", n_in, out_size, ws_size); grid = -1; return; }
        int dev = 0, cus = 0; if (hipGetDevice(&dev) != hipSuccess || hipDeviceGetAttribute(&cus, hipDeviceAttributeMultiprocessorCount, dev) != hipSuccess) { grid = -1; return; }
        (void)hipFuncSetAttribute((const void*)k_wconv, hipFuncAttributeMaxDynamicSharedMemorySize, LDS_BYTES);
        (void)hipFuncSetAttribute((const void*)k_rwkv_naive, hipFuncAttributeMaxDynamicSharedMemorySize, RW_LDS);
        grid = cus;
    }
    if (grid < 0) return;
    Params p; memset(&p, 0, sizeof(p));
    for (int i = 0; i < 25; ++i) p.in[i] = (const float*)d_in[i];
    p.out = (float*)d_out; p.ws = (unsigned char*)d_ws;
    (void)hipMemsetAsync((char*)d_ws + WS_CTL, 0, CTL_BYTES, stream);
    hipLaunchKernelGGL(k_pre, dim3(grid), dim3(512), 0, stream, p);
    for (int l = 0; l < DEPTH; ++l) {
        p.layer = l;
        hipLaunchKernelGGL(k_wconv, dim3(grid), dim3(512), LDS_BYTES, stream, p);
        launch_gemm<0>(p, grid, stream);
        hipLaunchKernelGGL(k_attn_naive, dim3(M * 8 / 4), dim3(256), 0, stream, p);
        hipLaunchKernelGGL(k_ret_naive, dim3(BATCH * 8), dim3(256), 0, stream, p);
        hipLaunchKernelGGL(k_rwkv_naive, dim3(BATCH * 8), dim3(256), RW_LDS, stream, p);
        launch_gemm<1>(p, grid, stream);
        launch_gemm<2>(p, grid, stream);
        launch_gemm<3>(p, grid, stream);
        launch_gemm<4>(p, grid, stream);
        launch_gemm<5>(p, grid, stream);
    }
}
```

```cpp
#include <hip/hip_runtime.h>
#include <cstdio>
#include <cstdint>
#include <cstring>

constexpr int D = 1024, BATCH = 16, T = 2048, DEPTH = 4, M = BATCH * T;
constexpr int HD = 64;
constexpr int NA = 4608;
constexpr int NG = 3072;
constexpr int INW = NA + NG;
constexpr int C_AQ = 0, C_AK = 512, C_AV = 640, C_RW = 768, C_RQ = 2560, C_RK = 3072, C_RV = 3584, C_RG = 4096;
constexpr int RWC = 1792;
constexpr int FF = 2816, FF2 = 2 * FF;
constexpr int NMIX = 1536;

constexpr size_t MiB = 1u << 20;
constexpr size_t WS_CTL = 0, CTL_BYTES = 1 * MiB;
constexpr size_t WS_WIN = 1 * MiB;
constexpr size_t WS_WMIX = WS_WIN + (size_t)INW * D * 2;
constexpr size_t WS_WOUT = WS_WMIX + (size_t)D * NMIX * 2;
constexpr size_t WS_WGU = WS_WOUT + (size_t)D * D * 2;
constexpr size_t WS_WDN = WS_WGU + (size_t)FF2 * D * 2;
constexpr size_t WS_XB = 38 * MiB;
constexpr size_t WS_MIXO = 102 * MiB;
constexpr size_t WS_BIG = 198 * MiB;
constexpr size_t WS_MIXED = WS_BIG + 192 * MiB;
constexpr size_t WS_RSS = 486 * MiB;
constexpr size_t WS_ROPE = 488 * MiB;
constexpr size_t WS_END = 489 * MiB;
static_assert(WS_WDN + (size_t)D * FF * 2 <= WS_XB, "weights fit");
static_assert(WS_BIG + (size_t)M * NA * 2 <= WS_RSS, "big region fits");

#define GAS __attribute__((address_space(1)))
#define LAS __attribute__((address_space(3)))
typedef unsigned short bf16;
typedef unsigned v4u __attribute__((ext_vector_type(4)));
typedef unsigned v2u __attribute__((ext_vector_type(2)));
typedef float v4f __attribute__((ext_vector_type(4)));
__device__ __forceinline__ unsigned f2bf(float f) { unsigned u = __builtin_bit_cast(unsigned, f); return (u + 0x7fffu + ((u >> 16) & 1u)) >> 16; }
__device__ __forceinline__ unsigned pk2(float lo, float hi) { return f2bf(lo) | (f2bf(hi) << 16); }
__device__ __forceinline__ float bf2f(unsigned short b) { return __builtin_bit_cast(float, (unsigned)b << 16); }
__device__ __forceinline__ float bflo(unsigned w) { return __builtin_bit_cast(float, w << 16); }
__device__ __forceinline__ float bfhi(unsigned w) { return __builtin_bit_cast(float, w & 0xffff0000u); }
__device__ __forceinline__ float wave_sum(float v) {
#pragma unroll
    for (int o = 1; o < 64; o <<= 1) v += __shfl_xor(v, o);
    return v;
}
__device__ __forceinline__ float wave_max(float v) {
#pragma unroll
    for (int o = 1; o < 64; o <<= 1) v = fmaxf(v, __shfl_xor(v, o));
    return v;
}
__device__ __forceinline__ float sigmoidf_(float x) { return 1.f / (1.f + __expf(-x)); }

__device__ __forceinline__ int otid() { int t = threadIdx.x; asm volatile("" : "+v"(t)); return t; }

struct Params {
    const float* in[25];
    float* out;
    unsigned char* ws;
    int layer; int pad;
};
enum { I_X = 0, I_N1G, I_WIN, I_QNG, I_KNG, I_SINK, I_WAO, I_MU, I_W0, I_W2, I_A0, I_A2, I_G2, I_KK, I_KA, I_RK, I_LNG, I_LNB, I_WRO, I_WTO, I_WOUT, I_N2G, I_WG, I_WU, I_WD };


namespace pg8 {
#define PG8_LAS __attribute__((address_space(3)))
typedef unsigned short bf16_t;
typedef short bf16x8 __attribute__((ext_vector_type(8)));
typedef float f32x4 __attribute__((ext_vector_type(4)));
typedef unsigned u32x4 __attribute__((ext_vector_type(4)));
constexpr int BM = 256, BK = 64, HALF = 128, HTB = HALF * BK * 2  , STAGE_BYTES = 8 * HTB, NXCD = 8, WGM = 8;

__host__ __device__ __forceinline__ int lds_byte(int r, int c) { const int st = (r >> 4) * 2 + (c >> 5), rr = r & 15, cc = c & 31, ob = rr * 64 + cc * 2; return st * 1024 + (ob ^ (((ob >> 9) & 1) << 5)); }
__host__ __device__ __forceinline__ void stage_rc(int b, int& R, int& C) { const int st = b / 1024, sb = b % 1024, swz = sb ^ (((sb >> 9) & 1) << 5); R = (st >> 1) * 16 + swz / 64; C = (st & 1) * 32 + (swz % 64) / 2; }
__host__ __device__ __forceinline__ int perm32(int rho) { const int n = rho >> 4, i = rho & 15; return 8 * (i >> 2) + 4 * n + (i & 3); }

struct Unit { int pm, pn; };
struct Gemm { const bf16_t* A; const bf16_t* Bt; int M, N, K; };

struct StaticOrder {
    int nM, nN, nwg, G, c;
    __host__ __device__ void init(int M, int N, int G_, int c_) { nM = M / BM; nN = N / BM; nwg = nM * nN; G = G_; c = c_; }
    __host__ __device__ bool next(int i, Unit& u) const {
        const long L = (long)i * G + c; if (L >= nwg) return false;
        int wgid = (int)L; { const int q = nwg / NXCD, r = nwg % NXCD, xcd = wgid % NXCD, off = wgid / NXCD; wgid = (xcd < r ? xcd * (q + 1) : r * (q + 1) + (xcd - r) * q) + off; }
        const int nig = WGM * nN, gid = wgid / nig, fm = gid * WGM, gsz = (nM - fm) < WGM ? (nM - fm) : WGM;
        u.pm = fm + ((wgid % nig) % gsz); u.pn = (wgid % nig) / gsz; return true;
    }
    __device__ __forceinline__ void a_ready(const Unit&) const {}
    __device__ __forceinline__ void done(const Unit&) const {}
};


__device__ __forceinline__ unsigned cvt_pk_bf16(float lo, float hi) { unsigned r; asm volatile("v_cvt_pk_bf16_f32 %0, %1, %2" : "=v"(r) : "v"(lo), "v"(hi)); return r; }
__device__ __forceinline__ float clampg(float x) { return __builtin_amdgcn_fmed3f(x, -30.0f, 30.0f); }
__device__ __forceinline__ float row_rstd(const float* rss, int row) {
    const f32x4* p = (const f32x4*)(rss + (size_t)row * 16);
    const f32x4 a = p[0], b = p[1], c = p[2], d = p[3];
    const float s = (((a.x + a.y) + (a.z + a.w)) + ((b.x + b.y) + (b.z + b.w))) + (((c.x + c.y) + (c.z + c.w)) + ((d.x + d.y) + (d.z + d.w)));
    return rsqrtf(s * (1.0f / 1024.0f) + 1e-6f);
}
struct EpiRowScale {
    static constexpr bool PERM = true, AFTER_DRAIN = false; static constexpr int KSEG = 0;
    bf16_t* O; int ldc; const float* rss;
    __device__ __forceinline__ void operator()(const f32x4 (&acc)[2][2][4][2], const Unit& u, int wr, int wc, int fr, int fq) const {
        const int row0 = u.pm * BM + wr * 64 + fr, col0 = u.pn * BM + wc * 32 + 8 * fq;
#pragma unroll
        for (int ai = 0; ai < 2; ++ai)
#pragma unroll
            for (int m = 0; m < 4; ++m) { const int row = row0 + ai * HALF + m * 16; const float rs = row_rstd(rss, row); bf16_t* rowp = O + (size_t)row * ldc + col0;
#pragma unroll
                for (int bj = 0; bj < 2; ++bj) { const f32x4 v0 = acc[ai][bj][m][0] * rs, v1 = acc[ai][bj][m][1] * rs;
                    u32x4 w; w.x = cvt_pk_bf16(v0[0], v0[1]); w.y = cvt_pk_bf16(v0[2], v0[3]); w.z = cvt_pk_bf16(v1[0], v1[1]); w.w = cvt_pk_bf16(v1[2], v1[3]);
                    *(u32x4*)(rowp + bj * HALF) = w; } }
    }
};
struct EpiSwiglu {
    static constexpr bool PERM = true, AFTER_DRAIN = false; static constexpr int KSEG = 0;
    bf16_t* O; int ldc; const float* rss;
    __device__ __forceinline__ void operator()(const f32x4 (&acc)[2][2][4][2], const Unit& u, int wr, int wc, int fr, int fq) const {
        const int row0 = u.pm * BM + wr * 64 + fr, col0 = u.pn * HALF + wc * 32 + 8 * fq;
#pragma unroll
        for (int ai = 0; ai < 2; ++ai)
#pragma unroll
            for (int m = 0; m < 4; ++m) { const int row = row0 + ai * HALF + m * 16; const float rs = row_rstd(rss, row); bf16_t* rowp = O + (size_t)row * ldc + col0;
                float o[8];
#pragma unroll
                for (int n = 0; n < 2; ++n)
#pragma unroll
                    for (int j = 0; j < 4; ++j) { const float g = acc[ai][0][m][n][j] * rs, up = acc[ai][1][m][n][j] * rs; o[4 * n + j] = g * up * __builtin_amdgcn_rcpf(1.0f + __expf(-g)); }
                u32x4 w; w.x = cvt_pk_bf16(o[0], o[1]); w.y = cvt_pk_bf16(o[2], o[3]); w.z = cvt_pk_bf16(o[4], o[5]); w.w = cvt_pk_bf16(o[6], o[7]);
                *(u32x4*)rowp = w; }
    }
};
struct EpiResid {
    static constexpr bool PERM = false, AFTER_DRAIN = false; static constexpr int KSEG = 0;
    float* X; bf16_t* XB; float* rss;
    __device__ __forceinline__ void operator()(const f32x4 (&acc)[2][2][4][2], const Unit& u, int wr, int wc, int fr, int fq) const {
        const int row0 = u.pm * BM + wr * 64 + fr, col0 = u.pn * BM + wc * 32 + 4 * fq;
#pragma unroll
        for (int ai = 0; ai < 2; ++ai)
#pragma unroll
            for (int m = 0; m < 4; ++m) { const int row = row0 + ai * HALF + m * 16; const size_t off = (size_t)row * 1024 + col0; float ss = 0.f;
#pragma unroll
                for (int bj = 0; bj < 2; ++bj)
#pragma unroll
                    for (int n = 0; n < 2; ++n) { const size_t o2 = off + bj * HALF + n * 16; const f32x4 x = *(const f32x4*)(X + o2) + acc[ai][bj][m][n];
                        *(f32x4*)(X + o2) = x; ss += (x[0] * x[0] + x[1] * x[1]) + (x[2] * x[2] + x[3] * x[3]);
                        unsigned long long w = (unsigned long long)cvt_pk_bf16(x[0], x[1]) | ((unsigned long long)cvt_pk_bf16(x[2], x[3]) << 32);
                        *(unsigned long long*)(XB + o2) = w; }
                ss += __shfl_xor(ss, 16); ss += __shfl_xor(ss, 32);
                if (fq == 0) rss[(size_t)row * 16 + u.pn * 4 + wc] = ss; }
    }
};
struct EpiGateMix {
    static constexpr bool PERM = true, AFTER_DRAIN = false; static constexpr int KSEG = 8;
    const bf16_t* Gt; bf16_t* O;
    __device__ __forceinline__ void seg(f32x4 (&acc)[2][2][4][2], const Unit& u, int s, int wr, int wc, int fr, int fq) const {
        const int row0 = u.pm * BM + wr * 64 + fr, col0 = u.pn * BM + wc * 32 + 8 * fq;
#pragma unroll
        for (int ai = 0; ai < 2; ++ai)
#pragma unroll
            for (int m = 0; m < 4; ++m) { const bf16_t* gp = Gt + (size_t)(row0 + ai * HALF + m * 16) * 3072 + (s - 1) * 1024 + col0;
#pragma unroll
                for (int bj = 0; bj < 2; ++bj) { const u32x4 lo = *(const u32x4*)(gp + bj * HALF), hi = *(const u32x4*)(gp + 1024 + bj * HALF);
#pragma unroll
                    for (int q = 0; q < 4; ++q) { const unsigned wl = lo[q], wh = hi[q];
                        const float l0 = clampg(__builtin_bit_cast(float, wl << 16)), l1 = clampg(__builtin_bit_cast(float, wl & 0xffff0000u)), h0 = clampg(__builtin_bit_cast(float, wh << 16)), h1 = clampg(__builtin_bit_cast(float, wh & 0xffff0000u));
                        const float r0 = (1.0f + __expf(-h0)) * __builtin_amdgcn_rcpf(1.0f + __expf(-l0)), r1 = (1.0f + __expf(-h1)) * __builtin_amdgcn_rcpf(1.0f + __expf(-l1));
                        acc[ai][bj][m][q >> 1][(q & 1) * 2] *= r0; acc[ai][bj][m][q >> 1][(q & 1) * 2 + 1] *= r1; } } }
    }
    __device__ __forceinline__ void operator()(const f32x4 (&acc)[2][2][4][2], const Unit& u, int wr, int wc, int fr, int fq) const {
        const int row0 = u.pm * BM + wr * 64 + fr, col0 = u.pn * BM + wc * 32 + 8 * fq;
#pragma unroll
        for (int ai = 0; ai < 2; ++ai)
#pragma unroll
            for (int m = 0; m < 4; ++m) { const int row = row0 + ai * HALF + m * 16; const bf16_t* gp = Gt + (size_t)row * 3072 + 2048 + col0; bf16_t* rowp = O + (size_t)row * 1024 + col0;
#pragma unroll
                for (int bj = 0; bj < 2; ++bj) { const u32x4 g = *(const u32x4*)(gp + bj * HALF); float o[8];
#pragma unroll
                    for (int q = 0; q < 4; ++q) { const unsigned w = g[q]; const float g0 = clampg(__builtin_bit_cast(float, w << 16)), g1 = clampg(__builtin_bit_cast(float, w & 0xffff0000u));
                        o[2 * q] = acc[ai][bj][m][q >> 1][(q & 1) * 2] * __builtin_amdgcn_rcpf(1.0f + __expf(-g0)); o[2 * q + 1] = acc[ai][bj][m][q >> 1][(q & 1) * 2 + 1] * __builtin_amdgcn_rcpf(1.0f + __expf(-g1)); }
                    u32x4 w; w.x = cvt_pk_bf16(o[0], o[1]); w.y = cvt_pk_bf16(o[2], o[3]); w.z = cvt_pk_bf16(o[4], o[5]); w.w = cvt_pk_bf16(o[6], o[7]);
                    *(u32x4*)(rowp + bj * HALF) = w; } }
    }
};


template <class Epi, class Sched, bool ALIGN_EPI = false, bool SP2 = false>
__device__ __forceinline__ void gemm_phase(PG8_LAS unsigned char* lds, const Gemm g, const Sched& S, const Epi& E) {
    int tid_ = threadIdx.x; asm volatile("" : "+v"(tid_));
    const int tid = tid_, wid = __builtin_amdgcn_readfirstlane(tid >> 6), lane = tid & 63, wr = wid >> 2, wc = wid & 3, fr = lane & 15, fq = lane >> 4;
    const int K = g.K, nt = K / BK;
    unsigned voffA[2], voffB[2];
#pragma unroll
    for (int i = 0; i < 2; ++i) { int R, C; stage_rc(tid * 16 + i * 8192, R, C); const int Rb = Epi::PERM ? ((R & ~31) + perm32(R & 31)) : R;
        voffA[i] = (unsigned)(R * K + C) * 2u; voffB[i] = (unsigned)(Rb * K + C) * 2u; }
    const size_t kstep = (size_t)(BK * 2);
    const size_t hstep = (size_t)HALF * K * 2;
    const size_t tstep = 2 * hstep;
    const unsigned ldsw = (unsigned)wid * 1024u;
    const int aoff = lds_byte(wr * 64 + fr, fq * 8), boff = lds_byte(wc * 32 + fr, fq * 8);
#define PG8_SA(b, h) (((b) * 2 + (h)) * HTB)
#define PG8_SB(b, h) ((4 + (b) * 2 + (h)) * HTB)
#define PG8_STAGE(bufoff, gbase, voff) do { _Pragma("unroll") for (int _i = 0; _i < 2; ++_i) \
        __builtin_amdgcn_global_load_lds((const unsigned*)((const char*)(gbase) + (voff)[_i]), (PG8_LAS unsigned*)(lds + (bufoff) + ldsw + _i * 8192), 16, 0, 0); } while (0)
#define PG8_LDA(dst, b, h) do { _Pragma("unroll") for (int m = 0; m < 4; ++m) _Pragma("unroll") for (int k = 0; k < 2; ++k) dst[m][k] = *(const PG8_LAS bf16x8*)(lds + PG8_SA(b, h) + aoff + m * 2048 + k * 1024); } while (0)
#define PG8_LDB(dst, b, h) do { _Pragma("unroll") for (int n = 0; n < 2; ++n) _Pragma("unroll") for (int k = 0; k < 2; ++k) dst[n][k] = *(const PG8_LAS bf16x8*)(lds + PG8_SB(b, h) + boff + n * 2048 + k * 1024); } while (0)
#define PG8_MMA(ai, bj, At, Bt) do { __builtin_amdgcn_s_setprio(1); _Pragma("unroll") for (int m = 0; m < 4; ++m) _Pragma("unroll") for (int n = 0; n < 2; ++n) _Pragma("unroll") for (int k = 0; k < 2; ++k) \
        acc[ai][bj][m][n] = __builtin_amdgcn_mfma_f32_16x16x32_bf16(Bt[n][k], At[m][k], acc[ai][bj][m][n], 0, 0, 0); __builtin_amdgcn_s_setprio(0); } while (0)
#define PG8_WAIT_V(n) asm volatile("s_waitcnt vmcnt(" #n ")" ::: "memory")
#define PG8_WAIT_L(n) asm volatile("s_waitcnt lgkmcnt(" #n ")" ::: "memory")
#define PG8_BAR __builtin_amdgcn_s_barrier()
#define PG8_SCHED __builtin_amdgcn_sched_barrier(0)
    Unit cur, nxt; int ui = 0;
    if (!S.next(0, cur)) return;
    f32x4 acc[2][2][4][2];
#pragma unroll
    for (int a = 0; a < 2; ++a)
#pragma unroll
        for (int b = 0; b < 2; ++b)
#pragma unroll
            for (int m = 0; m < 4; ++m)
#pragma unroll
                for (int n = 0; n < 2; ++n) acc[a][b][m][n] = (f32x4){0.f, 0.f, 0.f, 0.f};
    bf16x8 At[4][2], B0[2][2], B1[2][2];
    const char* cA = (const char*)g.A + (size_t)cur.pm * tstep; const char* cB = (const char*)g.Bt + (size_t)cur.pn * tstep;
    S.a_ready(cur);
    if constexpr (SP2) {
        PG8_STAGE(PG8_SB(0, 0), cB, voffB); PG8_STAGE(PG8_SB(0, 1), cB + hstep, voffB); PG8_STAGE(PG8_SA(0, 0), cA, voffA); PG8_STAGE(PG8_SA(0, 1), cA + hstep, voffA);
        if (wr == 1) PG8_BAR;
        PG8_WAIT_V(2); PG8_BAR;
        PG8_STAGE(PG8_SB(1, 0), cB + kstep, voffB); PG8_STAGE(PG8_SA(1, 0), cA + kstep, voffA); PG8_STAGE(PG8_SB(1, 1), cB + hstep + kstep, voffB);
        PG8_WAIT_V(6); PG8_BAR;
    } else {
        PG8_STAGE(PG8_SB(0, 0), cB, voffB); PG8_STAGE(PG8_SA(0, 0), cA, voffA); PG8_STAGE(PG8_SB(0, 1), cB + hstep, voffB); PG8_STAGE(PG8_SA(0, 1), cA + hstep, voffA);
        if (wr == 1) PG8_BAR;
        PG8_WAIT_V(4); PG8_BAR;
        PG8_STAGE(PG8_SB(1, 0), cB + kstep, voffB); PG8_STAGE(PG8_SA(1, 0), cA + kstep, voffA); PG8_STAGE(PG8_SB(1, 1), cB + hstep + kstep, voffB);
        PG8_WAIT_V(6); PG8_BAR;
    }
    for (;;) {
        const bool has_next = S.next(ui + 1, nxt);
        const char* nA = has_next ? (const char*)g.A + (size_t)nxt.pm * tstep : cA; const char* nB = has_next ? (const char*)g.Bt + (size_t)nxt.pn * tstep : cB;
        for (int t = 0; t < nt; t += 2) {
            const bool last = (t == nt - 2);
            const char* a1 = cA + (size_t)(t + 1) * kstep;
            const char* a2 = last ? nA : cA + (size_t)(t + 2) * kstep; const char* b2 = last ? nB : cB + (size_t)(t + 2) * kstep;
            const char* a3 = a2 + kstep; const char* b3 = b2 + kstep;
            if (last && has_next) S.a_ready(nxt);
            if constexpr (Epi::KSEG > 0) { if (t != 0 && (t % Epi::KSEG) == 0) E.seg(acc, cur, t / Epi::KSEG, wr, wc, fr, fq); }
            if constexpr (SP2) {
            PG8_LDB(B0, 0, 0); PG8_LDB(B1, 0, 1); PG8_SCHED; PG8_LDA(At, 0, 0); PG8_STAGE(PG8_SA(1, 1), a1 + hstep, voffA);
            PG8_WAIT_V(8); PG8_WAIT_L(0); PG8_BAR; PG8_MMA(0, 0, At, B0); PG8_MMA(0, 1, At, B1); PG8_BAR; PG8_SCHED;
            PG8_LDA(At, 0, 1); PG8_STAGE(PG8_SB(0, 0), b2, voffB); PG8_STAGE(PG8_SB(0, 1), b2 + hstep, voffB); PG8_STAGE(PG8_SA(0, 0), a2, voffA);
            PG8_WAIT_V(8); PG8_WAIT_L(0); PG8_BAR; PG8_MMA(1, 0, At, B0); PG8_MMA(1, 1, At, B1); PG8_BAR; PG8_SCHED;
            PG8_LDB(B0, 1, 0); PG8_LDB(B1, 1, 1); PG8_SCHED; PG8_LDA(At, 1, 0); PG8_STAGE(PG8_SA(0, 1), a2 + hstep, voffA);
            PG8_WAIT_V(8); PG8_WAIT_L(0); PG8_BAR; PG8_MMA(0, 0, At, B0); PG8_MMA(0, 1, At, B1); PG8_BAR; PG8_SCHED;
            PG8_LDA(At, 1, 1); PG8_STAGE(PG8_SB(1, 0), b3, voffB); PG8_STAGE(PG8_SB(1, 1), b3 + hstep, voffB); PG8_STAGE(PG8_SA(1, 0), a3, voffA);
            PG8_WAIT_V(8); PG8_WAIT_L(0); PG8_BAR; PG8_MMA(1, 0, At, B0); PG8_MMA(1, 1, At, B1); PG8_BAR; PG8_SCHED;
            } else {
            PG8_LDB(B0, 0, 0); PG8_SCHED; PG8_LDA(At, 0, 0); PG8_STAGE(PG8_SA(1, 1), a1 + hstep, voffA);
            PG8_WAIT_L(8); PG8_BAR; PG8_WAIT_L(0); PG8_MMA(0, 0, At, B0); PG8_BAR; PG8_SCHED;
            PG8_LDB(B1, 0, 1); PG8_STAGE(PG8_SB(0, 0), b2, voffB);
            PG8_BAR; PG8_WAIT_L(0); PG8_MMA(0, 1, At, B1); PG8_BAR;
            PG8_LDA(At, 0, 1); PG8_STAGE(PG8_SA(0, 0), a2, voffA);
            PG8_BAR; PG8_WAIT_L(0); PG8_MMA(1, 0, At, B0); PG8_BAR; PG8_SCHED;
            PG8_STAGE(PG8_SB(0, 1), b2 + hstep, voffB);
            PG8_WAIT_V(6); PG8_BAR; PG8_MMA(1, 1, At, B1); PG8_BAR;
            PG8_LDB(B0, 1, 0); PG8_SCHED; PG8_LDA(At, 1, 0); PG8_STAGE(PG8_SA(0, 1), a2 + hstep, voffA);
            PG8_WAIT_L(8); PG8_BAR; PG8_WAIT_L(0); PG8_MMA(0, 0, At, B0); PG8_BAR; PG8_SCHED;
            PG8_LDB(B1, 1, 1); PG8_STAGE(PG8_SB(1, 0), b3, voffB);
            PG8_BAR; PG8_WAIT_L(0); PG8_MMA(0, 1, At, B1); PG8_BAR;
            PG8_LDA(At, 1, 1); PG8_STAGE(PG8_SA(1, 0), a3, voffA);
            PG8_BAR; PG8_WAIT_L(0); PG8_MMA(1, 0, At, B0); PG8_BAR; PG8_SCHED;
            PG8_STAGE(PG8_SB(1, 1), b3 + hstep, voffB);
            PG8_WAIT_V(6); PG8_BAR; PG8_MMA(1, 1, At, B1); PG8_BAR;
            }
        }
        if constexpr (ALIGN_EPI) { if (wr == 0) PG8_BAR; }
        if constexpr (!Epi::AFTER_DRAIN) { E(acc, cur, wr, wc, fr, fq); S.done(cur); }
        if (!has_next) break;
#pragma unroll
        for (int a = 0; a < 2; ++a)
#pragma unroll
            for (int b = 0; b < 2; ++b)
#pragma unroll
                for (int m = 0; m < 4; ++m)
#pragma unroll
                    for (int n = 0; n < 2; ++n) acc[a][b][m][n] = (f32x4){0.f, 0.f, 0.f, 0.f};
        cur = nxt; cA = nA; cB = nB; ++ui;
        if constexpr (ALIGN_EPI) { if (wr == 1) PG8_BAR; }
    }
    PG8_WAIT_V(0);
    if constexpr (!ALIGN_EPI) { if (wr == 0) PG8_BAR; }
    PG8_BAR;
    if constexpr (Epi::AFTER_DRAIN) { E.fused(acc, cur, wr, wc, fr, fq, lds, wid, lane); S.done(cur); }
#undef PG8_SA
#undef PG8_SB
#undef PG8_STAGE
#undef PG8_LDA
#undef PG8_LDB
#undef PG8_MMA
#undef PG8_WAIT_V
#undef PG8_WAIT_L
#undef PG8_BAR
#undef PG8_SCHED
}
}


#define LDS_WAIT() asm volatile("s_waitcnt lgkmcnt(0)" ::: "memory")
constexpr int NWAVES = 8;
constexpr int LDS_BYTES = 147456;

__device__ __forceinline__ void tr_item(const float* W, int ldw, int k0, int n0, const float* scale, bf16* WT, int ldt, int drow0, int dcol0, LAS float* scr, int lane) {
    const int otid_ = otid();
#pragma unroll 8
    for (int i = 0; i < 32; ++i) { const int kk = 2 * i + (lane >> 5); float v = W[(size_t)(k0 + kk) * ldw + n0 + (lane & 31)]; if (scale) v *= scale[k0 + kk]; scr[kk * 33 + (lane & 31)] = v; }
    LDS_WAIT(); asm volatile("" ::: "memory");
    const int c = lane & 7;
#pragma unroll
    for (int j = 0; j < 4; ++j) { const int n = (lane >> 3) + 8 * j; const LAS float* s = scr + (8 * c) * 33 + n;
        v4u o; o.x = pk2(s[0 * 33], s[1 * 33]); o.y = pk2(s[2 * 33], s[3 * 33]); o.z = pk2(s[4 * 33], s[5 * 33]); o.w = pk2(s[6 * 33], s[7 * 33]);
        *(v4u*)(WT + (size_t)(drow0 + n) * ldt + dcol0 + 8 * c) = o; }
    LDS_WAIT(); asm volatile("" ::: "memory");
}
constexpr int WI_IN = 16 * 240, WI_MIX = 3 * 8 * 32, WI_OUT = 16 * 32, WI_G = 16 * 88, WI_DN = 44 * 32;
constexpr int WI_TOTAL = WI_IN + WI_MIX + WI_OUT + 2 * WI_G + WI_DN;
__device__ __forceinline__ void wconv_item(const Params& P, int l, int it, LAS float* scr, int lane) {
    const int otid_ = otid();
    unsigned char* ws = P.ws;
    if (it < WI_IN) { const int kb = it / 240, nb = it % 240; tr_item(P.in[I_WIN] + (size_t)l * D * INW, INW, 64 * kb, 32 * nb, P.in[I_N1G] + l * D, (bf16*)(ws + WS_WIN), D, 32 * nb, 64 * kb, scr, lane); return; }
    it -= WI_IN;
    if (it < WI_MIX) { const int br = it / 256, r = it % 256, kb = r / 32, nb = r % 32; const float* W = P.in[br == 0 ? I_WAO : (br == 1 ? I_WRO : I_WTO)] + (size_t)l * 512 * D;
        tr_item(W, D, 64 * kb, 32 * nb, nullptr, (bf16*)(ws + WS_WMIX), NMIX, 32 * nb, br * 512 + 64 * kb, scr, lane); return; }
    it -= WI_MIX;
    if (it < WI_OUT) { const int kb = it / 32, nb = it % 32; tr_item(P.in[I_WOUT] + (size_t)l * D * D, D, 64 * kb, 32 * nb, nullptr, (bf16*)(ws + WS_WOUT), D, 32 * nb, 64 * kb, scr, lane); return; }
    it -= WI_OUT;
    if (it < 2 * WI_G) { const int up = it / WI_G, r = it % WI_G, kb = r / 88, nb = r % 88, n0 = 32 * nb;
        tr_item(P.in[up ? I_WU : I_WG] + (size_t)l * D * FF, FF, 64 * kb, n0, P.in[I_N2G] + l * D, (bf16*)(ws + WS_WGU), D, (n0 / 128) * 256 + up * 128 + (n0 % 128), 64 * kb, scr, lane); return; }
    it -= 2 * WI_G;
    { const int kb = it / 32, nb = it % 32; tr_item(P.in[I_WD] + (size_t)l * FF * D, D, 64 * kb, 32 * nb, nullptr, (bf16*)(ws + WS_WDN), FF, 32 * nb, 64 * kb, scr, lane); }
}
__device__ __forceinline__ void phase_wconv(const Params& P, int l, LAS unsigned char* lds, int vcu, int G) {
    const int otid_ = otid();
    const int wave = __builtin_amdgcn_readfirstlane(otid_ >> 6), lane = otid_ & 63;
    LAS float* scr = (LAS float*)(lds + wave * 16384);
    for (int it = vcu * NWAVES + wave; it < WI_TOTAL; it += G * NWAVES) wconv_item(P, l, it, scr, lane);
}
__device__ __forceinline__ void phase_x0(const Params& P, int vcu, int G) {
    const int otid_ = otid();
    const int wave = __builtin_amdgcn_readfirstlane(otid_ >> 6), lane = otid_ & 63;
    const float* x = P.in[I_X]; float* out = P.out; bf16* xb = (bf16*)(P.ws + WS_XB); float* rss = (float*)(P.ws + WS_RSS);
    for (int m = vcu * NWAVES + wave; m < M; m += G * NWAVES) {
        const v4f* xr = (const v4f*)(x + (size_t)m * D) + lane; v4f* orow = (v4f*)(out + (size_t)m * D) + lane; unsigned long long* o8 = (unsigned long long*)(xb + (size_t)m * D) + lane;
        v4f v[4]; float s = 0.f;
#pragma unroll
        for (int j = 0; j < 4; ++j) { v[j] = xr[64 * j]; s += (v[j].x * v[j].x + v[j].y * v[j].y) + (v[j].z * v[j].z + v[j].w * v[j].w); }
        s = wave_sum(s);
#pragma unroll
        for (int j = 0; j < 4; ++j) { orow[64 * j] = v[j]; o8[64 * j] = (unsigned long long)pk2(v[j].x, v[j].y) | ((unsigned long long)pk2(v[j].z, v[j].w) << 32); }
        if (lane < 16) rss[(size_t)m * 16 + lane] = lane == 0 ? s : 0.f;
    }
    float* rope = (float*)(P.ws + WS_ROPE);
    for (int i = (vcu * NWAVES + wave) * 64 + lane; i < T * 32; i += G * NWAVES * 64) {
        const int t = i >> 5, j = i & 31; const float inv_freq = (float)exp(-((double)j / 32.0) * 9.210340371976184); const float ang = (float)t * inv_freq;
        const double xa = (double)ang, qd = rint(xa * 0.6366197723675814), fd = xa - qd * 1.5707963267948966; const int qi = (int)qd & 3;
        const float ff = (float)fd, f2 = ff * ff;
        const float sf = ff * (1.0f + f2 * (-1.6666667e-1f + f2 * (8.3333333e-3f + f2 * (-1.9841270e-4f + f2 * 2.7557319e-6f))));
        const float cf = 1.0f + f2 * (-0.5f + f2 * (4.1666667e-2f + f2 * (-1.3888889e-3f + f2 * (2.4801587e-5f + f2 * -2.7557319e-7f))));
        const float sn = (qi == 0) ? sf : (qi == 1) ? cf : (qi == 2) ? -sf : -cf, cs = (qi == 0) ? cf : (qi == 1) ? -sf : (qi == 2) ? -cf : sf;
        rope[2 * i] = cs; rope[2 * i + 1] = sn;
    }
}


template <int PH> __device__ __forceinline__ void gemm_phase_of(const Params& P, LAS unsigned char* lds, int G, int c) {
    unsigned char* ws = P.ws; const pg8::bf16_t* xb = (const pg8::bf16_t*)(ws + WS_XB); float* rss = (float*)(ws + WS_RSS);
    pg8::StaticOrder S;
    if constexpr (PH == 0) { pg8::Gemm g{xb, (const pg8::bf16_t*)(ws + WS_WIN), M, NA, D}; S.init(M, NA, G, c); pg8::EpiRowScale E{(pg8::bf16_t*)(ws + WS_BIG), NA, rss};
        pg8::gemm_phase<pg8::EpiRowScale, pg8::StaticOrder, true, true>(lds, g, S, E); }
    if constexpr (PH == 1) { pg8::Gemm g{xb, (const pg8::bf16_t*)(ws + WS_WIN) + (size_t)NA * D, M, NG, D}; S.init(M, NG, G, c); pg8::EpiRowScale E{(pg8::bf16_t*)(ws + WS_BIG), NG, rss};
        pg8::gemm_phase<pg8::EpiRowScale, pg8::StaticOrder, true, true>(lds, g, S, E); }
    if constexpr (PH == 2) { pg8::Gemm g{(const pg8::bf16_t*)(ws + WS_MIXO), (const pg8::bf16_t*)(ws + WS_WMIX), M, D, NMIX}; S.init(M, D, G, c); pg8::EpiGateMix E{(const pg8::bf16_t*)(ws + WS_BIG), (pg8::bf16_t*)(ws + WS_MIXED)};
        pg8::gemm_phase<pg8::EpiGateMix, pg8::StaticOrder, true, true>(lds, g, S, E); }
    if constexpr (PH == 3) { pg8::Gemm g{(const pg8::bf16_t*)(ws + WS_MIXED), (const pg8::bf16_t*)(ws + WS_WOUT), M, D, D}; S.init(M, D, G, c); pg8::EpiResid E{P.out, (pg8::bf16_t*)(ws + WS_XB), rss};
        pg8::gemm_phase<pg8::EpiResid, pg8::StaticOrder, true, true>(lds, g, S, E); }
    if constexpr (PH == 4) { pg8::Gemm g{xb, (const pg8::bf16_t*)(ws + WS_WGU), M, FF2, D}; S.init(M, FF2, G, c); pg8::EpiSwiglu E{(pg8::bf16_t*)(ws + WS_BIG), FF, rss};
        pg8::gemm_phase<pg8::EpiSwiglu, pg8::StaticOrder, true, true>(lds, g, S, E); }
    if constexpr (PH == 5) { pg8::Gemm g{(const pg8::bf16_t*)(ws + WS_BIG), (const pg8::bf16_t*)(ws + WS_WDN), M, D, FF}; S.init(M, D, G, c); pg8::EpiResid E{P.out, (pg8::bf16_t*)(ws + WS_XB), rss};
        pg8::gemm_phase<pg8::EpiResid, pg8::StaticOrder, true, true>(lds, g, S, E); }
}

__device__ __forceinline__ void attn_naive_phase(const Params& P, int l, LAS unsigned char* lds, int vcu, int G) {
    const int otid_ = otid();
    const int w = __builtin_amdgcn_readfirstlane(otid_ >> 6), lane = otid_ & 63;
    LAS float* sq = (LAS float*)(lds + w * 1024); LAS float* sp = sq + 64;
    const bf16* proj = (const bf16*)(P.ws + WS_BIG); bf16* mixo = (bf16*)(P.ws + WS_MIXO);
    const float* gq = P.in[I_QNG] + l * 64; const float* gk = P.in[I_KNG] + l * 64; const float* sinks = P.in[I_SINK] + l * 8;
    for (int task = vcu * NWAVES + w; task < M * 8; task += G * NWAVES) {
        const int qh = task & 7, tok = task >> 3, t = tok & (T - 1), kvh = qh >> 2;
        const float q = bf2f(proj[(size_t)tok * NA + C_AQ + qh * 64 + lane]);
        const float ssq = wave_sum(q * q);
        sq[lane] = q * rsqrtf(ssq * (1.f / 64.f) + 1e-6f) * gq[lane] * 0.125f * gk[lane];
        LDS_WAIT(); __builtin_amdgcn_wave_barrier();
        float s[2];
#pragma unroll
        for (int jj = 0; jj < 2; ++jj) { const int j = lane + 64 * jj, kp = t - 127 + j; s[jj] = -INFINITY;
            if (kp >= 0) { const v4u* kr = (const v4u*)(proj + (size_t)(tok - 127 + j) * NA + C_AK + kvh * 64); float ss = 0.f, dot = 0.f;
#pragma unroll
                for (int c = 0; c < 8; ++c) { const v4u kv = kr[c];
#pragma unroll
                    for (int e = 0; e < 4; ++e) { const float k0 = bflo(kv[e]), k1 = bfhi(kv[e]); ss += k0 * k0 + k1 * k1; dot += sq[8 * c + 2 * e] * k0 + sq[8 * c + 2 * e + 1] * k1; } }
                s[jj] = dot * rsqrtf(ss * (1.f / 64.f) + 1e-6f); } }
        const float sink = sinks[qh]; const float mx = fmaxf(wave_max(fmaxf(s[0], s[1])), sink);
        const float p0 = __expf(s[0] - mx), p1 = __expf(s[1] - mx);
        const float den = wave_sum(p0 + p1) + __expf(sink - mx);
        sp[lane] = p0 / den; sp[lane + 64] = p1 / den;
        LDS_WAIT(); __builtin_amdgcn_wave_barrier();
        float o = 0.f; const int j0 = (t >= 127) ? 0 : 127 - t;
        for (int j = j0; j < 128; ++j) o += sp[j] * bf2f(proj[(size_t)(tok - 127 + j) * NA + C_AV + kvh * 64 + lane]);
        mixo[(size_t)tok * NMIX + qh * 64 + lane] = (bf16)f2bf(o);
        LDS_WAIT(); __builtin_amdgcn_wave_barrier();
    }
}
__device__ __forceinline__ void ret_naive_phase(const Params& P, LAS unsigned char* lds, int vcu, int G) {
    const int otid_ = otid();
    if (vcu >= 64) return;
    const int half = otid_ >> 8, tid = otid_ & 255, unit = 2 * vcu + half, b = unit >> 3, h = unit & 7;
    LAS float* sq = (LAS float*)(lds + half * 32768); LAS float* sk = sq + 32 * 64; LAS float* sv = sk + 32 * 64; LAS float* so = sv + 32 * 64;
    const bf16* proj = (const bf16*)(P.ws + WS_BIG); bf16* mixo = (bf16*)(P.ws + WS_MIXO); const float* rope = (const float*)(P.ws + WS_ROPE);
    const float gamma = 1.0f - exp2f(-5.0f - (float)h);
    const int e = tid >> 2, dq = tid & 3;
    float R[16];
#pragma unroll
    for (int i = 0; i < 16; ++i) R[i] = 0.f;
    for (int t0 = 0; t0 < T; t0 += 32) {
        __syncthreads();
        for (int idx = tid; idx < 32 * 32; idx += 256) { const int tt = idx >> 5, j = idx & 31, pos = t0 + tt; const size_t row = (size_t)(b * T + pos) * NA;
            const float cs = rope[(pos * 32 + j) * 2], sn = rope[(pos * 32 + j) * 2 + 1];
            const float q1 = bf2f(proj[row + C_RQ + h * 64 + j]), q2 = bf2f(proj[row + C_RQ + h * 64 + 32 + j]);
            const float k1 = bf2f(proj[row + C_RK + h * 64 + j]), k2 = bf2f(proj[row + C_RK + h * 64 + 32 + j]);
            sq[tt * 64 + j] = q1 * cs - q2 * sn; sq[tt * 64 + j + 32] = q2 * cs + q1 * sn;
            sk[tt * 64 + j] = (k1 * cs - k2 * sn) * 0.125f; sk[tt * 64 + j + 32] = (k2 * cs + k1 * sn) * 0.125f; }
        for (int idx = tid; idx < 32 * 64; idx += 256) { const int tt = idx >> 6, c = idx & 63; sv[tt * 64 + c] = bf2f(proj[(size_t)(b * T + t0 + tt) * NA + C_RV + h * 64 + c]); }
        __syncthreads();
        for (int tt = 0; tt < 32; ++tt) { const float ve = sv[tt * 64 + e]; float o = 0.f;
#pragma unroll
            for (int i = 0; i < 16; ++i) { const int d = dq * 16 + i; R[i] = gamma * R[i] + sk[tt * 64 + d] * ve; o += sq[tt * 64 + d] * R[i]; }
            o += __shfl_xor(o, 1); o += __shfl_xor(o, 2);
            if (dq == 0) so[tt * 64 + e] = o; }
        __syncthreads();
        { const int tt = tid >> 3, e0 = (tid & 7) * 8; float ss = 0.f;
#pragma unroll
          for (int i = 0; i < 8; ++i) ss += so[tt * 64 + e0 + i] * so[tt * 64 + e0 + i];
          ss += __shfl_xor(ss, 1); ss += __shfl_xor(ss, 2); ss += __shfl_xor(ss, 4);
          const float rstd = rsqrtf(ss * (1.f / 64.f) + 1e-6f); const size_t row = (size_t)(b * T + t0 + tt);
#pragma unroll
          for (int i = 0; i < 8; ++i) { const float g = bf2f(proj[row * NA + C_RG + h * 64 + e0 + i]); mixo[row * NMIX + 1024 + h * 64 + e0 + i] = (bf16)f2bf(so[tt * 64 + e0 + i] * rstd * g / (1.0f + __expf(-g))); } }
    }
    __syncthreads();
}
constexpr int RW_TT = 16;
constexpr int RW_LDS = (64 * 64 * 2 + 128 * 64) * 4 + RW_TT * (64 * 11 + 128) * 4 + RW_TT * 4;
static_assert(RW_LDS <= 131072, "rwkv naive LDS");
__device__ __forceinline__ void rwkv_naive_phase(const Params& P, int l, LAS unsigned char* lds, int vcu, int G) {
    const int otid_ = otid();
    if (vcu >= 128) return;
    LAS float* W2s = (LAS float*)lds; LAS float* A2s = W2s + 64 * 64; LAS float* G2s = A2s + 64 * 64;
    LAS float* zr = G2s + 128 * 64; LAS float* zk = zr + RW_TT * 64; LAS float* zv = zk + RW_TT * 64; LAS float* zwd = zv + RW_TT * 64; LAS float* zad = zwd + RW_TT * 64;
    LAS float* zgd = zad + RW_TT * 64; LAS float* dec = zgd + RW_TT * 128; LAS float* av = dec + RW_TT * 64; LAS float* bv = av + RW_TT * 64; LAS float* gg = bv + RW_TT * 64; LAS float* ys = gg + RW_TT * 64;
    LAS float* km = ys + RW_TT * 64; LAS float* bs = km + RW_TT * 64;
    const int tid = otid_, lane = tid & 63, b = vcu >> 3, h = vcu & 7; const bool act = tid < 256;
    const bf16* proj = (const bf16*)(P.ws + WS_BIG); bf16* mixo = (bf16*)(P.ws + WS_MIXO);
    const float* mu = P.in[I_MU] + l * RWC; const float* w0 = P.in[I_W0] + l * 512 + h * 64; const float* a0 = P.in[I_A0] + l * 512 + h * 64;
    const float* kkw = P.in[I_KK] + l * 512 + h * 64; const float* kaw = P.in[I_KA] + l * 512 + h * 64; const float* rkw = P.in[I_RK] + l * 512 + h * 64;
    const float* lng = P.in[I_LNG] + l * 512 + h * 64; const float* lnb = P.in[I_LNB] + l * 512 + h * 64;
    __syncthreads();
    for (int i = tid; i < 64 * 64; i += 512) { const int c = i >> 6, j = i & 63; W2s[i] = P.in[I_W2][(size_t)l * 64 * 512 + c * 512 + h * 64 + j]; A2s[i] = P.in[I_A2][(size_t)l * 64 * 512 + c * 512 + h * 64 + j]; }
    for (int i = tid; i < 128 * 64; i += 512) { const int c = i >> 6, j = i & 63; G2s[i] = P.in[I_G2][(size_t)l * 128 * 512 + c * 512 + h * 64 + j]; }
    const int v_ = (tid & 255) >> 2, kq = tid & 3;
    float S[16];
#pragma unroll
    for (int i = 0; i < 16; ++i) S[i] = 0.f;
    for (int t0 = 0; t0 < T; t0 += RW_TT) {
        __syncthreads();
        for (int idx = tid; idx < RW_TT * 448; idx += 512) { const int tt = idx / 448, c = idx % 448, t = t0 + tt;
            int col; if (c < 192) col = (c >> 6) * 512 + h * 64 + (c & 63); else col = 1536 + (c - 192);
            const size_t row = (size_t)(b * T + t) * NA + C_RW + col;
            const float hc = bf2f(proj[row]), hp = t > 0 ? bf2f(proj[row - NA]) : 0.f; const float z = hc + mu[col] * (hp - hc);
            if (c < 64) zr[tt * 64 + c] = z; else if (c < 128) zk[tt * 64 + c - 64] = z; else if (c < 192) zv[tt * 64 + c - 128] = z;
            else if (c < 256) zwd[tt * 64 + c - 192] = tanhf(z); else if (c < 320) zad[tt * 64 + c - 256] = z; else zgd[tt * 128 + c - 320] = sigmoidf_(z); }
        __syncthreads();
        for (int i = 0; i < RW_TT / 8; ++i) { const int tt = (tid >> 6) + 8 * i, j = lane;
            float wl = w0[j], al = a0[j], gl = 0.f;
            for (int c = 0; c < 64; ++c) { wl += zwd[tt * 64 + c] * W2s[c * 64 + j]; al += zad[tt * 64 + c] * A2s[c * 64 + j]; }
            for (int c = 0; c < 128; ++c) gl += zgd[tt * 128 + c] * G2s[c * 64 + j];
            const float x = -wl; const float sp = fmaxf(x, 0.f) + log1pf(__expf(-fabsf(x)));
            const float wlog = -sp - 0.5f; const float dcy = __expf(-__expf(wlog));
            const float a = sigmoidf_(al);
            const float kraw = zk[tt * 64 + j]; const float kk0 = kraw * kkw[j]; const float nrm = sqrtf(wave_sum(kk0 * kk0)); const float kk = kk0 / fmaxf(nrm, 1e-12f);
            const float kmod = kraw * (1.0f + (a - 1.0f) * kaw[j]); const float r = zr[tt * 64 + j];
            const float bsum = wave_sum(r * kmod * rkw[j]);
            dec[tt * 64 + j] = dcy; av[tt * 64 + j] = -kk; bv[tt * 64 + j] = kk * a; km[tt * 64 + j] = kmod; gg[tt * 64 + j] = gl; if (j == 0) bs[tt] = bsum; }
        __syncthreads();
        if (act) {
        for (int tt = 0; tt < RW_TT; ++tt) { float sa = 0.f;
#pragma unroll
            for (int i = 0; i < 16; ++i) sa += S[i] * av[tt * 64 + kq * 16 + i];
            sa += __shfl_xor(sa, 1); sa += __shfl_xor(sa, 2);
            const float vv = zv[tt * 64 + v_]; float y = 0.f;
#pragma unroll
            for (int i = 0; i < 16; ++i) { const int k = kq * 16 + i; S[i] = S[i] * dec[tt * 64 + k] + sa * bv[tt * 64 + k] + vv * km[tt * 64 + k]; y += S[i] * zr[tt * 64 + k]; }
            y += __shfl_xor(y, 1); y += __shfl_xor(y, 2);
            if (kq == 0) ys[tt * 64 + v_] = y; }
        }
        __syncthreads();
        if (act) { const int tt = tid >> 4, v0 = (tid & 15) * 4; float s = 0.f;
#pragma unroll
          for (int i = 0; i < 4; ++i) s += ys[tt * 64 + v0 + i];
          s += __shfl_xor(s, 1); s += __shfl_xor(s, 2); s += __shfl_xor(s, 4); s += __shfl_xor(s, 8);
          const float mean = s * (1.f / 64.f); float q = 0.f;
#pragma unroll
          for (int i = 0; i < 4; ++i) { const float d = ys[tt * 64 + v0 + i] - mean; q += d * d; }
          q += __shfl_xor(q, 1); q += __shfl_xor(q, 2); q += __shfl_xor(q, 4); q += __shfl_xor(q, 8);
          const float rstd = rsqrtf(q * (1.f / 64.f) + 64e-5f); const size_t row = (size_t)(b * T + t0 + tt);
#pragma unroll
          for (int i = 0; i < 4; ++i) { const int v = v0 + i; const float yn = (ys[tt * 64 + v] - mean) * rstd * lng[v] + lnb[v];
              mixo[row * NMIX + 512 + h * 64 + v] = (bf16)f2bf((yn + bs[tt] * zv[tt * 64 + v]) * gg[tt * 64 + v]); } }
    }
    __syncthreads();
}

#define XB_TMO      128
#define XB_XCNT(j)  (256  + 64 * (j))
#define XB_XSUB(j)  (1280 + 64 * (j))
#define XB_XGEN(j)  (2304 + 64 * (j))
#define XB_TOP      3328
#define XB_TOPGEN   3392
#define XCD_BAR_WORDS 3456
#define XB_SPIN_CAP (1u << 18)
__device__ __forceinline__ unsigned xb_ld(unsigned* p)              { return __hip_atomic_load(p, __ATOMIC_RELAXED, __HIP_MEMORY_SCOPE_AGENT); }
__device__ __forceinline__ unsigned xb_add(unsigned* p, unsigned v) { return __hip_atomic_fetch_add(p, v, __ATOMIC_RELAXED, __HIP_MEMORY_SCOPE_AGENT); }
__device__ __forceinline__ unsigned xb_xcc_id() { return (unsigned)__builtin_amdgcn_s_getreg((3 << 11) | 20) & 0xFu; }
#define XB_SPIN(cond, bar) do { unsigned _sp = 0; while (cond) { __builtin_amdgcn_s_sleep(1); \
    if ((++_sp & 255u) == 0u) { if (xb_ld(&(bar)[XB_TMO])) break; if (_sp > XB_SPIN_CAP) { atomicAdd(&(bar)[XB_TMO], 1u); break; } } } } while (0)
struct XcdBarrier {
    unsigned* bar; unsigned x;
    volatile LAS unsigned* st;
};
__device__ __forceinline__ XcdBarrier xcd_barrier_post(unsigned* bar, volatile LAS unsigned* st) {
    XcdBarrier b; b.bar = bar; b.x = xb_xcc_id(); b.st = st;
    if (threadIdx.x == 0) (void)xb_add(&bar[XB_XCNT(b.x)], 1u);
    return b;
}
__device__ __forceinline__ void xcd_barrier_complete(unsigned* bar, unsigned x, unsigned& nloc, unsigned& nx) {
    const unsigned G = gridDim.x * gridDim.y * gridDim.z;
    unsigned sum, cnt, mine, sp = 0u;
    for (;;) {
        sum = 0u; cnt = 0u; mine = 0u;
#pragma unroll
        for (unsigned j = 0; j < 16; ++j) { const unsigned c = xb_ld(&bar[XB_XCNT(j)]); sum += c; cnt += (c > 0u) ? 1u : 0u; mine = (j == x) ? c : mine; }
        if (sum == G) break;
        __builtin_amdgcn_s_sleep(1);
        if ((++sp & 255u) == 0u) { if (xb_ld(&bar[XB_TMO])) break; if (sp > XB_SPIN_CAP) { atomicAdd(&bar[XB_TMO], 1u); break; } }
    }
    nloc = mine > 0u ? mine : 1u; nx = cnt > 0u ? cnt : 1u;
}
__device__ __forceinline__ void xcd_barrier(const XcdBarrier& b) {
    asm volatile("s_waitcnt vmcnt(0)" ::: "memory");
    __syncthreads();
    if (threadIdx.x == 0) {
        unsigned* bar = b.bar;
        __builtin_amdgcn_s_waitcnt(0);
        unsigned nloc = b.st[0], nx = b.st[1];
        if (nloc == 0u) { xcd_barrier_complete(bar, b.x, nloc, nx); b.st[0] = nloc; b.st[1] = nx; }
        const unsigned old = xb_add(&bar[XB_XSUB(b.x)], 1u);
        const unsigned gen = old / nloc;
        if (old + 1u == (gen + 1u) * nloc) {
            __builtin_amdgcn_fence(__ATOMIC_RELEASE, "agent");
            asm volatile("s_waitcnt vmcnt(0)" ::: "memory");
            const unsigned og = xb_add(&bar[XB_TOP], 1u);
            const unsigned tg = og / nx;
            if (og + 1u == (tg + 1u) * nx) xb_add(&bar[XB_TOPGEN], 1u);
            else XB_SPIN(xb_ld(&bar[XB_TOPGEN]) == tg, bar);
            __builtin_amdgcn_fence(__ATOMIC_ACQUIRE, "agent");
            xb_add(&bar[XB_XGEN(b.x)], 1u);
            asm volatile("s_waitcnt vmcnt(0)" ::: "memory");
        } else {
            XB_SPIN(xb_ld(&bar[XB_XGEN(b.x)]) == gen, bar);
            __builtin_amdgcn_fence(__ATOMIC_ACQUIRE, "agent");
            asm volatile("s_waitcnt vmcnt(0)" ::: "memory");
        }
    }
    __syncthreads();
}

constexpr int CW_BAR = 4096;
constexpr int MISC_OFF = 131072 + 320;
#ifndef NAIVE_ATTN
#define NAIVE_ATTN 1
#endif
#ifndef NAIVE_RET
#define NAIVE_RET 1
#endif
#ifndef NAIVE_RWKV
#define NAIVE_RWKV 1
#endif
__global__ void __launch_bounds__(512, 2) k_mega(Params P) {
    extern __shared__ __attribute__((aligned(16))) unsigned char lds_[];
    LAS unsigned char* lds = (LAS unsigned char*)lds_;
    const int tid = threadIdx.x, G = gridDim.x, bx = blockIdx.x, vcu = (G % 8 == 0) ? (bx % 8) * (G / 8) + bx / 8 : bx;
    volatile LAS unsigned* MISC = (volatile LAS unsigned*)(lds + MISC_OFF);
    for (int u = tid; u < (LDS_BYTES - 131072) / 4; u += 512) ((LAS unsigned*)(lds + 131072))[u] = 0u;
    __syncthreads();
    XcdBarrier bar = xcd_barrier_post((unsigned*)(P.ws + WS_CTL) + CW_BAR, MISC + 8);
#define GRID_BAR() xcd_barrier(bar)
    phase_x0(P, vcu, G);
    for (int l = 0; l < DEPTH; ++l) {
        phase_wconv(P, l, lds, vcu, G);
        GRID_BAR();
#if !defined(SKIP_G0)
        gemm_phase_of<0>(P, lds, G, bx);
#endif
        GRID_BAR();
#if !defined(SKIP_ATTN)
        attn_naive_phase(P, l, lds, vcu, G);
#endif
        __syncthreads();
#if !defined(SKIP_RET)
        ret_naive_phase(P, lds, vcu, G);
#endif
        __syncthreads();
#if !defined(SKIP_RWKV)
        rwkv_naive_phase(P, l, lds, vcu, G);
#endif
        GRID_BAR();
#if !defined(SKIP_G1)
        gemm_phase_of<1>(P, lds, G, bx);
#endif
        GRID_BAR();
#if !defined(SKIP_G2)
        gemm_phase_of<2>(P, lds, G, bx);
#endif
        GRID_BAR();
#if !defined(SKIP_G3)
        gemm_phase_of<3>(P, lds, G, bx);
#endif
        GRID_BAR();
#if !defined(SKIP_G4)
        gemm_phase_of<4>(P, lds, G, bx);
#endif
        GRID_BAR();
#if !defined(SKIP_G5)
        gemm_phase_of<5>(P, lds, G, bx);
#endif
        GRID_BAR();
    }
}

extern "C" void kernel_launch(void* const* d_in, const int* in_sizes, int n_in, void* d_out, int out_size, void* d_ws, size_t ws_size, hipStream_t stream) {
    static int grid = 0;
    if (grid == 0) {
        if (n_in != 25 || out_size != M * D || ws_size < WS_END) { fprintf(stderr, "kernel_launch: unexpected shapes (n_in %d, out %d, ws %zu)\n", n_in, out_size, ws_size); grid = -1; return; }
        int dev = 0, cus = 0, per_cu = 0; if (hipGetDevice(&dev) != hipSuccess || hipDeviceGetAttribute(&cus, hipDeviceAttributeMultiprocessorCount, dev) != hipSuccess) { grid = -1; return; }
        if (hipFuncSetAttribute((const void*)k_mega, hipFuncAttributeMaxDynamicSharedMemorySize, LDS_BYTES) != hipSuccess) { fprintf(stderr, "kernel_launch: hipFuncSetAttribute failed\n"); grid = -1; return; }
        if (hipOccupancyMaxActiveBlocksPerMultiprocessor(&per_cu, (const void*)k_mega, 512, LDS_BYTES) != hipSuccess || per_cu < 1) fprintf(stderr, "kernel_launch: occupancy query reports %d workgroups per CU\n", per_cu);
        (void)hipGetLastError();
        grid = cus;
    }
    if (grid < 0) return;
    Params p; memset(&p, 0, sizeof(p));
    for (int i = 0; i < 25; ++i) p.in[i] = (const float*)d_in[i];
    p.out = (float*)d_out; p.ws = (unsigned char*)d_ws;
    (void)hipMemsetAsync((char*)d_ws + WS_CTL, 0, CTL_BYTES, stream);
    hipLaunchKernelGGL(k_mega, dim3(grid), dim3(512), LDS_BYTES, stream, p);
}
```

```cpp
#include <hip/hip_runtime.h>
#include <cstdio>
#include <cstdint>
#include <cstring>

constexpr int D = 1024, BATCH = 16, T = 2048, DEPTH = 4, M = BATCH * T;
constexpr int HD = 64;
constexpr int NA = 4608;
constexpr int NG = 3072;
constexpr int INW = NA + NG;
constexpr int C_AQ = 0, C_AK = 512, C_AV = 640, C_RW = 768, C_RQ = 2560, C_RK = 3072, C_RV = 3584, C_RG = 4096;
constexpr int RWC = 1792;
constexpr int FF = 2816, FF2 = 2 * FF;
constexpr int NMIX = 1536;

constexpr size_t MiB = 1u << 20;
constexpr size_t WS_CTL = 0, CTL_BYTES = 1 * MiB;
constexpr size_t WS_WIN = 1 * MiB;
constexpr size_t WS_WMIX = WS_WIN + (size_t)INW * D * 2;
constexpr size_t WS_WOUT = WS_WMIX + (size_t)D * NMIX * 2;
constexpr size_t WS_WGU = WS_WOUT + (size_t)D * D * 2;
constexpr size_t WS_WDN = WS_WGU + (size_t)FF2 * D * 2;
constexpr size_t WS_XB = 38 * MiB;
constexpr size_t WS_MIXO = 102 * MiB;
constexpr size_t WS_BIG = 198 * MiB;
constexpr size_t WS_MIXED = WS_BIG + 192 * MiB;
constexpr size_t WS_RSS = 486 * MiB;
constexpr size_t WS_ROPE = 488 * MiB;
constexpr size_t WS_END = 489 * MiB;
static_assert(WS_WDN + (size_t)D * FF * 2 <= WS_XB, "weights fit");
static_assert(WS_BIG + (size_t)M * NA * 2 <= WS_RSS, "big region fits");

#define GAS __attribute__((address_space(1)))
#define LAS __attribute__((address_space(3)))
typedef unsigned short bf16;
typedef unsigned v4u __attribute__((ext_vector_type(4)));
typedef unsigned v2u __attribute__((ext_vector_type(2)));
typedef float v4f __attribute__((ext_vector_type(4)));
__device__ __forceinline__ unsigned f2bf(float f) { unsigned u = __builtin_bit_cast(unsigned, f); return (u + 0x7fffu + ((u >> 16) & 1u)) >> 16; }
__device__ __forceinline__ unsigned pk2(float lo, float hi) { return f2bf(lo) | (f2bf(hi) << 16); }
__device__ __forceinline__ float bf2f(unsigned short b) { return __builtin_bit_cast(float, (unsigned)b << 16); }
__device__ __forceinline__ float bflo(unsigned w) { return __builtin_bit_cast(float, w << 16); }
__device__ __forceinline__ float bfhi(unsigned w) { return __builtin_bit_cast(float, w & 0xffff0000u); }
__device__ __forceinline__ float wave_sum(float v) {
#pragma unroll
    for (int o = 1; o < 64; o <<= 1) v += __shfl_xor(v, o);
    return v;
}
__device__ __forceinline__ float wave_max(float v) {
#pragma unroll
    for (int o = 1; o < 64; o <<= 1) v = fmaxf(v, __shfl_xor(v, o));
    return v;
}
__device__ __forceinline__ float sigmoidf_(float x) { return 1.f / (1.f + __expf(-x)); }

__device__ __forceinline__ int otid() { int t = threadIdx.x; asm volatile("" : "+v"(t)); return t; }

struct Params {
    const float* in[25];
    float* out;
    unsigned char* ws;
    int layer; int pad;
};
typedef const __attribute__((address_space(4))) Params* KP;
enum { I_X = 0, I_N1G, I_WIN, I_QNG, I_KNG, I_SINK, I_WAO, I_MU, I_W0, I_W2, I_A0, I_A2, I_G2, I_KK, I_KA, I_RK, I_LNG, I_LNB, I_WRO, I_WTO, I_WOUT, I_N2G, I_WG, I_WU, I_WD };


namespace pg8 {
#define PG8_LAS __attribute__((address_space(3)))
typedef unsigned short bf16_t;
typedef short bf16x8 __attribute__((ext_vector_type(8)));
typedef float f32x4 __attribute__((ext_vector_type(4)));
typedef unsigned u32x4 __attribute__((ext_vector_type(4)));
constexpr int BM = 256, BK = 64, HALF = 128, HTB = HALF * BK * 2  , STAGE_BYTES = 8 * HTB, NXCD = 8, WGM = 8;

__host__ __device__ __forceinline__ int lds_byte(int r, int c) { const int st = (r >> 4) * 2 + (c >> 5), rr = r & 15, cc = c & 31, ob = rr * 64 + cc * 2; return st * 1024 + (ob ^ (((ob >> 9) & 1) << 5)); }
__host__ __device__ __forceinline__ void stage_rc(int b, int& R, int& C) { const int st = b / 1024, sb = b % 1024, swz = sb ^ (((sb >> 9) & 1) << 5); R = (st >> 1) * 16 + swz / 64; C = (st & 1) * 32 + (swz % 64) / 2; }
__host__ __device__ __forceinline__ int perm32(int rho) { const int n = rho >> 4, i = rho & 15; return 8 * (i >> 2) + 4 * n + (i & 3); }

struct Unit { int pm, pn; };
struct Gemm { const bf16_t* A; const bf16_t* Bt; int M, N, K; };

struct StaticOrder {
    int nM, nN, nwg, G, c;
    __host__ __device__ void init(int M, int N, int G_, int c_) { nM = M / BM; nN = N / BM; nwg = nM * nN; G = G_; c = c_; }
    __host__ __device__ bool next(int i, Unit& u) const {
        const long L = (long)i * G + c; if (L >= nwg) return false;
        int wgid = (int)L; { const int q = nwg / NXCD, r = nwg % NXCD, xcd = wgid % NXCD, off = wgid / NXCD; wgid = (xcd < r ? xcd * (q + 1) : r * (q + 1) + (xcd - r) * q) + off; }
        const int nig = WGM * nN, gid = wgid / nig, fm = gid * WGM, gsz = (nM - fm) < WGM ? (nM - fm) : WGM;
        u.pm = fm + ((wgid % nig) % gsz); u.pn = (wgid % nig) / gsz; return true;
    }
    __device__ __forceinline__ void a_ready(const Unit&) const {}
    __device__ __forceinline__ void done(const Unit&) const {}
};


typedef float f32x2_ __attribute__((ext_vector_type(2))); typedef __bf16 bf16x2_ __attribute__((ext_vector_type(2)));
__device__ __forceinline__ unsigned cvt_pk_bf16(float lo, float hi) { const f32x2_ x = {lo, hi}; return __builtin_bit_cast(unsigned, __builtin_convertvector(x, bf16x2_)); }
__device__ __forceinline__ float clampg(float x) { return __builtin_amdgcn_fmed3f(x, -30.0f, 30.0f); }
__device__ __forceinline__ float row_rstd(const float* rss, int row) {
    const f32x4* p = (const f32x4*)(rss + (size_t)row * 16);
    const f32x4 a = p[0], b = p[1], c = p[2], d = p[3];
    const float s = (((a.x + a.y) + (a.z + a.w)) + ((b.x + b.y) + (b.z + b.w))) + (((c.x + c.y) + (c.z + c.w)) + ((d.x + d.y) + (d.z + d.w)));
    return rsqrtf(s * (1.0f / 1024.0f) + 1e-6f);
}
struct EpiRowScale {
    static constexpr bool PERM = true, AFTER_DRAIN = false; static constexpr int KSEG = 0;
    bf16_t* O; int ldc; const float* rss;
    __device__ __forceinline__ void operator()(const f32x4 (&acc)[2][2][4][2], const Unit& u, int wr, int wc, int fr, int fq) const {
        const int row0 = u.pm * BM + wr * 64 + fr, col0 = u.pn * BM + wc * 32 + 8 * fq;
#pragma unroll
        for (int ai = 0; ai < 2; ++ai)
#pragma unroll
            for (int m = 0; m < 4; ++m) { const int row = row0 + ai * HALF + m * 16; const float rs = row_rstd(rss, row); bf16_t* rowp = O + (size_t)row * ldc + col0;
#pragma unroll
                for (int bj = 0; bj < 2; ++bj) { const f32x4 v0 = acc[ai][bj][m][0] * rs, v1 = acc[ai][bj][m][1] * rs;
                    u32x4 w; w.x = cvt_pk_bf16(v0[0], v0[1]); w.y = cvt_pk_bf16(v0[2], v0[3]); w.z = cvt_pk_bf16(v1[0], v1[1]); w.w = cvt_pk_bf16(v1[2], v1[3]);
                    *(u32x4*)(rowp + bj * HALF) = w; } }
    }
};
struct EpiSwiglu {
    static constexpr bool PERM = true, AFTER_DRAIN = false; static constexpr int KSEG = 0;
    bf16_t* O; int ldc; const float* rss;
    __device__ __forceinline__ void operator()(const f32x4 (&acc)[2][2][4][2], const Unit& u, int wr, int wc, int fr, int fq) const {
        const int row0 = u.pm * BM + wr * 64 + fr, col0 = u.pn * HALF + wc * 32 + 8 * fq;
#pragma unroll
        for (int ai = 0; ai < 2; ++ai)
#pragma unroll
            for (int m = 0; m < 4; ++m) { const int row = row0 + ai * HALF + m * 16; const float rs = row_rstd(rss, row); bf16_t* rowp = O + (size_t)row * ldc + col0;
                float o[8];
#pragma unroll
                for (int n = 0; n < 2; ++n)
#pragma unroll
                    for (int j = 0; j < 4; ++j) { const float g = acc[ai][0][m][n][j] * rs, up = acc[ai][1][m][n][j] * rs; o[4 * n + j] = g * up * __builtin_amdgcn_rcpf(1.0f + __expf(-g)); }
                u32x4 w; w.x = cvt_pk_bf16(o[0], o[1]); w.y = cvt_pk_bf16(o[2], o[3]); w.z = cvt_pk_bf16(o[4], o[5]); w.w = cvt_pk_bf16(o[6], o[7]);
                *(u32x4*)rowp = w; }
    }
};
struct EpiResid {
    static constexpr bool PERM = false, AFTER_DRAIN = false; static constexpr int KSEG = 0;
    float* X; bf16_t* XB; float* rss;
    __device__ __forceinline__ void operator()(const f32x4 (&acc)[2][2][4][2], const Unit& u, int wr, int wc, int fr, int fq) const {
        const int row0 = u.pm * BM + wr * 64 + fr, col0 = u.pn * BM + wc * 32 + 4 * fq;
#pragma unroll
        for (int ai = 0; ai < 2; ++ai)
#pragma unroll
            for (int m = 0; m < 4; ++m) { const int row = row0 + ai * HALF + m * 16; const size_t off = (size_t)row * 1024 + col0; float ss = 0.f;
#pragma unroll
                for (int bj = 0; bj < 2; ++bj)
#pragma unroll
                    for (int n = 0; n < 2; ++n) { const size_t o2 = off + bj * HALF + n * 16; const f32x4 x = *(const f32x4*)(X + o2) + acc[ai][bj][m][n];
                        *(f32x4*)(X + o2) = x; ss += (x[0] * x[0] + x[1] * x[1]) + (x[2] * x[2] + x[3] * x[3]);
                        unsigned long long w = (unsigned long long)cvt_pk_bf16(x[0], x[1]) | ((unsigned long long)cvt_pk_bf16(x[2], x[3]) << 32);
                        *(unsigned long long*)(XB + o2) = w; }
                ss += __shfl_xor(ss, 16); ss += __shfl_xor(ss, 32);
                if (fq == 0) rss[(size_t)row * 16 + u.pn * 4 + wc] = ss; }
    }
};
struct EpiGateMix {
    static constexpr bool PERM = true, AFTER_DRAIN = false; static constexpr int KSEG = 8;
    const bf16_t* Gt; bf16_t* O;
    __device__ __forceinline__ void seg(f32x4 (&acc)[2][2][4][2], const Unit& u, int s, int wr, int wc, int fr, int fq) const {
        const int row0 = u.pm * BM + wr * 64 + fr, col0 = u.pn * BM + wc * 32 + 8 * fq;
#pragma unroll
        for (int ai = 0; ai < 2; ++ai)
#pragma unroll
            for (int m = 0; m < 4; ++m) { const bf16_t* gp = Gt + (size_t)(row0 + ai * HALF + m * 16) * 3072 + (s - 1) * 1024 + col0;
#pragma unroll
                for (int bj = 0; bj < 2; ++bj) { const u32x4 lo = *(const u32x4*)(gp + bj * HALF), hi = *(const u32x4*)(gp + 1024 + bj * HALF);
#pragma unroll
                    for (int q = 0; q < 4; ++q) { const unsigned wl = lo[q], wh = hi[q];
                        const float l0 = clampg(__builtin_bit_cast(float, wl << 16)), l1 = clampg(__builtin_bit_cast(float, wl & 0xffff0000u)), h0 = clampg(__builtin_bit_cast(float, wh << 16)), h1 = clampg(__builtin_bit_cast(float, wh & 0xffff0000u));
                        const float r0 = (1.0f + __expf(-h0)) * __builtin_amdgcn_rcpf(1.0f + __expf(-l0)), r1 = (1.0f + __expf(-h1)) * __builtin_amdgcn_rcpf(1.0f + __expf(-l1));
                        acc[ai][bj][m][q >> 1][(q & 1) * 2] *= r0; acc[ai][bj][m][q >> 1][(q & 1) * 2 + 1] *= r1; } } }
    }
    __device__ __forceinline__ void operator()(const f32x4 (&acc)[2][2][4][2], const Unit& u, int wr, int wc, int fr, int fq) const {
        const int row0 = u.pm * BM + wr * 64 + fr, col0 = u.pn * BM + wc * 32 + 8 * fq;
#pragma unroll
        for (int ai = 0; ai < 2; ++ai)
#pragma unroll
            for (int m = 0; m < 4; ++m) { const int row = row0 + ai * HALF + m * 16; const bf16_t* gp = Gt + (size_t)row * 3072 + 2048 + col0; bf16_t* rowp = O + (size_t)row * 1024 + col0;
#pragma unroll
                for (int bj = 0; bj < 2; ++bj) { const u32x4 g = *(const u32x4*)(gp + bj * HALF); float o[8];
#pragma unroll
                    for (int q = 0; q < 4; ++q) { const unsigned w = g[q]; const float g0 = clampg(__builtin_bit_cast(float, w << 16)), g1 = clampg(__builtin_bit_cast(float, w & 0xffff0000u));
                        o[2 * q] = acc[ai][bj][m][q >> 1][(q & 1) * 2] * __builtin_amdgcn_rcpf(1.0f + __expf(-g0)); o[2 * q + 1] = acc[ai][bj][m][q >> 1][(q & 1) * 2 + 1] * __builtin_amdgcn_rcpf(1.0f + __expf(-g1)); }
                    u32x4 w; w.x = cvt_pk_bf16(o[0], o[1]); w.y = cvt_pk_bf16(o[2], o[3]); w.z = cvt_pk_bf16(o[4], o[5]); w.w = cvt_pk_bf16(o[6], o[7]);
                    *(u32x4*)(rowp + bj * HALF) = w; } }
    }
};


template <class Epi, class Sched, bool ALIGN_EPI = false, bool SP2 = false>
__device__ __forceinline__ void gemm_phase(PG8_LAS unsigned char* lds, const Gemm g, const Sched& S, const Epi& E) {
    int tid_ = threadIdx.x; asm volatile("" : "+v"(tid_));
    const int tid = tid_, wid = __builtin_amdgcn_readfirstlane(tid >> 6), lane = tid & 63, wr = wid >> 2, wc = wid & 3, fr = lane & 15, fq = lane >> 4;
    const int K = g.K, nt = K / BK;
    unsigned voffA[2], voffB[2];
#pragma unroll
    for (int i = 0; i < 2; ++i) { int R, C; stage_rc(tid * 16 + i * 8192, R, C); const int Rb = Epi::PERM ? ((R & ~31) + perm32(R & 31)) : R;
        voffA[i] = (unsigned)(R * K + C) * 2u; voffB[i] = (unsigned)(Rb * K + C) * 2u; }
    const size_t kstep = (size_t)(BK * 2);
    const size_t hstep = (size_t)HALF * K * 2;
    const size_t tstep = 2 * hstep;
    const unsigned ldsw = (unsigned)wid * 1024u;
    const int aoff = lds_byte(wr * 64 + fr, fq * 8), boff = lds_byte(wc * 32 + fr, fq * 8);
#define PG8_SA(b, h) (((b) * 2 + (h)) * HTB)
#define PG8_SB(b, h) ((4 + (b) * 2 + (h)) * HTB)
#define PG8_STAGE(bufoff, gbase, voff) do { _Pragma("unroll") for (int _i = 0; _i < 2; ++_i) \
        __builtin_amdgcn_global_load_lds((const unsigned*)((const char*)(gbase) + (voff)[_i]), (PG8_LAS unsigned*)(lds + (bufoff) + ldsw + _i * 8192), 16, 0, 0); } while (0)
#define PG8_LDA(dst, b, h) do { _Pragma("unroll") for (int m = 0; m < 4; ++m) _Pragma("unroll") for (int k = 0; k < 2; ++k) dst[m][k] = *(const PG8_LAS bf16x8*)(lds + PG8_SA(b, h) + aoff + m * 2048 + k * 1024); } while (0)
#define PG8_LDB(dst, b, h) do { _Pragma("unroll") for (int n = 0; n < 2; ++n) _Pragma("unroll") for (int k = 0; k < 2; ++k) dst[n][k] = *(const PG8_LAS bf16x8*)(lds + PG8_SB(b, h) + boff + n * 2048 + k * 1024); } while (0)
#define PG8_MMA(ai, bj, At, Bt) do { __builtin_amdgcn_s_setprio(1); _Pragma("unroll") for (int m = 0; m < 4; ++m) _Pragma("unroll") for (int n = 0; n < 2; ++n) _Pragma("unroll") for (int k = 0; k < 2; ++k) \
        acc[ai][bj][m][n] = __builtin_amdgcn_mfma_f32_16x16x32_bf16(Bt[n][k], At[m][k], acc[ai][bj][m][n], 0, 0, 0); __builtin_amdgcn_s_setprio(0); } while (0)
#define PG8_WAIT_V(n) asm volatile("s_waitcnt vmcnt(" #n ")" ::: "memory")
#define PG8_WAIT_L(n) asm volatile("s_waitcnt lgkmcnt(" #n ")" ::: "memory")
#define PG8_BAR __builtin_amdgcn_s_barrier()
#define PG8_SCHED __builtin_amdgcn_sched_barrier(0)
    Unit cur, nxt; int ui = 0;
    if (!S.next(0, cur)) return;
    f32x4 acc[2][2][4][2];
#pragma unroll
    for (int a = 0; a < 2; ++a)
#pragma unroll
        for (int b = 0; b < 2; ++b)
#pragma unroll
            for (int m = 0; m < 4; ++m)
#pragma unroll
                for (int n = 0; n < 2; ++n) acc[a][b][m][n] = (f32x4){0.f, 0.f, 0.f, 0.f};
    bf16x8 At[4][2], B0[2][2], B1[2][2];
    const char* cA = (const char*)g.A + (size_t)cur.pm * tstep; const char* cB = (const char*)g.Bt + (size_t)cur.pn * tstep;
    S.a_ready(cur);
    if constexpr (SP2) {
        PG8_STAGE(PG8_SB(0, 0), cB, voffB); PG8_STAGE(PG8_SB(0, 1), cB + hstep, voffB); PG8_STAGE(PG8_SA(0, 0), cA, voffA); PG8_STAGE(PG8_SA(0, 1), cA + hstep, voffA);
        if (wr == 1) PG8_BAR;
        PG8_WAIT_V(2); PG8_BAR;
        PG8_STAGE(PG8_SB(1, 0), cB + kstep, voffB); PG8_STAGE(PG8_SA(1, 0), cA + kstep, voffA); PG8_STAGE(PG8_SB(1, 1), cB + hstep + kstep, voffB);
        PG8_WAIT_V(6); PG8_BAR;
    } else {
        PG8_STAGE(PG8_SB(0, 0), cB, voffB); PG8_STAGE(PG8_SA(0, 0), cA, voffA); PG8_STAGE(PG8_SB(0, 1), cB + hstep, voffB); PG8_STAGE(PG8_SA(0, 1), cA + hstep, voffA);
        if (wr == 1) PG8_BAR;
        PG8_WAIT_V(4); PG8_BAR;
        PG8_STAGE(PG8_SB(1, 0), cB + kstep, voffB); PG8_STAGE(PG8_SA(1, 0), cA + kstep, voffA); PG8_STAGE(PG8_SB(1, 1), cB + hstep + kstep, voffB);
        PG8_WAIT_V(6); PG8_BAR;
    }
    for (;;) {
        const bool has_next = S.next(ui + 1, nxt);
        const char* nA = has_next ? (const char*)g.A + (size_t)nxt.pm * tstep : cA; const char* nB = has_next ? (const char*)g.Bt + (size_t)nxt.pn * tstep : cB;
        for (int t = 0; t < nt; t += 2) {
            const bool last = (t == nt - 2);
            const char* a1 = cA + (size_t)(t + 1) * kstep;
            const char* a2 = last ? nA : cA + (size_t)(t + 2) * kstep; const char* b2 = last ? nB : cB + (size_t)(t + 2) * kstep;
            const char* a3 = a2 + kstep; const char* b3 = b2 + kstep;
            if (last && has_next) S.a_ready(nxt);
            if constexpr (Epi::KSEG > 0) { if (t != 0 && (t % Epi::KSEG) == 0) E.seg(acc, cur, t / Epi::KSEG, wr, wc, fr, fq); }
            if constexpr (SP2) {
            PG8_LDB(B0, 0, 0); PG8_LDB(B1, 0, 1); PG8_SCHED; PG8_LDA(At, 0, 0); PG8_STAGE(PG8_SA(1, 1), a1 + hstep, voffA);
            PG8_WAIT_V(8); PG8_WAIT_L(0); PG8_BAR; PG8_MMA(0, 0, At, B0); PG8_MMA(0, 1, At, B1); PG8_BAR; PG8_SCHED;
            PG8_LDA(At, 0, 1); PG8_STAGE(PG8_SB(0, 0), b2, voffB); PG8_STAGE(PG8_SB(0, 1), b2 + hstep, voffB); PG8_STAGE(PG8_SA(0, 0), a2, voffA);
            PG8_WAIT_V(8); PG8_WAIT_L(0); PG8_BAR; PG8_MMA(1, 0, At, B0); PG8_MMA(1, 1, At, B1); PG8_BAR; PG8_SCHED;
            PG8_LDB(B0, 1, 0); PG8_LDB(B1, 1, 1); PG8_SCHED; PG8_LDA(At, 1, 0); PG8_STAGE(PG8_SA(0, 1), a2 + hstep, voffA);
            PG8_WAIT_V(8); PG8_WAIT_L(0); PG8_BAR; PG8_MMA(0, 0, At, B0); PG8_MMA(0, 1, At, B1); PG8_BAR; PG8_SCHED;
            PG8_LDA(At, 1, 1); PG8_STAGE(PG8_SB(1, 0), b3, voffB); PG8_STAGE(PG8_SB(1, 1), b3 + hstep, voffB); PG8_STAGE(PG8_SA(1, 0), a3, voffA);
            PG8_WAIT_V(8); PG8_WAIT_L(0); PG8_BAR; PG8_MMA(1, 0, At, B0); PG8_MMA(1, 1, At, B1); PG8_BAR; PG8_SCHED;
            } else {
            PG8_LDB(B0, 0, 0); PG8_SCHED; PG8_LDA(At, 0, 0); PG8_STAGE(PG8_SA(1, 1), a1 + hstep, voffA);
            PG8_WAIT_L(8); PG8_BAR; PG8_WAIT_L(0); PG8_MMA(0, 0, At, B0); PG8_BAR; PG8_SCHED;
            PG8_LDB(B1, 0, 1); PG8_STAGE(PG8_SB(0, 0), b2, voffB);
            PG8_BAR; PG8_WAIT_L(0); PG8_MMA(0, 1, At, B1); PG8_BAR;
            PG8_LDA(At, 0, 1); PG8_STAGE(PG8_SA(0, 0), a2, voffA);
            PG8_BAR; PG8_WAIT_L(0); PG8_MMA(1, 0, At, B0); PG8_BAR; PG8_SCHED;
            PG8_STAGE(PG8_SB(0, 1), b2 + hstep, voffB);
            PG8_WAIT_V(6); PG8_BAR; PG8_MMA(1, 1, At, B1); PG8_BAR;
            PG8_LDB(B0, 1, 0); PG8_SCHED; PG8_LDA(At, 1, 0); PG8_STAGE(PG8_SA(0, 1), a2 + hstep, voffA);
            PG8_WAIT_L(8); PG8_BAR; PG8_WAIT_L(0); PG8_MMA(0, 0, At, B0); PG8_BAR; PG8_SCHED;
            PG8_LDB(B1, 1, 1); PG8_STAGE(PG8_SB(1, 0), b3, voffB);
            PG8_BAR; PG8_WAIT_L(0); PG8_MMA(0, 1, At, B1); PG8_BAR;
            PG8_LDA(At, 1, 1); PG8_STAGE(PG8_SA(1, 0), a3, voffA);
            PG8_BAR; PG8_WAIT_L(0); PG8_MMA(1, 0, At, B0); PG8_BAR; PG8_SCHED;
            PG8_STAGE(PG8_SB(1, 1), b3 + hstep, voffB);
            PG8_WAIT_V(6); PG8_BAR; PG8_MMA(1, 1, At, B1); PG8_BAR;
            }
        }
        if constexpr (ALIGN_EPI) { if (wr == 0) PG8_BAR; }
        if constexpr (!Epi::AFTER_DRAIN) { E(acc, cur, wr, wc, fr, fq); S.done(cur); }
        if (!has_next) break;
#pragma unroll
        for (int a = 0; a < 2; ++a)
#pragma unroll
            for (int b = 0; b < 2; ++b)
#pragma unroll
                for (int m = 0; m < 4; ++m)
#pragma unroll
                    for (int n = 0; n < 2; ++n) acc[a][b][m][n] = (f32x4){0.f, 0.f, 0.f, 0.f};
        cur = nxt; cA = nA; cB = nB; ++ui;
        if constexpr (ALIGN_EPI) { if (wr == 1) PG8_BAR; }
    }
    PG8_WAIT_V(0);
    if constexpr (!ALIGN_EPI) { if (wr == 0) PG8_BAR; }
    PG8_BAR;
    if constexpr (Epi::AFTER_DRAIN) { E.fused(acc, cur, wr, wc, fr, fq, lds, wid, lane); S.done(cur); }
#undef PG8_SA
#undef PG8_SB
#undef PG8_STAGE
#undef PG8_LDA
#undef PG8_LDB
#undef PG8_MMA
#undef PG8_WAIT_V
#undef PG8_WAIT_L
#undef PG8_BAR
#undef PG8_SCHED
}
}


#define LDS_WAIT() asm volatile("s_waitcnt lgkmcnt(0)" ::: "memory")
constexpr int NWAVES = 8;
constexpr int LDS_BYTES = 157696;

__device__ __forceinline__ void tr_item(const float* W, int ldw, int k0, int n0, const float* scale, bf16* WT, int ldt, int drow0, int dcol0, LAS float* scr, int lane) {
    const int otid_ = otid();
#pragma unroll 8
    for (int i = 0; i < 32; ++i) { const int kk = 2 * i + (lane >> 5); float v = W[(size_t)(k0 + kk) * ldw + n0 + (lane & 31)]; if (scale) v *= scale[k0 + kk]; scr[kk * 33 + (lane & 31)] = v; }
    LDS_WAIT(); asm volatile("" ::: "memory");
    const int c = lane & 7;
#pragma unroll
    for (int j = 0; j < 4; ++j) { const int n = (lane >> 3) + 8 * j; const LAS float* s = scr + (8 * c) * 33 + n;
        v4u o; o.x = pk2(s[0 * 33], s[1 * 33]); o.y = pk2(s[2 * 33], s[3 * 33]); o.z = pk2(s[4 * 33], s[5 * 33]); o.w = pk2(s[6 * 33], s[7 * 33]);
        *(v4u*)(WT + (size_t)(drow0 + n) * ldt + dcol0 + 8 * c) = o; }
    LDS_WAIT(); asm volatile("" ::: "memory");
}
constexpr int WI_IN = 16 * 240, WI_MIX = 3 * 8 * 32, WI_OUT = 16 * 32, WI_G = 16 * 88, WI_DN = 44 * 32;
constexpr int WI_TOTAL = WI_IN + WI_MIX + WI_OUT + 2 * WI_G + WI_DN;
__device__ __forceinline__ void wconv_item(KP P, int l, int it, LAS float* scr, int lane) {
    const int otid_ = otid();
    unsigned char* ws = P->ws;
    if (it < WI_IN) { const int kb = it / 240, nb = it % 240; tr_item(P->in[I_WIN] + (size_t)l * D * INW, INW, 64 * kb, 32 * nb, P->in[I_N1G] + l * D, (bf16*)(ws + WS_WIN), D, 32 * nb, 64 * kb, scr, lane); return; }
    it -= WI_IN;
    if (it < WI_MIX) { const int br = it / 256, r = it % 256, kb = r / 32, nb = r % 32; const float* W = P->in[br == 0 ? I_WAO : (br == 1 ? I_WRO : I_WTO)] + (size_t)l * 512 * D;
        tr_item(W, D, 64 * kb, 32 * nb, nullptr, (bf16*)(ws + WS_WMIX), NMIX, 32 * nb, br * 512 + 64 * kb, scr, lane); return; }
    it -= WI_MIX;
    if (it < WI_OUT) { const int kb = it / 32, nb = it % 32; tr_item(P->in[I_WOUT] + (size_t)l * D * D, D, 64 * kb, 32 * nb, nullptr, (bf16*)(ws + WS_WOUT), D, 32 * nb, 64 * kb, scr, lane); return; }
    it -= WI_OUT;
    if (it < 2 * WI_G) { const int up = it / WI_G, r = it % WI_G, kb = r / 88, nb = r % 88, n0 = 32 * nb;
        tr_item(P->in[up ? I_WU : I_WG] + (size_t)l * D * FF, FF, 64 * kb, n0, P->in[I_N2G] + l * D, (bf16*)(ws + WS_WGU), D, (n0 / 128) * 256 + up * 128 + (n0 % 128), 64 * kb, scr, lane); return; }
    it -= 2 * WI_G;
    { const int kb = it / 32, nb = it % 32; tr_item(P->in[I_WD] + (size_t)l * FF * D, D, 64 * kb, 32 * nb, nullptr, (bf16*)(ws + WS_WDN), FF, 32 * nb, 64 * kb, scr, lane); }
}
__device__ __forceinline__ void phase_wconv(KP P, int l, LAS unsigned char* lds, int vcu, int G) {
    const int otid_ = otid();
    const int wave = __builtin_amdgcn_readfirstlane(otid_ >> 6), lane = otid_ & 63;
    LAS float* scr = (LAS float*)(lds + wave * 16384);
    for (int it = vcu * NWAVES + wave; it < WI_TOTAL; it += G * NWAVES) wconv_item(P, l, it, scr, lane);
}
__device__ __forceinline__ void phase_x0(KP P, int vcu, int G) {
    const int otid_ = otid();
    const int wave = __builtin_amdgcn_readfirstlane(otid_ >> 6), lane = otid_ & 63;
    const float* x = P->in[I_X]; float* out = P->out; bf16* xb = (bf16*)(P->ws + WS_XB); float* rss = (float*)(P->ws + WS_RSS);
    for (int m = vcu * NWAVES + wave; m < M; m += G * NWAVES) {
        const v4f* xr = (const v4f*)(x + (size_t)m * D) + lane; v4f* orow = (v4f*)(out + (size_t)m * D) + lane; unsigned long long* o8 = (unsigned long long*)(xb + (size_t)m * D) + lane;
        v4f v[4]; float s = 0.f;
#pragma unroll
        for (int j = 0; j < 4; ++j) { v[j] = xr[64 * j]; s += (v[j].x * v[j].x + v[j].y * v[j].y) + (v[j].z * v[j].z + v[j].w * v[j].w); }
        s = wave_sum(s);
#pragma unroll
        for (int j = 0; j < 4; ++j) { orow[64 * j] = v[j]; o8[64 * j] = (unsigned long long)pk2(v[j].x, v[j].y) | ((unsigned long long)pk2(v[j].z, v[j].w) << 32); }
        if (lane < 16) rss[(size_t)m * 16 + lane] = lane == 0 ? s : 0.f;
    }
    float* rope = (float*)(P->ws + WS_ROPE);
    for (int i = (vcu * NWAVES + wave) * 64 + lane; i < T * 32; i += G * NWAVES * 64) {
        const int t = i >> 5, j = i & 31; const float inv_freq = (float)exp(-((double)j / 32.0) * 9.210340371976184); const float ang = (float)t * inv_freq;
        const double xa = (double)ang, qd = rint(xa * 0.6366197723675814), fd = xa - qd * 1.5707963267948966; const int qi = (int)qd & 3;
        const float ff = (float)fd, f2 = ff * ff;
        const float sf = ff * (1.0f + f2 * (-1.6666667e-1f + f2 * (8.3333333e-3f + f2 * (-1.9841270e-4f + f2 * 2.7557319e-6f))));
        const float cf = 1.0f + f2 * (-0.5f + f2 * (4.1666667e-2f + f2 * (-1.3888889e-3f + f2 * (2.4801587e-5f + f2 * -2.7557319e-7f))));
        const float sn = (qi == 0) ? sf : (qi == 1) ? cf : (qi == 2) ? -sf : -cf, cs = (qi == 0) ? cf : (qi == 1) ? -sf : (qi == 2) ? -cf : sf;
        rope[2 * i] = cs; rope[2 * i + 1] = sn;
    }
}


template <int PH> __device__ __forceinline__ void gemm_phase_of(KP P, LAS unsigned char* lds, int G, int c) {
    unsigned char* ws = P->ws; const pg8::bf16_t* xb = (const pg8::bf16_t*)(ws + WS_XB); float* rss = (float*)(ws + WS_RSS);
    pg8::StaticOrder S;
    if constexpr (PH == 0) { pg8::Gemm g{xb, (const pg8::bf16_t*)(ws + WS_WIN), M, NA, D}; S.init(M, NA, G, c); pg8::EpiRowScale E{(pg8::bf16_t*)(ws + WS_BIG), NA, rss};
        pg8::gemm_phase<pg8::EpiRowScale, pg8::StaticOrder, true, true>(lds, g, S, E); }
    if constexpr (PH == 1) { pg8::Gemm g{xb, (const pg8::bf16_t*)(ws + WS_WIN) + (size_t)NA * D, M, NG, D}; S.init(M, NG, G, c); pg8::EpiRowScale E{(pg8::bf16_t*)(ws + WS_BIG), NG, rss};
        pg8::gemm_phase<pg8::EpiRowScale, pg8::StaticOrder, true, true>(lds, g, S, E); }
    if constexpr (PH == 2) { pg8::Gemm g{(const pg8::bf16_t*)(ws + WS_MIXO), (const pg8::bf16_t*)(ws + WS_WMIX), M, D, NMIX}; S.init(M, D, G, c); pg8::EpiGateMix E{(const pg8::bf16_t*)(ws + WS_BIG), (pg8::bf16_t*)(ws + WS_MIXED)};
        pg8::gemm_phase<pg8::EpiGateMix, pg8::StaticOrder, true, true>(lds, g, S, E); }
    if constexpr (PH == 3) { pg8::Gemm g{(const pg8::bf16_t*)(ws + WS_MIXED), (const pg8::bf16_t*)(ws + WS_WOUT), M, D, D}; S.init(M, D, G, c); pg8::EpiResid E{P->out, (pg8::bf16_t*)(ws + WS_XB), rss};
        pg8::gemm_phase<pg8::EpiResid, pg8::StaticOrder, true, true>(lds, g, S, E); }
    if constexpr (PH == 4) { pg8::Gemm g{xb, (const pg8::bf16_t*)(ws + WS_WGU), M, FF2, D}; S.init(M, FF2, G, c); pg8::EpiSwiglu E{(pg8::bf16_t*)(ws + WS_BIG), FF, rss};
        pg8::gemm_phase<pg8::EpiSwiglu, pg8::StaticOrder, true, true>(lds, g, S, E); }
    if constexpr (PH == 5) { pg8::Gemm g{(const pg8::bf16_t*)(ws + WS_BIG), (const pg8::bf16_t*)(ws + WS_WDN), M, D, FF}; S.init(M, D, G, c); pg8::EpiResid E{P->out, (pg8::bf16_t*)(ws + WS_XB), rss};
        pg8::gemm_phase<pg8::EpiResid, pg8::StaticOrder, true, true>(lds, g, S, E); }
}

typedef float f32x16 __attribute__((ext_vector_type(16)));
typedef short bf16x8v __attribute__((ext_vector_type(8)));
constexpr int AT_KS = 144;
constexpr int AT_VS = 520;
constexpr int AT_KOFF = 0, AT_VOFF = 256 * AT_KS, AT_GOFF = AT_VOFF + 64 * AT_VS;
typedef float v2f_ __attribute__((ext_vector_type(2)));
typedef __bf16 v2bf_ __attribute__((ext_vector_type(2)));
__device__ __forceinline__ unsigned cvtpk(float lo, float hi) { const v2f_ x = {lo, hi}; return __builtin_bit_cast(unsigned, __builtin_convertvector(x, v2bf_)); }
__device__ __forceinline__ void attn_phase(KP P, int l, LAS unsigned char* lds, int vcu, int G) {
    const int tid = otid(), w = __builtin_amdgcn_readfirstlane(tid >> 6), lane = tid & 63, r32 = lane & 31, h = lane >> 5;
    const bf16* proj = (const bf16*)(P->ws + WS_BIG); bf16* mixo = (bf16*)(P->ws + WS_MIXO);
    const float* gq = P->in[I_QNG] + l * 64; const float* gk = P->in[I_KNG] + l * 64; const float* sinks = P->in[I_SINK] + l * 8;
    LAS float* gqs = (LAS float*)(lds + AT_GOFF);
    constexpr float LOG2E = 1.4426950408889634f;
    __syncthreads();
    if (tid < 64) gqs[tid] = gq[tid] * (0.125f * LOG2E);
    for (int unit = vcu; unit < BATCH * 16 * 2; unit += G) {
        const int b = unit >> 5, n = (unit >> 1) & 15, kvh = unit & 1;
        __syncthreads();
        {
            const int r = tid >> 1, hf = tid & 1; const bool valid = (n > 0) || (r >= 128);
            const size_t grow = (size_t)(b * T + n * 128 - 128 + r) * NA;
            v4u kv[4], vv[4];
#pragma unroll
            for (int i = 0; i < 4; ++i) { kv[i] = (v4u){0u, 0u, 0u, 0u}; vv[i] = (v4u){0u, 0u, 0u, 0u}; }
            if (valid) {
#pragma unroll
                for (int i = 0; i < 4; ++i) { kv[i] = *(const v4u*)(proj + grow + C_AK + kvh * 64 + hf * 32 + 8 * i); vv[i] = *(const v4u*)(proj + grow + C_AV + kvh * 64 + hf * 32 + 8 * i); }
            }
            float ss = 0.f;
#pragma unroll
            for (int i = 0; i < 4; ++i)
#pragma unroll
                for (int e = 0; e < 4; ++e) { const float k0 = bflo(kv[i][e]), k1 = bfhi(kv[i][e]); ss += k0 * k0 + k1 * k1; }
            ss += __shfl_xor(ss, 1);
            const float rs = rsqrtf(ss * (1.f / 64.f) + 1e-6f);
#pragma unroll
            for (int i = 0; i < 4; ++i) { v4u o;
#pragma unroll
                for (int e = 0; e < 4; ++e) { const int d = hf * 32 + 8 * i + 2 * e; o[e] = cvtpk(bflo(kv[i][e]) * rs * gk[d], bfhi(kv[i][e]) * rs * gk[d + 1]); }
                *(LAS v4u*)(lds + AT_KOFF + r * AT_KS + hf * 64 + 16 * i) = o; }
#pragma unroll
            for (int i = 0; i < 4; ++i)
#pragma unroll
                for (int e = 0; e < 4; ++e) { const int d = hf * 32 + 8 * i + 2 * e;
                    *(LAS unsigned short*)(lds + AT_VOFF + d * AT_VS + r * 2) = (unsigned short)(vv[i][e] & 0xffffu);
                    *(LAS unsigned short*)(lds + AT_VOFF + (d + 1) * AT_VS + r * 2) = (unsigned short)(vv[i][e] >> 16); }
        }
        __syncthreads();
#pragma unroll 1
        for (int gi = 0; gi < 2; ++gi) {
            const int g = w >> 1, sb = (w & 1) * 2 + gi, hq = kvh * 4 + g;
            const size_t qrow = (size_t)(b * T + n * 128 + 32 * sb + r32);
            v4u qr[4]; float ss = 0.f;
#pragma unroll
            for (int s = 0; s < 4; ++s) { qr[s] = *(const v4u*)(proj + qrow * NA + C_AQ + hq * 64 + 8 * h + 16 * s);
#pragma unroll
                for (int e = 0; e < 4; ++e) { const float q0 = bflo(qr[s][e]), q1 = bfhi(qr[s][e]); ss += q0 * q0 + q1 * q1; } }
            ss += __shfl_xor(ss, 32);
            const float rs = rsqrtf(ss * (1.f / 64.f) + 1e-6f);
            bf16x8v Qf[4];
#pragma unroll
            for (int s = 0; s < 4; ++s) { const v4f g0 = *(const LAS v4f*)(gqs + 8 * h + 16 * s), g1 = *(const LAS v4f*)(gqs + 8 * h + 16 * s + 4); v4u o;
                o[0] = cvtpk(bflo(qr[s][0]) * rs * g0[0], bfhi(qr[s][0]) * rs * g0[1]); o[1] = cvtpk(bflo(qr[s][1]) * rs * g0[2], bfhi(qr[s][1]) * rs * g0[3]);
                o[2] = cvtpk(bflo(qr[s][2]) * rs * g1[0], bfhi(qr[s][2]) * rs * g1[1]); o[3] = cvtpk(bflo(qr[s][3]) * rs * g1[2], bfhi(qr[s][3]) * rs * g1[3]);
                Qf[s] = __builtin_bit_cast(bf16x8v, o); }
            f32x16 S[5];
#pragma unroll
            for (int c5 = 0; c5 < 5; ++c5) { f32x16 acc;
#pragma unroll
                for (int i = 0; i < 16; ++i) acc[i] = 0.f;
#pragma unroll
                for (int s = 0; s < 4; ++s) { const bf16x8v kf = *(const LAS bf16x8v*)(lds + AT_KOFF + (32 * (sb + c5) + r32) * AT_KS + (8 * h + 16 * s) * 2);
                    acc = __builtin_amdgcn_mfma_f32_32x32x16_bf16(kf, Qf[s], acc, 0, 0, 0); }
                S[c5] = acc; }
            const int qi = 32 * sb + r32; float mx = -INFINITY;
#pragma unroll
            for (int c5 = 0; c5 < 5; ++c5)
#pragma unroll
                for (int i = 0; i < 16; ++i) { const int si = 32 * (sb + c5) + 8 * (i >> 2) + 4 * h + (i & 3);
                    bool ok = true; if (c5 == 0) ok = si > qi; if (c5 == 4) ok = si <= qi + 128; if (n == 0) ok = ok && (si >= 128);
                    const float v = ok ? S[c5][i] : -INFINITY; S[c5][i] = v; mx = fmaxf(mx, v); }
            mx = fmaxf(mx, __shfl_xor(mx, 32));
            const float sink = sinks[hq] * LOG2E; mx = fmaxf(mx, sink);
            float sum = 0.f;
#pragma unroll
            for (int c5 = 0; c5 < 5; ++c5)
#pragma unroll
                for (int i = 0; i < 16; ++i) { const float p = __builtin_amdgcn_exp2f(S[c5][i] - mx); S[c5][i] = p; sum += p; }
            sum += __shfl_xor(sum, 32);
            const float inv = 1.0f / (sum + __builtin_amdgcn_exp2f(sink - mx));
            f32x16 O[2];
#pragma unroll
            for (int dt = 0; dt < 2; ++dt)
#pragma unroll
                for (int i = 0; i < 16; ++i) O[dt][i] = 0.f;
#pragma unroll
            for (int c5 = 0; c5 < 5; ++c5)
#pragma unroll
                for (int s = 0; s < 2; ++s) { v4u pw; pw[0] = cvtpk(S[c5][8 * s], S[c5][8 * s + 1]); pw[1] = cvtpk(S[c5][8 * s + 2], S[c5][8 * s + 3]); pw[2] = cvtpk(S[c5][8 * s + 4], S[c5][8 * s + 5]); pw[3] = cvtpk(S[c5][8 * s + 6], S[c5][8 * s + 7]);
                    const bf16x8v pf = __builtin_bit_cast(bf16x8v, pw);
#pragma unroll
                    for (int dt = 0; dt < 2; ++dt) { const LAS unsigned char* vp = lds + AT_VOFF + (32 * dt + r32) * AT_VS + (32 * (sb + c5) + 16 * s + 4 * h) * 2;
                        const v2u lo = *(const LAS v2u*)vp, hi = *(const LAS v2u*)(vp + 16); v4u vw; vw[0] = lo[0]; vw[1] = lo[1]; vw[2] = hi[0]; vw[3] = hi[1];
                        O[dt] = __builtin_amdgcn_mfma_f32_32x32x16_bf16(__builtin_bit_cast(bf16x8v, vw), pf, O[dt], 0, 0, 0); } }
#pragma unroll
            for (int dt = 0; dt < 2; ++dt)
#pragma unroll
                for (int q4 = 0; q4 < 4; ++q4) { v2u o; o[0] = cvtpk(O[dt][4 * q4] * inv, O[dt][4 * q4 + 1] * inv); o[1] = cvtpk(O[dt][4 * q4 + 2] * inv, O[dt][4 * q4 + 3] * inv);
                    *(v2u*)(mixo + qrow * NMIX + hq * 64 + 32 * dt + 8 * q4 + 4 * h) = o; }
        }
    }
    __syncthreads();
}

constexpr int RT_KS = 144, RT_TS = 264;
constexpr int RT_KOFF = 0, RT_KTOFF = 128 * RT_KS, RT_VTOFF = RT_KTOFF + 64 * RT_TS, RT_ROFF = RT_VTOFF + 64 * RT_TS, RT_SOFF = RT_ROFF + 64 * RT_KS, RT_END = RT_SOFF + 1024;
__device__ __forceinline__ void ret_unit(KP P, LAS unsigned char* lds, int b, int hh) {
    const int tid = otid(), w = __builtin_amdgcn_readfirstlane(tid >> 6), lane = tid & 63, r32 = lane & 31, h = lane >> 5;
    const bf16* proj = (const bf16*)(P->ws + WS_BIG); bf16* mixo = (bf16*)(P->ws + WS_MIXO); const float* rope = (const float*)(P->ws + WS_ROPE);
    const float lg = log2f(1.0f - exp2f(-5.0f - (float)hh));
    const float g128 = exp2f(128.0f * lg);
    const int qg = w >> 1, dt = w & 1;
    f32x16 Racc;
#pragma unroll
    for (int i = 0; i < 16; ++i) Racc[i] = 0.f;
    __syncthreads();
    for (int i = tid; i < 64 * RT_KS / 4; i += 512) ((LAS unsigned*)(lds + RT_ROFF))[i] = 0u;
#pragma unroll 1
    for (int n = 0; n < 16; ++n) {
        const size_t tok0 = (size_t)(b * T + n * 128);
        __syncthreads();
        {
            const int row = tid >> 2, p = tid & 3, pos = n * 128 + row; const size_t g = (tok0 + row) * NA;
            const v4u k1 = *(const v4u*)(proj + g + C_RK + hh * 64 + 8 * p), k2 = *(const v4u*)(proj + g + C_RK + hh * 64 + 32 + 8 * p);
            const v4u v1 = *(const v4u*)(proj + g + C_RV + hh * 64 + 8 * p), v2 = *(const v4u*)(proj + g + C_RV + hh * 64 + 32 + 8 * p);
            const v4f* rp = (const v4f*)(rope + ((size_t)pos * 32 + 8 * p) * 2);
            const float sc = 0.125f * exp2f(-(float)(row + 1) * lg);
            float o1[8], o2[8];
#pragma unroll
            for (int e = 0; e < 4; ++e) { const v4f cs = rp[e];
                const float a1 = bflo(k1[e]), a2 = bflo(k2[e]), b1 = bfhi(k1[e]), b2 = bfhi(k2[e]);
                o1[2 * e] = (a1 * cs[0] - a2 * cs[1]) * sc; o2[2 * e] = (a2 * cs[0] + a1 * cs[1]) * sc;
                o1[2 * e + 1] = (b1 * cs[2] - b2 * cs[3]) * sc; o2[2 * e + 1] = (b2 * cs[2] + b1 * cs[3]) * sc; }
            v4u w1, w2;
#pragma unroll
            for (int e = 0; e < 4; ++e) { w1[e] = cvtpk(o1[2 * e], o1[2 * e + 1]); w2[e] = cvtpk(o2[2 * e], o2[2 * e + 1]); }
            *(LAS v4u*)(lds + RT_KOFF + row * RT_KS + 16 * p) = w1; *(LAS v4u*)(lds + RT_KOFF + row * RT_KS + 64 + 16 * p) = w2;
#pragma unroll
            for (int e = 0; e < 4; ++e) { const int d = 8 * p + 2 * e;
                *(LAS unsigned short*)(lds + RT_KTOFF + d * RT_TS + row * 2) = (unsigned short)(w1[e] & 0xffffu); *(LAS unsigned short*)(lds + RT_KTOFF + (d + 1) * RT_TS + row * 2) = (unsigned short)(w1[e] >> 16);
                *(LAS unsigned short*)(lds + RT_KTOFF + (d + 32) * RT_TS + row * 2) = (unsigned short)(w2[e] & 0xffffu); *(LAS unsigned short*)(lds + RT_KTOFF + (d + 33) * RT_TS + row * 2) = (unsigned short)(w2[e] >> 16);
                *(LAS unsigned short*)(lds + RT_VTOFF + d * RT_TS + row * 2) = (unsigned short)(v1[e] & 0xffffu); *(LAS unsigned short*)(lds + RT_VTOFF + (d + 1) * RT_TS + row * 2) = (unsigned short)(v1[e] >> 16);
                *(LAS unsigned short*)(lds + RT_VTOFF + (d + 32) * RT_TS + row * 2) = (unsigned short)(v2[e] & 0xffffu); *(LAS unsigned short*)(lds + RT_VTOFF + (d + 33) * RT_TS + row * 2) = (unsigned short)(v2[e] >> 16); }
        }
        bf16x8v Qf[4];
        const size_t qtok = tok0 + 32 * qg + r32; const int qpos = n * 128 + 32 * qg + r32;
        {   v4u qr[4];
#pragma unroll
            for (int s = 0; s < 4; ++s) qr[s] = *(const v4u*)(proj + qtok * NA + C_RQ + hh * 64 + 8 * h + 16 * s);
            v4u qo[4];
#pragma unroll
            for (int s = 0; s < 2; ++s) { const v4f* rp = (const v4f*)(rope + ((size_t)qpos * 32 + 8 * h + 16 * s) * 2);
#pragma unroll
                for (int e = 0; e < 4; ++e) { const v4f cs = rp[e];
                    const float a1 = bflo(qr[s][e]), a2 = bflo(qr[s + 2][e]), b1 = bfhi(qr[s][e]), b2 = bfhi(qr[s + 2][e]);
                    qo[s][e] = cvtpk(a1 * cs[0] - a2 * cs[1], b1 * cs[2] - b2 * cs[3]); qo[s + 2][e] = cvtpk(a2 * cs[0] + a1 * cs[1], b2 * cs[2] + b1 * cs[3]); } }
#pragma unroll
            for (int s = 0; s < 4; ++s) Qf[s] = __builtin_bit_cast(bf16x8v, qo[s]);
        }
        __syncthreads();
        f32x16 O;
#pragma unroll
        for (int i = 0; i < 16; ++i) O[i] = 0.f;
#pragma unroll
        for (int s = 0; s < 4; ++s) { const bf16x8v rf = *(const LAS bf16x8v*)(lds + RT_ROFF + (32 * dt + r32) * RT_KS + (8 * h + 16 * s) * 2);
            O = __builtin_amdgcn_mfma_f32_32x32x16_bf16(rf, Qf[s], O, 0, 0, 0); }
#pragma unroll
        for (int c = 0; c < 4; ++c) { if (c <= qg) {
            f32x16 S;
#pragma unroll
            for (int i = 0; i < 16; ++i) S[i] = 0.f;
#pragma unroll
            for (int s = 0; s < 4; ++s) { const bf16x8v kf = *(const LAS bf16x8v*)(lds + RT_KOFF + (32 * c + r32) * RT_KS + (8 * h + 16 * s) * 2);
                S = __builtin_amdgcn_mfma_f32_32x32x16_bf16(kf, Qf[s], S, 0, 0, 0); }
            if (c == qg) {
#pragma unroll
                for (int i = 0; i < 16; ++i) { const int j = 8 * (i >> 2) + 4 * h + (i & 3); S[i] = (j <= r32) ? S[i] : 0.f; } }
#pragma unroll
            for (int s = 0; s < 2; ++s) { v4u pw; pw[0] = cvtpk(S[8 * s], S[8 * s + 1]); pw[1] = cvtpk(S[8 * s + 2], S[8 * s + 3]); pw[2] = cvtpk(S[8 * s + 4], S[8 * s + 5]); pw[3] = cvtpk(S[8 * s + 6], S[8 * s + 7]);
                const LAS unsigned char* vp = lds + RT_VTOFF + (32 * dt + r32) * RT_TS + (32 * c + 16 * s + 4 * h) * 2;
                const v2u lo = *(const LAS v2u*)vp, hi = *(const LAS v2u*)(vp + 16); v4u vw; vw[0] = lo[0]; vw[1] = lo[1]; vw[2] = hi[0]; vw[3] = hi[1];
                O = __builtin_amdgcn_mfma_f32_32x32x16_bf16(__builtin_bit_cast(bf16x8v, vw), __builtin_bit_cast(bf16x8v, pw), O, 0, 0, 0); } } }
        if (w < 4) { const int et = w >> 1, dtile = w & 1;
#pragma unroll
            for (int s = 0; s < 8; ++s) { const bf16x8v vf = *(const LAS bf16x8v*)(lds + RT_VTOFF + (32 * et + r32) * RT_TS + (16 * s + 8 * h) * 2);
                const bf16x8v kf = *(const LAS bf16x8v*)(lds + RT_KTOFF + (32 * dtile + r32) * RT_TS + (16 * s + 8 * h) * 2);
                Racc = __builtin_amdgcn_mfma_f32_32x32x16_bf16(vf, kf, Racc, 0, 0, 0); }
#pragma unroll
            for (int i = 0; i < 16; ++i) Racc[i] *= g128; }
        const float xi = exp2f((float)(32 * qg + r32 + 1) * lg); float ss = 0.f;
#pragma unroll
        for (int i = 0; i < 16; ++i) { O[i] *= xi; ss += O[i] * O[i]; }
        ss += __shfl_xor(ss, 32);
        LAS float* ssb = (LAS float*)(lds + RT_SOFF);
        if (h == 0) ssb[(qg * 2 + dt) * 32 + r32] = ss;
        __syncthreads();
        const float rstd = rsqrtf((ss + ssb[(qg * 2 + (dt ^ 1)) * 32 + r32]) * (1.f / 64.f) + 1e-6f);
        if (w < 4) { const int et = w >> 1, dtile = w & 1;
#pragma unroll
            for (int i = 0; i < 16; ++i) { const int e = 32 * et + 8 * (i >> 2) + 4 * h + (i & 3); *(LAS unsigned short*)(lds + RT_ROFF + e * RT_KS + (32 * dtile + r32) * 2) = (unsigned short)f2bf(Racc[i]); } }
#pragma unroll
        for (int q4 = 0; q4 < 4; ++q4) { const int e0 = 32 * dt + 8 * q4 + 4 * h; const v2u gw = *(const v2u*)(proj + qtok * NA + C_RG + hh * 64 + e0);
            const float g0 = bflo(gw[0]), g1 = bfhi(gw[0]), g2 = bflo(gw[1]), g3 = bfhi(gw[1]);
            v2u o; o[0] = cvtpk(O[4 * q4] * rstd * g0 / (1.0f + __expf(-g0)), O[4 * q4 + 1] * rstd * g1 / (1.0f + __expf(-g1)));
            o[1] = cvtpk(O[4 * q4 + 2] * rstd * g2 / (1.0f + __expf(-g2)), O[4 * q4 + 3] * rstd * g3 / (1.0f + __expf(-g3)));
            *(v2u*)(mixo + qtok * NMIX + 1024 + hh * 64 + e0) = o; }
    }
    __syncthreads();
}
__device__ __forceinline__ void ret_phase(KP P, LAS unsigned char* lds, int vcu, int G) {
    for (int unit = vcu; unit < BATCH * 8; unit += G) ret_unit(P, lds, unit >> 3, unit & 7);
}

template <int CTRL> __device__ __forceinline__ float dppf(float x) { return __builtin_bit_cast(float, __builtin_amdgcn_mov_dpp(__builtin_bit_cast(int, x), CTRL, 0xf, 0xf, true)); }
constexpr int DPP_X1 = 0xB1, DPP_X2 = 0x4E, DPP_X7 = 0x141, DPP_X8 = 0x128;
__device__ __forceinline__ float sum8(float x) { x += dppf<DPP_X1>(x); x += dppf<DPP_X2>(x); x += dppf<DPP_X7>(x); return x; }
__device__ __forceinline__ float sum16(float x) { x = sum8(x); x += dppf<DPP_X8>(x); return x; }
#define PROBE_SCAN2 0
constexpr int RS_TT = 32;
constexpr int RS_W2T = 0, RS_A2T = 9216, RS_G2T = 18432, RS_XW = 35840, RS_XA = RS_XW + RS_TT * 144, RS_XG = RS_XA + RS_TT * 144, RS_F0 = RS_XG + RS_TT * 272;
constexpr int RS_FA = RS_TT * 64 * 4;
constexpr int RS_ZR = RS_F0, RS_ZK = RS_F0 + RS_FA, RS_ZV = RS_F0 + 2 * RS_FA, RS_WL = RS_F0 + 3 * RS_FA, RS_AL = RS_F0 + 4 * RS_FA, RS_GL = RS_F0 + 5 * RS_FA, RS_AV = RS_F0 + 6 * RS_FA, RS_YS = RS_F0 + 7 * RS_FA, RS_BS = RS_F0 + 8 * RS_FA;
constexpr int RS_MU = RS_BS + RS_TT * 4, RS_CST = RS_MU + 448 * 4;
static_assert(RS_CST + 7 * 256 <= 131072, "rwkv LDS");
constexpr int RS_NP = (RS_TT * 56 + 511) / 512;
typedef float v2f __attribute__((ext_vector_type(2)));
__device__ __forceinline__ void rwkv_unit(KP P, int l, LAS unsigned char* lds, int b, int hh) {
    const int tid = otid(), w = __builtin_amdgcn_readfirstlane(tid >> 6), lane = tid & 63, r32 = lane & 31, h2 = lane >> 5;
    const bf16* proj = (const bf16*)(P->ws + WS_BIG); bf16* mixo = (bf16*)(P->ws + WS_MIXO);
    const float* mu = P->in[I_MU] + l * RWC; const float* w0 = P->in[I_W0] + l * 512 + hh * 64; const float* a0 = P->in[I_A0] + l * 512 + hh * 64;
    const float* kkw = P->in[I_KK] + l * 512 + hh * 64; const float* kaw = P->in[I_KA] + l * 512 + hh * 64; const float* rkw = P->in[I_RK] + l * 512 + hh * 64;
    const float* lng = P->in[I_LNG] + l * 512 + hh * 64; const float* lnb = P->in[I_LNB] + l * 512 + hh * 64;
    __syncthreads();
    for (int i = tid; i < 64 * 64; i += 512) { const int c = i >> 6, j = i & 63;
        *(LAS unsigned short*)(lds + RS_W2T + j * 144 + c * 2) = (unsigned short)f2bf(P->in[I_W2][(size_t)l * 64 * 512 + c * 512 + hh * 64 + j]);
        *(LAS unsigned short*)(lds + RS_A2T + j * 144 + c * 2) = (unsigned short)f2bf(P->in[I_A2][(size_t)l * 64 * 512 + c * 512 + hh * 64 + j]); }
    for (int i = tid; i < 128 * 64; i += 512) { const int c = i >> 6, j = i & 63;
        *(LAS unsigned short*)(lds + RS_G2T + j * 272 + c * 2) = (unsigned short)f2bf(P->in[I_G2][(size_t)l * 128 * 512 + c * 512 + hh * 64 + j]); }
    for (int i = tid; i < 448; i += 512) { const int p = i >> 3, e = i & 7; int col; if (p < 24) col = (p >> 3) * 512 + hh * 64 + (p & 7) * 8; else col = 1536 + (p - 24) * 8; ((LAS float*)(lds + RS_MU))[i] = mu[col + e]; }
    if (tid < 448) { const int a = tid >> 6, j = tid & 63; const float* src = a == 0 ? w0 : a == 1 ? a0 : a == 2 ? kkw : a == 3 ? kaw : a == 4 ? rkw : a == 5 ? lng : lnb; ((LAS float*)(lds + RS_CST))[tid] = src[j]; }
    v2f S2[4];
#pragma unroll
    for (int i = 0; i < 4; ++i) S2[i] = (v2f){0.f, 0.f};
    v4u pc[RS_NP], pp[RS_NP];
#define RS_LOADPIECES(T0) do { _Pragma("unroll") for (int it = 0; it < RS_NP; ++it) { const int idx = tid + it * 512; pc[it] = (v4u){0u, 0u, 0u, 0u}; pp[it] = (v4u){0u, 0u, 0u, 0u}; \
        if (idx < RS_TT * 56) { const int p = idx / RS_TT, tt = idx % RS_TT, t = (T0) + tt; int col; if (p < 24) col = (p >> 3) * 512 + hh * 64 + (p & 7) * 8; else col = 1536 + (p - 24) * 8; \
            const size_t g = (size_t)(b * T + t) * NA + C_RW + col; pc[it] = *(const v4u*)(proj + g); if (t > 0) pp[it] = *(const v4u*)(proj + g - NA); } } } while (0)
    RS_LOADPIECES(0);
#pragma unroll 1
    for (int t0 = 0; t0 < T; t0 += RS_TT) {
        __syncthreads();
#pragma unroll
        for (int it = 0; it < RS_NP; ++it) { const int idx = tid + it * 512; if (idx < RS_TT * 56) { const int p = idx / RS_TT, tt = idx % RS_TT;
            const v4u hc = pc[it], hp = pp[it];
            const v4f m0 = *(const LAS v4f*)(lds + RS_MU + p * 32), m1 = *(const LAS v4f*)(lds + RS_MU + p * 32 + 16);
            float z[8];
#pragma unroll
            for (int e = 0; e < 4; ++e) { const float c0 = bflo(hc[e]), c1 = bfhi(hc[e]), p0 = bflo(hp[e]), p1 = bfhi(hp[e]); const float ma = e < 2 ? m0[2 * e] : m1[2 * e - 4], mb = e < 2 ? m0[2 * e + 1] : m1[2 * e - 3];
                z[2 * e] = c0 + ma * (p0 - c0); z[2 * e + 1] = c1 + mb * (p1 - c1); }
            if (p < 24) { LAS float* dst = (LAS float*)(lds + (p < 8 ? RS_ZR : (p < 16 ? RS_ZK : RS_ZV)) + (tt * 64 + (p & 7) * 8) * 4);
                *(LAS v4f*)dst = (v4f){z[0], z[1], z[2], z[3]}; *(LAS v4f*)(dst + 4) = (v4f){z[4], z[5], z[6], z[7]}; }
            else { v4u o;
                if (p < 32) {
#pragma unroll
                    for (int e = 0; e < 4; ++e) o[e] = cvtpk(1.0f - 2.0f * __builtin_amdgcn_rcpf(1.0f + __expf(2.0f * z[2 * e])), 1.0f - 2.0f * __builtin_amdgcn_rcpf(1.0f + __expf(2.0f * z[2 * e + 1])));
                    *(LAS v4u*)(lds + RS_XW + tt * 144 + (p - 24) * 16) = o; }
                else if (p < 40) {
#pragma unroll
                    for (int e = 0; e < 4; ++e) o[e] = cvtpk(z[2 * e], z[2 * e + 1]);
                    *(LAS v4u*)(lds + RS_XA + tt * 144 + (p - 32) * 16) = o; }
                else {
#pragma unroll
                    for (int e = 0; e < 4; ++e) o[e] = cvtpk(__builtin_amdgcn_rcpf(1.0f + __expf(-z[2 * e])), __builtin_amdgcn_rcpf(1.0f + __expf(-z[2 * e + 1])));
                    *(LAS v4u*)(lds + RS_XG + tt * 272 + (p - 40) * 16) = o; } }
        } }
        __syncthreads();
        if (w < 6) { const int which = w >> 1, jt = w & 1; f32x16 acc;
#pragma unroll
            for (int i = 0; i < 16; ++i) acc[i] = 0.f;
            if (which < 2) { const int wo = which == 0 ? RS_W2T : RS_A2T, xo = which == 0 ? RS_XW : RS_XA;
#pragma unroll
                for (int s = 0; s < 4; ++s) { const bf16x8v af = *(const LAS bf16x8v*)(lds + wo + (32 * jt + r32) * 144 + (16 * s + 8 * h2) * 2), bfr = *(const LAS bf16x8v*)(lds + xo + r32 * 144 + (16 * s + 8 * h2) * 2);
                    acc = __builtin_amdgcn_mfma_f32_32x32x16_bf16(af, bfr, acc, 0, 0, 0); } }
            else {
#pragma unroll
                for (int s = 0; s < 8; ++s) { const bf16x8v af = *(const LAS bf16x8v*)(lds + RS_G2T + (32 * jt + r32) * 272 + (16 * s + 8 * h2) * 2), bfr = *(const LAS bf16x8v*)(lds + RS_XG + r32 * 272 + (16 * s + 8 * h2) * 2);
                    acc = __builtin_amdgcn_mfma_f32_32x32x16_bf16(af, bfr, acc, 0, 0, 0); } }
            const int oo = which == 0 ? RS_WL : (which == 1 ? RS_AL : RS_GL);
#pragma unroll
            for (int q4 = 0; q4 < 4; ++q4) *(LAS v4f*)(lds + oo + (r32 * 64 + 32 * jt + 8 * q4 + 4 * h2) * 4) = (v4f){acc[4 * q4], acc[4 * q4 + 1], acc[4 * q4 + 2], acc[4 * q4 + 3]}; }
        __syncthreads();
        { const int tt = tid >> 4, j0 = (tid & 15) * 4; const int o4 = (tt * 64 + j0) * 4;
          const v4f wl = *(const LAS v4f*)(lds + RS_WL + o4), al = *(const LAS v4f*)(lds + RS_AL + o4), zk = *(const LAS v4f*)(lds + RS_ZK + o4), zr = *(const LAS v4f*)(lds + RS_ZR + o4);
          const v4f w0v = *(const LAS v4f*)(lds + RS_CST + j0 * 4), a0v = *(const LAS v4f*)(lds + RS_CST + 256 + j0 * 4), kkv = *(const LAS v4f*)(lds + RS_CST + 512 + j0 * 4), kav = *(const LAS v4f*)(lds + RS_CST + 768 + j0 * 4), rkv = *(const LAS v4f*)(lds + RS_CST + 1024 + j0 * 4);
          v4f dcy, alp, kk0, km; float ssq = 0.f, bsum = 0.f;
#pragma unroll
          for (int e = 0; e < 4; ++e) { const float x = -(wl[e] + w0v[e]); const float sp = fmaxf(x, 0.f) + __logf(1.0f + __expf(-fabsf(x)));
              dcy[e] = __expf(-__expf(-sp - 0.5f)); alp[e] = __builtin_amdgcn_rcpf(1.0f + __expf(-(al[e] + a0v[e])));
              kk0[e] = zk[e] * kkv[e]; ssq += kk0[e] * kk0[e]; km[e] = zk[e] * (1.0f + (alp[e] - 1.0f) * kav[e]); bsum += zr[e] * km[e] * rkv[e]; }
          ssq = sum16(ssq); bsum = sum16(bsum);
          const float inv = __builtin_amdgcn_rcpf(fmaxf(__builtin_amdgcn_sqrtf(ssq), 1e-12f));
          v4f avv, bvv;
#pragma unroll
          for (int e = 0; e < 4; ++e) { const float kk = kk0[e] * inv; avv[e] = -kk; bvv[e] = kk * alp[e]; }
          *(LAS v4f*)(lds + RS_WL + o4) = dcy; *(LAS v4f*)(lds + RS_AL + o4) = bvv; *(LAS v4f*)(lds + RS_AV + o4) = avv; *(LAS v4f*)(lds + RS_ZK + o4) = km;
          if ((tid & 15) == 0) *(LAS float*)(lds + RS_BS + tt * 4) = bsum; }
        __syncthreads();
        if (t0 + RS_TT < T) RS_LOADPIECES(t0 + RS_TT);
#if PROBE_SCAN2
        v2f Ssave[4];
#pragma unroll
        for (int i = 0; i < 4; ++i) Ssave[i] = S2[i];
        for (int rep_ = 0; rep_ < 2; ++rep_) { if (rep_ == 1) {
#pragma unroll
            for (int i = 0; i < 4; ++i) S2[i] = Ssave[i]; }
#endif
        { const int v_ = tid >> 3, ks = tid & 7; LAS unsigned char* sb = lds + ks * 32; LAS unsigned char* vb = lds + RS_ZV + v_ * 4; LAS unsigned char* yb = lds + RS_YS + v_ * 4;
#pragma unroll
          for (int tt = 0; tt < RS_TT; ++tt) { const int o8 = tt * 256;
              const v4f a0_ = *(const LAS v4f*)(sb + RS_AV + o8), a1_ = *(const LAS v4f*)(sb + RS_AV + o8 + 16);
              const v4f d0_ = *(const LAS v4f*)(sb + RS_WL + o8), d1_ = *(const LAS v4f*)(sb + RS_WL + o8 + 16);
              const v4f b0_ = *(const LAS v4f*)(sb + RS_AL + o8), b1_ = *(const LAS v4f*)(sb + RS_AL + o8 + 16);
              const v4f k0_ = *(const LAS v4f*)(sb + RS_ZK + o8), k1_ = *(const LAS v4f*)(sb + RS_ZK + o8 + 16);
              const v4f r0_ = *(const LAS v4f*)(sb + RS_ZR + o8), r1_ = *(const LAS v4f*)(sb + RS_ZR + o8 + 16);
              const float vv = *(const LAS float*)(vb + o8);
              v2f ac = S2[0] * a0_.xy; ac = __builtin_elementwise_fma(S2[1], a0_.zw, ac); ac = __builtin_elementwise_fma(S2[2], a1_.xy, ac); ac = __builtin_elementwise_fma(S2[3], a1_.zw, ac);
              const float sa = sum8(ac.x + ac.y); const v2f sa2 = (v2f){sa, sa}, vv2 = (v2f){vv, vv};
              S2[0] = __builtin_elementwise_fma(S2[0], d0_.xy, __builtin_elementwise_fma(k0_.xy, vv2, b0_.xy * sa2));
              S2[1] = __builtin_elementwise_fma(S2[1], d0_.zw, __builtin_elementwise_fma(k0_.zw, vv2, b0_.zw * sa2));
              S2[2] = __builtin_elementwise_fma(S2[2], d1_.xy, __builtin_elementwise_fma(k1_.xy, vv2, b1_.xy * sa2));
              S2[3] = __builtin_elementwise_fma(S2[3], d1_.zw, __builtin_elementwise_fma(k1_.zw, vv2, b1_.zw * sa2));
              v2f yc = S2[0] * r0_.xy; yc = __builtin_elementwise_fma(S2[1], r0_.zw, yc); yc = __builtin_elementwise_fma(S2[2], r1_.xy, yc); yc = __builtin_elementwise_fma(S2[3], r1_.zw, yc);
              const float y = sum8(yc.x + yc.y);
              if (ks == 0) *(LAS float*)(yb + o8) = y; } }
#if PROBE_SCAN2
        }
#endif
        __syncthreads();
        { const int tt = tid >> 4, v0 = (tid & 15) * 4; const int o4 = (tt * 64 + v0) * 4;
          const v4f y4 = *(const LAS v4f*)(lds + RS_YS + o4), zv = *(const LAS v4f*)(lds + RS_ZV + o4), gl = *(const LAS v4f*)(lds + RS_GL + o4);
          const float mean = sum16((y4[0] + y4[1]) + (y4[2] + y4[3])) * (1.f / 64.f);
          const v4f d = y4 - mean; const float var = sum16((d[0] * d[0] + d[1] * d[1]) + (d[2] * d[2] + d[3] * d[3])) * (1.f / 64.f);
          const float rstd = rsqrtf(var + 64e-5f), bs = *(const LAS float*)(lds + RS_BS + tt * 4);
          const v4f lg4 = *(const LAS v4f*)(lds + RS_CST + 1280 + v0 * 4), lb4 = *(const LAS v4f*)(lds + RS_CST + 1536 + v0 * 4);
          float o[4];
#pragma unroll
          for (int e = 0; e < 4; ++e) o[e] = (d[e] * rstd * lg4[e] + lb4[e] + bs * zv[e]) * gl[e];
          v2u ow; ow[0] = cvtpk(o[0], o[1]); ow[1] = cvtpk(o[2], o[3]);
          *(v2u*)(mixo + (size_t)(b * T + t0 + tt) * NMIX + 512 + hh * 64 + v0) = ow; }
    }
    __syncthreads();
#undef RS_LOADPIECES
}
__device__ __forceinline__ void rwkv_phase(KP P, int l, LAS unsigned char* lds, int vcu, int G) {
    for (int unit = vcu; unit < BATCH * 8; unit += G) rwkv_unit(P, l, lds, unit >> 3, unit & 7);
}

constexpr int RC_SL = 9216;
constexpr int RC_A = 0 * RC_SL, RC_B = 1 * RC_SL, RC_K = 2 * RC_SL, RC_R = 3 * RC_SL, RC_V = 4 * RC_SL, RC_G = 5 * RC_SL, RC_S = 6 * RC_SL;
constexpr int RC_XW = 7 * RC_SL, RC_XA = 8 * RC_SL, RC_XG = 9 * RC_SL, RC_WL = 11 * RC_SL, RC_AL = 13 * RC_SL, RC_LW = 14 * RC_SL;
constexpr int RC_DINV = RC_B, RC_DINVT = RC_K, RC_NT = RC_V, RC_P = RC_V, RC_UT = RC_V, RC_BHT = RC_XW, RC_KHT = RC_XA, RC_VT = 9 * RC_SL, RC_LAB = 10 * RC_SL, RC_N = RC_LAB, RC_TINV = RC_LAB;
constexpr int RC_LABT = 11 * RC_SL, RC_N2 = RC_LABT, RC_RHST = RC_LABT, RC_LAK = 12 * RC_SL, RC_MRB = 13 * RC_SL, RC_MRK = RC_LW;
constexpr int RC_SM = RC_LW + 16384, RC_BS = RC_SM, RC_GC = RC_SM + 256, RC_PT = RC_SM + 512, RC_SSB = RC_PT + 2048, RC_DIAG = RC_SSB + 1024, RC_MU = RC_DIAG + 4096, RC_CST = RC_MU + 1792, RC_END = RC_CST + 1792;
static_assert(RC_END <= 156928, "chunked rwkv LDS");
template <int KSTEPS, int SA = 144, int SB = 144> __device__ __forceinline__ f32x16 rc_mm(f32x16 acc, const LAS unsigned char* A, int arow0, const LAS unsigned char* B, int brow0, int r32, int h, int kofs = 0) {
#pragma unroll
    for (int s = 0; s < KSTEPS; ++s) { const bf16x8v af = *(const LAS bf16x8v*)(A + (arow0 + r32) * SA + (kofs + 16 * s + 8 * h) * 2), bfr = *(const LAS bf16x8v*)(B + (brow0 + r32) * SB + (kofs + 16 * s + 8 * h) * 2);
        acc = __builtin_amdgcn_mfma_f32_32x32x16_bf16(af, bfr, acc, 0, 0, 0); }
    return acc;
}
__device__ __forceinline__ f32x16 rc_zero() { f32x16 z;
#pragma unroll
    for (int i = 0; i < 16; ++i) z[i] = 0.f;
    return z; }
__device__ __forceinline__ void rc_store_t(const f32x16& d, LAS unsigned char* O, int arow0, int brow0, int r32, int h) {
#pragma unroll
    for (int q4 = 0; q4 < 4; ++q4) { v2u o; o[0] = cvtpk(d[4 * q4], d[4 * q4 + 1]); o[1] = cvtpk(d[4 * q4 + 2], d[4 * q4 + 3]); *(LAS v2u*)(O + (brow0 + r32) * 144 + (arow0 + 8 * q4 + 4 * h) * 2) = o; }
}
__device__ __forceinline__ void rwkvc_unit(KP P, int l, LAS unsigned char* lds, int b, int hh) {
    const int tid = otid(), w = __builtin_amdgcn_readfirstlane(tid >> 6), lane = tid & 63, r32 = lane & 31, h = lane >> 5;
    const bf16* proj = (const bf16*)(P->ws + WS_BIG); bf16* mixo = (bf16*)(P->ws + WS_MIXO);
    const float* mu = P->in[I_MU] + l * RWC; const float* w0 = P->in[I_W0] + l * 512 + hh * 64; const float* a0 = P->in[I_A0] + l * 512 + hh * 64;
    const float* kkw = P->in[I_KK] + l * 512 + hh * 64; const float* kaw = P->in[I_KA] + l * 512 + hh * 64; const float* rkw = P->in[I_RK] + l * 512 + hh * 64;
    const float* lng = P->in[I_LNG] + l * 512 + hh * 64; const float* lnb = P->in[I_LNB] + l * 512 + hh * 64;
    __syncthreads();
    for (int i = tid; i < 448; i += 512) { const int p = i >> 3, e = i & 7; int col; if (p < 24) col = (p >> 3) * 512 + hh * 64 + (p & 7) * 8; else col = 1536 + (p - 24) * 8; ((LAS float*)(lds + RC_MU))[i] = mu[col + e]; }
    if (tid < 448) { const int a = tid >> 6, j = tid & 63; const float* src = a == 0 ? w0 : a == 1 ? a0 : a == 2 ? kkw : a == 3 ? kaw : a == 4 ? rkw : a == 5 ? lng : lnb; ((LAS float*)(lds + RC_CST))[tid] = src[j]; }
    bf16x8v wf[8];
    { const int jt = w & 1, j = hh * 64 + 32 * jt + r32;
#pragma unroll
      for (int s = 0; s < 8; ++s) { unsigned short e[8];
#pragma unroll
          for (int i = 0; i < 8; ++i) { float x; if (w < 4) { const int c = 16 * (s & 3) + 8 * h + i; x = (s < 4 ? P->in[I_W2] : P->in[I_A2])[(size_t)l * 64 * 512 + c * 512 + j]; } else { const int c = 16 * s + 8 * h + i; x = P->in[I_G2][(size_t)l * 128 * 512 + c * 512 + j]; }
              e[i] = (unsigned short)f2bf(x); }
          v4u pk; pk[0] = e[0] | ((unsigned)e[1] << 16); pk[1] = e[2] | ((unsigned)e[3] << 16); pk[2] = e[4] | ((unsigned)e[5] << 16); pk[3] = e[6] | ((unsigned)e[7] << 16);
          wf[s] = __builtin_bit_cast(bf16x8v, pk); } }
    f32x16 Sacc = rc_zero();
    v4u pc[7], pp[7];
#define RC_LOADPIECES(T0) do { _Pragma("unroll") for (int it = 0; it < 7; ++it) { const int idx = tid + it * 512; const int p = idx >> 6, tt = idx & 63, t = (T0) + tt; int col; if (p < 24) col = (p >> 3) * 512 + hh * 64 + (p & 7) * 8; else col = 1536 + (p - 24) * 8; \
        const size_t g = (size_t)(b * T + t) * NA + C_RW + col; pc[it] = *(const v4u*)(proj + g); pp[it] = (v4u){0u, 0u, 0u, 0u}; if (t > 0) pp[it] = *(const v4u*)(proj + g - NA); } } while (0)
    RC_LOADPIECES(0);
#pragma unroll 1
    for (int t0 = 0; t0 < T; t0 += 64) {
        f32x16 xacc, yacc;
        __syncthreads();
        { const int tid = otid(), w = __builtin_amdgcn_readfirstlane(tid >> 6), lane = tid & 63, r32 = lane & 31, h = lane >> 5; (void)w; (void)lane; (void)r32; (void)h;
        if (w < 4) rc_store_t(Sacc, lds + RC_S, 32 * (w >> 1), 32 * (w & 1), r32, h);
#pragma unroll
        for (int it = 0; it < 7; ++it) { const int idx = tid + it * 512; const int p = idx >> 6, tt = idx & 63;
            const v4u hc = pc[it], hp = pp[it];
            const v4f m0 = *(const LAS v4f*)(lds + RC_MU + p * 32), m1 = *(const LAS v4f*)(lds + RC_MU + p * 32 + 16);
            float z[8];
#pragma unroll
            for (int e = 0; e < 4; ++e) { const float c0 = bflo(hc[e]), c1 = bfhi(hc[e]), p0 = bflo(hp[e]), p1 = bfhi(hp[e]); const float ma = e < 2 ? m0[2 * e] : m1[2 * e - 4], mb = e < 2 ? m0[2 * e + 1] : m1[2 * e - 3];
                z[2 * e] = c0 + ma * (p0 - c0); z[2 * e + 1] = c1 + mb * (p1 - c1); }
            v4u o; int dst;
            if (p < 24) { dst = (p < 8 ? RC_R : (p < 16 ? RC_K : RC_V)) + tt * 144 + (p & 7) * 16;
#pragma unroll
                for (int e = 0; e < 4; ++e) o[e] = cvtpk(z[2 * e], z[2 * e + 1]); }
            else if (p < 32) { dst = RC_XW + tt * 144 + (p - 24) * 16;
#pragma unroll
                for (int e = 0; e < 4; ++e) o[e] = cvtpk(1.0f - 2.0f * __builtin_amdgcn_rcpf(1.0f + __expf(2.0f * z[2 * e])), 1.0f - 2.0f * __builtin_amdgcn_rcpf(1.0f + __expf(2.0f * z[2 * e + 1]))); }
            else if (p < 40) { dst = RC_XA + tt * 144 + (p - 32) * 16;
#pragma unroll
                for (int e = 0; e < 4; ++e) o[e] = cvtpk(z[2 * e], z[2 * e + 1]); }
            else { dst = RC_XG + tt * 272 + (p - 40) * 16;
#pragma unroll
                for (int e = 0; e < 4; ++e) o[e] = cvtpk(__builtin_amdgcn_rcpf(1.0f + __expf(-z[2 * e])), __builtin_amdgcn_rcpf(1.0f + __expf(-z[2 * e + 1]))); }
            *(LAS v4u*)(lds + dst) = o; }
        }
        __syncthreads();
        { const int tid = otid(), w = __builtin_amdgcn_readfirstlane(tid >> 6), lane = tid & 63, r32 = lane & 31, h = lane >> 5; (void)w; (void)lane; (void)r32; (void)h;
        { const int tt = (w >> 1) & 1, jt = w & 1;
          if (w < 4) { f32x16 aw = rc_zero(), aa = rc_zero();
#pragma unroll
              for (int s = 0; s < 4; ++s) { const bf16x8v xw = *(const LAS bf16x8v*)(lds + RC_XW + (32 * tt + r32) * 144 + (16 * s + 8 * h) * 2), xa = *(const LAS bf16x8v*)(lds + RC_XA + (32 * tt + r32) * 144 + (16 * s + 8 * h) * 2);
                  aw = __builtin_amdgcn_mfma_f32_32x32x16_bf16(wf[s], xw, aw, 0, 0, 0); aa = __builtin_amdgcn_mfma_f32_32x32x16_bf16(wf[4 + s], xa, aa, 0, 0, 0); }
#pragma unroll
              for (int q4 = 0; q4 < 4; ++q4) *(LAS v4f*)(lds + RC_WL + ((32 * tt + r32) * 64 + 32 * jt + 8 * q4 + 4 * h) * 4) = (v4f){aw[4 * q4], aw[4 * q4 + 1], aw[4 * q4 + 2], aw[4 * q4 + 3]};
              rc_store_t(aa, lds + RC_AL, 32 * jt, 32 * tt, r32, h); }
          else { f32x16 ag = rc_zero();
#pragma unroll
              for (int s = 0; s < 8; ++s) { const bf16x8v xg = *(const LAS bf16x8v*)(lds + RC_XG + (32 * tt + r32) * 272 + (16 * s + 8 * h) * 2); ag = __builtin_amdgcn_mfma_f32_32x32x16_bf16(wf[s], xg, ag, 0, 0, 0); }
              rc_store_t(ag, lds + RC_G, 32 * jt, 32 * tt, r32, h); } }
        }
        __syncthreads();
        { const int tid = otid(), w = __builtin_amdgcn_readfirstlane(tid >> 6), lane = tid & 63, r32 = lane & 31, h = lane >> 5; (void)w; (void)lane; (void)r32; (void)h;
        { const int t = tid >> 3, j0 = (tid & 7) * 8; const int ob = t * 144 + j0 * 2;
          const v4f wl0 = *(const LAS v4f*)(lds + RC_WL + (t * 64 + j0) * 4), wl1 = *(const LAS v4f*)(lds + RC_WL + (t * 64 + j0 + 4) * 4);
          const v4u alw = *(const LAS v4u*)(lds + RC_AL + ob), kw = *(const LAS v4u*)(lds + RC_K + ob), rw = *(const LAS v4u*)(lds + RC_R + ob);
          float lw[8], alp[8], kk0[8], km[8]; float ssq = 0.f, bsum = 0.f;
#pragma unroll
          for (int e = 0; e < 8; ++e) { const float wl = e < 4 ? wl0[e & 3] : wl1[e & 3]; const float cw0 = *(const LAS float*)(lds + RC_CST + (j0 + e) * 4), ca0 = *(const LAS float*)(lds + RC_CST + 256 + (j0 + e) * 4);
              const float ckk = *(const LAS float*)(lds + RC_CST + 512 + (j0 + e) * 4), cka = *(const LAS float*)(lds + RC_CST + 768 + (j0 + e) * 4), crk = *(const LAS float*)(lds + RC_CST + 1024 + (j0 + e) * 4);
              const float al = (e & 1) ? bfhi(alw[e >> 1]) : bflo(alw[e >> 1]), kr = (e & 1) ? bfhi(kw[e >> 1]) : bflo(kw[e >> 1]), rr = (e & 1) ? bfhi(rw[e >> 1]) : bflo(rw[e >> 1]);
              lw[e] = -0.60653066f * __builtin_amdgcn_rcpf(1.0f + __expf(-(wl + cw0)));
              alp[e] = __builtin_amdgcn_rcpf(1.0f + __expf(-(al + ca0)));
              kk0[e] = kr * ckk; ssq += kk0[e] * kk0[e]; km[e] = kr * (1.0f + (alp[e] - 1.0f) * cka); bsum += rr * km[e] * crk; }
          ssq = sum8(ssq); bsum = sum8(bsum);
          const float inv = __builtin_amdgcn_rcpf(fmaxf(__builtin_amdgcn_sqrtf(ssq), 1e-12f));
          v4u ao, bo, ko;
#pragma unroll
          for (int e = 0; e < 4; ++e) { const float ka = kk0[2 * e] * inv, kb = kk0[2 * e + 1] * inv; ao[e] = cvtpk(-ka, -kb); bo[e] = cvtpk(ka * alp[2 * e], kb * alp[2 * e + 1]); ko[e] = cvtpk(km[2 * e], km[2 * e + 1]); }
          *(LAS v4u*)(lds + RC_A + ob) = ao; *(LAS v4u*)(lds + RC_B + ob) = bo; *(LAS v4u*)(lds + RC_K + ob) = ko;
          *(LAS v4f*)(lds + RC_LW + (t * 64 + j0) * 4) = (v4f){lw[0], lw[1], lw[2], lw[3]}; *(LAS v4f*)(lds + RC_LW + (t * 64 + j0 + 4) * 4) = (v4f){lw[4], lw[5], lw[6], lw[7]};
          if ((tid & 7) == 0) *(LAS float*)(lds + RC_BS + t * 4) = bsum; }
        }
        __syncthreads();
        { const int tid = otid(), w = __builtin_amdgcn_readfirstlane(tid >> 6), lane = tid & 63, r32 = lane & 31, h = lane >> 5; (void)w; (void)lane; (void)r32; (void)h;
        { const int k = tid & 63, tq = tid >> 6; float c[8]; float run = 0.f;
#pragma unroll
          for (int i = 0; i < 8; ++i) { run += *(const LAS float*)(lds + RC_LW + ((8 * tq + i) * 64 + k) * 4); c[i] = run; }
          *(LAS float*)(lds + RC_PT + (tq * 64 + k) * 4) = run;
          __syncthreads();
          float base = 0.f;
#pragma unroll
          for (int q = 0; q < 7; ++q) { const float pv = *(const LAS float*)(lds + RC_PT + (q * 64 + k) * 4); base += (q < tq) ? pv : 0.f; }
#pragma unroll
          for (int i = 0; i < 8; ++i) *(LAS float*)(lds + RC_LW + ((8 * tq + i) * 64 + k) * 4) = c[i] + base;
          if (tq == 7) *(LAS float*)(lds + RC_GC + k * 4) = __expf(c[7] + base); }
        }
        __syncthreads();
        { const int tid = otid(), w = __builtin_amdgcn_readfirstlane(tid >> 6), lane = tid & 63, r32 = lane & 31, h = lane >> 5; (void)w; (void)lane; (void)r32; (void)h;
        { const int t = tid >> 3, j0 = (tid & 7) * 8; const int ob = t * 144 + j0 * 2;
          const v4f c0 = *(const LAS v4f*)(lds + RC_LW + (t * 64 + j0) * 4), c1 = *(const LAS v4f*)(lds + RC_LW + (t * 64 + j0 + 4) * 4);
          v4f p0 = (v4f){0.f, 0.f, 0.f, 0.f}, p1 = p0; if (t > 0) { p0 = *(const LAS v4f*)(lds + RC_LW + ((t - 1) * 64 + j0) * 4); p1 = *(const LAS v4f*)(lds + RC_LW + ((t - 1) * 64 + j0 + 4) * 4); }
          const v4u aw = *(const LAS v4u*)(lds + RC_A + ob), bw = *(const LAS v4u*)(lds + RC_B + ob), kw = *(const LAS v4u*)(lds + RC_K + ob), rw = *(const LAS v4u*)(lds + RC_R + ob);
          v4u ao, bo, ko, ro;
#pragma unroll
          for (int e = 0; e < 4; ++e) { const float cA = e < 2 ? c0[2 * e] : c1[2 * e - 4], cB = e < 2 ? c0[2 * e + 1] : c1[2 * e - 3], pA = e < 2 ? p0[2 * e] : p1[2 * e - 4], pB = e < 2 ? p0[2 * e + 1] : p1[2 * e - 3];
              const float e1a = __expf(cA), e1b = __expf(cB), e0a = __expf(pA), e0b = __expf(pB), eia = __builtin_amdgcn_rcpf(e1a), eib = __builtin_amdgcn_rcpf(e1b);
              ao[e] = cvtpk(bflo(aw[e]) * e0a, bfhi(aw[e]) * e0b); ro[e] = cvtpk(bflo(rw[e]) * e1a, bfhi(rw[e]) * e1b);
              bo[e] = cvtpk(bflo(bw[e]) * eia, bfhi(bw[e]) * eib); ko[e] = cvtpk(bflo(kw[e]) * eia, bfhi(kw[e]) * eib); }
          *(LAS v4u*)(lds + RC_A + ob) = ao; *(LAS v4u*)(lds + RC_B + ob) = bo; *(LAS v4u*)(lds + RC_K + ob) = ko; *(LAS v4u*)(lds + RC_R + ob) = ro; }
        }
        __syncthreads();
        { const int tid = otid(), w = __builtin_amdgcn_readfirstlane(tid >> 6), lane = tid & 63, r32 = lane & 31, h = lane >> 5; (void)w; (void)lane; (void)r32; (void)h;
#pragma unroll 1
        for (int job = w; job < 20; job += 8) { const int blk = job >> 2, ta = (job >> 1) & 1, tb = job & 1;
            const int ao = blk == 0 ? RC_B : blk == 1 ? RC_A : blk == 2 ? RC_K : blk == 3 ? RC_B : RC_K, bo = blk == 0 ? RC_A : blk == 1 ? RC_B : blk == 2 ? RC_A : RC_R;
            const int oo = blk == 0 ? RC_LAB : blk == 1 ? RC_LABT : blk == 2 ? RC_LAK : blk == 3 ? RC_MRB : RC_MRK;
            f32x16 d = rc_zero();
            const bool dead = (blk == 1) ? (tb > ta) : (ta > tb);
            if (!dead) d = rc_mm<4>(d, lds + ao, 32 * ta, lds + bo, 32 * tb, r32, h);
            const int n = 32 * tb + r32;
#pragma unroll
            for (int i = 0; i < 16; ++i) { const int m = 32 * ta + 8 * (i >> 2) + 4 * h + (i & 3); bool keep;
                if (blk == 1) keep = (n < m) && ((n >> 4) != (m >> 4)); else if (blk < 3) keep = m < n; else keep = m <= n;
                d[i] = keep ? d[i] : 0.f; }
            if (blk == 0 && ta == tb) {
#pragma unroll
                for (int i = 0; i < 16; ++i) { const int m = 32 * ta + 8 * (i >> 2) + 4 * h + (i & 3); if ((m >> 4) == (n >> 4)) *(LAS float*)(lds + RC_DIAG + ((n >> 4) * 256 + (n & 15) * 16 + (m & 15)) * 4) = d[i]; } }
            rc_store_t(d, lds + oo, 32 * ta, 32 * tb, r32, h); }
        { const int k = tid >> 3, tg = tid & 7; const float gc = *(const LAS float*)(lds + RC_GC + k * 4);
#pragma unroll
          for (int i = 0; i < 8; ++i) { const int t = tg + 8 * i;
              const float bt = bf2f(*(const LAS unsigned short*)(lds + RC_B + t * 144 + k * 2)), kt = bf2f(*(const LAS unsigned short*)(lds + RC_K + t * 144 + k * 2));
              *(LAS unsigned short*)(lds + RC_BHT + k * 144 + t * 2) = (unsigned short)f2bf(bt * gc); *(LAS unsigned short*)(lds + RC_KHT + k * 144 + t * 2) = (unsigned short)f2bf(kt * gc);
              *(LAS unsigned short*)(lds + RC_VT + k * 144 + t * 2) = *(const LAS unsigned short*)(lds + RC_V + t * 144 + k * 2); } }
        }
        __syncthreads();
        { const int tid = otid(), w = __builtin_amdgcn_readfirstlane(tid >> 6), lane = tid & 63, r32 = lane & 31, h = lane >> 5; (void)w; (void)lane; (void)r32; (void)h;
        { const int row = tid >> 3, cg = tid & 7; if ((row >> 4) != (cg >> 1)) { *(LAS v4u*)(lds + RC_DINV + row * 144 + cg * 16) = (v4u){0u, 0u, 0u, 0u}; *(LAS v4u*)(lds + RC_DINVT + row * 144 + cg * 16) = (v4u){0u, 0u, 0u, 0u}; } }
        if (w == 0) { const int blk = lane >> 4, c = lane & 15; float x[16];
#pragma unroll
            for (int t = 0; t < 16; ++t) { float s0 = (t == c) ? 1.f : 0.f, s1 = 0.f;
#pragma unroll
                for (int j = 0; j < t; ++j) { const float lv = *(const LAS float*)(lds + RC_DIAG + (blk * 256 + t * 16 + j) * 4); if (j & 1) s1 += lv * x[j]; else s0 += lv * x[j]; }
                x[t] = s0 + s1; }
#pragma unroll
            for (int t = 0; t < 16; ++t) *(LAS unsigned short*)(lds + RC_DINV + (16 * blk + t) * 144 + (16 * blk + c) * 2) = (unsigned short)f2bf(x[t]);
            v4u o0, o1;
#pragma unroll
            for (int e = 0; e < 4; ++e) { o0[e] = cvtpk(x[2 * e], x[2 * e + 1]); o1[e] = cvtpk(x[8 + 2 * e], x[9 + 2 * e]); }
            *(LAS v4u*)(lds + RC_DINVT + (16 * blk + c) * 144 + (16 * blk) * 2) = o0; *(LAS v4u*)(lds + RC_DINVT + (16 * blk + c) * 144 + (16 * blk + 8) * 2) = o1; }
        }
        __syncthreads();
        { const int tid = otid(), w = __builtin_amdgcn_readfirstlane(tid >> 6), lane = tid & 63, r32 = lane & 31, h = lane >> 5; (void)w; (void)lane; (void)r32; (void)h;
        { const int ta = (w >> 1) & 1, tb = w & 1; f32x16 d = rc_zero();
          if (w < 4) { d = rc_mm<4>(d, lds + RC_LABT, 32 * ta, lds + RC_DINV, 32 * tb, r32, h); }
          else       { d = rc_mm<4>(d, lds + RC_DINV, 32 * ta, lds + RC_LABT, 32 * tb, r32, h); }
          __syncthreads();
          rc_store_t(d, lds + (w < 4 ? RC_N : RC_NT), 32 * ta, 32 * tb, r32, h); }
        }
        __syncthreads();
        { const int tid = otid(), w = __builtin_amdgcn_readfirstlane(tid >> 6), lane = tid & 63, r32 = lane & 31, h = lane >> 5; (void)w; (void)lane; (void)r32; (void)h;
        xacc = rc_zero();
        if (w < 4) { const int ta = (w >> 1) & 1, tb = w & 1;
            xacc = rc_mm<4>(xacc, lds + RC_NT, 32 * ta, lds + RC_N, 32 * tb, r32, h);
#pragma unroll
            for (int i = 0; i < 16; ++i) { const int m = 32 * ta + 8 * (i >> 2) + 4 * h + (i & 3), n = 32 * tb + r32; if (m == n) xacc[i] += 1.0f; } }
        }
        __syncthreads();
        { const int tid = otid(), w = __builtin_amdgcn_readfirstlane(tid >> 6), lane = tid & 63, r32 = lane & 31, h = lane >> 5; (void)w; (void)lane; (void)r32; (void)h;
        if (w < 4) { const int ta = (w >> 1) & 1, tb = w & 1;
#pragma unroll
            for (int i = 0; i < 16; ++i) { const int m = 32 * ta + 8 * (i >> 2) + 4 * h + (i & 3), n = 32 * tb + r32; *(LAS unsigned short*)(lds + RC_N2 + m * 144 + n * 2) = (unsigned short)f2bf(xacc[i]); } }
        }
        __syncthreads();
        { const int tid = otid(), w = __builtin_amdgcn_readfirstlane(tid >> 6), lane = tid & 63, r32 = lane & 31, h = lane >> 5; (void)w; (void)lane; (void)r32; (void)h;
        if (w < 4) { const int ta = (w >> 1) & 1, tb = w & 1;
            xacc = rc_mm<4>(xacc, lds + RC_N2, 32 * ta, lds + RC_N, 32 * tb, r32, h);
            rc_store_t(xacc, lds + RC_P, 32 * ta, 32 * tb, r32, h); }
        }
        __syncthreads();
        { const int tid = otid(), w = __builtin_amdgcn_readfirstlane(tid >> 6), lane = tid & 63, r32 = lane & 31, h = lane >> 5; (void)w; (void)lane; (void)r32; (void)h;
        if (w < 4) { const int ta = (w >> 1) & 1, tb = w & 1; f32x16 d = rc_zero(); d = rc_mm<4>(d, lds + RC_DINVT, 32 * ta, lds + RC_P, 32 * tb, r32, h); rc_store_t(d, lds + RC_TINV, 32 * ta, 32 * tb, r32, h); }
        if (t0 + 64 < T) RC_LOADPIECES(t0 + 64);
        }
        __syncthreads();
        { const int tid = otid(), w = __builtin_amdgcn_readfirstlane(tid >> 6), lane = tid & 63, r32 = lane & 31, h = lane >> 5; (void)w; (void)lane; (void)r32; (void)h;
        if (w < 4) { const int ta = (w >> 1) & 1, tb = w & 1; f32x16 d = rc_zero(); d = rc_mm<4>(d, lds + RC_A, 32 * ta, lds + RC_S, 32 * tb, r32, h); d = rc_mm<4>(d, lds + RC_LAK, 32 * ta, lds + RC_VT, 32 * tb, r32, h);
            rc_store_t(d, lds + RC_RHST, 32 * ta, 32 * tb, r32, h); }
        }
        __syncthreads();
        { const int tid = otid(), w = __builtin_amdgcn_readfirstlane(tid >> 6), lane = tid & 63, r32 = lane & 31, h = lane >> 5; (void)w; (void)lane; (void)r32; (void)h;
        if (w < 4) { const int ta = (w >> 1) & 1, tb = w & 1; f32x16 d = rc_zero(); d = rc_mm<4>(d, lds + RC_TINV, 32 * ta, lds + RC_RHST, 32 * tb, r32, h); rc_store_t(d, lds + RC_UT, 32 * ta, 32 * tb, r32, h); }
        }
        __syncthreads();
        { const int tid = otid(), w = __builtin_amdgcn_readfirstlane(tid >> 6), lane = tid & 63, r32 = lane & 31, h = lane >> 5; (void)w; (void)lane; (void)r32; (void)h;
        yacc = rc_zero();
        { const int ta = (w >> 1) & 1, tb = w & 1;
          if (w < 4) {
#pragma unroll
              for (int i = 0; i < 16; ++i) Sacc[i] *= *(const LAS float*)(lds + RC_GC + (32 * ta + 8 * (i >> 2) + 4 * h + (i & 3)) * 4);
              Sacc = rc_mm<4>(Sacc, lds + RC_BHT, 32 * ta, lds + RC_UT, 32 * tb, r32, h); Sacc = rc_mm<4>(Sacc, lds + RC_KHT, 32 * ta, lds + RC_VT, 32 * tb, r32, h); }
          else { yacc = rc_mm<4>(yacc, lds + RC_S, 32 * ta, lds + RC_R, 32 * tb, r32, h); yacc = rc_mm<4>(yacc, lds + RC_UT, 32 * ta, lds + RC_MRB, 32 * tb, r32, h); yacc = rc_mm<4>(yacc, lds + RC_VT, 32 * ta, lds + RC_MRK, 32 * tb, r32, h);
              float s1 = 0.f, s2 = 0.f;
#pragma unroll
              for (int i = 0; i < 16; ++i) { s1 += yacc[i]; s2 += yacc[i] * yacc[i]; }
              s1 += __shfl_xor(s1, 32); s2 += __shfl_xor(s2, 32);
              if (h == 0) { *(LAS float*)(lds + RC_SSB + ((w - 4) * 32 + r32) * 8) = s1; *(LAS float*)(lds + RC_SSB + ((w - 4) * 32 + r32) * 8 + 4) = s2; } } }
        }
        __syncthreads();
        { const int tid = otid(), w = __builtin_amdgcn_readfirstlane(tid >> 6), lane = tid & 63, r32 = lane & 31, h = lane >> 5; (void)w; (void)lane; (void)r32; (void)h;
        if (w >= 4) { const int ta = (w >> 1) & 1, tb = w & 1, t = 32 * tb + r32;
            const float a1 = *(const LAS float*)(lds + RC_SSB + ((w - 4) * 32 + r32) * 8), a2 = *(const LAS float*)(lds + RC_SSB + ((w - 4) * 32 + r32) * 8 + 4);
            const float b1 = *(const LAS float*)(lds + RC_SSB + (((w - 4) ^ 2) * 32 + r32) * 8), b2 = *(const LAS float*)(lds + RC_SSB + (((w - 4) ^ 2) * 32 + r32) * 8 + 4);
            const float mean = (a1 + b1) * (1.f / 64.f), var = fmaxf((a2 + b2) * (1.f / 64.f) - mean * mean, 0.f), rstd = rsqrtf(var + 64e-5f), bs = *(const LAS float*)(lds + RC_BS + t * 4);
#pragma unroll
            for (int q4 = 0; q4 < 4; ++q4) { const int v0 = 32 * ta + 8 * q4 + 4 * h; const v2u gw = *(const LAS v2u*)(lds + RC_G + t * 144 + v0 * 2);
                const v4f lg4 = *(const LAS v4f*)(lds + RC_CST + 1280 + v0 * 4), lb4 = *(const LAS v4f*)(lds + RC_CST + 1536 + v0 * 4); float o[4];
#pragma unroll
                for (int e = 0; e < 4; ++e) { const float vv = bf2f(*(const LAS unsigned short*)(lds + RC_VT + (v0 + e) * 144 + t * 2)); const float g = (e & 1) ? bfhi(gw[e >> 1]) : bflo(gw[e >> 1]);
                    o[e] = ((yacc[4 * q4 + e] - mean) * rstd * lg4[e] + lb4[e] + bs * vv) * g; }
                v2u ow; ow[0] = cvtpk(o[0], o[1]); ow[1] = cvtpk(o[2], o[3]);
                *(v2u*)(mixo + (size_t)(b * T + t0 + t) * NMIX + 512 + hh * 64 + v0) = ow; } }

        }
    }
    __syncthreads();
#undef RC_LOADPIECES
}
__device__ __forceinline__ void rwkvc_phase(KP P, int l, LAS unsigned char* lds, int vcu, int G) {
    for (int unit = vcu; unit < BATCH * 8; unit += G) rwkvc_unit(P, l, lds, unit >> 3, unit & 7);
}

#define XB_TMO      128
#define XB_XCNT(j)  (256  + 64 * (j))
#define XB_XSUB(j)  (1280 + 64 * (j))
#define XB_XGEN(j)  (2304 + 64 * (j))
#define XB_TOP      3328
#define XB_TOPGEN   3392
#define XCD_BAR_WORDS 3456
#define XB_SPIN_CAP (1u << 18)
__device__ __forceinline__ unsigned xb_ld(unsigned* p)              { return __hip_atomic_load(p, __ATOMIC_RELAXED, __HIP_MEMORY_SCOPE_AGENT); }
__device__ __forceinline__ unsigned xb_add(unsigned* p, unsigned v) { return __hip_atomic_fetch_add(p, v, __ATOMIC_RELAXED, __HIP_MEMORY_SCOPE_AGENT); }
__device__ __forceinline__ unsigned xb_xcc_id() { return (unsigned)__builtin_amdgcn_s_getreg((3 << 11) | 20) & 0xFu; }
#define XB_SPIN(cond, bar) do { unsigned _sp = 0; while (cond) { __builtin_amdgcn_s_sleep(1); \
    if ((++_sp & 255u) == 0u) { if (xb_ld(&(bar)[XB_TMO])) break; if (_sp > XB_SPIN_CAP) { atomicAdd(&(bar)[XB_TMO], 1u); break; } } } } while (0)
struct XcdBarrier {
    unsigned* bar; unsigned x;
    volatile LAS unsigned* st;
};
__device__ __forceinline__ XcdBarrier xcd_barrier_post(unsigned* bar, volatile LAS unsigned* st) {
    XcdBarrier b; b.bar = bar; b.x = xb_xcc_id(); b.st = st;
    if (threadIdx.x == 0) (void)xb_add(&bar[XB_XCNT(b.x)], 1u);
    return b;
}
__device__ __forceinline__ void xcd_barrier_complete(unsigned* bar, unsigned x, unsigned& nloc, unsigned& nx) {
    const unsigned G = gridDim.x * gridDim.y * gridDim.z;
    unsigned sum, cnt, mine, sp = 0u;
    for (;;) {
        sum = 0u; cnt = 0u; mine = 0u;
#pragma unroll
        for (unsigned j = 0; j < 16; ++j) { const unsigned c = xb_ld(&bar[XB_XCNT(j)]); sum += c; cnt += (c > 0u) ? 1u : 0u; mine = (j == x) ? c : mine; }
        if (sum == G) break;
        __builtin_amdgcn_s_sleep(1);
        if ((++sp & 255u) == 0u) { if (xb_ld(&bar[XB_TMO])) break; if (sp > XB_SPIN_CAP) { atomicAdd(&bar[XB_TMO], 1u); break; } }
    }
    nloc = mine > 0u ? mine : 1u; nx = cnt > 0u ? cnt : 1u;
}
__device__ __forceinline__ void xcd_barrier(const XcdBarrier& b) {
    asm volatile("s_waitcnt vmcnt(0)" ::: "memory");
    __syncthreads();
    if (threadIdx.x == 0) {
        unsigned* bar = b.bar;
        __builtin_amdgcn_s_waitcnt(0);
        unsigned nloc = b.st[0], nx = b.st[1];
        if (nloc == 0u) { xcd_barrier_complete(bar, b.x, nloc, nx); b.st[0] = nloc; b.st[1] = nx; }
        const unsigned old = xb_add(&bar[XB_XSUB(b.x)], 1u);
        const unsigned gen = old / nloc;
        if (old + 1u == (gen + 1u) * nloc) {
            __builtin_amdgcn_fence(__ATOMIC_RELEASE, "agent");
            asm volatile("s_waitcnt vmcnt(0)" ::: "memory");
            const unsigned og = xb_add(&bar[XB_TOP], 1u);
            const unsigned tg = og / nx;
            if (og + 1u == (tg + 1u) * nx) xb_add(&bar[XB_TOPGEN], 1u);
            else XB_SPIN(xb_ld(&bar[XB_TOPGEN]) == tg, bar);
            __builtin_amdgcn_fence(__ATOMIC_ACQUIRE, "agent");
            xb_add(&bar[XB_XGEN(b.x)], 1u);
            asm volatile("s_waitcnt vmcnt(0)" ::: "memory");
        } else {
            XB_SPIN(xb_ld(&bar[XB_XGEN(b.x)]) == gen, bar);
            __builtin_amdgcn_fence(__ATOMIC_ACQUIRE, "agent");
            asm volatile("s_waitcnt vmcnt(0)" ::: "memory");
        }
    }
    __syncthreads();
}

constexpr int CW_BAR = 4096;
constexpr int MISC_OFF = 156928;
#ifndef NAIVE_ATTN
#define NAIVE_ATTN 0
#endif
#ifndef NAIVE_RET
#define NAIVE_RET 0
#endif
#ifndef NAIVE_RWKV
#define NAIVE_RWKV 0
#endif
#define RWKV_CHUNKED 1
#ifndef REP_RWKV
#define REP_RWKV 1
#endif
#ifndef REP_ATTN
#define REP_ATTN 1
#endif
#ifndef REP_RET
#define REP_RET 1
#endif
#ifndef REP_G0
#define REP_G0 1
#endif
#ifndef REP_G1
#define REP_G1 1
#endif
#ifndef REP_G2
#define REP_G2 1
#endif
#ifndef REP_G4
#define REP_G4 1
#endif
__global__ void __launch_bounds__(512, 2) k_mega(Params Pv) {
    KP P = (KP)__builtin_amdgcn_kernarg_segment_ptr();
#define PFRESH() asm volatile("" : "+s"(P))
    extern __shared__ __attribute__((aligned(16))) unsigned char lds_[];
    LAS unsigned char* lds = (LAS unsigned char*)lds_;
    const int tid = threadIdx.x, G = gridDim.x, bx = blockIdx.x, vcu = (G % 8 == 0) ? (bx % 8) * (G / 8) + bx / 8 : bx;
    volatile LAS unsigned* MISC = (volatile LAS unsigned*)(lds + MISC_OFF);
    for (int u = tid; u < (LDS_BYTES - MISC_OFF) / 4; u += 512) ((LAS unsigned*)(lds + MISC_OFF))[u] = 0u;
    __syncthreads();
    XcdBarrier bar = xcd_barrier_post((unsigned*)(P->ws + WS_CTL) + CW_BAR, MISC + 8);
#define GRID_BAR() xcd_barrier(bar)
    PFRESH(); phase_x0(P, vcu, G);
    for (int l = 0; l < DEPTH; ++l) {
        PFRESH(); phase_wconv(P, l, lds, vcu, G);
        GRID_BAR();
#if !defined(SKIP_G0)
        PFRESH(); for (int rep_ = 0; rep_ < REP_G0; ++rep_) gemm_phase_of<0>(P, lds, G, bx);
#endif
        GRID_BAR();
        PFRESH();
        { const int GH = G / 2;
#if RWKV_CHUNKED
          if (vcu < GH) { rwkvc_phase(P, l, lds, vcu, GH); }
#else
          if (vcu < GH) { rwkv_phase(P, l, lds, vcu, GH); }
#endif
          else { attn_phase(P, l, lds, vcu - GH, G - GH); __syncthreads(); ret_phase(P, lds, vcu - GH, G - GH); } }
        GRID_BAR();
#if !defined(SKIP_G1)
        PFRESH(); for (int rep_ = 0; rep_ < REP_G1; ++rep_) gemm_phase_of<1>(P, lds, G, bx);
#endif
        GRID_BAR();
#if !defined(SKIP_G2)
        PFRESH(); for (int rep_ = 0; rep_ < REP_G2; ++rep_) gemm_phase_of<2>(P, lds, G, bx);
#endif
        GRID_BAR();
#if !defined(SKIP_G3)
        PFRESH(); gemm_phase_of<3>(P, lds, G, bx);
#endif
        GRID_BAR();
#if !defined(SKIP_G4)
        PFRESH(); for (int rep_ = 0; rep_ < REP_G4; ++rep_) gemm_phase_of<4>(P, lds, G, bx);
#endif
        GRID_BAR();
#if !defined(SKIP_G5)
        PFRESH(); gemm_phase_of<5>(P, lds, G, bx);
#endif
        GRID_BAR();
    }
}

extern "C" void kernel_launch(void* const* d_in, const int* in_sizes, int n_in, void* d_out, int out_size, void* d_ws, size_t ws_size, hipStream_t stream) {
    static int grid = 0;
    if (grid == 0) {
        if (n_in != 25 || out_size != M * D || ws_size < WS_END) { fprintf(stderr, "kernel_launch: unexpected shapes (n_in %d, out %d, ws %zu)\n", n_in, out_size, ws_size); grid = -1; return; }
        int dev = 0, cus = 0, per_cu = 0; if (hipGetDevice(&dev) != hipSuccess || hipDeviceGetAttribute(&cus, hipDeviceAttributeMultiprocessorCount, dev) != hipSuccess) { grid = -1; return; }
        if (hipFuncSetAttribute((const void*)k_mega, hipFuncAttributeMaxDynamicSharedMemorySize, LDS_BYTES) != hipSuccess) { fprintf(stderr, "kernel_launch: hipFuncSetAttribute failed\n"); grid = -1; return; }
        if (hipOccupancyMaxActiveBlocksPerMultiprocessor(&per_cu, (const void*)k_mega, 512, LDS_BYTES) != hipSuccess || per_cu < 1) fprintf(stderr, "kernel_launch: occupancy query reports %d workgroups per CU\n", per_cu);
        (void)hipGetLastError();
        grid = cus;
    }
    if (grid < 0) return;
    Params p; memset(&p, 0, sizeof(p));
    for (int i = 0; i < 25; ++i) p.in[i] = (const float*)d_in[i];
    p.out = (float*)d_out; p.ws = (unsigned char*)d_ws;
    (void)hipMemsetAsync((char*)d_ws + WS_CTL, 0, CTL_BYTES, stream);
    hipLaunchKernelGGL(k_mega, dim3(grid), dim3(512), LDS_BYTES, stream, p);
}
```

```cpp
#include <hip/hip_runtime.h>
#include <cstdio>
#include <cstdint>
#include <cstring>

constexpr int D = 1024, BATCH = 16, T = 2048, DEPTH = 4, M = BATCH * T;
constexpr int HD = 64;
constexpr int NA = 4608;
constexpr int NG = 3072;
constexpr int INW = NA + NG;
constexpr int C_AQ = 0, C_AK = 512, C_AV = 640, C_RW = 768, C_RQ = 2560, C_RK = 3072, C_RV = 3584, C_RG = 4096;
constexpr int RWC = 1792;
constexpr int FF = 2816, FF2 = 2 * FF;
constexpr int NMIX = 1536;

constexpr size_t MiB = 1u << 20;
constexpr size_t WS_CTL = 0, CTL_BYTES = 1 * MiB;
constexpr size_t WS_WIN = 1 * MiB;
constexpr size_t WS_WMIX = WS_WIN + (size_t)INW * D * 2;
constexpr size_t WS_WOUT = WS_WMIX + (size_t)D * NMIX * 2;
constexpr size_t WS_WGU = WS_WOUT + (size_t)D * D * 2;
constexpr size_t WS_WDN = WS_WGU + (size_t)FF2 * D * 2;
constexpr size_t WS_XB = 38 * MiB;
constexpr size_t WS_MIXO = 102 * MiB;
constexpr size_t WS_BIG = 198 * MiB;
constexpr size_t WS_MIXED = WS_BIG + 192 * MiB;
constexpr size_t WS_RSS = 486 * MiB;
constexpr size_t WS_ROPE = 488 * MiB;
constexpr size_t WS_ROPE2 = WS_ROPE + 512 * 1024;
constexpr size_t WS_GX = 489 * MiB;
constexpr size_t WS_END = 505 * MiB;
static_assert(WS_WDN + (size_t)D * FF * 2 <= WS_XB && WS_WDN + (size_t)D * FF * 2 - WS_WIN <= 37 * MiB && 3 * 37 * MiB <= (size_t)M * D * 4, "weights fit");
static_assert(WS_BIG + (size_t)M * NA * 2 <= WS_RSS, "big region fits");

#define GAS __attribute__((address_space(1)))
#define LAS __attribute__((address_space(3)))
typedef unsigned short bf16;
typedef unsigned v4u __attribute__((ext_vector_type(4)));
typedef unsigned v2u __attribute__((ext_vector_type(2)));
typedef float v4f __attribute__((ext_vector_type(4)));
__device__ __forceinline__ unsigned f2bf(float f) { unsigned u = __builtin_bit_cast(unsigned, f); return (u + 0x7fffu + ((u >> 16) & 1u)) >> 16; }
__device__ __forceinline__ unsigned pk2(float lo, float hi) { return f2bf(lo) | (f2bf(hi) << 16); }
__device__ __forceinline__ float bf2f(unsigned short b) { return __builtin_bit_cast(float, (unsigned)b << 16); }
__device__ __forceinline__ float bflo(unsigned w) { return __builtin_bit_cast(float, w << 16); }
__device__ __forceinline__ float bfhi(unsigned w) { return __builtin_bit_cast(float, w & 0xffff0000u); }
__device__ __forceinline__ float wave_sum(float v) {
#pragma unroll
    for (int o = 1; o < 64; o <<= 1) v += __shfl_xor(v, o);
    return v;
}
__device__ __forceinline__ float wave_max(float v) {
#pragma unroll
    for (int o = 1; o < 64; o <<= 1) v = fmaxf(v, __shfl_xor(v, o));
    return v;
}
__device__ __forceinline__ float sigmoidf_(float x) { return 1.f / (1.f + __expf(-x)); }

__device__ __forceinline__ int otid() { int t = threadIdx.x; asm volatile("" : "+v"(t)); return t; }

struct Params {
    const float* in[25];
    float* out;
    unsigned char* ws;
    int layer; int pad;
};
typedef const __attribute__((address_space(4))) Params* KP;
constexpr size_t WL_STRIDE = 37 * MiB;
__device__ __forceinline__ unsigned char* wbase(KP P, int l) { return l == DEPTH - 1 ? P->ws : (unsigned char*)P->out + (size_t)l * WL_STRIDE - WS_WIN; }
enum { I_X = 0, I_N1G, I_WIN, I_QNG, I_KNG, I_SINK, I_WAO, I_MU, I_W0, I_W2, I_A0, I_A2, I_G2, I_KK, I_KA, I_RK, I_LNG, I_LNB, I_WRO, I_WTO, I_WOUT, I_N2G, I_WG, I_WU, I_WD };


namespace pg8 {
#define PG8_LAS __attribute__((address_space(3)))
typedef unsigned short bf16_t;
typedef short bf16x8 __attribute__((ext_vector_type(8)));
typedef float f32x4 __attribute__((ext_vector_type(4)));
typedef unsigned u32x4 __attribute__((ext_vector_type(4)));
constexpr int BM = 256, BK = 64, HALF = 128, HTB = HALF * BK * 2  , STAGE_BYTES = 8 * HTB, NXCD = 8, WGM = 8;

__host__ __device__ __forceinline__ int lds_byte(int r, int c) { const int st = (r >> 4) * 2 + (c >> 5), rr = r & 15, cc = c & 31, ob = rr * 64 + cc * 2; return st * 1024 + (ob ^ (((ob >> 9) & 1) << 5)); }
__host__ __device__ __forceinline__ void stage_rc(int b, int& R, int& C) { const int st = b / 1024, sb = b % 1024, swz = sb ^ (((sb >> 9) & 1) << 5); R = (st >> 1) * 16 + swz / 64; C = (st & 1) * 32 + (swz % 64) / 2; }
__host__ __device__ __forceinline__ int perm32(int rho) { const int n = rho >> 4, i = rho & 15; return 8 * (i >> 2) + 4 * n + (i & 3); }

struct Unit { int pm, pn; };
struct Gemm { const bf16_t* A; const bf16_t* Bt; int M, N, K, lda; };

struct StaticOrder {
    int nM, nN, nwg, G, c;
    __host__ __device__ void init(int M, int N, int G_, int c_) { nM = M / BM; nN = N / BM; nwg = nM * nN; G = G_; c = c_; }
    __host__ __device__ bool next(int i, Unit& u) const {
        const long L = (long)i * G + c; if (L >= nwg) return false;
        int wgid = (int)L; { const int q = nwg / NXCD, r = nwg % NXCD, xcd = wgid % NXCD, off = wgid / NXCD; wgid = (xcd < r ? xcd * (q + 1) : r * (q + 1) + (xcd - r) * q) + off; }
        const int nig = WGM * nN, gid = wgid / nig, fm = gid * WGM, gsz = (nM - fm) < WGM ? (nM - fm) : WGM;
        u.pm = fm + ((wgid % nig) % gsz); u.pn = (wgid % nig) / gsz; return true;
    }
    __device__ __forceinline__ void a_ready(const Unit&) const {}
    __device__ __forceinline__ void done(const Unit&) const {}
};


typedef float f32x2_ __attribute__((ext_vector_type(2))); typedef __bf16 bf16x2_ __attribute__((ext_vector_type(2)));
__device__ __forceinline__ unsigned cvt_pk_bf16(float lo, float hi) { const f32x2_ x = {lo, hi}; return __builtin_bit_cast(unsigned, __builtin_convertvector(x, bf16x2_)); }
__device__ __forceinline__ float clampg(float x) { return __builtin_amdgcn_fmed3f(x, -30.0f, 30.0f); }
__device__ __forceinline__ float row_rstd(const float* rss, int row) {
    const f32x4* p = (const f32x4*)(rss + (size_t)row * 16);
    const f32x4 a = p[0], b = p[1], c = p[2], d = p[3];
    const float s = (((a.x + a.y) + (a.z + a.w)) + ((b.x + b.y) + (b.z + b.w))) + (((c.x + c.y) + (c.z + c.w)) + ((d.x + d.y) + (d.z + d.w)));
    return rsqrtf(s * (1.0f / 1024.0f) + 1e-6f);
}
struct RowTab {
    const float* rss;
    __device__ __forceinline__ void tab_load(const Unit& u, int tid, f32x4& a, f32x4& b) const { const f32x4* p = (const f32x4*)(rss + ((size_t)u.pm * BM + (tid >> 1)) * 16 + (tid & 1) * 8); a = p[0]; b = p[1]; }
    __device__ __forceinline__ void tab_store(PG8_LAS float* tab, int tid, const f32x4& a, const f32x4& b) const {
        float s = ((a.x + a.y) + (a.z + a.w)) + ((b.x + b.y) + (b.z + b.w)); s += __shfl_xor(s, 1);
        if ((tid & 1) == 0) tab[tid >> 1] = rsqrtf(s * (1.0f / 1024.0f) + 1e-6f); }
};
struct EpiRowScale : RowTab {
    static constexpr bool PERM = true, AFTER_DRAIN = false, ROWTAB = true, ACCINIT = false; static constexpr int KSEG = 0;
    bf16_t* O; int ldc;
    __device__ __forceinline__ void operator()(const f32x4 (&acc)[2][2][4][2], const Unit& u, int wr, int wc, int fr, int fq, const PG8_LAS float* tab) const {
        const int row0 = u.pm * BM + wr * 64 + fr, col0 = u.pn * BM + wc * 32 + 8 * fq;
#pragma unroll
        for (int ai = 0; ai < 2; ++ai)
#pragma unroll
            for (int m = 0; m < 4; ++m) { const int row = row0 + ai * HALF + m * 16; const float rs = tab[wr * 64 + fr + ai * HALF + m * 16]; bf16_t* rowp = O + (size_t)row * ldc + col0;
#pragma unroll
                for (int bj = 0; bj < 2; ++bj) { const f32x4 v0 = acc[ai][bj][m][0] * rs, v1 = acc[ai][bj][m][1] * rs;
                    u32x4 w; w.x = cvt_pk_bf16(v0[0], v0[1]); w.y = cvt_pk_bf16(v0[2], v0[3]); w.z = cvt_pk_bf16(v1[0], v1[1]); w.w = cvt_pk_bf16(v1[2], v1[3]);
                    *(u32x4*)(rowp + bj * HALF) = w; } }
    }
};
struct GateMap { bf16_t* proj; bf16_t* gx;
    __device__ __forceinline__ bf16_t* tile(int gt, int& ld) const { if (gt < 11) { ld = 4608; return proj + (gt < 3 ? gt * 256 : 2560 + (gt - 3) * 256); } ld = 256; return gx; } };
struct EpiGates : RowTab {
    static constexpr bool PERM = true, AFTER_DRAIN = false, ROWTAB = true, ACCINIT = false; static constexpr int KSEG = 0;
    GateMap gm;
    __device__ __forceinline__ void operator()(const f32x4 (&acc)[2][2][4][2], const Unit& u, int wr, int wc, int fr, int fq, const PG8_LAS float* tab) const {
        int ld; bf16_t* base = gm.tile(u.pn, ld); const int row0 = u.pm * BM + wr * 64 + fr, col0 = wc * 32 + 8 * fq;
#pragma unroll
        for (int ai = 0; ai < 2; ++ai)
#pragma unroll
            for (int m = 0; m < 4; ++m) { const int row = row0 + ai * HALF + m * 16; const float rs = tab[wr * 64 + fr + ai * HALF + m * 16]; bf16_t* rowp = base + (size_t)row * ld + col0;
#pragma unroll
                for (int bj = 0; bj < 2; ++bj) { const f32x4 v0 = acc[ai][bj][m][0] * rs, v1 = acc[ai][bj][m][1] * rs;
                    u32x4 w; w.x = cvt_pk_bf16(v0[0], v0[1]); w.y = cvt_pk_bf16(v0[2], v0[3]); w.z = cvt_pk_bf16(v1[0], v1[1]); w.w = cvt_pk_bf16(v1[2], v1[3]);
                    *(u32x4*)(rowp + bj * HALF) = w; } }
    }
};
struct EpiSwiglu : RowTab {
    static constexpr bool PERM = true, AFTER_DRAIN = false, ROWTAB = true, ACCINIT = false; static constexpr int KSEG = 0;
    bf16_t* O; int ldc;
    __device__ __forceinline__ void operator()(const f32x4 (&acc)[2][2][4][2], const Unit& u, int wr, int wc, int fr, int fq, const PG8_LAS float* tab) const {
        const int row0 = u.pm * BM + wr * 64 + fr, col0 = u.pn * HALF + wc * 32 + 8 * fq;
#pragma unroll
        for (int ai = 0; ai < 2; ++ai)
#pragma unroll
            for (int m = 0; m < 4; ++m) { const int row = row0 + ai * HALF + m * 16; const float rs = tab[wr * 64 + fr + ai * HALF + m * 16]; bf16_t* rowp = O + (size_t)row * ldc + col0;
                float o[8];
#pragma unroll
                for (int n = 0; n < 2; ++n)
#pragma unroll
                    for (int j = 0; j < 4; ++j) { const float g = acc[ai][0][m][n][j] * rs, up = acc[ai][1][m][n][j] * rs; o[4 * n + j] = g * up * __builtin_amdgcn_rcpf(1.0f + __expf(-g)); }
                u32x4 w; w.x = cvt_pk_bf16(o[0], o[1]); w.y = cvt_pk_bf16(o[2], o[3]); w.z = cvt_pk_bf16(o[4], o[5]); w.w = cvt_pk_bf16(o[6], o[7]);
                *(u32x4*)rowp = w; }
    }
};
struct EpiResid {
    static constexpr bool PERM = true, AFTER_DRAIN = false, ROWTAB = false, ACCINIT = true; static constexpr int KSEG = 0;
    bf16_t* XB; float* rss; float* OUT;
    __device__ __forceinline__ void init(f32x4 (&acc)[2][2][4][2], const Unit& u, int wr, int wc, int fr, int fq) const {
        const int row0 = u.pm * BM + wr * 64 + fr, col0 = u.pn * BM + wc * 32 + 8 * fq;
#pragma unroll
        for (int ai = 0; ai < 2; ++ai) { u32x4 xin[4][2];
#pragma unroll
            for (int m = 0; m < 4; ++m)
#pragma unroll
                for (int bj = 0; bj < 2; ++bj) xin[m][bj] = *(const u32x4*)(XB + (size_t)(row0 + ai * HALF + m * 16) * 1024 + col0 + bj * HALF);
#pragma unroll
            for (int m = 0; m < 4; ++m)
#pragma unroll
                for (int bj = 0; bj < 2; ++bj)
#pragma unroll
                    for (int q = 0; q < 4; ++q) { const unsigned w = xin[m][bj][q]; acc[ai][bj][m][q >> 1][(q & 1) * 2] = __builtin_bit_cast(float, w << 16); acc[ai][bj][m][q >> 1][(q & 1) * 2 + 1] = __builtin_bit_cast(float, w & 0xffff0000u); } }
    }
    __device__ __forceinline__ void operator()(const f32x4 (&acc)[2][2][4][2], const Unit& u, int wr, int wc, int fr, int fq) const {
        const int row0 = u.pm * BM + wr * 64 + fr, col0 = u.pn * BM + wc * 32 + 8 * fq;
#pragma unroll
        for (int g = 0; g < 8; ++g) { const int ai = g >> 2, m = g & 3; const int row = row0 + ai * HALF + m * 16; const size_t off = (size_t)row * 1024 + col0; float ss = 0.f;
#pragma unroll
            for (int bj = 0; bj < 2; ++bj) { const f32x4 x0 = acc[ai][bj][m][0], x1 = acc[ai][bj][m][1];
                ss += ((x0[0] * x0[0] + x0[1] * x0[1]) + (x0[2] * x0[2] + x0[3] * x0[3])) + ((x1[0] * x1[0] + x1[1] * x1[1]) + (x1[2] * x1[2] + x1[3] * x1[3]));
                u32x4 w; w.x = cvt_pk_bf16(x0[0], x0[1]); w.y = cvt_pk_bf16(x0[2], x0[3]); w.z = cvt_pk_bf16(x1[0], x1[1]); w.w = cvt_pk_bf16(x1[2], x1[3]);
                *(u32x4*)(XB + off + bj * HALF) = w;
                if (OUT) { *(f32x4*)(OUT + off + bj * HALF) = x0; *(f32x4*)(OUT + off + bj * HALF + 4) = x1; } }
            ss += __shfl_xor(ss, 16); ss += __shfl_xor(ss, 32);
            if (fq == 0) rss[(size_t)row * 16 + u.pn * 4 + wc] = ss; }
    }
};
struct EpiGateMix {
    static constexpr bool PERM = true, AFTER_DRAIN = false, ROWTAB = false, ACCINIT = false; static constexpr int KSEG = 8;
    GateMap gm; bf16_t* O; int ldo;
    static constexpr int PF = 4;
    __device__ __forceinline__ void seg(f32x4 (&acc)[2][2][4][2], const Unit& u, int s, int wr, int wc, int fr, int fq) const {
        const int row0 = u.pm * BM + wr * 64 + fr, col0 = wc * 32 + 8 * fq; int ldl, ldh; const bf16_t* bl = gm.tile((s - 1) * 4 + u.pn, ldl); const bf16_t* bh = gm.tile(s * 4 + u.pn, ldh);
        u32x4 lo[PF][2], hi[PF][2];
#pragma unroll
        for (int g = 0; g < PF; ++g) { const size_t rown = (size_t)(row0 + (g >> 2) * HALF + (g & 3) * 16);
#pragma unroll
            for (int bj = 0; bj < 2; ++bj) { lo[g][bj] = *(const u32x4*)(bl + rown * ldl + col0 + bj * HALF); hi[g][bj] = *(const u32x4*)(bh + rown * ldh + col0 + bj * HALF); } }
#pragma unroll
        for (int g = 0; g < 8; ++g) { const int ai = g >> 2, m = g & 3, sl = g % PF;
#pragma unroll
            for (int bj = 0; bj < 2; ++bj)
#pragma unroll
                for (int q = 0; q < 4; ++q) { const unsigned wl = lo[sl][bj][q], wh = hi[sl][bj][q];
                    const float l0 = clampg(__builtin_bit_cast(float, wl << 16)), l1 = clampg(__builtin_bit_cast(float, wl & 0xffff0000u)), h0 = clampg(__builtin_bit_cast(float, wh << 16)), h1 = clampg(__builtin_bit_cast(float, wh & 0xffff0000u));
                    const float r0 = (1.0f + __expf(-h0)) * __builtin_amdgcn_rcpf(1.0f + __expf(-l0)), r1 = (1.0f + __expf(-h1)) * __builtin_amdgcn_rcpf(1.0f + __expf(-l1));
                    acc[ai][bj][m][q >> 1][(q & 1) * 2] *= r0; acc[ai][bj][m][q >> 1][(q & 1) * 2 + 1] *= r1; }
            if (g + PF < 8) { const size_t rown = (size_t)(row0 + ((g + PF) >> 2) * HALF + ((g + PF) & 3) * 16);
#pragma unroll
                for (int bj = 0; bj < 2; ++bj) { lo[sl][bj] = *(const u32x4*)(bl + rown * ldl + col0 + bj * HALF); hi[sl][bj] = *(const u32x4*)(bh + rown * ldh + col0 + bj * HALF); } } }
    }
    __device__ __forceinline__ void operator()(const f32x4 (&acc)[2][2][4][2], const Unit& u, int wr, int wc, int fr, int fq) const {
        const int row0 = u.pm * BM + wr * 64 + fr, col0 = wc * 32 + 8 * fq; int ldg; const bf16_t* bg = gm.tile(8 + u.pn, ldg);
        u32x4 gc[PF][2];
#pragma unroll
        for (int g = 0; g < PF; ++g) { const size_t rown = (size_t)(row0 + (g >> 2) * HALF + (g & 3) * 16);
#pragma unroll
            for (int bj = 0; bj < 2; ++bj) gc[g][bj] = *(const u32x4*)(bg + rown * ldg + col0 + bj * HALF); }
#pragma unroll
        for (int gi = 0; gi < 8; ++gi) { const int ai = gi >> 2, m = gi & 3, sl = gi % PF; const int row = row0 + ai * HALF + m * 16; bf16_t* rowp = O + (size_t)row * ldo + u.pn * BM + col0;
#pragma unroll
            for (int bj = 0; bj < 2; ++bj) { const u32x4 g = gc[sl][bj]; float o[8];
#pragma unroll
                for (int q = 0; q < 4; ++q) { const unsigned w = g[q]; const float g0 = clampg(__builtin_bit_cast(float, w << 16)), g1 = clampg(__builtin_bit_cast(float, w & 0xffff0000u));
                    o[2 * q] = acc[ai][bj][m][q >> 1][(q & 1) * 2] * __builtin_amdgcn_rcpf(1.0f + __expf(-g0)); o[2 * q + 1] = acc[ai][bj][m][q >> 1][(q & 1) * 2 + 1] * __builtin_amdgcn_rcpf(1.0f + __expf(-g1)); }
                u32x4 w; w.x = cvt_pk_bf16(o[0], o[1]); w.y = cvt_pk_bf16(o[2], o[3]); w.z = cvt_pk_bf16(o[4], o[5]); w.w = cvt_pk_bf16(o[6], o[7]);
                *(u32x4*)(rowp + bj * HALF) = w; }
            if (gi + PF < 8) { const size_t rown = (size_t)(row0 + ((gi + PF) >> 2) * HALF + ((gi + PF) & 3) * 16);
#pragma unroll
                for (int bj = 0; bj < 2; ++bj) gc[sl][bj] = *(const u32x4*)(bg + rown * ldg + col0 + bj * HALF); } }
    }
};


template <class Epi, class Sched, bool ALIGN_EPI = false, bool SP2 = false>
__device__ __forceinline__ void gemm_phase(PG8_LAS unsigned char* lds, const Gemm g, const Sched& S, const Epi& E) {
    int tid_ = threadIdx.x; asm volatile("" : "+v"(tid_));
    const int tid = tid_, wid = __builtin_amdgcn_readfirstlane(tid >> 6), lane = tid & 63, wr = wid >> 2, wc = wid & 3, fr = lane & 15, fq = lane >> 4;
    const int K = g.K, nt = K / BK;
    unsigned voffA[2], voffB[2];
#pragma unroll
    for (int i = 0; i < 2; ++i) { int R, C; stage_rc(tid * 16 + i * 8192, R, C); const int Rb = Epi::PERM ? ((R & ~31) + perm32(R & 31)) : R;
        voffA[i] = (unsigned)(R * g.lda + C) * 2u; voffB[i] = (unsigned)(Rb * K + C) * 2u; }
    const size_t kstep = (size_t)(BK * 2);
    const size_t hstepB = (size_t)HALF * K * 2, hstepA = (size_t)HALF * g.lda * 2;
    const size_t tstepB = 2 * hstepB, tstepA = 2 * hstepA;
    const unsigned ldsw = (unsigned)wid * 1024u;
    const int aoff = lds_byte(wr * 64 + fr, fq * 8), boff = lds_byte(wc * 32 + fr, fq * 8);
#define PG8_SA(b, h) (((b) * 2 + (h)) * HTB)
#define PG8_SB(b, h) ((4 + (b) * 2 + (h)) * HTB)
#define PG8_STAGE(bufoff, gbase, voff) do { _Pragma("unroll") for (int _i = 0; _i < 2; ++_i) \
        __builtin_amdgcn_global_load_lds((const unsigned*)((const char*)(gbase) + (voff)[_i]), (PG8_LAS unsigned*)(lds + (bufoff) + ldsw + _i * 8192), 16, 0, 0); } while (0)
#define PG8_LDA(dst, b, h) do { _Pragma("unroll") for (int m = 0; m < 4; ++m) _Pragma("unroll") for (int k = 0; k < 2; ++k) dst[m][k] = *(const PG8_LAS bf16x8*)(lds + PG8_SA(b, h) + aoff + m * 2048 + k * 1024); } while (0)
#define PG8_LDB(dst, b, h) do { _Pragma("unroll") for (int n = 0; n < 2; ++n) _Pragma("unroll") for (int k = 0; k < 2; ++k) dst[n][k] = *(const PG8_LAS bf16x8*)(lds + PG8_SB(b, h) + boff + n * 2048 + k * 1024); } while (0)
#define PG8_MMA(ai, bj, At, Bt) do { __builtin_amdgcn_s_setprio(1); _Pragma("unroll") for (int m = 0; m < 4; ++m) _Pragma("unroll") for (int n = 0; n < 2; ++n) _Pragma("unroll") for (int k = 0; k < 2; ++k) \
        acc[ai][bj][m][n] = __builtin_amdgcn_mfma_f32_16x16x32_bf16(Bt[n][k], At[m][k], acc[ai][bj][m][n], 0, 0, 0); __builtin_amdgcn_s_setprio(0); } while (0)
#define PG8_WAIT_V(n) asm volatile("s_waitcnt vmcnt(" #n ")" ::: "memory")
#define PG8_WAIT_L(n) asm volatile("s_waitcnt lgkmcnt(" #n ")" ::: "memory")
#define PG8_BAR __builtin_amdgcn_s_barrier()
#define PG8_SCHED __builtin_amdgcn_sched_barrier(0)
    Unit cur, nxt; int ui = 0;
    if (!S.next(0, cur)) return;
    f32x4 rt0 = (f32x4){0.f, 0.f, 0.f, 0.f}, rt1 = rt0;
    if constexpr (Epi::ROWTAB) { E.tab_load(cur, tid, rt0, rt1); E.tab_store((PG8_LAS float*)(lds + STAGE_BYTES), tid, rt0, rt1); }
    f32x4 acc[2][2][4][2];
#pragma unroll
    for (int a = 0; a < 2; ++a)
#pragma unroll
        for (int b = 0; b < 2; ++b)
#pragma unroll
            for (int m = 0; m < 4; ++m)
#pragma unroll
                for (int n = 0; n < 2; ++n) acc[a][b][m][n] = (f32x4){0.f, 0.f, 0.f, 0.f};
    if constexpr (Epi::ACCINIT) E.init(acc, cur, wr, wc, fr, fq);
    bf16x8 At[4][2], B0[2][2], B1[2][2];
    const char* cA = (const char*)g.A + (size_t)cur.pm * tstepA; const char* cB = (const char*)g.Bt + (size_t)cur.pn * tstepB;
    S.a_ready(cur);
    if constexpr (SP2) {
        PG8_STAGE(PG8_SB(0, 0), cB, voffB); PG8_STAGE(PG8_SB(0, 1), cB + hstepB, voffB); PG8_STAGE(PG8_SA(0, 0), cA, voffA); PG8_STAGE(PG8_SA(0, 1), cA + hstepA, voffA);
        if (wr == 1) PG8_BAR;
        PG8_WAIT_V(2); PG8_BAR;
        PG8_STAGE(PG8_SB(1, 0), cB + kstep, voffB); PG8_STAGE(PG8_SA(1, 0), cA + kstep, voffA); PG8_STAGE(PG8_SB(1, 1), cB + hstepB + kstep, voffB);
        PG8_WAIT_V(6); PG8_BAR;
    } else {
        PG8_STAGE(PG8_SB(0, 0), cB, voffB); PG8_STAGE(PG8_SA(0, 0), cA, voffA); PG8_STAGE(PG8_SB(0, 1), cB + hstepB, voffB); PG8_STAGE(PG8_SA(0, 1), cA + hstepA, voffA);
        if (wr == 1) PG8_BAR;
        PG8_WAIT_V(4); PG8_BAR;
        PG8_STAGE(PG8_SB(1, 0), cB + kstep, voffB); PG8_STAGE(PG8_SA(1, 0), cA + kstep, voffA); PG8_STAGE(PG8_SB(1, 1), cB + hstepB + kstep, voffB);
        PG8_WAIT_V(6); PG8_BAR;
    }
    for (;;) {
        const bool has_next = S.next(ui + 1, nxt);
        const char* nA = has_next ? (const char*)g.A + (size_t)nxt.pm * tstepA : cA; const char* nB = has_next ? (const char*)g.Bt + (size_t)nxt.pn * tstepB : cB;
        for (int t = 0; t < nt; t += 2) {
            const bool last = (t == nt - 2);
            const char* a1 = cA + (size_t)(t + 1) * kstep;
            const char* a2 = last ? nA : cA + (size_t)(t + 2) * kstep; const char* b2 = last ? nB : cB + (size_t)(t + 2) * kstep;
            const char* a3 = a2 + kstep; const char* b3 = b2 + kstep;
            if (last && has_next) S.a_ready(nxt);
            if constexpr (Epi::ROWTAB) { if (has_next) { if (t == nt - 4) E.tab_load(nxt, tid, rt0, rt1);
                                                         if (last) E.tab_store((PG8_LAS float*)(lds + STAGE_BYTES + ((ui + 1) & 1) * 1024), tid, rt0, rt1); } }
            if constexpr (Epi::KSEG > 0) { if (t != 0 && (t % Epi::KSEG) == 0) {
                if constexpr (ALIGN_EPI) { if (wr == 0) PG8_BAR; }
                E.seg(acc, cur, t / Epi::KSEG, wr, wc, fr, fq);
                if constexpr (ALIGN_EPI) { if (wr == 1) PG8_BAR; } } }
            if constexpr (SP2) {
            PG8_LDB(B0, 0, 0); PG8_LDB(B1, 0, 1); PG8_SCHED; PG8_LDA(At, 0, 0); PG8_STAGE(PG8_SA(1, 1), a1 + hstepA, voffA);
            PG8_WAIT_V(8); PG8_WAIT_L(0); PG8_BAR; PG8_MMA(0, 0, At, B0); PG8_MMA(0, 1, At, B1); PG8_BAR; PG8_SCHED;
            PG8_LDA(At, 0, 1); PG8_STAGE(PG8_SB(0, 0), b2, voffB); PG8_STAGE(PG8_SB(0, 1), b2 + hstepB, voffB); PG8_STAGE(PG8_SA(0, 0), a2, voffA);
            PG8_WAIT_V(8); PG8_WAIT_L(0); PG8_BAR; PG8_MMA(1, 0, At, B0); PG8_MMA(1, 1, At, B1); PG8_BAR; PG8_SCHED;
            PG8_LDB(B0, 1, 0); PG8_LDB(B1, 1, 1); PG8_SCHED; PG8_LDA(At, 1, 0); PG8_STAGE(PG8_SA(0, 1), a2 + hstepA, voffA);
            PG8_WAIT_V(8); PG8_WAIT_L(0); PG8_BAR; PG8_MMA(0, 0, At, B0); PG8_MMA(0, 1, At, B1); PG8_BAR; PG8_SCHED;
            PG8_LDA(At, 1, 1); PG8_STAGE(PG8_SB(1, 0), b3, voffB); PG8_STAGE(PG8_SB(1, 1), b3 + hstepB, voffB); PG8_STAGE(PG8_SA(1, 0), a3, voffA);
            PG8_WAIT_V(8); PG8_WAIT_L(0); PG8_BAR; PG8_MMA(1, 0, At, B0); PG8_MMA(1, 1, At, B1); PG8_BAR; PG8_SCHED;
            } else {
            PG8_LDB(B0, 0, 0); PG8_SCHED; PG8_LDA(At, 0, 0); PG8_STAGE(PG8_SA(1, 1), a1 + hstepA, voffA);
            PG8_WAIT_L(8); PG8_BAR; PG8_WAIT_L(0); PG8_MMA(0, 0, At, B0); PG8_BAR; PG8_SCHED;
            PG8_LDB(B1, 0, 1); PG8_STAGE(PG8_SB(0, 0), b2, voffB);
            PG8_BAR; PG8_WAIT_L(0); PG8_MMA(0, 1, At, B1); PG8_BAR;
            PG8_LDA(At, 0, 1); PG8_STAGE(PG8_SA(0, 0), a2, voffA);
            PG8_BAR; PG8_WAIT_L(0); PG8_MMA(1, 0, At, B0); PG8_BAR; PG8_SCHED;
            PG8_STAGE(PG8_SB(0, 1), b2 + hstepB, voffB);
            PG8_WAIT_V(6); PG8_BAR; PG8_MMA(1, 1, At, B1); PG8_BAR;
            PG8_LDB(B0, 1, 0); PG8_SCHED; PG8_LDA(At, 1, 0); PG8_STAGE(PG8_SA(0, 1), a2 + hstepA, voffA);
            PG8_WAIT_L(8); PG8_BAR; PG8_WAIT_L(0); PG8_MMA(0, 0, At, B0); PG8_BAR; PG8_SCHED;
            PG8_LDB(B1, 1, 1); PG8_STAGE(PG8_SB(1, 0), b3, voffB);
            PG8_BAR; PG8_WAIT_L(0); PG8_MMA(0, 1, At, B1); PG8_BAR;
            PG8_LDA(At, 1, 1); PG8_STAGE(PG8_SA(1, 0), a3, voffA);
            PG8_BAR; PG8_WAIT_L(0); PG8_MMA(1, 0, At, B0); PG8_BAR; PG8_SCHED;
            PG8_STAGE(PG8_SB(1, 1), b3 + hstepB, voffB);
            PG8_WAIT_V(6); PG8_BAR; PG8_MMA(1, 1, At, B1); PG8_BAR;
            }
        }
        if constexpr (ALIGN_EPI) { if (wr == 0) PG8_BAR; }
        if constexpr (!Epi::AFTER_DRAIN) { if constexpr (Epi::ROWTAB) E(acc, cur, wr, wc, fr, fq, (const PG8_LAS float*)(lds + STAGE_BYTES + (ui & 1) * 1024)); else E(acc, cur, wr, wc, fr, fq); S.done(cur); }
        if (!has_next) break;
#pragma unroll
        for (int a = 0; a < 2; ++a)
#pragma unroll
            for (int b = 0; b < 2; ++b)
#pragma unroll
                for (int m = 0; m < 4; ++m)
#pragma unroll
                    for (int n = 0; n < 2; ++n) acc[a][b][m][n] = (f32x4){0.f, 0.f, 0.f, 0.f};
        if constexpr (Epi::ACCINIT) E.init(acc, nxt, wr, wc, fr, fq);
        cur = nxt; cA = nA; cB = nB; ++ui;
        if constexpr (ALIGN_EPI) { if (wr == 1) PG8_BAR; }
    }
    PG8_WAIT_V(0);
    if constexpr (!ALIGN_EPI) { if (wr == 0) PG8_BAR; }
    PG8_BAR;
    if constexpr (Epi::AFTER_DRAIN) { E.fused(acc, cur, wr, wc, fr, fq, lds, wid, lane); S.done(cur); }
#undef PG8_SA
#undef PG8_SB
#undef PG8_STAGE
#undef PG8_LDA
#undef PG8_LDB
#undef PG8_MMA
#undef PG8_WAIT_V
#undef PG8_WAIT_L
#undef PG8_BAR
#undef PG8_SCHED
}
}


#define LDS_WAIT() asm volatile("s_waitcnt lgkmcnt(0)" ::: "memory")
constexpr int NWAVES = 8;
constexpr int LDS_BYTES = 157696;

struct WItem { const float* W; const float* scale; bf16* WT; int ldw, k0, n0, ldt, drow0, dcol0; };
constexpr int WI_IN = 16 * 240, WI_MIX = 3 * 8 * 32, WI_OUT = 16 * 32, WI_G = 16 * 88, WI_DN = 44 * 32;
constexpr int WI_TOTAL = WI_IN + WI_MIX + WI_OUT + 2 * WI_G + WI_DN;
__device__ __forceinline__ void witem_desc(KP P, int gi, WItem& d) {
    const int l = gi / WI_TOTAL; int it = gi - l * WI_TOTAL;
    unsigned char* ws = wbase(P, l);
    if (it < WI_IN) { const int kb = it / 240, nb = it % 240; d.W = P->in[I_WIN] + (size_t)l * D * INW; d.ldw = INW; d.k0 = 64 * kb; d.n0 = 32 * nb; d.scale = P->in[I_N1G] + l * D; d.WT = (bf16*)(ws + WS_WIN); d.ldt = D; d.drow0 = 32 * nb; d.dcol0 = 64 * kb; return; }
    it -= WI_IN;
    if (it < WI_MIX) { const int br = it / 256, r = it % 256, kb = r / 32, nb = r % 32; d.W = P->in[br == 0 ? I_WAO : (br == 1 ? I_WRO : I_WTO)] + (size_t)l * 512 * D;
        d.ldw = D; d.k0 = 64 * kb; d.n0 = 32 * nb; d.scale = nullptr; d.WT = (bf16*)(ws + WS_WMIX); d.ldt = NMIX; d.drow0 = 32 * nb; d.dcol0 = br * 512 + 64 * kb; return; }
    it -= WI_MIX;
    if (it < WI_OUT) { const int kb = it / 32, nb = it % 32; d.W = P->in[I_WOUT] + (size_t)l * D * D; d.ldw = D; d.k0 = 64 * kb; d.n0 = 32 * nb; d.scale = nullptr; d.WT = (bf16*)(ws + WS_WOUT); d.ldt = D; d.drow0 = 32 * nb; d.dcol0 = 64 * kb; return; }
    it -= WI_OUT;
    if (it < 2 * WI_G) { const int up = it / WI_G, r = it % WI_G, kb = r / 88, nb = r % 88, n0 = 32 * nb;
        d.W = P->in[up ? I_WU : I_WG] + (size_t)l * D * FF; d.ldw = FF; d.k0 = 64 * kb; d.n0 = n0; d.scale = P->in[I_N2G] + l * D; d.WT = (bf16*)(ws + WS_WGU); d.ldt = D; d.drow0 = (n0 / 128) * 256 + up * 128 + (n0 % 128); d.dcol0 = 64 * kb; return; }
    it -= 2 * WI_G;
    { const int kb = it / 32, nb = it % 32; d.W = P->in[I_WD] + (size_t)l * FF * D; d.ldw = D; d.k0 = 64 * kb; d.n0 = 32 * nb; d.scale = nullptr; d.WT = (bf16*)(ws + WS_WDN); d.ldt = FF; d.drow0 = 32 * nb; d.dcol0 = 64 * kb; }
}
__device__ __forceinline__ void witem_load(const WItem& d, int lane, v4f (&r)[8], v4f (&sc)[2]) {
    const float* src = d.W + (size_t)(d.k0 + (lane >> 3)) * d.ldw + d.n0 + 4 * (lane & 7);
#pragma unroll
    for (int i = 0; i < 8; ++i) r[i] = *(const v4f*)(src + (size_t)(8 * i) * d.ldw);
    sc[0] = (v4f){1.f, 1.f, 1.f, 1.f}; sc[1] = sc[0];
    if (d.scale) { const v4f* sp = (const v4f*)(d.scale + d.k0 + 8 * (lane & 7)); sc[0] = sp[0]; sc[1] = sp[1]; }
}
__device__ __forceinline__ void witem_store(const WItem& d, int lane, const v4f (&r)[8], const v4f (&sc)[2], LAS float* scr) {
    { LAS float* w = scr + (lane >> 3) * 33 + 4 * (lane & 7);
#pragma unroll
      for (int i = 0; i < 8; ++i) { w[(8 * i) * 33 + 0] = r[i].x; w[(8 * i) * 33 + 1] = r[i].y; w[(8 * i) * 33 + 2] = r[i].z; w[(8 * i) * 33 + 3] = r[i].w; } }
    LDS_WAIT(); asm volatile("" ::: "memory");
    const int c = lane & 7;
#pragma unroll
    for (int j = 0; j < 4; ++j) { const int n = (lane >> 3) + 8 * j; const LAS float* s = scr + (8 * c) * 33 + n;
        v4u o; o.x = pk2(s[0 * 33] * sc[0].x, s[1 * 33] * sc[0].y); o.y = pk2(s[2 * 33] * sc[0].z, s[3 * 33] * sc[0].w); o.z = pk2(s[4 * 33] * sc[1].x, s[5 * 33] * sc[1].y); o.w = pk2(s[6 * 33] * sc[1].z, s[7 * 33] * sc[1].w);
        *(v4u*)(d.WT + (size_t)(d.drow0 + n) * d.ldt + d.dcol0 + 8 * c) = o; }
    LDS_WAIT(); asm volatile("" ::: "memory");
}
__device__ __forceinline__ void phase_wconv_all(KP P, LAS unsigned char* lds, int vcu, int G) {
    const int otid_ = otid();
    const int wave = __builtin_amdgcn_readfirstlane(otid_ >> 6), lane = otid_ & 63;
    LAS float* scr = (LAS float*)(lds + wave * 16384);
    const int step = G * NWAVES, total = DEPTH * WI_TOTAL;
    int gi = vcu * NWAVES + wave;
    if (gi >= total) return;
    WItem cur, nxt; v4f rc[8], rn[8], sc[2], sn[2];
    witem_desc(P, gi, cur); witem_load(cur, lane, rc, sc);
#pragma unroll 1
    for (;;) {
        const int gn = gi + step; const bool has_next = gn < total;
        if (has_next) { witem_desc(P, gn, nxt); witem_load(nxt, lane, rn, sn); }
        witem_store(cur, lane, rc, sc, scr);
        if (!has_next) break;
        cur = nxt; gi = gn;
#pragma unroll
        for (int i = 0; i < 8; ++i) rc[i] = rn[i];
        sc[0] = sn[0]; sc[1] = sn[1];
    }
}
__device__ __forceinline__ void phase_x0(KP P, int vcu, int G) {
    const int otid_ = otid();
    const int wave = __builtin_amdgcn_readfirstlane(otid_ >> 6), lane = otid_ & 63;
    const float* x = P->in[I_X]; bf16* xb = (bf16*)(P->ws + WS_XB); float* rss = (float*)(P->ws + WS_RSS);
    for (int m0 = vcu * NWAVES + wave; m0 < M; m0 += 2 * G * NWAVES) {
        v4f v[2][4];
#pragma unroll
        for (int q = 0; q < 2; ++q) { const int m = m0 + q * G * NWAVES; const v4f* xr = (const v4f*)(x + (size_t)(m < M ? m : m0) * D) + lane;
#pragma unroll
            for (int j = 0; j < 4; ++j) v[q][j] = xr[64 * j]; }
#pragma unroll
        for (int q = 0; q < 2; ++q) { const int m = m0 + q * G * NWAVES; if (m < M) { unsigned long long* o8 = (unsigned long long*)(xb + (size_t)m * D) + lane; float s = 0.f;
#pragma unroll
            for (int j = 0; j < 4; ++j) s += (v[q][j].x * v[q][j].x + v[q][j].y * v[q][j].y) + (v[q][j].z * v[q][j].z + v[q][j].w * v[q][j].w);
            s = wave_sum(s);
#pragma unroll
            for (int j = 0; j < 4; ++j) { o8[64 * j] = (unsigned long long)pk2(v[q][j].x, v[q][j].y) | ((unsigned long long)pk2(v[q][j].z, v[q][j].w) << 32); }
            if (lane < 16) rss[(size_t)m * 16 + lane] = lane == 0 ? s : 0.f; } }
    }
    float* rope = (float*)(P->ws + WS_ROPE);
    for (int i = (vcu * NWAVES + wave) * 64 + lane; i < T * 32; i += G * NWAVES * 64) {
        const int t = i >> 5, j = i & 31; const float inv_freq = (float)exp(-((double)j / 32.0) * 9.210340371976184); const float ang = (float)t * inv_freq;
        const double xa = (double)ang, qd = rint(xa * 0.6366197723675814), fd = xa - qd * 1.5707963267948966; const int qi = (int)qd & 3;
        const float ff = (float)fd, f2 = ff * ff;
        const float sf = ff * (1.0f + f2 * (-1.6666667e-1f + f2 * (8.3333333e-3f + f2 * (-1.9841270e-4f + f2 * 2.7557319e-6f))));
        const float cf = 1.0f + f2 * (-0.5f + f2 * (4.1666667e-2f + f2 * (-1.3888889e-3f + f2 * (2.4801587e-5f + f2 * -2.7557319e-7f))));
        const float sn = (qi == 0) ? sf : (qi == 1) ? cf : (qi == 2) ? -sf : -cf, cs = (qi == 0) ? cf : (qi == 1) ? -sf : (qi == 2) ? -cf : sf;
        rope[2 * i] = cs; rope[2 * i + 1] = sn;
        { float* rope2 = (float*)(P->ws + WS_ROPE2); const int p = j >> 3, e = (j & 7) >> 1, o = j & 1;
          const size_t q = (((size_t)e * T + t) * 4 + p) * 4 + 2 * o; rope2[q] = cs; rope2[q + 1] = sn; }
    }
}


#define RESID_ALIGN true
#define STAGGER_US10 0
template <int PH> __device__ __forceinline__ void gemm_phase_of(KP P, int l, LAS unsigned char* lds, int G, int c) {
    asm volatile("" : "+s"(l), "+s"(G), "+s"(c));
    const bool final_layer = (l == DEPTH - 1); const unsigned char* wb = wbase(P, l);
    unsigned char* ws = P->ws; const pg8::bf16_t* xb = (const pg8::bf16_t*)(ws + WS_XB); float* rss = (float*)(ws + WS_RSS);
    if constexpr (STAGGER_US10 > 0 && (PH == 0 || PH == 1 || PH == 4)) {
        if (otid() == 0) { const unsigned long long t0 = __builtin_amdgcn_s_memrealtime(), dt = (unsigned long long)(((unsigned)c >> 3) & 7u) * STAGGER_US10 * 10ull;
            while (__builtin_amdgcn_s_memrealtime() - t0 < dt) __builtin_amdgcn_s_sleep(8); }
        __syncthreads(); }
    pg8::StaticOrder S;
    if constexpr (PH == 0) { pg8::Gemm g{xb, (const pg8::bf16_t*)(wb + WS_WIN), M, NA, D, D}; S.init(M, NA, G, c); pg8::EpiRowScale E{{rss}, (pg8::bf16_t*)(ws + WS_BIG), NA};
        pg8::gemm_phase<pg8::EpiRowScale, pg8::StaticOrder, true, true>(lds, g, S, E); }
    if constexpr (PH == 1) { pg8::Gemm g{xb, (const pg8::bf16_t*)(wb + WS_WIN) + (size_t)NA * D, M, NG, D, D}; S.init(M, NG, G, c); pg8::EpiGates E{{rss}, pg8::GateMap{(pg8::bf16_t*)(ws + WS_BIG), (pg8::bf16_t*)(ws + WS_GX)}};
        pg8::gemm_phase<pg8::EpiGates, pg8::StaticOrder, true, true>(lds, g, S, E); }
    if constexpr (PH == 2) { pg8::Gemm g{(const pg8::bf16_t*)(ws + WS_MIXO), (const pg8::bf16_t*)(wb + WS_WMIX), M, D, NMIX, NMIX}; S.init(M, D, G, c); pg8::EpiGateMix E{pg8::GateMap{(pg8::bf16_t*)(ws + WS_BIG), (pg8::bf16_t*)(ws + WS_GX)}, (pg8::bf16_t*)(ws + WS_BIG) + C_RW, NA};
        pg8::gemm_phase<pg8::EpiGateMix, pg8::StaticOrder, true, true>(lds, g, S, E); }
    if constexpr (PH == 3) { pg8::Gemm g{(const pg8::bf16_t*)(ws + WS_BIG) + C_RW, (const pg8::bf16_t*)(wb + WS_WOUT), M, D, D, NA}; S.init(M, D, G, c); pg8::EpiResid E{(pg8::bf16_t*)(ws + WS_XB), rss, nullptr};
        pg8::gemm_phase<pg8::EpiResid, pg8::StaticOrder, RESID_ALIGN, true>(lds, g, S, E); }
    if constexpr (PH == 4) { pg8::Gemm g{xb, (const pg8::bf16_t*)(wb + WS_WGU), M, FF2, D, D}; S.init(M, FF2, G, c); pg8::EpiSwiglu E{{rss}, (pg8::bf16_t*)(ws + WS_BIG), NA};
        pg8::gemm_phase<pg8::EpiSwiglu, pg8::StaticOrder, true, true>(lds, g, S, E); }
    if constexpr (PH == 5) { pg8::Gemm g{(const pg8::bf16_t*)(ws + WS_BIG), (const pg8::bf16_t*)(wb + WS_WDN), M, D, FF, NA}; S.init(M, D, G, c); pg8::EpiResid E{(pg8::bf16_t*)(ws + WS_XB), rss, final_layer ? P->out : nullptr};
        pg8::gemm_phase<pg8::EpiResid, pg8::StaticOrder, RESID_ALIGN, true>(lds, g, S, E); }
}

typedef float f32x16 __attribute__((ext_vector_type(16)));
typedef short bf16x8v __attribute__((ext_vector_type(8)));
constexpr int AT_KS = 144;
constexpr int AT_VS = 520;
constexpr int AT_KOFF = 0, AT_VOFF = 256 * AT_KS, AT_GOFF = AT_VOFF + 64 * AT_VS;
typedef float v2f_ __attribute__((ext_vector_type(2)));
typedef __bf16 v2bf_ __attribute__((ext_vector_type(2)));
__device__ __forceinline__ unsigned cvtpk(float lo, float hi) { const v2f_ x = {lo, hi}; return __builtin_bit_cast(unsigned, __builtin_convertvector(x, v2bf_)); }
#define LDS_BAR() do { asm volatile("s_waitcnt lgkmcnt(0)" ::: "memory"); __builtin_amdgcn_s_barrier(); asm volatile("" ::: "memory"); } while (0)
__device__ __forceinline__ void attn_phase(KP P, int l, LAS unsigned char* lds, int u0, int ustep, int uend) {
    const int tid = otid(), w = __builtin_amdgcn_readfirstlane(tid >> 6), lane = tid & 63, r32 = lane & 31, h = lane >> 5;
    const bf16* proj = (const bf16*)(P->ws + WS_BIG); bf16* mixo = (bf16*)(P->ws + WS_MIXO);
    const float* gq = P->in[I_QNG] + l * 64; const float* gk = P->in[I_KNG] + l * 64; const float* sinks = P->in[I_SINK] + l * 8;
    LAS float* gqs = (LAS float*)(lds + AT_GOFF);
    constexpr float LOG2E = 1.4426950408889634f;
    __syncthreads();
    if (tid < 64) { gqs[tid] = gq[tid] * (0.125f * LOG2E); gqs[64 + tid] = gk[tid]; }
    v4u kv[4], vv[4];
#define AT_LOAD(U) do { const int b_ = (U) >> 5, n_ = ((U) >> 1) & 15, kvh_ = (U) & 1, r_ = tid >> 1, hf_ = tid & 1; const size_t grow_ = (size_t)(b_ * T + n_ * 128 - 128 + r_) * NA; \
        _Pragma("unroll") for (int i = 0; i < 4; ++i) { kv[i] = (v4u){0u, 0u, 0u, 0u}; vv[i] = (v4u){0u, 0u, 0u, 0u}; } \
        if ((n_ > 0) || (r_ >= 128)) { _Pragma("unroll") for (int i = 0; i < 4; ++i) { kv[i] = *(const v4u*)(proj + grow_ + C_AK + kvh_ * 64 + hf_ * 32 + 8 * i); vv[i] = *(const v4u*)(proj + grow_ + C_AV + kvh_ * 64 + hf_ * 32 + 8 * i); } } } while (0)
    if (u0 < uend) AT_LOAD(u0);
    for (int unit = u0; unit < uend; unit += ustep) {
        const int b = unit >> 5, n = (unit >> 1) & 15, kvh = unit & 1;
        LDS_BAR();
        {
            const int r = tid >> 1, hf = tid & 1;
            float ss = 0.f;
#pragma unroll
            for (int i = 0; i < 4; ++i)
#pragma unroll
                for (int e = 0; e < 4; ++e) { const float k0 = bflo(kv[i][e]), k1 = bfhi(kv[i][e]); ss += k0 * k0 + k1 * k1; }
            ss += __shfl_xor(ss, 1);
            const float rs = rsqrtf(ss * (1.f / 64.f) + 1e-6f);
#pragma unroll
            for (int i = 0; i < 4; ++i) { v4u o;
#pragma unroll
                for (int e = 0; e < 4; ++e) { const int d = hf * 32 + 8 * i + 2 * e; o[e] = cvtpk(bflo(kv[i][e]) * rs * gqs[64 + d], bfhi(kv[i][e]) * rs * gqs[64 + d + 1]); }
                *(LAS v4u*)(lds + AT_KOFF + r * AT_KS + hf * 64 + 16 * i) = o; }
#pragma unroll
            for (int i = 0; i < 4; ++i)
#pragma unroll
                for (int e = 0; e < 4; ++e) { const int d = hf * 32 + 8 * i + 2 * e;
                    *(LAS unsigned short*)(lds + AT_VOFF + d * AT_VS + r * 2) = (unsigned short)(vv[i][e] & 0xffffu);
                    *(LAS unsigned short*)(lds + AT_VOFF + (d + 1) * AT_VS + r * 2) = (unsigned short)(vv[i][e] >> 16); }
        }
        LDS_BAR();
        if (unit + ustep < uend) AT_LOAD(unit + ustep);
#pragma unroll 1
        for (int gi = 0; gi < 2; ++gi) {
            const int g = w >> 1, sb = (w & 1) * 2 + gi, hq = kvh * 4 + g;
            const size_t qrow = (size_t)(b * T + n * 128 + 32 * sb + r32);
            v4u qr[4]; float ss = 0.f;
#pragma unroll
            for (int s = 0; s < 4; ++s) { qr[s] = *(const v4u*)(proj + qrow * NA + C_AQ + hq * 64 + 8 * h + 16 * s);
#pragma unroll
                for (int e = 0; e < 4; ++e) { const float q0 = bflo(qr[s][e]), q1 = bfhi(qr[s][e]); ss += q0 * q0 + q1 * q1; } }
            ss += __shfl_xor(ss, 32);
            const float rs = rsqrtf(ss * (1.f / 64.f) + 1e-6f);
            bf16x8v Qf[4];
#pragma unroll
            for (int s = 0; s < 4; ++s) { const v4f g0 = *(const LAS v4f*)(gqs + 8 * h + 16 * s), g1 = *(const LAS v4f*)(gqs + 8 * h + 16 * s + 4); v4u o;
                o[0] = cvtpk(bflo(qr[s][0]) * rs * g0[0], bfhi(qr[s][0]) * rs * g0[1]); o[1] = cvtpk(bflo(qr[s][1]) * rs * g0[2], bfhi(qr[s][1]) * rs * g0[3]);
                o[2] = cvtpk(bflo(qr[s][2]) * rs * g1[0], bfhi(qr[s][2]) * rs * g1[1]); o[3] = cvtpk(bflo(qr[s][3]) * rs * g1[2], bfhi(qr[s][3]) * rs * g1[3]);
                Qf[s] = __builtin_bit_cast(bf16x8v, o); }
            f32x16 S[5];
#pragma unroll
            for (int c5 = 0; c5 < 5; ++c5) { f32x16 acc;
#pragma unroll
                for (int i = 0; i < 16; ++i) acc[i] = 0.f;
#pragma unroll
                for (int s = 0; s < 4; ++s) { const bf16x8v kf = *(const LAS bf16x8v*)(lds + AT_KOFF + (32 * (sb + c5) + r32) * AT_KS + (8 * h + 16 * s) * 2);
                    acc = __builtin_amdgcn_mfma_f32_32x32x16_bf16(kf, Qf[s], acc, 0, 0, 0); }
                S[c5] = acc; }
            const int qi = 32 * sb + r32; float mx = -INFINITY;
#pragma unroll
            for (int c5 = 0; c5 < 5; ++c5)
#pragma unroll
                for (int i = 0; i < 16; ++i) { const int si = 32 * (sb + c5) + 8 * (i >> 2) + 4 * h + (i & 3);
                    bool ok = true; if (c5 == 0) ok = si > qi; if (c5 == 4) ok = si <= qi + 128; if (n == 0) ok = ok && (si >= 128);
                    const float v = ok ? S[c5][i] : -INFINITY; S[c5][i] = v; mx = fmaxf(mx, v); }
            mx = fmaxf(mx, __shfl_xor(mx, 32));
            const float sink = sinks[hq] * LOG2E; mx = fmaxf(mx, sink);
            float sum = 0.f;
#pragma unroll
            for (int c5 = 0; c5 < 5; ++c5)
#pragma unroll
                for (int i = 0; i < 16; ++i) { const float p = __builtin_amdgcn_exp2f(S[c5][i] - mx); S[c5][i] = p; sum += p; }
            sum += __shfl_xor(sum, 32);
            const float inv = 1.0f / (sum + __builtin_amdgcn_exp2f(sink - mx));
            f32x16 O[2];
#pragma unroll
            for (int dt = 0; dt < 2; ++dt)
#pragma unroll
                for (int i = 0; i < 16; ++i) O[dt][i] = 0.f;
#pragma unroll
            for (int c5 = 0; c5 < 5; ++c5)
#pragma unroll
                for (int s = 0; s < 2; ++s) { v4u pw; pw[0] = cvtpk(S[c5][8 * s], S[c5][8 * s + 1]); pw[1] = cvtpk(S[c5][8 * s + 2], S[c5][8 * s + 3]); pw[2] = cvtpk(S[c5][8 * s + 4], S[c5][8 * s + 5]); pw[3] = cvtpk(S[c5][8 * s + 6], S[c5][8 * s + 7]);
                    const bf16x8v pf = __builtin_bit_cast(bf16x8v, pw);
#pragma unroll
                    for (int dt = 0; dt < 2; ++dt) { const LAS unsigned char* vp = lds + AT_VOFF + (32 * dt + r32) * AT_VS + (32 * (sb + c5) + 16 * s + 4 * h) * 2;
                        const v2u lo = *(const LAS v2u*)vp, hi = *(const LAS v2u*)(vp + 16); v4u vw; vw[0] = lo[0]; vw[1] = lo[1]; vw[2] = hi[0]; vw[3] = hi[1];
                        O[dt] = __builtin_amdgcn_mfma_f32_32x32x16_bf16(__builtin_bit_cast(bf16x8v, vw), pf, O[dt], 0, 0, 0); } }
#pragma unroll
            for (int dt = 0; dt < 2; ++dt)
#pragma unroll
                for (int q4 = 0; q4 < 4; ++q4) { v2u o; o[0] = cvtpk(O[dt][4 * q4] * inv, O[dt][4 * q4 + 1] * inv); o[1] = cvtpk(O[dt][4 * q4 + 2] * inv, O[dt][4 * q4 + 3] * inv);
                    *(v2u*)(mixo + qrow * NMIX + hq * 64 + 32 * dt + 8 * q4 + 4 * h) = o; }
        }
    }
    __syncthreads();
#undef AT_LOAD
}

constexpr int RT_KS = 144, RT_TS = 272;
constexpr int RT_KOFF = 0, RT_KTOFF = 128 * RT_KS, RT_VTOFF = RT_KTOFF + 64 * RT_TS, RT_ROFF = RT_VTOFF + 64 * RT_TS, RT_SOFF = RT_ROFF + 64 * RT_KS, RT_QOFF = RT_SOFF + 1024, RT_GOFF = RT_QOFF + 128 * RT_KS, RT_END = RT_GOFF + 128 * RT_KS;
static_assert(RT_END <= 131072, "retention LDS");
__device__ __forceinline__ void ret_unit(KP P, LAS unsigned char* lds, int b, int hh) {
    const int tid = otid(), w = __builtin_amdgcn_readfirstlane(tid >> 6), lane = tid & 63, r32 = lane & 31, h = lane >> 5;
    const bf16* proj = (const bf16*)(P->ws + WS_BIG); bf16* mixo = (bf16*)(P->ws + WS_MIXO); const float* rope2 = (const float*)(P->ws + WS_ROPE2);
    const float lg = log2f(1.0f - exp2f(-5.0f - (float)hh));
    const float g128 = exp2f(128.0f * lg);
    const int qg = w >> 1, dt = w & 1;
    f32x16 Racc;
#pragma unroll
    for (int i = 0; i < 16; ++i) Racc[i] = 0.f;
    __syncthreads();
    for (int i = tid; i < 64 * RT_KS / 4; i += 512) ((LAS unsigned*)(lds + RT_ROFF))[i] = 0u;
    v4u pk1, pk2, pv1, pv2, pq1, pq2, pg1, pg2; v4f prk[4];
#define RT_PREFETCH(N) do { const int row_ = tid >> 2, p_ = tid & 3; const size_t g_ = ((size_t)(b * T + (N) * 128) + row_) * NA + hh * 64 + 8 * p_; \
        pk1 = *(const v4u*)(proj + g_ + C_RK); pk2 = *(const v4u*)(proj + g_ + C_RK + 32); pv1 = *(const v4u*)(proj + g_ + C_RV); pv2 = *(const v4u*)(proj + g_ + C_RV + 32); \
        pq1 = *(const v4u*)(proj + g_ + C_RQ); pq2 = *(const v4u*)(proj + g_ + C_RQ + 32); pg1 = *(const v4u*)(proj + g_ + C_RG); pg2 = *(const v4u*)(proj + g_ + C_RG + 32); \
        _Pragma("unroll") for (int e_ = 0; e_ < 4; ++e_) prk[e_] = *(const v4f*)(rope2 + (((size_t)e_ * T + (N) * 128 + row_) * 4 + p_) * 4); } while (0)
    RT_PREFETCH(0);
#pragma unroll 1
    for (int n = 0; n < 16; ++n) {
        const size_t tok0 = (size_t)(b * T + n * 128);
        LDS_BAR();
        {
            const int row = tid >> 2, p = tid & 3;
            const v4u k1 = pk1, k2 = pk2, v1 = pv1, v2 = pv2, q1 = pq1, q2 = pq2;
            const float sc = 0.125f * exp2f(-(float)(row + 1) * lg);
            v4u w1, w2, x1, x2;
#pragma unroll
            for (int e = 0; e < 4; ++e) { const v4f cs = prk[e];
                { const float a1 = bflo(k1[e]), a2 = bflo(k2[e]), b1 = bfhi(k1[e]), b2 = bfhi(k2[e]);
                  w1[e] = cvtpk((a1 * cs[0] - a2 * cs[1]) * sc, (b1 * cs[2] - b2 * cs[3]) * sc); w2[e] = cvtpk((a2 * cs[0] + a1 * cs[1]) * sc, (b2 * cs[2] + b1 * cs[3]) * sc); }
                { const float a1 = bflo(q1[e]), a2 = bflo(q2[e]), b1 = bfhi(q1[e]), b2 = bfhi(q2[e]);
                  x1[e] = cvtpk(a1 * cs[0] - a2 * cs[1], b1 * cs[2] - b2 * cs[3]); x2[e] = cvtpk(a2 * cs[0] + a1 * cs[1], b2 * cs[2] + b1 * cs[3]); } }
            *(LAS v4u*)(lds + RT_KOFF + row * RT_KS + 16 * p) = w1; *(LAS v4u*)(lds + RT_KOFF + row * RT_KS + 64 + 16 * p) = w2;
            *(LAS v4u*)(lds + RT_QOFF + row * RT_KS + 16 * p) = x1; *(LAS v4u*)(lds + RT_QOFF + row * RT_KS + 64 + 16 * p) = x2;
            *(LAS v4u*)(lds + RT_GOFF + row * RT_KS + 16 * p) = pg1; *(LAS v4u*)(lds + RT_GOFF + row * RT_KS + 64 + 16 * p) = pg2;
#pragma unroll
            for (int e = 0; e < 4; ++e) { const int d = 8 * p + 2 * e;
                *(LAS unsigned short*)(lds + RT_KTOFF + d * RT_TS + row * 2) = (unsigned short)(w1[e] & 0xffffu); *(LAS unsigned short*)(lds + RT_KTOFF + (d + 1) * RT_TS + row * 2) = (unsigned short)(w1[e] >> 16);
                *(LAS unsigned short*)(lds + RT_KTOFF + (d + 32) * RT_TS + row * 2) = (unsigned short)(w2[e] & 0xffffu); *(LAS unsigned short*)(lds + RT_KTOFF + (d + 33) * RT_TS + row * 2) = (unsigned short)(w2[e] >> 16);
                *(LAS unsigned short*)(lds + RT_VTOFF + d * RT_TS + row * 2) = (unsigned short)(v1[e] & 0xffffu); *(LAS unsigned short*)(lds + RT_VTOFF + (d + 1) * RT_TS + row * 2) = (unsigned short)(v1[e] >> 16);
                *(LAS unsigned short*)(lds + RT_VTOFF + (d + 32) * RT_TS + row * 2) = (unsigned short)(v2[e] & 0xffffu); *(LAS unsigned short*)(lds + RT_VTOFF + (d + 33) * RT_TS + row * 2) = (unsigned short)(v2[e] >> 16); }
        }
        LDS_BAR();
        if (n + 1 < 16) RT_PREFETCH(n + 1);
        bf16x8v Qf[4];
        const size_t qtok = tok0 + 32 * qg + r32;
#pragma unroll
        for (int s = 0; s < 4; ++s) Qf[s] = *(const LAS bf16x8v*)(lds + RT_QOFF + (32 * qg + r32) * RT_KS + (8 * h + 16 * s) * 2);
        f32x16 O;
#pragma unroll
        for (int i = 0; i < 16; ++i) O[i] = 0.f;
#pragma unroll
        for (int s = 0; s < 4; ++s) { const bf16x8v rf = *(const LAS bf16x8v*)(lds + RT_ROFF + (32 * dt + r32) * RT_KS + (8 * h + 16 * s) * 2);
            O = __builtin_amdgcn_mfma_f32_32x32x16_bf16(rf, Qf[s], O, 0, 0, 0); }
#pragma unroll
        for (int c = 0; c < 4; ++c) { if (c <= qg) {
            f32x16 S;
#pragma unroll
            for (int i = 0; i < 16; ++i) S[i] = 0.f;
#pragma unroll
            for (int s = 0; s < 4; ++s) { const bf16x8v kf = *(const LAS bf16x8v*)(lds + RT_KOFF + (32 * c + r32) * RT_KS + (8 * h + 16 * s) * 2);
                S = __builtin_amdgcn_mfma_f32_32x32x16_bf16(kf, Qf[s], S, 0, 0, 0); }
            if (c == qg) {
#pragma unroll
                for (int i = 0; i < 16; ++i) { const int j = 8 * (i >> 2) + 4 * h + (i & 3); S[i] = (j <= r32) ? S[i] : 0.f; } }
#pragma unroll
            for (int s = 0; s < 2; ++s) { v4u pw; pw[0] = cvtpk(S[8 * s], S[8 * s + 1]); pw[1] = cvtpk(S[8 * s + 2], S[8 * s + 3]); pw[2] = cvtpk(S[8 * s + 4], S[8 * s + 5]); pw[3] = cvtpk(S[8 * s + 6], S[8 * s + 7]);
                const LAS unsigned char* vp = lds + RT_VTOFF + (32 * dt + r32) * RT_TS + (32 * c + 16 * s + 4 * h) * 2;
                const v2u lo = *(const LAS v2u*)vp, hi = *(const LAS v2u*)(vp + 16); v4u vw; vw[0] = lo[0]; vw[1] = lo[1]; vw[2] = hi[0]; vw[3] = hi[1];
                O = __builtin_amdgcn_mfma_f32_32x32x16_bf16(__builtin_bit_cast(bf16x8v, vw), __builtin_bit_cast(bf16x8v, pw), O, 0, 0, 0); } } }
        if (w < 4) { const int et = w >> 1, dtile = w & 1;
#pragma unroll
            for (int s = 0; s < 8; ++s) { const bf16x8v vf = *(const LAS bf16x8v*)(lds + RT_VTOFF + (32 * et + r32) * RT_TS + (16 * s + 8 * h) * 2);
                const bf16x8v kf = *(const LAS bf16x8v*)(lds + RT_KTOFF + (32 * dtile + r32) * RT_TS + (16 * s + 8 * h) * 2);
                Racc = __builtin_amdgcn_mfma_f32_32x32x16_bf16(vf, kf, Racc, 0, 0, 0); }
#pragma unroll
            for (int i = 0; i < 16; ++i) Racc[i] *= g128; }
        const float xi = exp2f((float)(32 * qg + r32 + 1) * lg); float ss = 0.f;
#pragma unroll
        for (int i = 0; i < 16; ++i) { O[i] *= xi; ss += O[i] * O[i]; }
        ss += __shfl_xor(ss, 32);
        LAS float* ssb = (LAS float*)(lds + RT_SOFF);
        if (h == 0) ssb[(qg * 2 + dt) * 32 + r32] = ss;
        LDS_BAR();
        const float rstd = rsqrtf((ss + ssb[(qg * 2 + (dt ^ 1)) * 32 + r32]) * (1.f / 64.f) + 1e-6f);
        if (w < 4) { const int et = w >> 1, dtile = w & 1;
#pragma unroll
            for (int i = 0; i < 16; ++i) { const int e = 32 * et + 8 * (i >> 2) + 4 * h + (i & 3); *(LAS unsigned short*)(lds + RT_ROFF + e * RT_KS + (32 * dtile + r32) * 2) = (unsigned short)f2bf(Racc[i]); } }
#pragma unroll
        for (int q4 = 0; q4 < 4; ++q4) { const int e0 = 32 * dt + 8 * q4 + 4 * h; const v2u gw = *(const LAS v2u*)(lds + RT_GOFF + (32 * qg + r32) * RT_KS + e0 * 2);
            const float g0 = bflo(gw[0]), g1 = bfhi(gw[0]), g2 = bflo(gw[1]), g3 = bfhi(gw[1]);
            v2u o; o[0] = cvtpk(O[4 * q4] * rstd * g0 / (1.0f + __expf(-g0)), O[4 * q4 + 1] * rstd * g1 / (1.0f + __expf(-g1)));
            o[1] = cvtpk(O[4 * q4 + 2] * rstd * g2 / (1.0f + __expf(-g2)), O[4 * q4 + 3] * rstd * g3 / (1.0f + __expf(-g3)));
            *(v2u*)(mixo + qtok * NMIX + 1024 + hh * 64 + e0) = o; }
    }
    __syncthreads();
#undef RT_PREFETCH
}
__device__ __forceinline__ void ret_phase(KP P, LAS unsigned char* lds, int vcu, int G) {
    for (int unit = vcu; unit < BATCH * 8; unit += G) ret_unit(P, lds, unit >> 3, unit & 7);
}

template <int CTRL> __device__ __forceinline__ float dppf(float x) { return __builtin_bit_cast(float, __builtin_amdgcn_mov_dpp(__builtin_bit_cast(int, x), CTRL, 0xf, 0xf, true)); }
constexpr int DPP_X1 = 0xB1, DPP_X2 = 0x4E, DPP_X7 = 0x141, DPP_X8 = 0x128;
__device__ __forceinline__ float sum8(float x) { x += dppf<DPP_X1>(x); x += dppf<DPP_X2>(x); x += dppf<DPP_X7>(x); return x; }
__device__ __forceinline__ float sum16(float x) { x = sum8(x); x += dppf<DPP_X8>(x); return x; }
#define PROBE_SCAN2 0
constexpr int RS_TT = 32;
constexpr int RS_W2T = 0, RS_A2T = 9216, RS_G2T = 18432, RS_XW = 35840, RS_XA = RS_XW + RS_TT * 144, RS_XG = RS_XA + RS_TT * 144, RS_F0 = RS_XG + RS_TT * 272;
constexpr int RS_FA = RS_TT * 64 * 4;
constexpr int RS_ZR = RS_F0, RS_ZK = RS_F0 + RS_FA, RS_ZV = RS_F0 + 2 * RS_FA, RS_WL = RS_F0 + 3 * RS_FA, RS_AL = RS_F0 + 4 * RS_FA, RS_GL = RS_F0 + 5 * RS_FA, RS_AV = RS_F0 + 6 * RS_FA, RS_YS = RS_F0 + 7 * RS_FA, RS_BS = RS_F0 + 8 * RS_FA;
constexpr int RS_MU = RS_BS + RS_TT * 4, RS_CST = RS_MU + 448 * 4;
static_assert(RS_CST + 7 * 256 <= 131072, "rwkv LDS");
constexpr int RS_NP = (RS_TT * 56 + 511) / 512;
typedef float v2f __attribute__((ext_vector_type(2)));
__device__ __forceinline__ void rwkv_unit(KP P, int l, LAS unsigned char* lds, int b, int hh) {
    const int tid = otid(), w = __builtin_amdgcn_readfirstlane(tid >> 6), lane = tid & 63, r32 = lane & 31, h2 = lane >> 5;
    const bf16* proj = (const bf16*)(P->ws + WS_BIG); bf16* mixo = (bf16*)(P->ws + WS_MIXO);
    const float* mu = P->in[I_MU] + l * RWC; const float* w0 = P->in[I_W0] + l * 512 + hh * 64; const float* a0 = P->in[I_A0] + l * 512 + hh * 64;
    const float* kkw = P->in[I_KK] + l * 512 + hh * 64; const float* kaw = P->in[I_KA] + l * 512 + hh * 64; const float* rkw = P->in[I_RK] + l * 512 + hh * 64;
    const float* lng = P->in[I_LNG] + l * 512 + hh * 64; const float* lnb = P->in[I_LNB] + l * 512 + hh * 64;
    __syncthreads();
    for (int i = tid; i < 64 * 64; i += 512) { const int c = i >> 6, j = i & 63;
        *(LAS unsigned short*)(lds + RS_W2T + j * 144 + c * 2) = (unsigned short)f2bf(P->in[I_W2][(size_t)l * 64 * 512 + c * 512 + hh * 64 + j]);
        *(LAS unsigned short*)(lds + RS_A2T + j * 144 + c * 2) = (unsigned short)f2bf(P->in[I_A2][(size_t)l * 64 * 512 + c * 512 + hh * 64 + j]); }
    for (int i = tid; i < 128 * 64; i += 512) { const int c = i >> 6, j = i & 63;
        *(LAS unsigned short*)(lds + RS_G2T + j * 272 + c * 2) = (unsigned short)f2bf(P->in[I_G2][(size_t)l * 128 * 512 + c * 512 + hh * 64 + j]); }
    for (int i = tid; i < 448; i += 512) { const int p = i >> 3, e = i & 7; int col; if (p < 24) col = (p >> 3) * 512 + hh * 64 + (p & 7) * 8; else col = 1536 + (p - 24) * 8; ((LAS float*)(lds + RS_MU))[i] = mu[col + e]; }
    if (tid < 448) { const int a = tid >> 6, j = tid & 63; const float* src = a == 0 ? w0 : a == 1 ? a0 : a == 2 ? kkw : a == 3 ? kaw : a == 4 ? rkw : a == 5 ? lng : lnb; ((LAS float*)(lds + RS_CST))[tid] = src[j]; }
    v2f S2[4];
#pragma unroll
    for (int i = 0; i < 4; ++i) S2[i] = (v2f){0.f, 0.f};
    v4u pc[RS_NP], pp[RS_NP];
#define RS_LOADPIECES(T0) do { _Pragma("unroll") for (int it = 0; it < RS_NP; ++it) { const int idx = tid + it * 512; pc[it] = (v4u){0u, 0u, 0u, 0u}; pp[it] = (v4u){0u, 0u, 0u, 0u}; \
        if (idx < RS_TT * 56) { const int p = idx / RS_TT, tt = idx % RS_TT, t = (T0) + tt; int col; if (p < 24) col = (p >> 3) * 512 + hh * 64 + (p & 7) * 8; else col = 1536 + (p - 24) * 8; \
            const size_t g = (size_t)(b * T + t) * NA + C_RW + col; pc[it] = *(const v4u*)(proj + g); if (t > 0) pp[it] = *(const v4u*)(proj + g - NA); } } } while (0)
    RS_LOADPIECES(0);
#pragma unroll 1
    for (int t0 = 0; t0 < T; t0 += RS_TT) {
        __syncthreads();
#pragma unroll
        for (int it = 0; it < RS_NP; ++it) { const int idx = tid + it * 512; if (idx < RS_TT * 56) { const int p = idx / RS_TT, tt = idx % RS_TT;
            const v4u hc = pc[it], hp = pp[it];
            const v4f m0 = *(const LAS v4f*)(lds + RS_MU + p * 32), m1 = *(const LAS v4f*)(lds + RS_MU + p * 32 + 16);
            float z[8];
#pragma unroll
            for (int e = 0; e < 4; ++e) { const float c0 = bflo(hc[e]), c1 = bfhi(hc[e]), p0 = bflo(hp[e]), p1 = bfhi(hp[e]); const float ma = e < 2 ? m0[2 * e] : m1[2 * e - 4], mb = e < 2 ? m0[2 * e + 1] : m1[2 * e - 3];
                z[2 * e] = c0 + ma * (p0 - c0); z[2 * e + 1] = c1 + mb * (p1 - c1); }
            if (p < 24) { LAS float* dst = (LAS float*)(lds + (p < 8 ? RS_ZR : (p < 16 ? RS_ZK : RS_ZV)) + (tt * 64 + (p & 7) * 8) * 4);
                *(LAS v4f*)dst = (v4f){z[0], z[1], z[2], z[3]}; *(LAS v4f*)(dst + 4) = (v4f){z[4], z[5], z[6], z[7]}; }
            else { v4u o;
                if (p < 32) {
#pragma unroll
                    for (int e = 0; e < 4; ++e) o[e] = cvtpk(1.0f - 2.0f * __builtin_amdgcn_rcpf(1.0f + __expf(2.0f * z[2 * e])), 1.0f - 2.0f * __builtin_amdgcn_rcpf(1.0f + __expf(2.0f * z[2 * e + 1])));
                    *(LAS v4u*)(lds + RS_XW + tt * 144 + (p - 24) * 16) = o; }
                else if (p < 40) {
#pragma unroll
                    for (int e = 0; e < 4; ++e) o[e] = cvtpk(z[2 * e], z[2 * e + 1]);
                    *(LAS v4u*)(lds + RS_XA + tt * 144 + (p - 32) * 16) = o; }
                else {
#pragma unroll
                    for (int e = 0; e < 4; ++e) o[e] = cvtpk(__builtin_amdgcn_rcpf(1.0f + __expf(-z[2 * e])), __builtin_amdgcn_rcpf(1.0f + __expf(-z[2 * e + 1])));
                    *(LAS v4u*)(lds + RS_XG + tt * 272 + (p - 40) * 16) = o; } }
        } }
        __syncthreads();
        if (w < 6) { const int which = w >> 1, jt = w & 1; f32x16 acc;
#pragma unroll
            for (int i = 0; i < 16; ++i) acc[i] = 0.f;
            if (which < 2) { const int wo = which == 0 ? RS_W2T : RS_A2T, xo = which == 0 ? RS_XW : RS_XA;
#pragma unroll
                for (int s = 0; s < 4; ++s) { const bf16x8v af = *(const LAS bf16x8v*)(lds + wo + (32 * jt + r32) * 144 + (16 * s + 8 * h2) * 2), bfr = *(const LAS bf16x8v*)(lds + xo + r32 * 144 + (16 * s + 8 * h2) * 2);
                    acc = __builtin_amdgcn_mfma_f32_32x32x16_bf16(af, bfr, acc, 0, 0, 0); } }
            else {
#pragma unroll
                for (int s = 0; s < 8; ++s) { const bf16x8v af = *(const LAS bf16x8v*)(lds + RS_G2T + (32 * jt + r32) * 272 + (16 * s + 8 * h2) * 2), bfr = *(const LAS bf16x8v*)(lds + RS_XG + r32 * 272 + (16 * s + 8 * h2) * 2);
                    acc = __builtin_amdgcn_mfma_f32_32x32x16_bf16(af, bfr, acc, 0, 0, 0); } }
            const int oo = which == 0 ? RS_WL : (which == 1 ? RS_AL : RS_GL);
#pragma unroll
            for (int q4 = 0; q4 < 4; ++q4) *(LAS v4f*)(lds + oo + (r32 * 64 + 32 * jt + 8 * q4 + 4 * h2) * 4) = (v4f){acc[4 * q4], acc[4 * q4 + 1], acc[4 * q4 + 2], acc[4 * q4 + 3]}; }
        __syncthreads();
        { const int tt = tid >> 4, j0 = (tid & 15) * 4; const int o4 = (tt * 64 + j0) * 4;
          const v4f wl = *(const LAS v4f*)(lds + RS_WL + o4), al = *(const LAS v4f*)(lds + RS_AL + o4), zk = *(const LAS v4f*)(lds + RS_ZK + o4), zr = *(const LAS v4f*)(lds + RS_ZR + o4);
          const v4f w0v = *(const LAS v4f*)(lds + RS_CST + j0 * 4), a0v = *(const LAS v4f*)(lds + RS_CST + 256 + j0 * 4), kkv = *(const LAS v4f*)(lds + RS_CST + 512 + j0 * 4), kav = *(const LAS v4f*)(lds + RS_CST + 768 + j0 * 4), rkv = *(const LAS v4f*)(lds + RS_CST + 1024 + j0 * 4);
          v4f dcy, alp, kk0, km; float ssq = 0.f, bsum = 0.f;
#pragma unroll
          for (int e = 0; e < 4; ++e) { const float x = -(wl[e] + w0v[e]); const float sp = fmaxf(x, 0.f) + __logf(1.0f + __expf(-fabsf(x)));
              dcy[e] = __expf(-__expf(-sp - 0.5f)); alp[e] = __builtin_amdgcn_rcpf(1.0f + __expf(-(al[e] + a0v[e])));
              kk0[e] = zk[e] * kkv[e]; ssq += kk0[e] * kk0[e]; km[e] = zk[e] * (1.0f + (alp[e] - 1.0f) * kav[e]); bsum += zr[e] * km[e] * rkv[e]; }
          ssq = sum16(ssq); bsum = sum16(bsum);
          const float inv = __builtin_amdgcn_rcpf(fmaxf(__builtin_amdgcn_sqrtf(ssq), 1e-12f));
          v4f avv, bvv;
#pragma unroll
          for (int e = 0; e < 4; ++e) { const float kk = kk0[e] * inv; avv[e] = -kk; bvv[e] = kk * alp[e]; }
          *(LAS v4f*)(lds + RS_WL + o4) = dcy; *(LAS v4f*)(lds + RS_AL + o4) = bvv; *(LAS v4f*)(lds + RS_AV + o4) = avv; *(LAS v4f*)(lds + RS_ZK + o4) = km;
          if ((tid & 15) == 0) *(LAS float*)(lds + RS_BS + tt * 4) = bsum; }
        __syncthreads();
        if (t0 + RS_TT < T) RS_LOADPIECES(t0 + RS_TT);
#if PROBE_SCAN2
        v2f Ssave[4];
#pragma unroll
        for (int i = 0; i < 4; ++i) Ssave[i] = S2[i];
        for (int rep_ = 0; rep_ < 2; ++rep_) { if (rep_ == 1) {
#pragma unroll
            for (int i = 0; i < 4; ++i) S2[i] = Ssave[i]; }
#endif
        { const int v_ = tid >> 3, ks = tid & 7; LAS unsigned char* sb = lds + ks * 32; LAS unsigned char* vb = lds + RS_ZV + v_ * 4; LAS unsigned char* yb = lds + RS_YS + v_ * 4;
#pragma unroll
          for (int tt = 0; tt < RS_TT; ++tt) { const int o8 = tt * 256;
              const v4f a0_ = *(const LAS v4f*)(sb + RS_AV + o8), a1_ = *(const LAS v4f*)(sb + RS_AV + o8 + 16);
              const v4f d0_ = *(const LAS v4f*)(sb + RS_WL + o8), d1_ = *(const LAS v4f*)(sb + RS_WL + o8 + 16);
              const v4f b0_ = *(const LAS v4f*)(sb + RS_AL + o8), b1_ = *(const LAS v4f*)(sb + RS_AL + o8 + 16);
              const v4f k0_ = *(const LAS v4f*)(sb + RS_ZK + o8), k1_ = *(const LAS v4f*)(sb + RS_ZK + o8 + 16);
              const v4f r0_ = *(const LAS v4f*)(sb + RS_ZR + o8), r1_ = *(const LAS v4f*)(sb + RS_ZR + o8 + 16);
              const float vv = *(const LAS float*)(vb + o8);
              v2f ac = S2[0] * a0_.xy; ac = __builtin_elementwise_fma(S2[1], a0_.zw, ac); ac = __builtin_elementwise_fma(S2[2], a1_.xy, ac); ac = __builtin_elementwise_fma(S2[3], a1_.zw, ac);
              const float sa = sum8(ac.x + ac.y); const v2f sa2 = (v2f){sa, sa}, vv2 = (v2f){vv, vv};
              S2[0] = __builtin_elementwise_fma(S2[0], d0_.xy, __builtin_elementwise_fma(k0_.xy, vv2, b0_.xy * sa2));
              S2[1] = __builtin_elementwise_fma(S2[1], d0_.zw, __builtin_elementwise_fma(k0_.zw, vv2, b0_.zw * sa2));
              S2[2] = __builtin_elementwise_fma(S2[2], d1_.xy, __builtin_elementwise_fma(k1_.xy, vv2, b1_.xy * sa2));
              S2[3] = __builtin_elementwise_fma(S2[3], d1_.zw, __builtin_elementwise_fma(k1_.zw, vv2, b1_.zw * sa2));
              v2f yc = S2[0] * r0_.xy; yc = __builtin_elementwise_fma(S2[1], r0_.zw, yc); yc = __builtin_elementwise_fma(S2[2], r1_.xy, yc); yc = __builtin_elementwise_fma(S2[3], r1_.zw, yc);
              const float y = sum8(yc.x + yc.y);
              if (ks == 0) *(LAS float*)(yb + o8) = y; } }
#if PROBE_SCAN2
        }
#endif
        __syncthreads();
        { const int tt = tid >> 4, v0 = (tid & 15) * 4; const int o4 = (tt * 64 + v0) * 4;
          const v4f y4 = *(const LAS v4f*)(lds + RS_YS + o4), zv = *(const LAS v4f*)(lds + RS_ZV + o4), gl = *(const LAS v4f*)(lds + RS_GL + o4);
          const float mean = sum16((y4[0] + y4[1]) + (y4[2] + y4[3])) * (1.f / 64.f);
          const v4f d = y4 - mean; const float var = sum16((d[0] * d[0] + d[1] * d[1]) + (d[2] * d[2] + d[3] * d[3])) * (1.f / 64.f);
          const float rstd = rsqrtf(var + 64e-5f), bs = *(const LAS float*)(lds + RS_BS + tt * 4);
          const v4f lg4 = *(const LAS v4f*)(lds + RS_CST + 1280 + v0 * 4), lb4 = *(const LAS v4f*)(lds + RS_CST + 1536 + v0 * 4);
          float o[4];
#pragma unroll
          for (int e = 0; e < 4; ++e) o[e] = (d[e] * rstd * lg4[e] + lb4[e] + bs * zv[e]) * gl[e];
          v2u ow; ow[0] = cvtpk(o[0], o[1]); ow[1] = cvtpk(o[2], o[3]);
          *(v2u*)(mixo + (size_t)(b * T + t0 + tt) * NMIX + 512 + hh * 64 + v0) = ow; }
    }
    __syncthreads();
#undef RS_LOADPIECES
}
__device__ __forceinline__ void rwkv_phase(KP P, int l, LAS unsigned char* lds, int vcu, int G) {
    for (int unit = vcu; unit < BATCH * 8; unit += G) rwkv_unit(P, l, lds, unit >> 3, unit & 7);
}

#define RC_BAR() do { asm volatile("s_waitcnt lgkmcnt(0)" ::: "memory"); __builtin_amdgcn_s_barrier(); asm volatile("" ::: "memory"); } while (0)
constexpr int RC_SL = 9216;
constexpr int RC_A = 0 * RC_SL, RC_B = 1 * RC_SL, RC_K = 2 * RC_SL, RC_R = 3 * RC_SL, RC_V = 4 * RC_SL, RC_G = 5 * RC_SL, RC_S = 6 * RC_SL;
constexpr int RC_XW = 7 * RC_SL, RC_XA = 8 * RC_SL, RC_XG = 9 * RC_SL, RC_WL = 11 * RC_SL, RC_AL = 13 * RC_SL, RC_LW = 14 * RC_SL;
constexpr int RC_DINV = RC_B, RC_DINVT = RC_K, RC_NT = 9 * RC_SL, RC_P = RC_B, RC_UT = RC_V, RC_BHT = RC_XW, RC_KHT = RC_XA, RC_VT = 9 * RC_SL, RC_LAB = 10 * RC_SL, RC_N = RC_LAB, RC_TINV = RC_LAB;
constexpr int RC_LABT = 11 * RC_SL, RC_N2 = RC_LABT, RC_RHST = RC_LABT, RC_LAK = 12 * RC_SL, RC_MRB = 13 * RC_SL, RC_MRK = RC_LW;
constexpr int RC_SM = RC_LW + 16384, RC_BS = RC_SM, RC_GC = RC_SM + 256, RC_PT = RC_SM + 512, RC_SSB = RC_PT + 2048, RC_DIAG = RC_SSB + 1024, RC_MU = RC_DIAG + 4096, RC_CST = RC_MU + 1792, RC_END = RC_CST + 1792;
static_assert(RC_END <= 156928, "chunked rwkv LDS");
template <int KSTEPS, int SA = 144, int SB = 144> __device__ __forceinline__ f32x16 rc_mm(f32x16 acc, const LAS unsigned char* A, int arow0, const LAS unsigned char* B, int brow0, int r32, int h, int kofs = 0) {
#pragma unroll
    for (int s = 0; s < KSTEPS; ++s) { const bf16x8v af = *(const LAS bf16x8v*)(A + (arow0 + r32) * SA + (kofs + 16 * s + 8 * h) * 2), bfr = *(const LAS bf16x8v*)(B + (brow0 + r32) * SB + (kofs + 16 * s + 8 * h) * 2);
        acc = __builtin_amdgcn_mfma_f32_32x32x16_bf16(af, bfr, acc, 0, 0, 0); }
    return acc;
}
__device__ __forceinline__ f32x16 rc_zero() { f32x16 z;
#pragma unroll
    for (int i = 0; i < 16; ++i) z[i] = 0.f;
    return z; }
template <int KSTEPS> __device__ __forceinline__ f32x16 rc_mm2(f32x16 acc, const LAS unsigned char* A, int arow0, const LAS unsigned char* B, int brow0, int r32, int h) {
    f32x16 a1 = rc_zero();
#pragma unroll
    for (int s = 0; s < KSTEPS; ++s) { const bf16x8v af = *(const LAS bf16x8v*)(A + (arow0 + r32) * 144 + (16 * s + 8 * h) * 2), bfr = *(const LAS bf16x8v*)(B + (brow0 + r32) * 144 + (16 * s + 8 * h) * 2);
        if (s & 1) a1 = __builtin_amdgcn_mfma_f32_32x32x16_bf16(af, bfr, a1, 0, 0, 0); else acc = __builtin_amdgcn_mfma_f32_32x32x16_bf16(af, bfr, acc, 0, 0, 0); }
#pragma unroll
    for (int i = 0; i < 16; ++i) acc[i] += a1[i];
    return acc;
}
__device__ __forceinline__ bf16x8v rc_frag_bd(const LAS unsigned char* cb, int row, int s, int h) {
    v4u z = (v4u){0u, 0u, 0u, 0u}; if ((row >> 4) == s) z = *(const LAS v4u*)(cb + (row >> 4) * 1024 + ((row & 15) * 16 + 8 * h) * 2); return __builtin_bit_cast(bf16x8v, z); }
template <bool BD_A> __device__ __forceinline__ f32x16 rc_mm_bd(f32x16 acc, const LAS unsigned char* A, int arow0, const LAS unsigned char* B, int brow0, int r32, int h) {
    f32x16 a1 = rc_zero();
#pragma unroll
    for (int s = 0; s < 4; ++s) { const bf16x8v af = BD_A ? rc_frag_bd(A, arow0 + r32, s, h) : *(const LAS bf16x8v*)(A + (arow0 + r32) * 144 + (16 * s + 8 * h) * 2);
        const bf16x8v bfr = BD_A ? *(const LAS bf16x8v*)(B + (brow0 + r32) * 144 + (16 * s + 8 * h) * 2) : rc_frag_bd(B, brow0 + r32, s, h);
        if (s & 1) a1 = __builtin_amdgcn_mfma_f32_32x32x16_bf16(af, bfr, a1, 0, 0, 0); else acc = __builtin_amdgcn_mfma_f32_32x32x16_bf16(af, bfr, acc, 0, 0, 0); }
#pragma unroll
    for (int i = 0; i < 16; ++i) acc[i] += a1[i];
    return acc;
}
__device__ __forceinline__ void rc_store_t(const f32x16& d, LAS unsigned char* O, int arow0, int brow0, int r32, int h) {
#pragma unroll
    for (int q4 = 0; q4 < 4; ++q4) { v2u o; o[0] = cvtpk(d[4 * q4], d[4 * q4 + 1]); o[1] = cvtpk(d[4 * q4 + 2], d[4 * q4 + 3]); *(LAS v2u*)(O + (brow0 + r32) * 144 + (arow0 + 8 * q4 + 4 * h) * 2) = o; }
}
__device__ __forceinline__ void rwkvc_unit(KP P, int l, LAS unsigned char* lds, int b, int hh) {
    const int tid = otid(), w = __builtin_amdgcn_readfirstlane(tid >> 6), lane = tid & 63, r32 = lane & 31, h = lane >> 5;
    const bf16* proj = (const bf16*)(P->ws + WS_BIG); bf16* mixo = (bf16*)(P->ws + WS_MIXO);
    const float* mu = P->in[I_MU] + l * RWC; const float* w0 = P->in[I_W0] + l * 512 + hh * 64; const float* a0 = P->in[I_A0] + l * 512 + hh * 64;
    const float* kkw = P->in[I_KK] + l * 512 + hh * 64; const float* kaw = P->in[I_KA] + l * 512 + hh * 64; const float* rkw = P->in[I_RK] + l * 512 + hh * 64;
    const float* lng = P->in[I_LNG] + l * 512 + hh * 64; const float* lnb = P->in[I_LNB] + l * 512 + hh * 64;
    __syncthreads();
    for (int i = tid; i < 448; i += 512) { const int p = i >> 3, e = i & 7; int col; if (p < 24) col = (p >> 3) * 512 + hh * 64 + (p & 7) * 8; else col = 1536 + (p - 24) * 8; ((LAS float*)(lds + RC_MU))[i] = mu[col + e]; }
    if (tid < 448) { const int a = tid >> 6, j = tid & 63; const float* src = a == 0 ? w0 : a == 1 ? a0 : a == 2 ? kkw : a == 3 ? kaw : a == 4 ? rkw : a == 5 ? lng : lnb; ((LAS float*)(lds + RC_CST))[tid] = src[j]; }
    bf16x8v wf[8];
    { const int jt = w & 1, j = hh * 64 + 32 * jt + r32;
#pragma unroll
      for (int s = 0; s < 8; ++s) { unsigned short e[8];
#pragma unroll
          for (int i = 0; i < 8; ++i) { float x; if (w < 4) { const int c = 16 * (s & 3) + 8 * h + i; x = (s < 4 ? P->in[I_W2] : P->in[I_A2])[(size_t)l * 64 * 512 + c * 512 + j]; } else { const int c = 16 * s + 8 * h + i; x = P->in[I_G2][(size_t)l * 128 * 512 + c * 512 + j]; }
              e[i] = (unsigned short)f2bf(x); }
          v4u pk; pk[0] = e[0] | ((unsigned)e[1] << 16); pk[1] = e[2] | ((unsigned)e[3] << 16); pk[2] = e[4] | ((unsigned)e[5] << 16); pk[3] = e[6] | ((unsigned)e[7] << 16);
          wf[s] = __builtin_bit_cast(bf16x8v, pk); } }
    f32x16 Sacc = rc_zero();
    v4u pc[7], pp[7];
#define RC_LOADPIECES(T0) do { _Pragma("unroll") for (int it = 0; it < 7; ++it) { const int q_ = it * 8 + (tid >> 6), p = 8 * (q_ % 7) + (tid & 7), tt = 8 * (q_ / 7) + ((tid & 63) >> 3), t = (T0) + tt; int col; if (p < 24) col = (p >> 3) * 512 + hh * 64 + (p & 7) * 8; else col = 1536 + (p - 24) * 8; \
        const size_t g = (size_t)(b * T + t) * NA + C_RW + col; pc[it] = *(const v4u*)(proj + g); pp[it] = (v4u){0u, 0u, 0u, 0u}; if (t > 0) pp[it] = *(const v4u*)(proj + g - NA); } } while (0)
    RC_LOADPIECES(0);
#pragma unroll 1
    for (int t0 = 0; t0 < T; t0 += 64) {
        f32x16 xacc, yacc;
        RC_BAR();
        { const int tid = otid(), w = __builtin_amdgcn_readfirstlane(tid >> 6), lane = tid & 63, r32 = lane & 31, h = lane >> 5; (void)w; (void)lane; (void)r32; (void)h;
        if (w < 4) rc_store_t(Sacc, lds + RC_S, 32 * (w >> 1), 32 * (w & 1), r32, h);
#pragma unroll
        for (int it = 0; it < 7; ++it) { const int q_ = it * 8 + (tid >> 6), p = 8 * (q_ % 7) + (tid & 7), tt = 8 * (q_ / 7) + ((tid & 63) >> 3);
            const v4u hc = pc[it], hp = pp[it];
            const v4f m0 = *(const LAS v4f*)(lds + RC_MU + p * 32), m1 = *(const LAS v4f*)(lds + RC_MU + p * 32 + 16);
            float z[8];
#pragma unroll
            for (int e = 0; e < 4; ++e) { const float c0 = bflo(hc[e]), c1 = bfhi(hc[e]), p0 = bflo(hp[e]), p1 = bfhi(hp[e]); const float ma = e < 2 ? m0[2 * e] : m1[2 * e - 4], mb = e < 2 ? m0[2 * e + 1] : m1[2 * e - 3];
                z[2 * e] = c0 + ma * (p0 - c0); z[2 * e + 1] = c1 + mb * (p1 - c1); }
            v4u o; int dst;
            if (p < 24) { dst = (p < 8 ? RC_R : (p < 16 ? RC_K : RC_V)) + tt * 144 + (p & 7) * 16;
#pragma unroll
                for (int e = 0; e < 4; ++e) o[e] = cvtpk(z[2 * e], z[2 * e + 1]); }
            else if (p < 32) { dst = RC_XW + tt * 144 + (p - 24) * 16;
#pragma unroll
                for (int e = 0; e < 4; ++e) o[e] = cvtpk(1.0f - 2.0f * __builtin_amdgcn_rcpf(1.0f + __expf(2.0f * z[2 * e])), 1.0f - 2.0f * __builtin_amdgcn_rcpf(1.0f + __expf(2.0f * z[2 * e + 1]))); }
            else if (p < 40) { dst = RC_XA + tt * 144 + (p - 32) * 16;
#pragma unroll
                for (int e = 0; e < 4; ++e) o[e] = cvtpk(z[2 * e], z[2 * e + 1]); }
            else { dst = RC_XG + tt * 272 + (p - 40) * 16;
#pragma unroll
                for (int e = 0; e < 4; ++e) o[e] = cvtpk(__builtin_amdgcn_rcpf(1.0f + __expf(-z[2 * e])), __builtin_amdgcn_rcpf(1.0f + __expf(-z[2 * e + 1]))); }
            *(LAS v4u*)(lds + dst) = o; }
        }
        RC_BAR();
        { const int tid = otid(), w = __builtin_amdgcn_readfirstlane(tid >> 6), lane = tid & 63, r32 = lane & 31, h = lane >> 5; (void)w; (void)lane; (void)r32; (void)h;
        { const int tt = (w >> 1) & 1, jt = w & 1;
          if (w < 4) { f32x16 aw = rc_zero(), aa = rc_zero();
#pragma unroll
              for (int s = 0; s < 4; ++s) { const bf16x8v xw = *(const LAS bf16x8v*)(lds + RC_XW + (32 * tt + r32) * 144 + (16 * s + 8 * h) * 2), xa = *(const LAS bf16x8v*)(lds + RC_XA + (32 * tt + r32) * 144 + (16 * s + 8 * h) * 2);
                  aw = __builtin_amdgcn_mfma_f32_32x32x16_bf16(wf[s], xw, aw, 0, 0, 0); aa = __builtin_amdgcn_mfma_f32_32x32x16_bf16(wf[4 + s], xa, aa, 0, 0, 0); }
#pragma unroll
              for (int q4 = 0; q4 < 4; ++q4) *(LAS v4f*)(lds + RC_WL + ((32 * tt + r32) * 64 + 32 * jt + 8 * q4 + 4 * h) * 4) = (v4f){aw[4 * q4], aw[4 * q4 + 1], aw[4 * q4 + 2], aw[4 * q4 + 3]};
              rc_store_t(aa, lds + RC_AL, 32 * jt, 32 * tt, r32, h); }
          else { f32x16 ag = rc_zero();
#pragma unroll
              for (int s = 0; s < 8; ++s) { const bf16x8v xg = *(const LAS bf16x8v*)(lds + RC_XG + (32 * tt + r32) * 272 + (16 * s + 8 * h) * 2); ag = __builtin_amdgcn_mfma_f32_32x32x16_bf16(wf[s], xg, ag, 0, 0, 0); }
              rc_store_t(ag, lds + RC_G, 32 * jt, 32 * tt, r32, h); } }
        }
        RC_BAR();
        { const int tid = otid(), w = __builtin_amdgcn_readfirstlane(tid >> 6), lane = tid & 63, r32 = lane & 31, h = lane >> 5; (void)w; (void)lane; (void)r32; (void)h;
        { const int t = tid >> 3, j0 = (tid & 7) * 8; const int ob = t * 144 + j0 * 2;
          const v4f wl0 = *(const LAS v4f*)(lds + RC_WL + (t * 64 + j0) * 4), wl1 = *(const LAS v4f*)(lds + RC_WL + (t * 64 + j0 + 4) * 4);
          const v4u alw = *(const LAS v4u*)(lds + RC_AL + ob), kw = *(const LAS v4u*)(lds + RC_K + ob), rw = *(const LAS v4u*)(lds + RC_R + ob);
          float lw[8], alp[8], kk0[8], km[8]; float ssq = 0.f, bsum = 0.f;
          v4f cst[5][2];
#pragma unroll
          for (int a = 0; a < 5; ++a) { cst[a][0] = *(const LAS v4f*)(lds + RC_CST + a * 256 + j0 * 4); cst[a][1] = *(const LAS v4f*)(lds + RC_CST + a * 256 + j0 * 4 + 16); }
#pragma unroll
          for (int e = 0; e < 8; ++e) { const float wl = e < 4 ? wl0[e & 3] : wl1[e & 3]; const float cw0 = cst[0][e >> 2][e & 3], ca0 = cst[1][e >> 2][e & 3];
              const float ckk = cst[2][e >> 2][e & 3], cka = cst[3][e >> 2][e & 3], crk = cst[4][e >> 2][e & 3];
              const float al = (e & 1) ? bfhi(alw[e >> 1]) : bflo(alw[e >> 1]), kr = (e & 1) ? bfhi(kw[e >> 1]) : bflo(kw[e >> 1]), rr = (e & 1) ? bfhi(rw[e >> 1]) : bflo(rw[e >> 1]);
              lw[e] = -0.60653066f * __builtin_amdgcn_rcpf(1.0f + __expf(-(wl + cw0)));
              alp[e] = __builtin_amdgcn_rcpf(1.0f + __expf(-(al + ca0)));
              kk0[e] = kr * ckk; ssq += kk0[e] * kk0[e]; km[e] = kr * (1.0f + (alp[e] - 1.0f) * cka); bsum += rr * km[e] * crk; }
          ssq = sum8(ssq); bsum = sum8(bsum);
          const float inv = __builtin_amdgcn_rcpf(fmaxf(__builtin_amdgcn_sqrtf(ssq), 1e-12f));
          v4u ao, bo, ko;
#pragma unroll
          for (int e = 0; e < 4; ++e) { const float ka = kk0[2 * e] * inv, kb = kk0[2 * e + 1] * inv; ao[e] = cvtpk(-ka, -kb); bo[e] = cvtpk(ka * alp[2 * e], kb * alp[2 * e + 1]); ko[e] = cvtpk(km[2 * e], km[2 * e + 1]); }
          *(LAS v4u*)(lds + RC_A + ob) = ao; *(LAS v4u*)(lds + RC_B + ob) = bo; *(LAS v4u*)(lds + RC_K + ob) = ko;
          *(LAS v4f*)(lds + RC_LW + (t * 64 + j0) * 4) = (v4f){lw[0], lw[1], lw[2], lw[3]}; *(LAS v4f*)(lds + RC_LW + (t * 64 + j0 + 4) * 4) = (v4f){lw[4], lw[5], lw[6], lw[7]};
          if ((tid & 7) == 0) *(LAS float*)(lds + RC_BS + t * 4) = bsum; }
        }
        RC_BAR();
        { const int tid = otid(), w = __builtin_amdgcn_readfirstlane(tid >> 6), lane = tid & 63, r32 = lane & 31, h = lane >> 5; (void)w; (void)lane; (void)r32; (void)h;
        { const int k = tid & 63, tq = tid >> 6; float c[8]; float run = 0.f;
#pragma unroll
          for (int i = 0; i < 8; ++i) { run += *(const LAS float*)(lds + RC_LW + ((8 * tq + i) * 64 + k) * 4); c[i] = run; }
          *(LAS float*)(lds + RC_PT + (tq * 64 + k) * 4) = run;
          RC_BAR();
          float base = 0.f;
#pragma unroll
          for (int q = 0; q < 7; ++q) { const float pv = *(const LAS float*)(lds + RC_PT + (q * 64 + k) * 4); base += (q < tq) ? pv : 0.f; }
#pragma unroll
          for (int i = 0; i < 8; ++i) *(LAS float*)(lds + RC_LW + ((8 * tq + i) * 64 + k) * 4) = c[i] + base;
          if (tq == 7) *(LAS float*)(lds + RC_GC + k * 4) = __expf(c[7] + base); }
        }
        RC_BAR();
        { const int tid = otid(), w = __builtin_amdgcn_readfirstlane(tid >> 6), lane = tid & 63, r32 = lane & 31, h = lane >> 5; (void)w; (void)lane; (void)r32; (void)h;
        { const int t = tid >> 3, j0 = (tid & 7) * 8; const int ob = t * 144 + j0 * 2;
          const v4f c0 = *(const LAS v4f*)(lds + RC_LW + (t * 64 + j0) * 4), c1 = *(const LAS v4f*)(lds + RC_LW + (t * 64 + j0 + 4) * 4);
          v4f p0 = (v4f){0.f, 0.f, 0.f, 0.f}, p1 = p0; if (t > 0) { p0 = *(const LAS v4f*)(lds + RC_LW + ((t - 1) * 64 + j0) * 4); p1 = *(const LAS v4f*)(lds + RC_LW + ((t - 1) * 64 + j0 + 4) * 4); }
          const v4u aw = *(const LAS v4u*)(lds + RC_A + ob), bw = *(const LAS v4u*)(lds + RC_B + ob), kw = *(const LAS v4u*)(lds + RC_K + ob), rw = *(const LAS v4u*)(lds + RC_R + ob);
          v4u ao, bo, ko, ro;
#pragma unroll
          for (int e = 0; e < 4; ++e) { const float cA = e < 2 ? c0[2 * e] : c1[2 * e - 4], cB = e < 2 ? c0[2 * e + 1] : c1[2 * e - 3], pA = e < 2 ? p0[2 * e] : p1[2 * e - 4], pB = e < 2 ? p0[2 * e + 1] : p1[2 * e - 3];
              const float e1a = __expf(cA), e1b = __expf(cB), e0a = __expf(pA), e0b = __expf(pB), eia = __builtin_amdgcn_rcpf(e1a), eib = __builtin_amdgcn_rcpf(e1b);
              ao[e] = cvtpk(bflo(aw[e]) * e0a, bfhi(aw[e]) * e0b); ro[e] = cvtpk(bflo(rw[e]) * e1a, bfhi(rw[e]) * e1b);
              bo[e] = cvtpk(bflo(bw[e]) * eia, bfhi(bw[e]) * eib); ko[e] = cvtpk(bflo(kw[e]) * eia, bfhi(kw[e]) * eib); }
          *(LAS v4u*)(lds + RC_A + ob) = ao; *(LAS v4u*)(lds + RC_B + ob) = bo; *(LAS v4u*)(lds + RC_K + ob) = ko; *(LAS v4u*)(lds + RC_R + ob) = ro; }
        }
        RC_BAR();
        { const int tid = otid(), w = __builtin_amdgcn_readfirstlane(tid >> 6), lane = tid & 63, r32 = lane & 31, h = lane >> 5; (void)w; (void)lane; (void)r32; (void)h;
        if (w == 0 || w == 3) { const int tq = w == 0 ? 0 : 1; f32x16 d = rc_zero(); d = rc_mm2<4>(d, lds + RC_B, 32 * tq, lds + RC_A, 32 * tq, r32, h);
            const int n = 32 * tq + r32;
#pragma unroll
            for (int i = 0; i < 16; ++i) { const int m = 32 * tq + 8 * (i >> 2) + 4 * h + (i & 3); if ((m >> 4) == (n >> 4)) *(LAS float*)(lds + RC_DIAG + ((n >> 4) * 256 + (m & 15) * 16 + (n & 15)) * 4) = (m < n) ? d[i] : 0.f; }
            asm volatile("s_waitcnt lgkmcnt(0)" ::: "memory");
            if (lane < 32) { const int blk = 2 * tq + (lane >> 4), c = lane & 15; float x[16];
#pragma unroll
                for (int t = 0; t < 16; ++t) x[t] = (t == c) ? 1.f : 0.f;
#pragma unroll
                for (int j = 0; j < 15; ++j) {
#pragma unroll
                    for (int q = (j + 1) >> 2; q < 4; ++q) { const v4f l4 = *(const LAS v4f*)(lds + RC_DIAG + (blk * 256 + j * 16 + 4 * q) * 4);
#pragma unroll
                        for (int e = 0; e < 4; ++e) { const int t = 4 * q + e; if (t > j) x[t] += l4[e] * x[j]; } } }
                asm volatile("s_waitcnt lgkmcnt(0)" ::: "memory");
                LAS unsigned char* cb = lds + RC_DIAG + blk * 1024;
#pragma unroll
                for (int t = 0; t < 16; ++t) *(LAS unsigned short*)(cb + (t * 16 + c) * 2) = (unsigned short)f2bf(x[t]);
                v4u o0, o1;
#pragma unroll
                for (int e = 0; e < 4; ++e) { o0[e] = cvtpk(x[2 * e], x[2 * e + 1]); o1[e] = cvtpk(x[8 + 2 * e], x[9 + 2 * e]); }
                *(LAS v4u*)(cb + 512 + c * 32) = o0; *(LAS v4u*)(cb + 512 + c * 32 + 16) = o1; } }
        else { const int slot = w < 3 ? w - 1 : w - 2;
#pragma unroll 1
            for (int q = slot; q < 16; q += 6) { const int blk = 1 + (q >> 2), ta = (q >> 1) & 1, tb = q & 1;
                const int ao = blk == 1 ? RC_A : blk == 2 ? RC_K : blk == 3 ? RC_B : RC_K, bo = blk == 1 ? RC_B : blk == 2 ? RC_A : RC_R;
                const int oo = blk == 1 ? RC_LABT : blk == 2 ? RC_LAK : blk == 3 ? RC_MRB : RC_MRK;
                f32x16 d = rc_zero();
                const bool dead = (blk == 1) ? (tb > ta) : (ta > tb);
                if (!dead) d = rc_mm2<4>(d, lds + ao, 32 * ta, lds + bo, 32 * tb, r32, h);
                if (ta == tb) { const int n = 32 * tb + r32;
#pragma unroll
                    for (int i = 0; i < 16; ++i) { const int m = 32 * ta + 8 * (i >> 2) + 4 * h + (i & 3); bool keep;
                        if (blk == 1) keep = (n < m) && ((n >> 4) != (m >> 4)); else if (blk < 3) keep = m < n; else keep = m <= n;
                        d[i] = keep ? d[i] : 0.f; } }
                rc_store_t(d, lds + oo, 32 * ta, 32 * tb, r32, h); } }
        }
        RC_BAR();
        { const int tid = otid(), w = __builtin_amdgcn_readfirstlane(tid >> 6), lane = tid & 63, r32 = lane & 31, h = lane >> 5; (void)w; (void)lane; (void)r32; (void)h;
        { const int ta = (w >> 1) & 1, tb = w & 1; f32x16 d = rc_zero();
          if (w < 4) { d = rc_mm_bd<false>(d, lds + RC_LABT, 32 * ta, lds + RC_DIAG, 32 * tb, r32, h); }
          else       { d = rc_mm_bd<true>(d, lds + RC_DIAG, 32 * ta, lds + RC_LABT, 32 * tb, r32, h); }
          rc_store_t(d, lds + (w < 4 ? RC_N : RC_NT), 32 * ta, 32 * tb, r32, h); }
        }
        RC_BAR();
        { const int tid = otid(), w = __builtin_amdgcn_readfirstlane(tid >> 6), lane = tid & 63, r32 = lane & 31, h = lane >> 5; (void)w; (void)lane; (void)r32; (void)h;
        xacc = rc_zero();
        if (w < 4) { const int ta = (w >> 1) & 1, tb = w & 1;
            xacc = rc_mm2<4>(xacc, lds + RC_NT, 32 * ta, lds + RC_N, 32 * tb, r32, h);
#pragma unroll
            for (int i = 0; i < 16; ++i) { const int m = 32 * ta + 8 * (i >> 2) + 4 * h + (i & 3), n = 32 * tb + r32; if (m == n) xacc[i] += 1.0f; } }
        if (w >= 4) { const int t4 = tid - 256, k = t4 >> 2, tg = t4 & 3; const float gc = *(const LAS float*)(lds + RC_GC + k * 4);
#pragma unroll
            for (int i = 0; i < 16; ++i) { const int t = tg + 4 * i;
                const float bt = bf2f(*(const LAS unsigned short*)(lds + RC_B + t * 144 + k * 2)), kt = bf2f(*(const LAS unsigned short*)(lds + RC_K + t * 144 + k * 2));
                *(LAS unsigned short*)(lds + RC_BHT + k * 144 + t * 2) = (unsigned short)f2bf(bt * gc); *(LAS unsigned short*)(lds + RC_KHT + k * 144 + t * 2) = (unsigned short)f2bf(kt * gc); } }
        if (w < 4) { const int ta = (w >> 1) & 1, tb = w & 1;
#pragma unroll
            for (int i = 0; i < 16; ++i) { const int m = 32 * ta + 8 * (i >> 2) + 4 * h + (i & 3), n = 32 * tb + r32; *(LAS unsigned short*)(lds + RC_N2 + m * 144 + n * 2) = (unsigned short)f2bf(xacc[i]); } }
        }
        RC_BAR();
        { const int tid = otid(), w = __builtin_amdgcn_readfirstlane(tid >> 6), lane = tid & 63, r32 = lane & 31, h = lane >> 5; (void)w; (void)lane; (void)r32; (void)h;
        if (w < 4) { const int ta = (w >> 1) & 1, tb = w & 1;
            xacc = rc_mm2<4>(xacc, lds + RC_N2, 32 * ta, lds + RC_N, 32 * tb, r32, h);
            rc_store_t(xacc, lds + RC_P, 32 * ta, 32 * tb, r32, h); }
        else { const int t4 = tid - 256, k = t4 >> 2, tg = t4 & 3;
#pragma unroll
            for (int i = 0; i < 16; ++i) { const int t = tg + 4 * i; *(LAS unsigned short*)(lds + RC_VT + k * 144 + t * 2) = *(const LAS unsigned short*)(lds + RC_V + t * 144 + k * 2); } }
        }
        RC_BAR();
        { const int tid = otid(), w = __builtin_amdgcn_readfirstlane(tid >> 6), lane = tid & 63, r32 = lane & 31, h = lane >> 5; (void)w; (void)lane; (void)r32; (void)h;
        { const int ta = (w >> 1) & 1, tb = w & 1; f32x16 d = rc_zero();
          if (w < 4) { d = rc_mm_bd<true>(d, lds + RC_DIAG + 512, 32 * ta, lds + RC_P, 32 * tb, r32, h); rc_store_t(d, lds + RC_TINV, 32 * ta, 32 * tb, r32, h); }
          else { d = rc_mm2<4>(d, lds + RC_A, 32 * ta, lds + RC_S, 32 * tb, r32, h); d = rc_mm2<4>(d, lds + RC_LAK, 32 * ta, lds + RC_VT, 32 * tb, r32, h); rc_store_t(d, lds + RC_RHST, 32 * ta, 32 * tb, r32, h); } }
        if (t0 + 64 < T) RC_LOADPIECES(t0 + 64);
        }
        RC_BAR();
        { const int tid = otid(), w = __builtin_amdgcn_readfirstlane(tid >> 6), lane = tid & 63, r32 = lane & 31, h = lane >> 5; (void)w; (void)lane; (void)r32; (void)h;
        if (w < 4) { const int ta = (w >> 1) & 1, tb = w & 1; f32x16 d = rc_zero(); d = rc_mm2<4>(d, lds + RC_TINV, 32 * ta, lds + RC_RHST, 32 * tb, r32, h); rc_store_t(d, lds + RC_UT, 32 * ta, 32 * tb, r32, h); }
        }
        RC_BAR();
        { const int tid = otid(), w = __builtin_amdgcn_readfirstlane(tid >> 6), lane = tid & 63, r32 = lane & 31, h = lane >> 5; (void)w; (void)lane; (void)r32; (void)h;
        yacc = rc_zero();
        { const int ta = (w >> 1) & 1, tb = w & 1;
          if (w < 4) {
#pragma unroll
              for (int i = 0; i < 16; ++i) Sacc[i] *= *(const LAS float*)(lds + RC_GC + (32 * ta + 8 * (i >> 2) + 4 * h + (i & 3)) * 4);
              Sacc = rc_mm2<4>(Sacc, lds + RC_BHT, 32 * ta, lds + RC_UT, 32 * tb, r32, h); Sacc = rc_mm2<4>(Sacc, lds + RC_KHT, 32 * ta, lds + RC_VT, 32 * tb, r32, h); }
          else { yacc = rc_mm2<4>(yacc, lds + RC_S, 32 * ta, lds + RC_R, 32 * tb, r32, h); yacc = rc_mm2<4>(yacc, lds + RC_UT, 32 * ta, lds + RC_MRB, 32 * tb, r32, h); yacc = rc_mm2<4>(yacc, lds + RC_VT, 32 * ta, lds + RC_MRK, 32 * tb, r32, h);
              float s1 = 0.f, s2 = 0.f;
#pragma unroll
              for (int i = 0; i < 16; ++i) { s1 += yacc[i]; s2 += yacc[i] * yacc[i]; }
              s1 += __shfl_xor(s1, 32); s2 += __shfl_xor(s2, 32);
              if (h == 0) { *(LAS float*)(lds + RC_SSB + ((w - 4) * 32 + r32) * 8) = s1; *(LAS float*)(lds + RC_SSB + ((w - 4) * 32 + r32) * 8 + 4) = s2; } } }
        }
        RC_BAR();
        { const int tid = otid(), w = __builtin_amdgcn_readfirstlane(tid >> 6), lane = tid & 63, r32 = lane & 31, h = lane >> 5; (void)w; (void)lane; (void)r32; (void)h;
        if (w >= 4) { const int ta = (w >> 1) & 1, tb = w & 1, t = 32 * tb + r32;
            const float a1 = *(const LAS float*)(lds + RC_SSB + ((w - 4) * 32 + r32) * 8), a2 = *(const LAS float*)(lds + RC_SSB + ((w - 4) * 32 + r32) * 8 + 4);
            const float b1 = *(const LAS float*)(lds + RC_SSB + (((w - 4) ^ 2) * 32 + r32) * 8), b2 = *(const LAS float*)(lds + RC_SSB + (((w - 4) ^ 2) * 32 + r32) * 8 + 4);
            const float mean = (a1 + b1) * (1.f / 64.f), var = fmaxf((a2 + b2) * (1.f / 64.f) - mean * mean, 0.f), rstd = rsqrtf(var + 64e-5f), bs = *(const LAS float*)(lds + RC_BS + t * 4);
#pragma unroll
            for (int q4 = 0; q4 < 4; ++q4) { const int v0 = 32 * ta + 8 * q4 + 4 * h; const v2u gw = *(const LAS v2u*)(lds + RC_G + t * 144 + v0 * 2);
                const v4f lg4 = *(const LAS v4f*)(lds + RC_CST + 1280 + v0 * 4), lb4 = *(const LAS v4f*)(lds + RC_CST + 1536 + v0 * 4); float o[4];
#pragma unroll
                for (int e = 0; e < 4; ++e) { const float vv = bf2f(*(const LAS unsigned short*)(lds + RC_VT + (v0 + e) * 144 + t * 2)); const float g = (e & 1) ? bfhi(gw[e >> 1]) : bflo(gw[e >> 1]);
                    o[e] = ((yacc[4 * q4 + e] - mean) * rstd * lg4[e] + lb4[e] + bs * vv) * g; }
                v2u ow; ow[0] = cvtpk(o[0], o[1]); ow[1] = cvtpk(o[2], o[3]);
                *(v2u*)(mixo + (size_t)(b * T + t0 + t) * NMIX + 512 + hh * 64 + v0) = ow; } }

        }
    }
    __syncthreads();
#undef RC_LOADPIECES
}
__device__ __forceinline__ void rwkvc_phase(KP P, int l, LAS unsigned char* lds, int vcu, int G) {
    for (int unit = vcu; unit < BATCH * 8; unit += G) rwkvc_unit(P, l, lds, unit >> 3, unit & 7);
}

#define XB_TMO      128
#define XB_XCNT(j)  (256  + 64 * (j))
#define XB_XSUB(j)  (1280 + 64 * (j))
#define XB_XGEN(j)  (2304 + 64 * (j))
#define XB_TOP      3328
#define XB_TOPGEN   3392
#define XCD_BAR_WORDS 3456
#define XB_SPIN_CAP (1u << 18)
__device__ __forceinline__ unsigned xb_ld(unsigned* p)              { return __hip_atomic_load(p, __ATOMIC_RELAXED, __HIP_MEMORY_SCOPE_AGENT); }
__device__ __forceinline__ unsigned xb_add(unsigned* p, unsigned v) { return __hip_atomic_fetch_add(p, v, __ATOMIC_RELAXED, __HIP_MEMORY_SCOPE_AGENT); }
__device__ __forceinline__ unsigned xb_xcc_id() { return (unsigned)__builtin_amdgcn_s_getreg((3 << 11) | 20) & 0xFu; }
#define XB_SPIN(cond, bar) do { unsigned _sp = 0; while (cond) { __builtin_amdgcn_s_sleep(1); \
    if ((++_sp & 255u) == 0u) { if (xb_ld(&(bar)[XB_TMO])) break; if (_sp > XB_SPIN_CAP) { atomicAdd(&(bar)[XB_TMO], 1u); break; } } } } while (0)
struct XcdBarrier {
    unsigned* bar; unsigned x;
    volatile LAS unsigned* st;
    unsigned n;
};
__device__ __forceinline__ XcdBarrier xcd_barrier_post(unsigned* bar, volatile LAS unsigned* st, unsigned n) {
    XcdBarrier b; b.bar = bar; b.x = xb_xcc_id(); b.st = st; b.n = n;
    if (threadIdx.x == 0) (void)xb_add(&bar[XB_XCNT(b.x)], 1u);
    return b;
}
__device__ __forceinline__ void xcd_barrier_complete(unsigned* bar, unsigned x, unsigned G, unsigned& nloc, unsigned& nx) {
    unsigned sum, cnt, mine, sp = 0u;
    for (;;) {
        sum = 0u; cnt = 0u; mine = 0u;
#pragma unroll
        for (unsigned j = 0; j < 16; ++j) { const unsigned c = xb_ld(&bar[XB_XCNT(j)]); sum += c; cnt += (c > 0u) ? 1u : 0u; mine = (j == x) ? c : mine; }
        if (sum == G) break;
        __builtin_amdgcn_s_sleep(1);
        if ((++sp & 255u) == 0u) { if (xb_ld(&bar[XB_TMO])) break; if (sp > XB_SPIN_CAP) { atomicAdd(&bar[XB_TMO], 1u); break; } }
    }
    nloc = mine > 0u ? mine : 1u; nx = cnt > 0u ? cnt : 1u;
}
template <bool LOCAL> __device__ __forceinline__ void xcd_barrier(const XcdBarrier& b) {
    asm volatile("s_waitcnt vmcnt(0)" ::: "memory");
    __syncthreads();
    if (threadIdx.x == 0) {
        unsigned* bar = b.bar;
        __builtin_amdgcn_s_waitcnt(0);
        unsigned nloc = b.st[0], nx = b.st[1];
        if (nloc == 0u) { xcd_barrier_complete(bar, b.x, b.n, nloc, nx); b.st[0] = nloc; b.st[1] = nx; }
        const bool one = LOCAL && nx == 1u;
        const unsigned old = xb_add(&bar[XB_XSUB(b.x)], 1u);
        const unsigned gen = old / nloc;
        if (old + 1u == (gen + 1u) * nloc) {
            if (!one) { __builtin_amdgcn_fence(__ATOMIC_RELEASE, "agent");
                        asm volatile("s_waitcnt vmcnt(0)" ::: "memory"); }
            const unsigned og = xb_add(&bar[XB_TOP], 1u);
            const unsigned tg = og / nx;
            if (og + 1u == (tg + 1u) * nx) xb_add(&bar[XB_TOPGEN], 1u);
            else XB_SPIN(xb_ld(&bar[XB_TOPGEN]) == tg, bar);
            if (!one) __builtin_amdgcn_fence(__ATOMIC_ACQUIRE, "agent");
            else asm volatile("buffer_inv sc0" ::: "memory");
            xb_add(&bar[XB_XGEN(b.x)], 1u);
            asm volatile("s_waitcnt vmcnt(0)" ::: "memory");
        } else {
            XB_SPIN(xb_ld(&bar[XB_XGEN(b.x)]) == gen, bar);
            if (!one) __builtin_amdgcn_fence(__ATOMIC_ACQUIRE, "agent");
            else asm volatile("buffer_inv sc0" ::: "memory");
            asm volatile("s_waitcnt vmcnt(0)" ::: "memory");
        }
    }
    __syncthreads();
}

constexpr int CW_BAR = 4096;
constexpr int MISC_OFF = 156928;
constexpr int CW_HB = 8192;
constexpr int CW_WDONE = 8192 + 1024;
constexpr int CW_GBAR = 65536;
__device__ __forceinline__ void half_barrier(unsigned* ctl, int cw, unsigned target) {
    asm volatile("s_waitcnt vmcnt(0) lgkmcnt(0)" ::: "memory");
    __syncthreads();
    if (threadIdx.x == 0) {
        (void)xb_add(&ctl[cw], 1u);
        unsigned sp = 0;
        while (xb_ld(&ctl[cw]) < target) { __builtin_amdgcn_s_sleep(2);
            if ((++sp & 255u) == 0u) { if (xb_ld(&ctl[CW_BAR + XB_TMO])) break; if (sp > XB_SPIN_CAP) { atomicAdd(&ctl[CW_BAR + XB_TMO], 1u); break; } } }
        asm volatile("" ::: "memory");
    }
    __syncthreads();
}
#ifndef NAIVE_ATTN
#define NAIVE_ATTN 0
#endif
#ifndef NAIVE_RET
#define NAIVE_RET 0
#endif
#ifndef NAIVE_RWKV
#define NAIVE_RWKV 0
#endif
#define RWKV_CHUNKED 1
#define GROUP_LOCAL 1
#define ATT_FIRST 1
#ifndef REP_RWKV
#define REP_RWKV 1
#endif
#ifndef REP_ATTN
#define REP_ATTN 1
#endif
#ifndef REP_RET
#define REP_RET 1
#endif
#ifndef REP_G0
#define REP_G0 1
#endif
#ifndef REP_G1
#define REP_G1 1
#endif
#ifndef REP_G2
#define REP_G2 1
#endif
#ifndef REP_G4
#define REP_G4 1
#endif
__global__ void __launch_bounds__(512, 2) k_mega(Params Pv) {
    KP P = (KP)__builtin_amdgcn_kernarg_segment_ptr();
#define PFRESH() asm volatile("" : "+s"(P))
    extern __shared__ __attribute__((aligned(16))) unsigned char lds_[];
    LAS unsigned char* lds = (LAS unsigned char*)lds_;
    const int tid = threadIdx.x, G = gridDim.x, bx = blockIdx.x, vcu = (G % 8 == 0) ? (bx % 8) * (G / 8) + bx / 8 : bx;
    volatile LAS unsigned* MISC = (volatile LAS unsigned*)(lds + MISC_OFF);
    for (int u = tid; u < (LDS_BYTES - MISC_OFF) / 4; u += 512) ((LAS unsigned*)(lds + MISC_OFF))[u] = 0u;
    __syncthreads();
    const int GS = G / 8, grp = vcu / GS, rk = vcu % GS, GSH = GS / 2;
    XcdBarrier bar = xcd_barrier_post((unsigned*)(P->ws + WS_CTL) + CW_BAR, MISC + 8, (unsigned)G);
    { XcdBarrier gb0 = xcd_barrier_post((unsigned*)(P->ws + WS_CTL) + CW_GBAR + 4096 * grp, MISC + 12, (unsigned)GS); (void)gb0; }
#define GRID_BAR() do { asm volatile("" : "+s"(bar.x)); xcd_barrier<false>(bar); } while (0)
#define GROUP_BAR() do { int g_ = grp; asm volatile("" : "+s"(g_)); XcdBarrier gb_; gb_.bar = (unsigned*)(P->ws + WS_CTL) + CW_GBAR + 4096 * g_; gb_.x = xb_xcc_id(); gb_.st = MISC + 12; gb_.n = (unsigned)GS; xcd_barrier<GROUP_LOCAL != 0>(gb_); } while (0)
    PFRESH(); phase_x0(P, vcu, G);
    PFRESH(); phase_wconv_all(P, lds, vcu, G);
    GRID_BAR();
    for (int l = 0; l < DEPTH; ++l) {
        PFRESH(); gemm_phase_of<0>(P, l, lds, G, bx);
        GROUP_BAR();
        PFRESH();
        { unsigned* ctl = (unsigned*)(P->ws + WS_CTL); const int cw = CW_HB + 64 * grp;
          if (rk < GSH) { attn_phase(P, l, lds, 64 * grp + rk, GSH, 64 * grp + GSH * ATT_FIRST); half_barrier(ctl, cw, 0u); PFRESH();
                          for (int unit = 16 * grp + rk; unit < 16 * grp + 16; unit += GSH) rwkvc_unit(P, l, lds, unit >> 3, unit & 7); }
          else { const int r2 = rk - GSH;
                 attn_phase(P, l, lds, 64 * grp + GSH * ATT_FIRST + r2, GS - GSH, 64 * grp + 64); __syncthreads();
                 for (int unit = 16 * grp + r2; unit < 16 * grp + 16; unit += GS - GSH) ret_unit(P, lds, unit >> 3, unit & 7);
                 half_barrier(ctl, cw, (unsigned)GS * (unsigned)(l + 1));
                 PFRESH(); gemm_phase_of<1>(P, l, lds, 8 * (GS - GSH), 8 * r2 + grp); } }
        GROUP_BAR();
        PFRESH(); gemm_phase_of<2>(P, l, lds, G, bx);
        GROUP_BAR();
        PFRESH(); gemm_phase_of<3>(P, l, lds, G, bx);
        GROUP_BAR();
        PFRESH(); gemm_phase_of<4>(P, l, lds, G, bx);
        GROUP_BAR();
        if (l == DEPTH - 1) {
            unsigned* ctl = (unsigned*)(P->ws + WS_CTL);
            if (tid == 0) { unsigned sp = 0; while (xb_ld(&ctl[CW_WDONE]) < (unsigned)G) { __builtin_amdgcn_s_sleep(8);
                if ((++sp & 255u) == 0u) { if (xb_ld(&ctl[CW_BAR + XB_TMO])) break; if (sp > XB_SPIN_CAP) { atomicAdd(&ctl[CW_BAR + XB_TMO], 1u); break; } } } }
            __syncthreads(); }
        PFRESH(); gemm_phase_of<5>(P, l, lds, G, bx);
        if (l == DEPTH - 2) { asm volatile("s_waitcnt vmcnt(0)" ::: "memory"); __syncthreads(); if (tid == 0) (void)xb_add((unsigned*)(P->ws + WS_CTL) + CW_WDONE, 1u); }
        if (l < DEPTH - 1) GROUP_BAR();
    }
#if PROBE_T
    if (vcu == 0 && tid == 0) { const unsigned long long tt_ = *(volatile unsigned long long*)(P->ws + WS_CTL + 65536) * 8ull; const unsigned long long t0_ = __builtin_amdgcn_s_memrealtime(); while (__builtin_amdgcn_s_memrealtime() - t0_ < tt_) __builtin_amdgcn_s_sleep(8); }
#endif
}

extern "C" void kernel_launch(void* const* d_in, const int* in_sizes, int n_in, void* d_out, int out_size, void* d_ws, size_t ws_size, hipStream_t stream) {
    static int grid = 0;
    if (grid == 0) {
        if (n_in != 25 || out_size != M * D || ws_size < WS_END) { fprintf(stderr, "kernel_launch: unexpected shapes (n_in %d, out %d, ws %zu)\n", n_in, out_size, ws_size); grid = -1; return; }
        int dev = 0, cus = 0, per_cu = 0; if (hipGetDevice(&dev) != hipSuccess || hipDeviceGetAttribute(&cus, hipDeviceAttributeMultiprocessorCount, dev) != hipSuccess) { grid = -1; return; }
        if (hipFuncSetAttribute((const void*)k_mega, hipFuncAttributeMaxDynamicSharedMemorySize, LDS_BYTES) != hipSuccess) { fprintf(stderr, "kernel_launch: hipFuncSetAttribute failed\n"); grid = -1; return; }
        if (hipOccupancyMaxActiveBlocksPerMultiprocessor(&per_cu, (const void*)k_mega, 512, LDS_BYTES) != hipSuccess || per_cu < 1) fprintf(stderr, "kernel_launch: occupancy query reports %d workgroups per CU\n", per_cu);
        (void)hipGetLastError();
        grid = cus - cus % 16;
        if (grid < 16) { grid = -1; return; }
    }
    if (grid < 0) return;
    Params p; memset(&p, 0, sizeof(p));
    for (int i = 0; i < 25; ++i) p.in[i] = (const float*)d_in[i];
    p.out = (float*)d_out; p.ws = (unsigned char*)d_ws;
    (void)hipMemsetAsync((char*)d_ws + WS_CTL, 0, CTL_BYTES, stream);
    hipLaunchKernelGGL(k_mega, dim3(grid), dim3(512), LDS_BYTES, stream, p);
}
```

```cpp
#include <hip/hip_runtime.h>
#include <cstdio>
#include <cstdint>
#include <cstring>

constexpr int D = 1024, BATCH = 16, T = 2048, DEPTH = 4, M = BATCH * T;
constexpr int HD = 64;
constexpr int NA = 4608;
constexpr int NG = 3072;
constexpr int INW = NA + NG;
constexpr int C_AQ = 0, C_AK = 512, C_AV = 640, C_RW = 768, C_RQ = 2560, C_RK = 3072, C_RV = 3584, C_RG = 4096;
constexpr int RWC = 1792;
constexpr int FF = 2816, FF2 = 2 * FF;
constexpr int NMIX = 1536;

constexpr size_t MiB = 1u << 20;
constexpr size_t WS_CTL = 0, CTL_BYTES = 1 * MiB;
constexpr size_t WS_WIN = 1 * MiB;
constexpr size_t WS_WMIX = WS_WIN + (size_t)INW * D * 2;
constexpr size_t WS_WOUT = WS_WMIX + (size_t)D * NMIX * 2;
constexpr size_t WS_WGU = WS_WOUT + (size_t)D * D * 2;
constexpr size_t WS_WDN = WS_WGU + (size_t)FF2 * D * 2;
constexpr size_t WS_XB = 38 * MiB;
constexpr size_t WS_MIXO = 102 * MiB;
constexpr size_t WS_BIG = 198 * MiB;
constexpr size_t WS_MIXED = WS_BIG + 192 * MiB;
constexpr size_t WS_RSS = 486 * MiB;
constexpr size_t WS_ROPE = 488 * MiB;
constexpr size_t WS_ROPE2 = WS_ROPE + 512 * 1024;
constexpr size_t WS_GX = 489 * MiB;
constexpr size_t WS_END = 505 * MiB;
static_assert(WS_WDN + (size_t)D * FF * 2 <= WS_XB && WS_WDN + (size_t)D * FF * 2 - WS_WIN <= 37 * MiB && 3 * 37 * MiB <= (size_t)M * D * 4, "weights fit");
static_assert(WS_BIG + (size_t)M * NA * 2 <= WS_RSS, "big region fits");

#define GAS __attribute__((address_space(1)))
#define LAS __attribute__((address_space(3)))
typedef unsigned short bf16;
typedef unsigned v4u __attribute__((ext_vector_type(4)));
typedef unsigned v2u __attribute__((ext_vector_type(2)));
typedef float v4f __attribute__((ext_vector_type(4)));
__device__ __forceinline__ unsigned f2bf(float f) { unsigned u = __builtin_bit_cast(unsigned, f); return (u + 0x7fffu + ((u >> 16) & 1u)) >> 16; }
__device__ __forceinline__ unsigned pk2(float lo, float hi) { return f2bf(lo) | (f2bf(hi) << 16); }
__device__ __forceinline__ float bf2f(unsigned short b) { return __builtin_bit_cast(float, (unsigned)b << 16); }
__device__ __forceinline__ float bflo(unsigned w) { return __builtin_bit_cast(float, w << 16); }
__device__ __forceinline__ float bfhi(unsigned w) { return __builtin_bit_cast(float, w & 0xffff0000u); }
__device__ __forceinline__ float wave_sum(float v) {
#pragma unroll
    for (int o = 1; o < 64; o <<= 1) v += __shfl_xor(v, o);
    return v;
}
__device__ __forceinline__ float wave_max(float v) {
#pragma unroll
    for (int o = 1; o < 64; o <<= 1) v = fmaxf(v, __shfl_xor(v, o));
    return v;
}
__device__ __forceinline__ float sigmoidf_(float x) { return 1.f / (1.f + __expf(-x)); }

__device__ __forceinline__ int otid() { int t = threadIdx.x; asm volatile("" : "+v"(t)); return t; }

struct Params {
    const float* in[25];
    float* out;
    unsigned char* ws;
    int layer; int pad;
};
typedef const __attribute__((address_space(4))) Params* KP;
constexpr size_t WL_STRIDE = 37 * MiB;
__device__ __forceinline__ unsigned char* wbase(KP P, int l) { return l == DEPTH - 1 ? P->ws : (unsigned char*)P->out + (size_t)l * WL_STRIDE - WS_WIN; }
constexpr size_t OUT_ZS = (DEPTH - 1) * WL_STRIDE;
static_assert(OUT_ZS + (size_t)M * 256 * 2 <= (size_t)M * D * 4, "zs fits in d_out");
enum { I_X = 0, I_N1G, I_WIN, I_QNG, I_KNG, I_SINK, I_WAO, I_MU, I_W0, I_W2, I_A0, I_A2, I_G2, I_KK, I_KA, I_RK, I_LNG, I_LNB, I_WRO, I_WTO, I_WOUT, I_N2G, I_WG, I_WU, I_WD };


namespace pg8 {
#define PG8_LAS __attribute__((address_space(3)))
typedef unsigned short bf16_t;
typedef short bf16x8 __attribute__((ext_vector_type(8)));
typedef float f32x4 __attribute__((ext_vector_type(4)));
typedef unsigned u32x4 __attribute__((ext_vector_type(4)));
constexpr int BM = 256, BK = 64, HALF = 128, HTB = HALF * BK * 2  , STAGE_BYTES = 8 * HTB, NXCD = 8, WGM = 8;

__host__ __device__ __forceinline__ int lds_byte(int r, int c) { const int st = (r >> 4) * 2 + (c >> 5), rr = r & 15, cc = c & 31, ob = rr * 64 + cc * 2; return st * 1024 + (ob ^ (((ob >> 9) & 1) << 5)); }
__host__ __device__ __forceinline__ void stage_rc(int b, int& R, int& C) { const int st = b / 1024, sb = b % 1024, swz = sb ^ (((sb >> 9) & 1) << 5); R = (st >> 1) * 16 + swz / 64; C = (st & 1) * 32 + (swz % 64) / 2; }
__host__ __device__ __forceinline__ int perm32(int rho) { const int n = rho >> 4, i = rho & 15; return 8 * (i >> 2) + 4 * n + (i & 3); }

struct Unit { int pm, pn; };
struct Gemm { const bf16_t* A; const bf16_t* Bt; int M, N, K, lda; };

struct StaticOrder {
    int nM, nN, nwg, G, c, i0, ni;
    __host__ __device__ void init(int M, int N, int G_, int c_) { nM = M / BM; nN = N / BM; nwg = nM * nN; G = G_; c = c_; i0 = 0; ni = 1 << 30; }
    __host__ __device__ bool next(int i, Unit& u) const {
        if (i >= ni) return false;
        const long L = (long)(i0 + i) * G + c; if (L >= nwg) return false;
        int wgid = (int)L; { const int q = nwg / NXCD, r = nwg % NXCD, xcd = wgid % NXCD, off = wgid / NXCD; wgid = (xcd < r ? xcd * (q + 1) : r * (q + 1) + (xcd - r) * q) + off; }
        const int nig = WGM * nN, gid = wgid / nig, fm = gid * WGM, gsz = (nM - fm) < WGM ? (nM - fm) : WGM;
        u.pm = fm + ((wgid % nig) % gsz); u.pn = (wgid % nig) / gsz; return true;
    }
    __device__ __forceinline__ void a_ready(const Unit&) const {}
    __device__ __forceinline__ void done(const Unit&) const {}
};


typedef float f32x2_ __attribute__((ext_vector_type(2))); typedef __bf16 bf16x2_ __attribute__((ext_vector_type(2)));
__device__ __forceinline__ unsigned cvt_pk_bf16(float lo, float hi) { const f32x2_ x = {lo, hi}; return __builtin_bit_cast(unsigned, __builtin_convertvector(x, bf16x2_)); }
__device__ __forceinline__ float clampg(float x) { return __builtin_amdgcn_fmed3f(x, -30.0f, 30.0f); }
__device__ __forceinline__ float row_rstd(const float* rss, int row) {
    const f32x4* p = (const f32x4*)(rss + (size_t)row * 16);
    const f32x4 a = p[0], b = p[1], c = p[2], d = p[3];
    const float s = (((a.x + a.y) + (a.z + a.w)) + ((b.x + b.y) + (b.z + b.w))) + (((c.x + c.y) + (c.z + c.w)) + ((d.x + d.y) + (d.z + d.w)));
    return rsqrtf(s * (1.0f / 1024.0f) + 1e-6f);
}
struct RowTab {
    const float* rss;
    __device__ __forceinline__ void tab_load(const Unit& u, int tid, f32x4& a, f32x4& b) const { const f32x4* p = (const f32x4*)(rss + ((size_t)u.pm * BM + (tid >> 1)) * 16 + (tid & 1) * 8); a = p[0]; b = p[1]; }
    __device__ __forceinline__ void tab_store(PG8_LAS float* tab, int tid, const f32x4& a, const f32x4& b) const {
        float s = ((a.x + a.y) + (a.z + a.w)) + ((b.x + b.y) + (b.z + b.w)); s += __shfl_xor(s, 1);
        if ((tid & 1) == 0) tab[tid >> 1] = rsqrtf(s * (1.0f / 1024.0f) + 1e-6f); }
};
struct EpiRowScale : RowTab {
    static constexpr bool PERM = true, AFTER_DRAIN = false, ROWTAB = true, ACCINIT = false; static constexpr int KSEG = 0;
    bf16_t* O; int ldc;
    __device__ __forceinline__ void operator()(const f32x4 (&acc)[2][2][4][2], const Unit& u, int wr, int wc, int fr, int fq, const PG8_LAS float* tab) const {
        const int row0 = u.pm * BM + wr * 64 + fr, col0 = u.pn * BM + wc * 32 + 8 * fq;
#pragma unroll
        for (int ai = 0; ai < 2; ++ai)
#pragma unroll
            for (int m = 0; m < 4; ++m) { const int row = row0 + ai * HALF + m * 16; const float rs = tab[wr * 64 + fr + ai * HALF + m * 16]; bf16_t* rowp = O + (size_t)row * ldc + col0;
#pragma unroll
                for (int bj = 0; bj < 2; ++bj) { const f32x4 v0 = acc[ai][bj][m][0] * rs, v1 = acc[ai][bj][m][1] * rs;
                    u32x4 w; w.x = cvt_pk_bf16(v0[0], v0[1]); w.y = cvt_pk_bf16(v0[2], v0[3]); w.z = cvt_pk_bf16(v1[0], v1[1]); w.w = cvt_pk_bf16(v1[2], v1[3]);
                    *(u32x4*)(rowp + bj * HALF) = w; } }
    }
};
struct GateMap { bf16_t* proj; bf16_t* gx;
    __device__ __forceinline__ bf16_t* tile(int gt, int& ld) const { if (gt < 11) { ld = 4608; return proj + (gt < 3 ? gt * 256 : 2560 + (gt - 3) * 256); } ld = 256; return gx; } };
struct EpiGates : RowTab {
    static constexpr bool PERM = true, AFTER_DRAIN = false, ROWTAB = true, ACCINIT = false; static constexpr int KSEG = 0;
    GateMap gm;
    __device__ __forceinline__ void operator()(const f32x4 (&acc)[2][2][4][2], const Unit& u, int wr, int wc, int fr, int fq, const PG8_LAS float* tab) const {
        int ld; bf16_t* base = gm.tile(u.pn, ld); const int row0 = u.pm * BM + wr * 64 + fr, col0 = wc * 32 + 8 * fq;
#pragma unroll
        for (int ai = 0; ai < 2; ++ai)
#pragma unroll
            for (int m = 0; m < 4; ++m) { const int row = row0 + ai * HALF + m * 16; const float rs = tab[wr * 64 + fr + ai * HALF + m * 16]; bf16_t* rowp = base + (size_t)row * ld + col0;
#pragma unroll
                for (int bj = 0; bj < 2; ++bj) { const f32x4 v0 = acc[ai][bj][m][0] * rs, v1 = acc[ai][bj][m][1] * rs;
                    u32x4 w; w.x = cvt_pk_bf16(v0[0], v0[1]); w.y = cvt_pk_bf16(v0[2], v0[3]); w.z = cvt_pk_bf16(v1[0], v1[1]); w.w = cvt_pk_bf16(v1[2], v1[3]);
                    *(u32x4*)(rowp + bj * HALF) = w; } }
    }
};
struct EpiSwiglu : RowTab {
    static constexpr bool PERM = true, AFTER_DRAIN = false, ROWTAB = true, ACCINIT = false; static constexpr int KSEG = 0;
    bf16_t* O; int ldc;
    __device__ __forceinline__ void operator()(const f32x4 (&acc)[2][2][4][2], const Unit& u, int wr, int wc, int fr, int fq, const PG8_LAS float* tab) const {
        const int row0 = u.pm * BM + wr * 64 + fr, col0 = u.pn * HALF + wc * 32 + 8 * fq;
#pragma unroll
        for (int ai = 0; ai < 2; ++ai)
#pragma unroll
            for (int m = 0; m < 4; ++m) { const int row = row0 + ai * HALF + m * 16; const float rs = tab[wr * 64 + fr + ai * HALF + m * 16]; bf16_t* rowp = O + (size_t)row * ldc + col0;
                float o[8];
#pragma unroll
                for (int n = 0; n < 2; ++n)
#pragma unroll
                    for (int j = 0; j < 4; ++j) { const float g = acc[ai][0][m][n][j] * rs, up = acc[ai][1][m][n][j] * rs; o[4 * n + j] = g * up * __builtin_amdgcn_rcpf(1.0f + __expf(-g)); }
                u32x4 w; w.x = cvt_pk_bf16(o[0], o[1]); w.y = cvt_pk_bf16(o[2], o[3]); w.z = cvt_pk_bf16(o[4], o[5]); w.w = cvt_pk_bf16(o[6], o[7]);
                *(u32x4*)rowp = w; }
    }
};
struct EpiResid {
    static constexpr bool PERM = true, AFTER_DRAIN = false, ROWTAB = false, ACCINIT = true; static constexpr int KSEG = 0;
    bf16_t* XB; float* rss; float* OUT;
    __device__ __forceinline__ void init(f32x4 (&acc)[2][2][4][2], const Unit& u, int wr, int wc, int fr, int fq) const {
        const int row0 = u.pm * BM + wr * 64 + fr, col0 = u.pn * BM + wc * 32 + 8 * fq;
#pragma unroll
        for (int ai = 0; ai < 2; ++ai) { u32x4 xin[4][2];
#pragma unroll
            for (int m = 0; m < 4; ++m)
#pragma unroll
                for (int bj = 0; bj < 2; ++bj) xin[m][bj] = *(const u32x4*)(XB + (size_t)(row0 + ai * HALF + m * 16) * 1024 + col0 + bj * HALF);
#pragma unroll
            for (int m = 0; m < 4; ++m)
#pragma unroll
                for (int bj = 0; bj < 2; ++bj)
#pragma unroll
                    for (int q = 0; q < 4; ++q) { const unsigned w = xin[m][bj][q]; acc[ai][bj][m][q >> 1][(q & 1) * 2] = __builtin_bit_cast(float, w << 16); acc[ai][bj][m][q >> 1][(q & 1) * 2 + 1] = __builtin_bit_cast(float, w & 0xffff0000u); } }
    }
    __device__ __forceinline__ void operator()(const f32x4 (&acc)[2][2][4][2], const Unit& u, int wr, int wc, int fr, int fq) const {
        const int row0 = u.pm * BM + wr * 64 + fr, col0 = u.pn * BM + wc * 32 + 8 * fq;
#pragma unroll
        for (int g = 0; g < 8; ++g) { const int ai = g >> 2, m = g & 3; const int row = row0 + ai * HALF + m * 16; const size_t off = (size_t)row * 1024 + col0; float ss = 0.f;
#pragma unroll
            for (int bj = 0; bj < 2; ++bj) { const f32x4 x0 = acc[ai][bj][m][0], x1 = acc[ai][bj][m][1];
                ss += ((x0[0] * x0[0] + x0[1] * x0[1]) + (x0[2] * x0[2] + x0[3] * x0[3])) + ((x1[0] * x1[0] + x1[1] * x1[1]) + (x1[2] * x1[2] + x1[3] * x1[3]));
                u32x4 w; w.x = cvt_pk_bf16(x0[0], x0[1]); w.y = cvt_pk_bf16(x0[2], x0[3]); w.z = cvt_pk_bf16(x1[0], x1[1]); w.w = cvt_pk_bf16(x1[2], x1[3]);
                *(u32x4*)(XB + off + bj * HALF) = w;
                if (OUT) { *(f32x4*)(OUT + off + bj * HALF) = x0; *(f32x4*)(OUT + off + bj * HALF + 4) = x1; } }
            ss += __shfl_xor(ss, 16); ss += __shfl_xor(ss, 32);
            if (fq == 0) rss[(size_t)row * 16 + u.pn * 4 + wc] = ss; }
    }
};
struct EpiGateMix {
    static constexpr bool PERM = true, AFTER_DRAIN = false, ROWTAB = false, ACCINIT = false; static constexpr int KSEG = 8;
    GateMap gm; bf16_t* O; int ldo;
    static constexpr int PF = 4;
    __device__ __forceinline__ void seg(f32x4 (&acc)[2][2][4][2], const Unit& u, int s, int wr, int wc, int fr, int fq) const {
        const int row0 = u.pm * BM + wr * 64 + fr, col0 = wc * 32 + 8 * fq; int ldl, ldh; const bf16_t* bl = gm.tile((s - 1) * 4 + u.pn, ldl); const bf16_t* bh = gm.tile(s * 4 + u.pn, ldh);
        u32x4 lo[PF][2], hi[PF][2];
#pragma unroll
        for (int g = 0; g < PF; ++g) { const size_t rown = (size_t)(row0 + (g >> 2) * HALF + (g & 3) * 16);
#pragma unroll
            for (int bj = 0; bj < 2; ++bj) { lo[g][bj] = *(const u32x4*)(bl + rown * ldl + col0 + bj * HALF); hi[g][bj] = *(const u32x4*)(bh + rown * ldh + col0 + bj * HALF); } }
#pragma unroll
        for (int g = 0; g < 8; ++g) { const int ai = g >> 2, m = g & 3, sl = g % PF;
#pragma unroll
            for (int bj = 0; bj < 2; ++bj)
#pragma unroll
                for (int q = 0; q < 4; ++q) { const unsigned wl = lo[sl][bj][q], wh = hi[sl][bj][q];
                    const float l0 = clampg(__builtin_bit_cast(float, wl << 16)), l1 = clampg(__builtin_bit_cast(float, wl & 0xffff0000u)), h0 = clampg(__builtin_bit_cast(float, wh << 16)), h1 = clampg(__builtin_bit_cast(float, wh & 0xffff0000u));
                    const float r0 = (1.0f + __expf(-h0)) * __builtin_amdgcn_rcpf(1.0f + __expf(-l0)), r1 = (1.0f + __expf(-h1)) * __builtin_amdgcn_rcpf(1.0f + __expf(-l1));
                    acc[ai][bj][m][q >> 1][(q & 1) * 2] *= r0; acc[ai][bj][m][q >> 1][(q & 1) * 2 + 1] *= r1; }
            if (g + PF < 8) { const size_t rown = (size_t)(row0 + ((g + PF) >> 2) * HALF + ((g + PF) & 3) * 16);
#pragma unroll
                for (int bj = 0; bj < 2; ++bj) { lo[sl][bj] = *(const u32x4*)(bl + rown * ldl + col0 + bj * HALF); hi[sl][bj] = *(const u32x4*)(bh + rown * ldh + col0 + bj * HALF); } } }
    }
    __device__ __forceinline__ void operator()(const f32x4 (&acc)[2][2][4][2], const Unit& u, int wr, int wc, int fr, int fq) const {
        const int row0 = u.pm * BM + wr * 64 + fr, col0 = wc * 32 + 8 * fq; int ldg; const bf16_t* bg = gm.tile(8 + u.pn, ldg);
        u32x4 gc[PF][2];
#pragma unroll
        for (int g = 0; g < PF; ++g) { const size_t rown = (size_t)(row0 + (g >> 2) * HALF + (g & 3) * 16);
#pragma unroll
            for (int bj = 0; bj < 2; ++bj) gc[g][bj] = *(const u32x4*)(bg + rown * ldg + col0 + bj * HALF); }
#pragma unroll
        for (int gi = 0; gi < 8; ++gi) { const int ai = gi >> 2, m = gi & 3, sl = gi % PF; const int row = row0 + ai * HALF + m * 16; bf16_t* rowp = O + (size_t)row * ldo + u.pn * BM + col0;
#pragma unroll
            for (int bj = 0; bj < 2; ++bj) { const u32x4 g = gc[sl][bj]; float o[8];
#pragma unroll
                for (int q = 0; q < 4; ++q) { const unsigned w = g[q]; const float g0 = clampg(__builtin_bit_cast(float, w << 16)), g1 = clampg(__builtin_bit_cast(float, w & 0xffff0000u));
                    o[2 * q] = acc[ai][bj][m][q >> 1][(q & 1) * 2] * __builtin_amdgcn_rcpf(1.0f + __expf(-g0)); o[2 * q + 1] = acc[ai][bj][m][q >> 1][(q & 1) * 2 + 1] * __builtin_amdgcn_rcpf(1.0f + __expf(-g1)); }
                u32x4 w; w.x = cvt_pk_bf16(o[0], o[1]); w.y = cvt_pk_bf16(o[2], o[3]); w.z = cvt_pk_bf16(o[4], o[5]); w.w = cvt_pk_bf16(o[6], o[7]);
                *(u32x4*)(rowp + bj * HALF) = w; }
            if (gi + PF < 8) { const size_t rown = (size_t)(row0 + ((gi + PF) >> 2) * HALF + ((gi + PF) & 3) * 16);
#pragma unroll
                for (int bj = 0; bj < 2; ++bj) gc[sl][bj] = *(const u32x4*)(bg + rown * ldg + col0 + bj * HALF); } }
    }
};


template <class Epi, class Sched, bool ALIGN_EPI = false, bool SP2 = false>
__device__ __forceinline__ void gemm_phase(PG8_LAS unsigned char* lds, const Gemm g, const Sched& S, const Epi& E) {
    int tid_ = threadIdx.x; asm volatile("" : "+v"(tid_));
    const int tid = tid_, wid = __builtin_amdgcn_readfirstlane(tid >> 6), lane = tid & 63, wr = wid >> 2, wc = wid & 3, fr = lane & 15, fq = lane >> 4;
    const int K = g.K, nt = K / BK;
    unsigned voffA[2], voffB[2];
#pragma unroll
    for (int i = 0; i < 2; ++i) { int R, C; stage_rc(tid * 16 + i * 8192, R, C); const int Rb = Epi::PERM ? ((R & ~31) + perm32(R & 31)) : R;
        voffA[i] = (unsigned)(R * g.lda + C) * 2u; voffB[i] = (unsigned)(Rb * K + C) * 2u; }
    const size_t kstep = (size_t)(BK * 2);
    const size_t hstepB = (size_t)HALF * K * 2, hstepA = (size_t)HALF * g.lda * 2;
    const size_t tstepB = 2 * hstepB, tstepA = 2 * hstepA;
    const unsigned ldsw = (unsigned)wid * 1024u;
    const int aoff = lds_byte(wr * 64 + fr, fq * 8), boff = lds_byte(wc * 32 + fr, fq * 8);
#define PG8_SA(b, h) (((b) * 2 + (h)) * HTB)
#define PG8_SB(b, h) ((4 + (b) * 2 + (h)) * HTB)
#define PG8_STAGE(bufoff, gbase, voff) do { _Pragma("unroll") for (int _i = 0; _i < 2; ++_i) \
        __builtin_amdgcn_global_load_lds((const unsigned*)((const char*)(gbase) + (voff)[_i]), (PG8_LAS unsigned*)(lds + (bufoff) + ldsw + _i * 8192), 16, 0, 0); } while (0)
#define PG8_LDA(dst, b, h) do { _Pragma("unroll") for (int m = 0; m < 4; ++m) _Pragma("unroll") for (int k = 0; k < 2; ++k) dst[m][k] = *(const PG8_LAS bf16x8*)(lds + PG8_SA(b, h) + aoff + m * 2048 + k * 1024); } while (0)
#define PG8_LDB(dst, b, h) do { _Pragma("unroll") for (int n = 0; n < 2; ++n) _Pragma("unroll") for (int k = 0; k < 2; ++k) dst[n][k] = *(const PG8_LAS bf16x8*)(lds + PG8_SB(b, h) + boff + n * 2048 + k * 1024); } while (0)
#define PG8_MMA(ai, bj, At, Bt) do { __builtin_amdgcn_s_setprio(1); _Pragma("unroll") for (int m = 0; m < 4; ++m) _Pragma("unroll") for (int n = 0; n < 2; ++n) _Pragma("unroll") for (int k = 0; k < 2; ++k) \
        acc[ai][bj][m][n] = __builtin_amdgcn_mfma_f32_16x16x32_bf16(Bt[n][k], At[m][k], acc[ai][bj][m][n], 0, 0, 0); __builtin_amdgcn_s_setprio(0); } while (0)
#define PG8_WAIT_V(n) asm volatile("s_waitcnt vmcnt(" #n ")" ::: "memory")
#define PG8_WAIT_L(n) asm volatile("s_waitcnt lgkmcnt(" #n ")" ::: "memory")
#define PG8_BAR __builtin_amdgcn_s_barrier()
#define PG8_SCHED __builtin_amdgcn_sched_barrier(0)
    Unit cur, nxt; int ui = 0;
    if (!S.next(0, cur)) return;
    f32x4 rt0 = (f32x4){0.f, 0.f, 0.f, 0.f}, rt1 = rt0;
    if constexpr (Epi::ROWTAB) { E.tab_load(cur, tid, rt0, rt1); E.tab_store((PG8_LAS float*)(lds + STAGE_BYTES), tid, rt0, rt1); }
    f32x4 acc[2][2][4][2];
#pragma unroll
    for (int a = 0; a < 2; ++a)
#pragma unroll
        for (int b = 0; b < 2; ++b)
#pragma unroll
            for (int m = 0; m < 4; ++m)
#pragma unroll
                for (int n = 0; n < 2; ++n) acc[a][b][m][n] = (f32x4){0.f, 0.f, 0.f, 0.f};
    if constexpr (Epi::ACCINIT) E.init(acc, cur, wr, wc, fr, fq);
    bf16x8 At[4][2], B0[2][2], B1[2][2];
    const char* cA = (const char*)g.A + (size_t)cur.pm * tstepA; const char* cB = (const char*)g.Bt + (size_t)cur.pn * tstepB;
    S.a_ready(cur);
    if constexpr (SP2) {
        PG8_STAGE(PG8_SB(0, 0), cB, voffB); PG8_STAGE(PG8_SB(0, 1), cB + hstepB, voffB); PG8_STAGE(PG8_SA(0, 0), cA, voffA); PG8_STAGE(PG8_SA(0, 1), cA + hstepA, voffA);
        if (wr == 1) PG8_BAR;
        PG8_WAIT_V(2); PG8_BAR;
        PG8_STAGE(PG8_SB(1, 0), cB + kstep, voffB); PG8_STAGE(PG8_SA(1, 0), cA + kstep, voffA); PG8_STAGE(PG8_SB(1, 1), cB + hstepB + kstep, voffB);
        PG8_WAIT_V(6); PG8_BAR;
    } else {
        PG8_STAGE(PG8_SB(0, 0), cB, voffB); PG8_STAGE(PG8_SA(0, 0), cA, voffA); PG8_STAGE(PG8_SB(0, 1), cB + hstepB, voffB); PG8_STAGE(PG8_SA(0, 1), cA + hstepA, voffA);
        if (wr == 1) PG8_BAR;
        PG8_WAIT_V(4); PG8_BAR;
        PG8_STAGE(PG8_SB(1, 0), cB + kstep, voffB); PG8_STAGE(PG8_SA(1, 0), cA + kstep, voffA); PG8_STAGE(PG8_SB(1, 1), cB + hstepB + kstep, voffB);
        PG8_WAIT_V(6); PG8_BAR;
    }
    for (;;) {
        const bool has_next = S.next(ui + 1, nxt);
        const char* nA = has_next ? (const char*)g.A + (size_t)nxt.pm * tstepA : cA; const char* nB = has_next ? (const char*)g.Bt + (size_t)nxt.pn * tstepB : cB;
        for (int t = 0; t < nt; t += 2) {
            const bool last = (t == nt - 2);
            const char* a1 = cA + (size_t)(t + 1) * kstep;
            const char* a2 = last ? nA : cA + (size_t)(t + 2) * kstep; const char* b2 = last ? nB : cB + (size_t)(t + 2) * kstep;
            const char* a3 = a2 + kstep; const char* b3 = b2 + kstep;
            if (last && has_next) S.a_ready(nxt);
            if constexpr (Epi::ROWTAB) { if (has_next) { if (t == nt - 4) E.tab_load(nxt, tid, rt0, rt1);
                                                         if (last) E.tab_store((PG8_LAS float*)(lds + STAGE_BYTES + ((ui + 1) & 1) * 1024), tid, rt0, rt1); } }
            if constexpr (Epi::KSEG > 0) { if (t != 0 && (t % Epi::KSEG) == 0) {
                if constexpr (ALIGN_EPI) { if (wr == 0) PG8_BAR; }
                E.seg(acc, cur, t / Epi::KSEG, wr, wc, fr, fq);
                if constexpr (ALIGN_EPI) { if (wr == 1) PG8_BAR; } } }
            if constexpr (SP2) {
            PG8_LDB(B0, 0, 0); PG8_LDB(B1, 0, 1); PG8_SCHED; PG8_LDA(At, 0, 0); PG8_STAGE(PG8_SA(1, 1), a1 + hstepA, voffA);
            PG8_WAIT_V(8); PG8_WAIT_L(0); PG8_BAR; PG8_MMA(0, 0, At, B0); PG8_MMA(0, 1, At, B1); PG8_BAR; PG8_SCHED;
            PG8_LDA(At, 0, 1); PG8_STAGE(PG8_SB(0, 0), b2, voffB); PG8_STAGE(PG8_SB(0, 1), b2 + hstepB, voffB); PG8_STAGE(PG8_SA(0, 0), a2, voffA);
            PG8_WAIT_V(8); PG8_WAIT_L(0); PG8_BAR; PG8_MMA(1, 0, At, B0); PG8_MMA(1, 1, At, B1); PG8_BAR; PG8_SCHED;
            PG8_LDB(B0, 1, 0); PG8_LDB(B1, 1, 1); PG8_SCHED; PG8_LDA(At, 1, 0); PG8_STAGE(PG8_SA(0, 1), a2 + hstepA, voffA);
            PG8_WAIT_V(8); PG8_WAIT_L(0); PG8_BAR; PG8_MMA(0, 0, At, B0); PG8_MMA(0, 1, At, B1); PG8_BAR; PG8_SCHED;
            PG8_LDA(At, 1, 1); PG8_STAGE(PG8_SB(1, 0), b3, voffB); PG8_STAGE(PG8_SB(1, 1), b3 + hstepB, voffB); PG8_STAGE(PG8_SA(1, 0), a3, voffA);
            PG8_WAIT_V(8); PG8_WAIT_L(0); PG8_BAR; PG8_MMA(1, 0, At, B0); PG8_MMA(1, 1, At, B1); PG8_BAR; PG8_SCHED;
            } else {
            PG8_LDB(B0, 0, 0); PG8_SCHED; PG8_LDA(At, 0, 0); PG8_STAGE(PG8_SA(1, 1), a1 + hstepA, voffA);
            PG8_WAIT_L(8); PG8_BAR; PG8_WAIT_L(0); PG8_MMA(0, 0, At, B0); PG8_BAR; PG8_SCHED;
            PG8_LDB(B1, 0, 1); PG8_STAGE(PG8_SB(0, 0), b2, voffB);
            PG8_BAR; PG8_WAIT_L(0); PG8_MMA(0, 1, At, B1); PG8_BAR;
            PG8_LDA(At, 0, 1); PG8_STAGE(PG8_SA(0, 0), a2, voffA);
            PG8_BAR; PG8_WAIT_L(0); PG8_MMA(1, 0, At, B0); PG8_BAR; PG8_SCHED;
            PG8_STAGE(PG8_SB(0, 1), b2 + hstepB, voffB);
            PG8_WAIT_V(6); PG8_BAR; PG8_MMA(1, 1, At, B1); PG8_BAR;
            PG8_LDB(B0, 1, 0); PG8_SCHED; PG8_LDA(At, 1, 0); PG8_STAGE(PG8_SA(0, 1), a2 + hstepA, voffA);
            PG8_WAIT_L(8); PG8_BAR; PG8_WAIT_L(0); PG8_MMA(0, 0, At, B0); PG8_BAR; PG8_SCHED;
            PG8_LDB(B1, 1, 1); PG8_STAGE(PG8_SB(1, 0), b3, voffB);
            PG8_BAR; PG8_WAIT_L(0); PG8_MMA(0, 1, At, B1); PG8_BAR;
            PG8_LDA(At, 1, 1); PG8_STAGE(PG8_SA(1, 0), a3, voffA);
            PG8_BAR; PG8_WAIT_L(0); PG8_MMA(1, 0, At, B0); PG8_BAR; PG8_SCHED;
            PG8_STAGE(PG8_SB(1, 1), b3 + hstepB, voffB);
            PG8_WAIT_V(6); PG8_BAR; PG8_MMA(1, 1, At, B1); PG8_BAR;
            }
        }
        if constexpr (ALIGN_EPI) { if (wr == 0) PG8_BAR; }
        if constexpr (!Epi::AFTER_DRAIN) { if constexpr (Epi::ROWTAB) E(acc, cur, wr, wc, fr, fq, (const PG8_LAS float*)(lds + STAGE_BYTES + (ui & 1) * 1024)); else E(acc, cur, wr, wc, fr, fq); S.done(cur); }
        if (!has_next) break;
#pragma unroll
        for (int a = 0; a < 2; ++a)
#pragma unroll
            for (int b = 0; b < 2; ++b)
#pragma unroll
                for (int m = 0; m < 4; ++m)
#pragma unroll
                    for (int n = 0; n < 2; ++n) acc[a][b][m][n] = (f32x4){0.f, 0.f, 0.f, 0.f};
        if constexpr (Epi::ACCINIT) E.init(acc, nxt, wr, wc, fr, fq);
        cur = nxt; cA = nA; cB = nB; ++ui;
        if constexpr (ALIGN_EPI) { if (wr == 1) PG8_BAR; }
    }
    PG8_WAIT_V(0);
    if constexpr (!ALIGN_EPI) { if (wr == 0) PG8_BAR; }
    PG8_BAR;
    if constexpr (Epi::AFTER_DRAIN) { E.fused(acc, cur, wr, wc, fr, fq, lds, wid, lane); S.done(cur); }
#undef PG8_SA
#undef PG8_SB
#undef PG8_STAGE
#undef PG8_LDA
#undef PG8_LDB
#undef PG8_MMA
#undef PG8_WAIT_V
#undef PG8_WAIT_L
#undef PG8_BAR
#undef PG8_SCHED
}
}


#define LDS_WAIT() asm volatile("s_waitcnt lgkmcnt(0)" ::: "memory")
constexpr int NWAVES = 8;
constexpr int LDS_BYTES = 157696;

struct WItem { const float* W; const float* scale; bf16* WT; int ldw, k0, n0, ldt, drow0, dcol0; };
constexpr int WI_IN = 16 * 240, WI_MIX = 3 * 8 * 32, WI_OUT = 16 * 32, WI_G = 16 * 88, WI_DN = 44 * 32;
constexpr int WI_TOTAL = WI_IN + WI_MIX + WI_OUT + 2 * WI_G + WI_DN;
__device__ __forceinline__ void witem_desc(KP P, int gi, WItem& d) {
    const int l = gi / WI_TOTAL; int it = gi - l * WI_TOTAL;
    unsigned char* ws = wbase(P, l);
    if (it < WI_IN) { const int kb = it / 240, nb = it % 240; d.W = P->in[I_WIN] + (size_t)l * D * INW; d.ldw = INW; d.k0 = 64 * kb; d.n0 = 32 * nb; d.scale = P->in[I_N1G] + l * D; d.WT = (bf16*)(ws + WS_WIN); d.ldt = D; d.drow0 = 32 * nb; d.dcol0 = 64 * kb; return; }
    it -= WI_IN;
    if (it < WI_MIX) { const int br = it / 256, r = it % 256, kb = r / 32, nb = r % 32; d.W = P->in[br == 0 ? I_WAO : (br == 1 ? I_WRO : I_WTO)] + (size_t)l * 512 * D;
        d.ldw = D; d.k0 = 64 * kb; d.n0 = 32 * nb; d.scale = nullptr; d.WT = (bf16*)(ws + WS_WMIX); d.ldt = NMIX; d.drow0 = 32 * nb; d.dcol0 = br * 512 + 64 * kb; return; }
    it -= WI_MIX;
    if (it < WI_OUT) { const int kb = it / 32, nb = it % 32; d.W = P->in[I_WOUT] + (size_t)l * D * D; d.ldw = D; d.k0 = 64 * kb; d.n0 = 32 * nb; d.scale = nullptr; d.WT = (bf16*)(ws + WS_WOUT); d.ldt = D; d.drow0 = 32 * nb; d.dcol0 = 64 * kb; return; }
    it -= WI_OUT;
    if (it < 2 * WI_G) { const int up = it / WI_G, r = it % WI_G, kb = r / 88, nb = r % 88, n0 = 32 * nb;
        d.W = P->in[up ? I_WU : I_WG] + (size_t)l * D * FF; d.ldw = FF; d.k0 = 64 * kb; d.n0 = n0; d.scale = P->in[I_N2G] + l * D; d.WT = (bf16*)(ws + WS_WGU); d.ldt = D; d.drow0 = (n0 / 128) * 256 + up * 128 + (n0 % 128); d.dcol0 = 64 * kb; return; }
    it -= 2 * WI_G;
    { const int kb = it / 32, nb = it % 32; d.W = P->in[I_WD] + (size_t)l * FF * D; d.ldw = D; d.k0 = 64 * kb; d.n0 = 32 * nb; d.scale = nullptr; d.WT = (bf16*)(ws + WS_WDN); d.ldt = FF; d.drow0 = 32 * nb; d.dcol0 = 64 * kb; }
}
__device__ __forceinline__ void witem_load(const WItem& d, int lane, v4f (&r)[8], v4f (&sc)[2]) {
    const float* src = d.W + (size_t)(d.k0 + (lane >> 3)) * d.ldw + d.n0 + 4 * (lane & 7);
#pragma unroll
    for (int i = 0; i < 8; ++i) r[i] = *(const v4f*)(src + (size_t)(8 * i) * d.ldw);
    sc[0] = (v4f){1.f, 1.f, 1.f, 1.f}; sc[1] = sc[0];
    if (d.scale) { const v4f* sp = (const v4f*)(d.scale + d.k0 + 8 * (lane & 7)); sc[0] = sp[0]; sc[1] = sp[1]; }
}
__device__ __forceinline__ void witem_store(const WItem& d, int lane, const v4f (&r)[8], const v4f (&sc)[2], LAS float* scr) {
    { LAS float* w = scr + (lane >> 3) * 33 + 4 * (lane & 7);
#pragma unroll
      for (int i = 0; i < 8; ++i) { w[(8 * i) * 33 + 0] = r[i].x; w[(8 * i) * 33 + 1] = r[i].y; w[(8 * i) * 33 + 2] = r[i].z; w[(8 * i) * 33 + 3] = r[i].w; } }
    LDS_WAIT(); asm volatile("" ::: "memory");
    const int c = lane & 7;
#pragma unroll
    for (int j = 0; j < 4; ++j) { const int n = (lane >> 3) + 8 * j; const LAS float* s = scr + (8 * c) * 33 + n;
        v4u o; o.x = pk2(s[0 * 33] * sc[0].x, s[1 * 33] * sc[0].y); o.y = pk2(s[2 * 33] * sc[0].z, s[3 * 33] * sc[0].w); o.z = pk2(s[4 * 33] * sc[1].x, s[5 * 33] * sc[1].y); o.w = pk2(s[6 * 33] * sc[1].z, s[7 * 33] * sc[1].w);
        *(v4u*)(d.WT + (size_t)(d.drow0 + n) * d.ldt + d.dcol0 + 8 * c) = o; }
    LDS_WAIT(); asm volatile("" ::: "memory");
}
__device__ __forceinline__ void phase_wconv_all(KP P, LAS unsigned char* lds, int vcu, int G) {
    const int otid_ = otid();
    const int wave = __builtin_amdgcn_readfirstlane(otid_ >> 6), lane = otid_ & 63;
    LAS float* scr = (LAS float*)(lds + wave * 16384);
    const int step = G * NWAVES, total = DEPTH * WI_TOTAL;
    int gi = vcu * NWAVES + wave;
    if (gi >= total) return;
    WItem cur, nxt; v4f rc[8], rn[8], sc[2], sn[2];
    witem_desc(P, gi, cur); witem_load(cur, lane, rc, sc);
#pragma unroll 1
    for (;;) {
        const int gn = gi + step; const bool has_next = gn < total;
        if (has_next) { witem_desc(P, gn, nxt); witem_load(nxt, lane, rn, sn); }
        witem_store(cur, lane, rc, sc, scr);
        if (!has_next) break;
        cur = nxt; gi = gn;
#pragma unroll
        for (int i = 0; i < 8; ++i) rc[i] = rn[i];
        sc[0] = sn[0]; sc[1] = sn[1];
    }
}
__device__ __forceinline__ void phase_x0(KP P, int vcu, int G) {
    const int otid_ = otid();
    const int wave = __builtin_amdgcn_readfirstlane(otid_ >> 6), lane = otid_ & 63;
    const float* x = P->in[I_X]; bf16* xb = (bf16*)(P->ws + WS_XB); float* rss = (float*)(P->ws + WS_RSS);
    for (int m0 = vcu * NWAVES + wave; m0 < M; m0 += 2 * G * NWAVES) {
        v4f v[2][4];
#pragma unroll
        for (int q = 0; q < 2; ++q) { const int m = m0 + q * G * NWAVES; const v4f* xr = (const v4f*)(x + (size_t)(m < M ? m : m0) * D) + lane;
#pragma unroll
            for (int j = 0; j < 4; ++j) v[q][j] = xr[64 * j]; }
#pragma unroll
        for (int q = 0; q < 2; ++q) { const int m = m0 + q * G * NWAVES; if (m < M) { unsigned long long* o8 = (unsigned long long*)(xb + (size_t)m * D) + lane; float s = 0.f;
#pragma unroll
            for (int j = 0; j < 4; ++j) s += (v[q][j].x * v[q][j].x + v[q][j].y * v[q][j].y) + (v[q][j].z * v[q][j].z + v[q][j].w * v[q][j].w);
            s = wave_sum(s);
#pragma unroll
            for (int j = 0; j < 4; ++j) { o8[64 * j] = (unsigned long long)pk2(v[q][j].x, v[q][j].y) | ((unsigned long long)pk2(v[q][j].z, v[q][j].w) << 32); }
            if (lane < 16) rss[(size_t)m * 16 + lane] = lane == 0 ? s : 0.f; } }
    }
    float* rope = (float*)(P->ws + WS_ROPE);
    for (int i = (vcu * NWAVES + wave) * 64 + lane; i < T * 32; i += G * NWAVES * 64) {
        const int t = i >> 5, j = i & 31; const float inv_freq = (float)exp(-((double)j / 32.0) * 9.210340371976184); const float ang = (float)t * inv_freq;
        const double xa = (double)ang, qd = rint(xa * 0.6366197723675814), fd = xa - qd * 1.5707963267948966; const int qi = (int)qd & 3;
        const float ff = (float)fd, f2 = ff * ff;
        const float sf = ff * (1.0f + f2 * (-1.6666667e-1f + f2 * (8.3333333e-3f + f2 * (-1.9841270e-4f + f2 * 2.7557319e-6f))));
        const float cf = 1.0f + f2 * (-0.5f + f2 * (4.1666667e-2f + f2 * (-1.3888889e-3f + f2 * (2.4801587e-5f + f2 * -2.7557319e-7f))));
        const float sn = (qi == 0) ? sf : (qi == 1) ? cf : (qi == 2) ? -sf : -cf, cs = (qi == 0) ? cf : (qi == 1) ? -sf : (qi == 2) ? -cf : sf;
        rope[2 * i] = cs; rope[2 * i + 1] = sn;
        { float* rope2 = (float*)(P->ws + WS_ROPE2); const int p = j >> 3, e = (j & 7) >> 1, o = j & 1;
          const size_t q = (((size_t)e * T + t) * 4 + p) * 4 + 2 * o; rope2[q] = cs; rope2[q + 1] = sn; }
    }
}


#define RESID_ALIGN true
#define STAGGER_US10 0
template <int PH> __device__ __forceinline__ void gemm_phase_of(KP P, int l, LAS unsigned char* lds, int G, int c, int i0 = 0, int ni = 1 << 30) {
    asm volatile("" : "+s"(l), "+s"(G), "+s"(c), "+s"(i0), "+s"(ni));
    const bool final_layer = (l == DEPTH - 1); const unsigned char* wb = wbase(P, l);
    unsigned char* ws = P->ws; const pg8::bf16_t* xb = (const pg8::bf16_t*)(ws + WS_XB); float* rss = (float*)(ws + WS_RSS);
    if constexpr (STAGGER_US10 > 0 && (PH == 0 || PH == 1 || PH == 4)) {
        if (otid() == 0) { const unsigned long long t0 = __builtin_amdgcn_s_memrealtime(), dt = (unsigned long long)(((unsigned)c >> 3) & 7u) * STAGGER_US10 * 10ull;
            while (__builtin_amdgcn_s_memrealtime() - t0 < dt) __builtin_amdgcn_s_sleep(8); }
        __syncthreads(); }
    pg8::StaticOrder S;
    if constexpr (PH == 0) { pg8::Gemm g{xb, (const pg8::bf16_t*)(wb + WS_WIN), M, NA, D, D}; S.init(M, NA, G, c); pg8::EpiRowScale E{{rss}, (pg8::bf16_t*)(ws + WS_BIG), NA};
        pg8::gemm_phase<pg8::EpiRowScale, pg8::StaticOrder, true, true>(lds, g, S, E); }
    if constexpr (PH == 1) { pg8::Gemm g{xb, (const pg8::bf16_t*)(wb + WS_WIN) + (size_t)NA * D, M, NG, D, D}; S.init(M, NG, G, c); S.i0 = i0; S.ni = ni; pg8::EpiGates E{{rss}, pg8::GateMap{(pg8::bf16_t*)(ws + WS_BIG), (pg8::bf16_t*)(ws + WS_GX)}};
        pg8::gemm_phase<pg8::EpiGates, pg8::StaticOrder, true, true>(lds, g, S, E); }
    if constexpr (PH == 2) { pg8::Gemm g{(const pg8::bf16_t*)(ws + WS_MIXO), (const pg8::bf16_t*)(wb + WS_WMIX), M, D, NMIX, NMIX}; S.init(M, D, G, c); pg8::EpiGateMix E{pg8::GateMap{(pg8::bf16_t*)(ws + WS_BIG), (pg8::bf16_t*)(ws + WS_GX)}, (pg8::bf16_t*)(ws + WS_BIG) + C_RW, NA};
        pg8::gemm_phase<pg8::EpiGateMix, pg8::StaticOrder, true, true>(lds, g, S, E); }
    if constexpr (PH == 3) { pg8::Gemm g{(const pg8::bf16_t*)(ws + WS_BIG) + C_RW, (const pg8::bf16_t*)(wb + WS_WOUT), M, D, D, NA}; S.init(M, D, G, c); pg8::EpiResid E{(pg8::bf16_t*)(ws + WS_XB), rss, nullptr};
        pg8::gemm_phase<pg8::EpiResid, pg8::StaticOrder, RESID_ALIGN, true>(lds, g, S, E); }
    if constexpr (PH == 4) { pg8::Gemm g{xb, (const pg8::bf16_t*)(wb + WS_WGU), M, FF2, D, D}; S.init(M, FF2, G, c); pg8::EpiSwiglu E{{rss}, (pg8::bf16_t*)(ws + WS_BIG), NA};
        pg8::gemm_phase<pg8::EpiSwiglu, pg8::StaticOrder, true, true>(lds, g, S, E); }
    if constexpr (PH == 5) { pg8::Gemm g{(const pg8::bf16_t*)(ws + WS_BIG), (const pg8::bf16_t*)(wb + WS_WDN), M, D, FF, NA}; S.init(M, D, G, c); pg8::EpiResid E{(pg8::bf16_t*)(ws + WS_XB), rss, final_layer ? P->out : nullptr};
        pg8::gemm_phase<pg8::EpiResid, pg8::StaticOrder, RESID_ALIGN, true>(lds, g, S, E); }
}

typedef float f32x16 __attribute__((ext_vector_type(16)));
typedef short bf16x8v __attribute__((ext_vector_type(8)));
constexpr int AT_KS = 144;
constexpr int AT_VS = 520;
constexpr int AT_KOFF = 0, AT_VOFF = 256 * AT_KS, AT_GOFF = AT_VOFF + 64 * AT_VS;
typedef float v2f_ __attribute__((ext_vector_type(2)));
typedef __bf16 v2bf_ __attribute__((ext_vector_type(2)));
__device__ __forceinline__ unsigned cvtpk(float lo, float hi) { const v2f_ x = {lo, hi}; return __builtin_bit_cast(unsigned, __builtin_convertvector(x, v2bf_)); }
#define LDS_BAR() do { asm volatile("s_waitcnt lgkmcnt(0)" ::: "memory"); __builtin_amdgcn_s_barrier(); asm volatile("" ::: "memory"); } while (0)
__device__ __forceinline__ void attn_phase(KP P, int l, LAS unsigned char* lds, int u0, int ustep, int uend) {
    const int tid = otid(), w = __builtin_amdgcn_readfirstlane(tid >> 6), lane = tid & 63, r32 = lane & 31, h = lane >> 5;
    const bf16* proj = (const bf16*)(P->ws + WS_BIG); bf16* mixo = (bf16*)(P->ws + WS_MIXO);
    const float* gq = P->in[I_QNG] + l * 64; const float* gk = P->in[I_KNG] + l * 64; const float* sinks = P->in[I_SINK] + l * 8;
    LAS float* gqs = (LAS float*)(lds + AT_GOFF);
    constexpr float LOG2E = 1.4426950408889634f;
    __syncthreads();
    if (tid < 64) { gqs[tid] = gq[tid] * (0.125f * LOG2E); gqs[64 + tid] = gk[tid]; }
    v4u kv[4], vv[4];
#define AT_LOAD(U) do { const int b_ = (U) >> 5, n_ = ((U) >> 1) & 15, kvh_ = (U) & 1, r_ = tid >> 1, hf_ = tid & 1; const size_t grow_ = (size_t)(b_ * T + n_ * 128 - 128 + r_) * NA; \
        _Pragma("unroll") for (int i = 0; i < 4; ++i) { kv[i] = (v4u){0u, 0u, 0u, 0u}; vv[i] = (v4u){0u, 0u, 0u, 0u}; } \
        if ((n_ > 0) || (r_ >= 128)) { _Pragma("unroll") for (int i = 0; i < 4; ++i) { kv[i] = *(const v4u*)(proj + grow_ + C_AK + kvh_ * 64 + hf_ * 32 + 8 * i); vv[i] = *(const v4u*)(proj + grow_ + C_AV + kvh_ * 64 + hf_ * 32 + 8 * i); } } } while (0)
    if (u0 < uend) AT_LOAD(u0);
    for (int unit = u0; unit < uend; unit += ustep) {
        const int b = unit >> 5, n = (unit >> 1) & 15, kvh = unit & 1;
        LDS_BAR();
        {
            const int r = tid >> 1, hf = tid & 1;
            float ss = 0.f;
#pragma unroll
            for (int i = 0; i < 4; ++i)
#pragma unroll
                for (int e = 0; e < 4; ++e) { const float k0 = bflo(kv[i][e]), k1 = bfhi(kv[i][e]); ss += k0 * k0 + k1 * k1; }
            ss += __shfl_xor(ss, 1);
            const float rs = rsqrtf(ss * (1.f / 64.f) + 1e-6f);
#pragma unroll
            for (int i = 0; i < 4; ++i) { v4u o;
#pragma unroll
                for (int e = 0; e < 4; ++e) { const int d = hf * 32 + 8 * i + 2 * e; o[e] = cvtpk(bflo(kv[i][e]) * rs * gqs[64 + d], bfhi(kv[i][e]) * rs * gqs[64 + d + 1]); }
                *(LAS v4u*)(lds + AT_KOFF + r * AT_KS + hf * 64 + 16 * i) = o; }
#pragma unroll
            for (int i = 0; i < 4; ++i)
#pragma unroll
                for (int e = 0; e < 4; ++e) { const int d = hf * 32 + 8 * i + 2 * e;
                    *(LAS unsigned short*)(lds + AT_VOFF + d * AT_VS + r * 2) = (unsigned short)(vv[i][e] & 0xffffu);
                    *(LAS unsigned short*)(lds + AT_VOFF + (d + 1) * AT_VS + r * 2) = (unsigned short)(vv[i][e] >> 16); }
        }
        LDS_BAR();
        if (unit + ustep < uend) AT_LOAD(unit + ustep);
#pragma unroll 1
        for (int gi = 0; gi < 2; ++gi) {
            const int g = w >> 1, sb = (w & 1) * 2 + gi, hq = kvh * 4 + g;
            const size_t qrow = (size_t)(b * T + n * 128 + 32 * sb + r32);
            v4u qr[4]; float ss = 0.f;
#pragma unroll
            for (int s = 0; s < 4; ++s) { qr[s] = *(const v4u*)(proj + qrow * NA + C_AQ + hq * 64 + 8 * h + 16 * s);
#pragma unroll
                for (int e = 0; e < 4; ++e) { const float q0 = bflo(qr[s][e]), q1 = bfhi(qr[s][e]); ss += q0 * q0 + q1 * q1; } }
            ss += __shfl_xor(ss, 32);
            const float rs = rsqrtf(ss * (1.f / 64.f) + 1e-6f);
            bf16x8v Qf[4];
#pragma unroll
            for (int s = 0; s < 4; ++s) { const v4f g0 = *(const LAS v4f*)(gqs + 8 * h + 16 * s), g1 = *(const LAS v4f*)(gqs + 8 * h + 16 * s + 4); v4u o;
                o[0] = cvtpk(bflo(qr[s][0]) * rs * g0[0], bfhi(qr[s][0]) * rs * g0[1]); o[1] = cvtpk(bflo(qr[s][1]) * rs * g0[2], bfhi(qr[s][1]) * rs * g0[3]);
                o[2] = cvtpk(bflo(qr[s][2]) * rs * g1[0], bfhi(qr[s][2]) * rs * g1[1]); o[3] = cvtpk(bflo(qr[s][3]) * rs * g1[2], bfhi(qr[s][3]) * rs * g1[3]);
                Qf[s] = __builtin_bit_cast(bf16x8v, o); }
            f32x16 S[5];
#pragma unroll
            for (int c5 = 0; c5 < 5; ++c5) { f32x16 acc;
#pragma unroll
                for (int i = 0; i < 16; ++i) acc[i] = 0.f;
#pragma unroll
                for (int s = 0; s < 4; ++s) { const bf16x8v kf = *(const LAS bf16x8v*)(lds + AT_KOFF + (32 * (sb + c5) + r32) * AT_KS + (8 * h + 16 * s) * 2);
                    acc = __builtin_amdgcn_mfma_f32_32x32x16_bf16(kf, Qf[s], acc, 0, 0, 0); }
                S[c5] = acc; }
            const int qi = 32 * sb + r32; float mx = -INFINITY;
#pragma unroll
            for (int c5 = 0; c5 < 5; ++c5)
#pragma unroll
                for (int i = 0; i < 16; ++i) { const int si = 32 * (sb + c5) + 8 * (i >> 2) + 4 * h + (i & 3);
                    bool ok = true; if (c5 == 0) ok = si > qi; if (c5 == 4) ok = si <= qi + 128; if (n == 0) ok = ok && (si >= 128);
                    const float v = ok ? S[c5][i] : -INFINITY; S[c5][i] = v; mx = fmaxf(mx, v); }
            mx = fmaxf(mx, __shfl_xor(mx, 32));
            const float sink = sinks[hq] * LOG2E; mx = fmaxf(mx, sink);
            float sum = 0.f;
#pragma unroll
            for (int c5 = 0; c5 < 5; ++c5)
#pragma unroll
                for (int i = 0; i < 16; ++i) { const float p = __builtin_amdgcn_exp2f(S[c5][i] - mx); S[c5][i] = p; sum += p; }
            sum += __shfl_xor(sum, 32);
            const float inv = 1.0f / (sum + __builtin_amdgcn_exp2f(sink - mx));
            f32x16 O[2];
#pragma unroll
            for (int dt = 0; dt < 2; ++dt)
#pragma unroll
                for (int i = 0; i < 16; ++i) O[dt][i] = 0.f;
#pragma unroll
            for (int c5 = 0; c5 < 5; ++c5)
#pragma unroll
                for (int s = 0; s < 2; ++s) { v4u pw; pw[0] = cvtpk(S[c5][8 * s], S[c5][8 * s + 1]); pw[1] = cvtpk(S[c5][8 * s + 2], S[c5][8 * s + 3]); pw[2] = cvtpk(S[c5][8 * s + 4], S[c5][8 * s + 5]); pw[3] = cvtpk(S[c5][8 * s + 6], S[c5][8 * s + 7]);
                    const bf16x8v pf = __builtin_bit_cast(bf16x8v, pw);
#pragma unroll
                    for (int dt = 0; dt < 2; ++dt) { const LAS unsigned char* vp = lds + AT_VOFF + (32 * dt + r32) * AT_VS + (32 * (sb + c5) + 16 * s + 4 * h) * 2;
                        const v2u lo = *(const LAS v2u*)vp, hi = *(const LAS v2u*)(vp + 16); v4u vw; vw[0] = lo[0]; vw[1] = lo[1]; vw[2] = hi[0]; vw[3] = hi[1];
                        O[dt] = __builtin_amdgcn_mfma_f32_32x32x16_bf16(__builtin_bit_cast(bf16x8v, vw), pf, O[dt], 0, 0, 0); } }
#pragma unroll
            for (int dt = 0; dt < 2; ++dt)
#pragma unroll
                for (int q4 = 0; q4 < 4; ++q4) { v2u o; o[0] = cvtpk(O[dt][4 * q4] * inv, O[dt][4 * q4 + 1] * inv); o[1] = cvtpk(O[dt][4 * q4 + 2] * inv, O[dt][4 * q4 + 3] * inv);
                    *(v2u*)(mixo + qrow * NMIX + hq * 64 + 32 * dt + 8 * q4 + 4 * h) = o; }
        }
    }
    __syncthreads();
#undef AT_LOAD
}

constexpr int RT_KS = 144, RT_TS = 272;
constexpr int RT_KOFF = 0, RT_KTOFF = 128 * RT_KS, RT_VTOFF = RT_KTOFF + 64 * RT_TS, RT_ROFF = RT_VTOFF + 64 * RT_TS, RT_SOFF = RT_ROFF + 64 * RT_KS, RT_QOFF = RT_SOFF + 1024, RT_GOFF = RT_QOFF + 128 * RT_KS, RT_END = RT_GOFF + 128 * RT_KS;
static_assert(RT_END <= 131072, "retention LDS");
__device__ __forceinline__ void ret_unit(KP P, LAS unsigned char* lds, int b, int hh) {
    const int tid = otid(), w = __builtin_amdgcn_readfirstlane(tid >> 6), lane = tid & 63, r32 = lane & 31, h = lane >> 5;
    const bf16* proj = (const bf16*)(P->ws + WS_BIG); bf16* mixo = (bf16*)(P->ws + WS_MIXO); const float* rope2 = (const float*)(P->ws + WS_ROPE2);
    const float lg = log2f(1.0f - exp2f(-5.0f - (float)hh));
    const float g128 = exp2f(128.0f * lg);
    const int qg = w >> 1, dt = w & 1;
    f32x16 Racc;
#pragma unroll
    for (int i = 0; i < 16; ++i) Racc[i] = 0.f;
    __syncthreads();
    for (int i = tid; i < 64 * RT_KS / 4; i += 512) ((LAS unsigned*)(lds + RT_ROFF))[i] = 0u;
    v4u pk1, pk2, pv1, pv2, pq1, pq2, pg1, pg2; v4f prk[4];
#define RT_PREFETCH(N) do { const int row_ = tid >> 2, p_ = tid & 3; const size_t g_ = ((size_t)(b * T + (N) * 128) + row_) * NA + hh * 64 + 8 * p_; \
        pk1 = *(const v4u*)(proj + g_ + C_RK); pk2 = *(const v4u*)(proj + g_ + C_RK + 32); pv1 = *(const v4u*)(proj + g_ + C_RV); pv2 = *(const v4u*)(proj + g_ + C_RV + 32); \
        pq1 = *(const v4u*)(proj + g_ + C_RQ); pq2 = *(const v4u*)(proj + g_ + C_RQ + 32); pg1 = *(const v4u*)(proj + g_ + C_RG); pg2 = *(const v4u*)(proj + g_ + C_RG + 32); \
        _Pragma("unroll") for (int e_ = 0; e_ < 4; ++e_) prk[e_] = *(const v4f*)(rope2 + (((size_t)e_ * T + (N) * 128 + row_) * 4 + p_) * 4); } while (0)
    RT_PREFETCH(0);
#pragma unroll 1
    for (int n = 0; n < 16; ++n) {
        const size_t tok0 = (size_t)(b * T + n * 128);
        LDS_BAR();
        {
            const int row = tid >> 2, p = tid & 3;
            const v4u k1 = pk1, k2 = pk2, v1 = pv1, v2 = pv2, q1 = pq1, q2 = pq2;
            const float sc = 0.125f * exp2f(-(float)(row + 1) * lg);
            v4u w1, w2, x1, x2;
#pragma unroll
            for (int e = 0; e < 4; ++e) { const v4f cs = prk[e];
                { const float a1 = bflo(k1[e]), a2 = bflo(k2[e]), b1 = bfhi(k1[e]), b2 = bfhi(k2[e]);
                  w1[e] = cvtpk((a1 * cs[0] - a2 * cs[1]) * sc, (b1 * cs[2] - b2 * cs[3]) * sc); w2[e] = cvtpk((a2 * cs[0] + a1 * cs[1]) * sc, (b2 * cs[2] + b1 * cs[3]) * sc); }
                { const float a1 = bflo(q1[e]), a2 = bflo(q2[e]), b1 = bfhi(q1[e]), b2 = bfhi(q2[e]);
                  x1[e] = cvtpk(a1 * cs[0] - a2 * cs[1], b1 * cs[2] - b2 * cs[3]); x2[e] = cvtpk(a2 * cs[0] + a1 * cs[1], b2 * cs[2] + b1 * cs[3]); } }
            *(LAS v4u*)(lds + RT_KOFF + row * RT_KS + 16 * p) = w1; *(LAS v4u*)(lds + RT_KOFF + row * RT_KS + 64 + 16 * p) = w2;
            *(LAS v4u*)(lds + RT_QOFF + row * RT_KS + 16 * p) = x1; *(LAS v4u*)(lds + RT_QOFF + row * RT_KS + 64 + 16 * p) = x2;
            *(LAS v4u*)(lds + RT_GOFF + row * RT_KS + 16 * p) = pg1; *(LAS v4u*)(lds + RT_GOFF + row * RT_KS + 64 + 16 * p) = pg2;
#pragma unroll
            for (int e = 0; e < 4; ++e) { const int d = 8 * p + 2 * e;
                *(LAS unsigned short*)(lds + RT_KTOFF + d * RT_TS + row * 2) = (unsigned short)(w1[e] & 0xffffu); *(LAS unsigned short*)(lds + RT_KTOFF + (d + 1) * RT_TS + row * 2) = (unsigned short)(w1[e] >> 16);
                *(LAS unsigned short*)(lds + RT_KTOFF + (d + 32) * RT_TS + row * 2) = (unsigned short)(w2[e] & 0xffffu); *(LAS unsigned short*)(lds + RT_KTOFF + (d + 33) * RT_TS + row * 2) = (unsigned short)(w2[e] >> 16);
                *(LAS unsigned short*)(lds + RT_VTOFF + d * RT_TS + row * 2) = (unsigned short)(v1[e] & 0xffffu); *(LAS unsigned short*)(lds + RT_VTOFF + (d + 1) * RT_TS + row * 2) = (unsigned short)(v1[e] >> 16);
                *(LAS unsigned short*)(lds + RT_VTOFF + (d + 32) * RT_TS + row * 2) = (unsigned short)(v2[e] & 0xffffu); *(LAS unsigned short*)(lds + RT_VTOFF + (d + 33) * RT_TS + row * 2) = (unsigned short)(v2[e] >> 16); }
        }
        LDS_BAR();
        if (n + 1 < 16) RT_PREFETCH(n + 1);
        bf16x8v Qf[4];
        const size_t qtok = tok0 + 32 * qg + r32;
#pragma unroll
        for (int s = 0; s < 4; ++s) Qf[s] = *(const LAS bf16x8v*)(lds + RT_QOFF + (32 * qg + r32) * RT_KS + (8 * h + 16 * s) * 2);
        f32x16 O;
#pragma unroll
        for (int i = 0; i < 16; ++i) O[i] = 0.f;
#pragma unroll
        for (int s = 0; s < 4; ++s) { const bf16x8v rf = *(const LAS bf16x8v*)(lds + RT_ROFF + (32 * dt + r32) * RT_KS + (8 * h + 16 * s) * 2);
            O = __builtin_amdgcn_mfma_f32_32x32x16_bf16(rf, Qf[s], O, 0, 0, 0); }
#pragma unroll
        for (int c = 0; c < 4; ++c) { if (c <= qg) {
            f32x16 S;
#pragma unroll
            for (int i = 0; i < 16; ++i) S[i] = 0.f;
#pragma unroll
            for (int s = 0; s < 4; ++s) { const bf16x8v kf = *(const LAS bf16x8v*)(lds + RT_KOFF + (32 * c + r32) * RT_KS + (8 * h + 16 * s) * 2);
                S = __builtin_amdgcn_mfma_f32_32x32x16_bf16(kf, Qf[s], S, 0, 0, 0); }
            if (c == qg) {
#pragma unroll
                for (int i = 0; i < 16; ++i) { const int j = 8 * (i >> 2) + 4 * h + (i & 3); S[i] = (j <= r32) ? S[i] : 0.f; } }
#pragma unroll
            for (int s = 0; s < 2; ++s) { v4u pw; pw[0] = cvtpk(S[8 * s], S[8 * s + 1]); pw[1] = cvtpk(S[8 * s + 2], S[8 * s + 3]); pw[2] = cvtpk(S[8 * s + 4], S[8 * s + 5]); pw[3] = cvtpk(S[8 * s + 6], S[8 * s + 7]);
                const LAS unsigned char* vp = lds + RT_VTOFF + (32 * dt + r32) * RT_TS + (32 * c + 16 * s + 4 * h) * 2;
                const v2u lo = *(const LAS v2u*)vp, hi = *(const LAS v2u*)(vp + 16); v4u vw; vw[0] = lo[0]; vw[1] = lo[1]; vw[2] = hi[0]; vw[3] = hi[1];
                O = __builtin_amdgcn_mfma_f32_32x32x16_bf16(__builtin_bit_cast(bf16x8v, vw), __builtin_bit_cast(bf16x8v, pw), O, 0, 0, 0); } } }
        if (w < 4) { const int et = w >> 1, dtile = w & 1;
#pragma unroll
            for (int s = 0; s < 8; ++s) { const bf16x8v vf = *(const LAS bf16x8v*)(lds + RT_VTOFF + (32 * et + r32) * RT_TS + (16 * s + 8 * h) * 2);
                const bf16x8v kf = *(const LAS bf16x8v*)(lds + RT_KTOFF + (32 * dtile + r32) * RT_TS + (16 * s + 8 * h) * 2);
                Racc = __builtin_amdgcn_mfma_f32_32x32x16_bf16(vf, kf, Racc, 0, 0, 0); }
#pragma unroll
            for (int i = 0; i < 16; ++i) Racc[i] *= g128; }
        const float xi = exp2f((float)(32 * qg + r32 + 1) * lg); float ss = 0.f;
#pragma unroll
        for (int i = 0; i < 16; ++i) { O[i] *= xi; ss += O[i] * O[i]; }
        ss += __shfl_xor(ss, 32);
        LAS float* ssb = (LAS float*)(lds + RT_SOFF);
        if (h == 0) ssb[(qg * 2 + dt) * 32 + r32] = ss;
        LDS_BAR();
        const float rstd = rsqrtf((ss + ssb[(qg * 2 + (dt ^ 1)) * 32 + r32]) * (1.f / 64.f) + 1e-6f);
        if (w < 4) { const int et = w >> 1, dtile = w & 1;
#pragma unroll
            for (int i = 0; i < 16; ++i) { const int e = 32 * et + 8 * (i >> 2) + 4 * h + (i & 3); *(LAS unsigned short*)(lds + RT_ROFF + e * RT_KS + (32 * dtile + r32) * 2) = (unsigned short)f2bf(Racc[i]); } }
#pragma unroll
        for (int q4 = 0; q4 < 4; ++q4) { const int e0 = 32 * dt + 8 * q4 + 4 * h; const v2u gw = *(const LAS v2u*)(lds + RT_GOFF + (32 * qg + r32) * RT_KS + e0 * 2);
            const float g0 = bflo(gw[0]), g1 = bfhi(gw[0]), g2 = bflo(gw[1]), g3 = bfhi(gw[1]);
            v2u o; o[0] = cvtpk(O[4 * q4] * rstd * g0 / (1.0f + __expf(-g0)), O[4 * q4 + 1] * rstd * g1 / (1.0f + __expf(-g1)));
            o[1] = cvtpk(O[4 * q4 + 2] * rstd * g2 / (1.0f + __expf(-g2)), O[4 * q4 + 3] * rstd * g3 / (1.0f + __expf(-g3)));
            *(v2u*)(mixo + qtok * NMIX + 1024 + hh * 64 + e0) = o; }
    }
    __syncthreads();
#undef RT_PREFETCH
}
__device__ __forceinline__ void ret_phase(KP P, LAS unsigned char* lds, int vcu, int G) {
    for (int unit = vcu; unit < BATCH * 8; unit += G) ret_unit(P, lds, unit >> 3, unit & 7);
}

template <int CTRL> __device__ __forceinline__ float dppf(float x) { return __builtin_bit_cast(float, __builtin_amdgcn_mov_dpp(__builtin_bit_cast(int, x), CTRL, 0xf, 0xf, true)); }
constexpr int DPP_X1 = 0xB1, DPP_X2 = 0x4E, DPP_X7 = 0x141, DPP_X8 = 0x128;
__device__ __forceinline__ float sum8(float x) { x += dppf<DPP_X1>(x); x += dppf<DPP_X2>(x); x += dppf<DPP_X7>(x); return x; }
__device__ __forceinline__ float sum16(float x) { x = sum8(x); x += dppf<DPP_X8>(x); return x; }
#define PROBE_SCAN2 0
constexpr int RS_TT = 32;
constexpr int RS_W2T = 0, RS_A2T = 9216, RS_G2T = 18432, RS_XW = 35840, RS_XA = RS_XW + RS_TT * 144, RS_XG = RS_XA + RS_TT * 144, RS_F0 = RS_XG + RS_TT * 272;
constexpr int RS_FA = RS_TT * 64 * 4;
constexpr int RS_ZR = RS_F0, RS_ZK = RS_F0 + RS_FA, RS_ZV = RS_F0 + 2 * RS_FA, RS_WL = RS_F0 + 3 * RS_FA, RS_AL = RS_F0 + 4 * RS_FA, RS_GL = RS_F0 + 5 * RS_FA, RS_AV = RS_F0 + 6 * RS_FA, RS_YS = RS_F0 + 7 * RS_FA, RS_BS = RS_F0 + 8 * RS_FA;
constexpr int RS_MU = RS_BS + RS_TT * 4, RS_CST = RS_MU + 448 * 4;
static_assert(RS_CST + 7 * 256 <= 131072, "rwkv LDS");
constexpr int RS_NP = (RS_TT * 56 + 511) / 512;
typedef float v2f __attribute__((ext_vector_type(2)));
__device__ __forceinline__ void rwkv_unit(KP P, int l, LAS unsigned char* lds, int b, int hh) {
    const int tid = otid(), w = __builtin_amdgcn_readfirstlane(tid >> 6), lane = tid & 63, r32 = lane & 31, h2 = lane >> 5;
    const bf16* proj = (const bf16*)(P->ws + WS_BIG); bf16* mixo = (bf16*)(P->ws + WS_MIXO);
    const float* mu = P->in[I_MU] + l * RWC; const float* w0 = P->in[I_W0] + l * 512 + hh * 64; const float* a0 = P->in[I_A0] + l * 512 + hh * 64;
    const float* kkw = P->in[I_KK] + l * 512 + hh * 64; const float* kaw = P->in[I_KA] + l * 512 + hh * 64; const float* rkw = P->in[I_RK] + l * 512 + hh * 64;
    const float* lng = P->in[I_LNG] + l * 512 + hh * 64; const float* lnb = P->in[I_LNB] + l * 512 + hh * 64;
    __syncthreads();
    for (int i = tid; i < 64 * 64; i += 512) { const int c = i >> 6, j = i & 63;
        *(LAS unsigned short*)(lds + RS_W2T + j * 144 + c * 2) = (unsigned short)f2bf(P->in[I_W2][(size_t)l * 64 * 512 + c * 512 + hh * 64 + j]);
        *(LAS unsigned short*)(lds + RS_A2T + j * 144 + c * 2) = (unsigned short)f2bf(P->in[I_A2][(size_t)l * 64 * 512 + c * 512 + hh * 64 + j]); }
    for (int i = tid; i < 128 * 64; i += 512) { const int c = i >> 6, j = i & 63;
        *(LAS unsigned short*)(lds + RS_G2T + j * 272 + c * 2) = (unsigned short)f2bf(P->in[I_G2][(size_t)l * 128 * 512 + c * 512 + hh * 64 + j]); }
    for (int i = tid; i < 448; i += 512) { const int p = i >> 3, e = i & 7; int col; if (p < 24) col = (p >> 3) * 512 + hh * 64 + (p & 7) * 8; else col = 1536 + (p - 24) * 8; ((LAS float*)(lds + RS_MU))[i] = mu[col + e]; }
    if (tid < 448) { const int a = tid >> 6, j = tid & 63; const float* src = a == 0 ? w0 : a == 1 ? a0 : a == 2 ? kkw : a == 3 ? kaw : a == 4 ? rkw : a == 5 ? lng : lnb; ((LAS float*)(lds + RS_CST))[tid] = src[j]; }
    v2f S2[4];
#pragma unroll
    for (int i = 0; i < 4; ++i) S2[i] = (v2f){0.f, 0.f};
    v4u pc[RS_NP], pp[RS_NP];
#define RS_LOADPIECES(T0) do { _Pragma("unroll") for (int it = 0; it < RS_NP; ++it) { const int idx = tid + it * 512; pc[it] = (v4u){0u, 0u, 0u, 0u}; pp[it] = (v4u){0u, 0u, 0u, 0u}; \
        if (idx < RS_TT * 56) { const int p = idx / RS_TT, tt = idx % RS_TT, t = (T0) + tt; int col; if (p < 24) col = (p >> 3) * 512 + hh * 64 + (p & 7) * 8; else col = 1536 + (p - 24) * 8; \
            const size_t g = (size_t)(b * T + t) * NA + C_RW + col; pc[it] = *(const v4u*)(proj + g); if (t > 0) pp[it] = *(const v4u*)(proj + g - NA); } } } while (0)
    RS_LOADPIECES(0);
#pragma unroll 1
    for (int t0 = 0; t0 < T; t0 += RS_TT) {
        __syncthreads();
#pragma unroll
        for (int it = 0; it < RS_NP; ++it) { const int idx = tid + it * 512; if (idx < RS_TT * 56) { const int p = idx / RS_TT, tt = idx % RS_TT;
            const v4u hc = pc[it], hp = pp[it];
            const v4f m0 = *(const LAS v4f*)(lds + RS_MU + p * 32), m1 = *(const LAS v4f*)(lds + RS_MU + p * 32 + 16);
            float z[8];
#pragma unroll
            for (int e = 0; e < 4; ++e) { const float c0 = bflo(hc[e]), c1 = bfhi(hc[e]), p0 = bflo(hp[e]), p1 = bfhi(hp[e]); const float ma = e < 2 ? m0[2 * e] : m1[2 * e - 4], mb = e < 2 ? m0[2 * e + 1] : m1[2 * e - 3];
                z[2 * e] = c0 + ma * (p0 - c0); z[2 * e + 1] = c1 + mb * (p1 - c1); }
            if (p < 24) { LAS float* dst = (LAS float*)(lds + (p < 8 ? RS_ZR : (p < 16 ? RS_ZK : RS_ZV)) + (tt * 64 + (p & 7) * 8) * 4);
                *(LAS v4f*)dst = (v4f){z[0], z[1], z[2], z[3]}; *(LAS v4f*)(dst + 4) = (v4f){z[4], z[5], z[6], z[7]}; }
            else { v4u o;
                if (p < 32) {
#pragma unroll
                    for (int e = 0; e < 4; ++e) o[e] = cvtpk(1.0f - 2.0f * __builtin_amdgcn_rcpf(1.0f + __expf(2.0f * z[2 * e])), 1.0f - 2.0f * __builtin_amdgcn_rcpf(1.0f + __expf(2.0f * z[2 * e + 1])));
                    *(LAS v4u*)(lds + RS_XW + tt * 144 + (p - 24) * 16) = o; }
                else if (p < 40) {
#pragma unroll
                    for (int e = 0; e < 4; ++e) o[e] = cvtpk(z[2 * e], z[2 * e + 1]);
                    *(LAS v4u*)(lds + RS_XA + tt * 144 + (p - 32) * 16) = o; }
                else {
#pragma unroll
                    for (int e = 0; e < 4; ++e) o[e] = cvtpk(__builtin_amdgcn_rcpf(1.0f + __expf(-z[2 * e])), __builtin_amdgcn_rcpf(1.0f + __expf(-z[2 * e + 1])));
                    *(LAS v4u*)(lds + RS_XG + tt * 272 + (p - 40) * 16) = o; } }
        } }
        __syncthreads();
        if (w < 6) { const int which = w >> 1, jt = w & 1; f32x16 acc;
#pragma unroll
            for (int i = 0; i < 16; ++i) acc[i] = 0.f;
            if (which < 2) { const int wo = which == 0 ? RS_W2T : RS_A2T, xo = which == 0 ? RS_XW : RS_XA;
#pragma unroll
                for (int s = 0; s < 4; ++s) { const bf16x8v af = *(const LAS bf16x8v*)(lds + wo + (32 * jt + r32) * 144 + (16 * s + 8 * h2) * 2), bfr = *(const LAS bf16x8v*)(lds + xo + r32 * 144 + (16 * s + 8 * h2) * 2);
                    acc = __builtin_amdgcn_mfma_f32_32x32x16_bf16(af, bfr, acc, 0, 0, 0); } }
            else {
#pragma unroll
                for (int s = 0; s < 8; ++s) { const bf16x8v af = *(const LAS bf16x8v*)(lds + RS_G2T + (32 * jt + r32) * 272 + (16 * s + 8 * h2) * 2), bfr = *(const LAS bf16x8v*)(lds + RS_XG + r32 * 272 + (16 * s + 8 * h2) * 2);
                    acc = __builtin_amdgcn_mfma_f32_32x32x16_bf16(af, bfr, acc, 0, 0, 0); } }
            const int oo = which == 0 ? RS_WL : (which == 1 ? RS_AL : RS_GL);
#pragma unroll
            for (int q4 = 0; q4 < 4; ++q4) *(LAS v4f*)(lds + oo + (r32 * 64 + 32 * jt + 8 * q4 + 4 * h2) * 4) = (v4f){acc[4 * q4], acc[4 * q4 + 1], acc[4 * q4 + 2], acc[4 * q4 + 3]}; }
        __syncthreads();
        { const int tt = tid >> 4, j0 = (tid & 15) * 4; const int o4 = (tt * 64 + j0) * 4;
          const v4f wl = *(const LAS v4f*)(lds + RS_WL + o4), al = *(const LAS v4f*)(lds + RS_AL + o4), zk = *(const LAS v4f*)(lds + RS_ZK + o4), zr = *(const LAS v4f*)(lds + RS_ZR + o4);
          const v4f w0v = *(const LAS v4f*)(lds + RS_CST + j0 * 4), a0v = *(const LAS v4f*)(lds + RS_CST + 256 + j0 * 4), kkv = *(const LAS v4f*)(lds + RS_CST + 512 + j0 * 4), kav = *(const LAS v4f*)(lds + RS_CST + 768 + j0 * 4), rkv = *(const LAS v4f*)(lds + RS_CST + 1024 + j0 * 4);
          v4f dcy, alp, kk0, km; float ssq = 0.f, bsum = 0.f;
#pragma unroll
          for (int e = 0; e < 4; ++e) { const float x = -(wl[e] + w0v[e]); const float sp = fmaxf(x, 0.f) + __logf(1.0f + __expf(-fabsf(x)));
              dcy[e] = __expf(-__expf(-sp - 0.5f)); alp[e] = __builtin_amdgcn_rcpf(1.0f + __expf(-(al[e] + a0v[e])));
              kk0[e] = zk[e] * kkv[e]; ssq += kk0[e] * kk0[e]; km[e] = zk[e] * (1.0f + (alp[e] - 1.0f) * kav[e]); bsum += zr[e] * km[e] * rkv[e]; }
          ssq = sum16(ssq); bsum = sum16(bsum);
          const float inv = __builtin_amdgcn_rcpf(fmaxf(__builtin_amdgcn_sqrtf(ssq), 1e-12f));
          v4f avv, bvv;
#pragma unroll
          for (int e = 0; e < 4; ++e) { const float kk = kk0[e] * inv; avv[e] = -kk; bvv[e] = kk * alp[e]; }
          *(LAS v4f*)(lds + RS_WL + o4) = dcy; *(LAS v4f*)(lds + RS_AL + o4) = bvv; *(LAS v4f*)(lds + RS_AV + o4) = avv; *(LAS v4f*)(lds + RS_ZK + o4) = km;
          if ((tid & 15) == 0) *(LAS float*)(lds + RS_BS + tt * 4) = bsum; }
        __syncthreads();
        if (t0 + RS_TT < T) RS_LOADPIECES(t0 + RS_TT);
#if PROBE_SCAN2
        v2f Ssave[4];
#pragma unroll
        for (int i = 0; i < 4; ++i) Ssave[i] = S2[i];
        for (int rep_ = 0; rep_ < 2; ++rep_) { if (rep_ == 1) {
#pragma unroll
            for (int i = 0; i < 4; ++i) S2[i] = Ssave[i]; }
#endif
        { const int v_ = tid >> 3, ks = tid & 7; LAS unsigned char* sb = lds + ks * 32; LAS unsigned char* vb = lds + RS_ZV + v_ * 4; LAS unsigned char* yb = lds + RS_YS + v_ * 4;
#pragma unroll
          for (int tt = 0; tt < RS_TT; ++tt) { const int o8 = tt * 256;
              const v4f a0_ = *(const LAS v4f*)(sb + RS_AV + o8), a1_ = *(const LAS v4f*)(sb + RS_AV + o8 + 16);
              const v4f d0_ = *(const LAS v4f*)(sb + RS_WL + o8), d1_ = *(const LAS v4f*)(sb + RS_WL + o8 + 16);
              const v4f b0_ = *(const LAS v4f*)(sb + RS_AL + o8), b1_ = *(const LAS v4f*)(sb + RS_AL + o8 + 16);
              const v4f k0_ = *(const LAS v4f*)(sb + RS_ZK + o8), k1_ = *(const LAS v4f*)(sb + RS_ZK + o8 + 16);
              const v4f r0_ = *(const LAS v4f*)(sb + RS_ZR + o8), r1_ = *(const LAS v4f*)(sb + RS_ZR + o8 + 16);
              const float vv = *(const LAS float*)(vb + o8);
              v2f ac = S2[0] * a0_.xy; ac = __builtin_elementwise_fma(S2[1], a0_.zw, ac); ac = __builtin_elementwise_fma(S2[2], a1_.xy, ac); ac = __builtin_elementwise_fma(S2[3], a1_.zw, ac);
              const float sa = sum8(ac.x + ac.y); const v2f sa2 = (v2f){sa, sa}, vv2 = (v2f){vv, vv};
              S2[0] = __builtin_elementwise_fma(S2[0], d0_.xy, __builtin_elementwise_fma(k0_.xy, vv2, b0_.xy * sa2));
              S2[1] = __builtin_elementwise_fma(S2[1], d0_.zw, __builtin_elementwise_fma(k0_.zw, vv2, b0_.zw * sa2));
              S2[2] = __builtin_elementwise_fma(S2[2], d1_.xy, __builtin_elementwise_fma(k1_.xy, vv2, b1_.xy * sa2));
              S2[3] = __builtin_elementwise_fma(S2[3], d1_.zw, __builtin_elementwise_fma(k1_.zw, vv2, b1_.zw * sa2));
              v2f yc = S2[0] * r0_.xy; yc = __builtin_elementwise_fma(S2[1], r0_.zw, yc); yc = __builtin_elementwise_fma(S2[2], r1_.xy, yc); yc = __builtin_elementwise_fma(S2[3], r1_.zw, yc);
              const float y = sum8(yc.x + yc.y);
              if (ks == 0) *(LAS float*)(yb + o8) = y; } }
#if PROBE_SCAN2
        }
#endif
        __syncthreads();
        { const int tt = tid >> 4, v0 = (tid & 15) * 4; const int o4 = (tt * 64 + v0) * 4;
          const v4f y4 = *(const LAS v4f*)(lds + RS_YS + o4), zv = *(const LAS v4f*)(lds + RS_ZV + o4), gl = *(const LAS v4f*)(lds + RS_GL + o4);
          const float mean = sum16((y4[0] + y4[1]) + (y4[2] + y4[3])) * (1.f / 64.f);
          const v4f d = y4 - mean; const float var = sum16((d[0] * d[0] + d[1] * d[1]) + (d[2] * d[2] + d[3] * d[3])) * (1.f / 64.f);
          const float rstd = rsqrtf(var + 64e-5f), bs = *(const LAS float*)(lds + RS_BS + tt * 4);
          const v4f lg4 = *(const LAS v4f*)(lds + RS_CST + 1280 + v0 * 4), lb4 = *(const LAS v4f*)(lds + RS_CST + 1536 + v0 * 4);
          float o[4];
#pragma unroll
          for (int e = 0; e < 4; ++e) o[e] = (d[e] * rstd * lg4[e] + lb4[e] + bs * zv[e]) * gl[e];
          v2u ow; ow[0] = cvtpk(o[0], o[1]); ow[1] = cvtpk(o[2], o[3]);
          *(v2u*)(mixo + (size_t)(b * T + t0 + tt) * NMIX + 512 + hh * 64 + v0) = ow; }
    }
    __syncthreads();
#undef RS_LOADPIECES
}
__device__ __forceinline__ void rwkv_phase(KP P, int l, LAS unsigned char* lds, int vcu, int G) {
    for (int unit = vcu; unit < BATCH * 8; unit += G) rwkv_unit(P, l, lds, unit >> 3, unit & 7);
}

#define RC_BAR() do { asm volatile("s_waitcnt lgkmcnt(0)" ::: "memory"); __builtin_amdgcn_s_barrier(); asm volatile("" ::: "memory"); } while (0)
constexpr int RC_SL = 9216;
constexpr int RC_A = 0 * RC_SL, RC_B = 1 * RC_SL, RC_K = 2 * RC_SL, RC_R = 3 * RC_SL, RC_V = 4 * RC_SL, RC_G = 5 * RC_SL, RC_S = 6 * RC_SL;
constexpr int RC_XW = 7 * RC_SL, RC_XA = 8 * RC_SL, RC_XG = 9 * RC_SL, RC_WL = 11 * RC_SL, RC_AL = 13 * RC_SL, RC_LW = 14 * RC_SL;
constexpr int RC_DINV = RC_B, RC_DINVT = RC_K, RC_NT = 9 * RC_SL, RC_P = RC_B, RC_UT = RC_V, RC_BHT = RC_XW, RC_KHT = RC_XA, RC_VT = 9 * RC_SL, RC_LAB = 10 * RC_SL, RC_N = RC_LAB, RC_TINV = RC_LAB;
constexpr int RC_LABT = 11 * RC_SL, RC_N2 = RC_LABT, RC_RHST = RC_LABT, RC_LAK = 12 * RC_SL, RC_MRB = 13 * RC_SL, RC_MRK = RC_LW;
constexpr int RC_SM = RC_LW + 16384, RC_BS = RC_SM, RC_GC = RC_SM + 256, RC_PT = RC_SM + 512, RC_SSB = RC_PT + 2048, RC_DIAG = RC_SSB + 1024, RC_MU = RC_DIAG + 4096, RC_CST = RC_MU + 1792, RC_END = RC_CST + 1792;
static_assert(RC_END <= 156928, "chunked rwkv LDS");
template <int KSTEPS, int SA = 144, int SB = 144> __device__ __forceinline__ f32x16 rc_mm(f32x16 acc, const LAS unsigned char* A, int arow0, const LAS unsigned char* B, int brow0, int r32, int h, int kofs = 0) {
#pragma unroll
    for (int s = 0; s < KSTEPS; ++s) { const bf16x8v af = *(const LAS bf16x8v*)(A + (arow0 + r32) * SA + (kofs + 16 * s + 8 * h) * 2), bfr = *(const LAS bf16x8v*)(B + (brow0 + r32) * SB + (kofs + 16 * s + 8 * h) * 2);
        acc = __builtin_amdgcn_mfma_f32_32x32x16_bf16(af, bfr, acc, 0, 0, 0); }
    return acc;
}
__device__ __forceinline__ f32x16 rc_zero() { f32x16 z;
#pragma unroll
    for (int i = 0; i < 16; ++i) z[i] = 0.f;
    return z; }
template <int KSTEPS> __device__ __forceinline__ f32x16 rc_mm2(f32x16 acc, const LAS unsigned char* A, int arow0, const LAS unsigned char* B, int brow0, int r32, int h) {
    f32x16 a1 = rc_zero();
#pragma unroll
    for (int s = 0; s < KSTEPS; ++s) { const bf16x8v af = *(const LAS bf16x8v*)(A + (arow0 + r32) * 144 + (16 * s + 8 * h) * 2), bfr = *(const LAS bf16x8v*)(B + (brow0 + r32) * 144 + (16 * s + 8 * h) * 2);
        if (s & 1) a1 = __builtin_amdgcn_mfma_f32_32x32x16_bf16(af, bfr, a1, 0, 0, 0); else acc = __builtin_amdgcn_mfma_f32_32x32x16_bf16(af, bfr, acc, 0, 0, 0); }
#pragma unroll
    for (int i = 0; i < 16; ++i) acc[i] += a1[i];
    return acc;
}
__device__ __forceinline__ bf16x8v rc_frag_bd(const LAS unsigned char* cb, int row, int s, int h) {
    v4u z = (v4u){0u, 0u, 0u, 0u}; if ((row >> 4) == s) z = *(const LAS v4u*)(cb + (row >> 4) * 1024 + ((row & 15) * 16 + 8 * h) * 2); return __builtin_bit_cast(bf16x8v, z); }
template <bool BD_A> __device__ __forceinline__ f32x16 rc_mm_bd(f32x16 acc, const LAS unsigned char* A, int arow0, const LAS unsigned char* B, int brow0, int r32, int h) {
    f32x16 a1 = rc_zero();
#pragma unroll
    for (int s = 0; s < 4; ++s) { const bf16x8v af = BD_A ? rc_frag_bd(A, arow0 + r32, s, h) : *(const LAS bf16x8v*)(A + (arow0 + r32) * 144 + (16 * s + 8 * h) * 2);
        const bf16x8v bfr = BD_A ? *(const LAS bf16x8v*)(B + (brow0 + r32) * 144 + (16 * s + 8 * h) * 2) : rc_frag_bd(B, brow0 + r32, s, h);
        if (s & 1) a1 = __builtin_amdgcn_mfma_f32_32x32x16_bf16(af, bfr, a1, 0, 0, 0); else acc = __builtin_amdgcn_mfma_f32_32x32x16_bf16(af, bfr, acc, 0, 0, 0); }
#pragma unroll
    for (int i = 0; i < 16; ++i) acc[i] += a1[i];
    return acc;
}
__device__ __forceinline__ void rc_store_t(const f32x16& d, LAS unsigned char* O, int arow0, int brow0, int r32, int h) {
#pragma unroll
    for (int q4 = 0; q4 < 4; ++q4) { v2u o; o[0] = cvtpk(d[4 * q4], d[4 * q4 + 1]); o[1] = cvtpk(d[4 * q4 + 2], d[4 * q4 + 3]); *(LAS v2u*)(O + (brow0 + r32) * 144 + (arow0 + 8 * q4 + 4 * h) * 2) = o; }
}
__device__ __forceinline__ void rwkv_prepass(KP P, int l, int b, int j, int rows) {
    const int tid = otid(), p = tid & 31;
    const bf16* proj = (const bf16*)(P->ws + WS_BIG); bf16* zs = (bf16*)((unsigned char*)P->out + OUT_ZS);
    const v4f* mup = (const v4f*)(P->in[I_MU] + l * RWC + 1536 + 8 * p); const v4f m0 = mup[0], m1 = mup[1];
    const float be = p < 8 ? -2.f : -1.f, al = p < 8 ? 2.f : 1.f, ga = p < 8 ? -1.f : 0.f; const bool plain = (p >= 8 && p < 16);
#pragma unroll 4
    for (int r = tid >> 5; r < rows; r += 16) { const int t = j * rows + r; const size_t g = (size_t)(b * T + t) * NA + C_RW + 1536 + 8 * p;
        const v4u hc = *(const v4u*)(proj + g); v4u hp = (v4u){0u, 0u, 0u, 0u}; if (t > 0) hp = *(const v4u*)(proj + g - NA);
        v4u o;
#pragma unroll
        for (int e = 0; e < 4; ++e) { const float c0 = bflo(hc[e]), c1 = bfhi(hc[e]), p0 = bflo(hp[e]), p1 = bfhi(hp[e]); const float ma = e < 2 ? m0[2 * e] : m1[2 * e - 4], mb = e < 2 ? m0[2 * e + 1] : m1[2 * e - 3];
            const float z0 = c0 + ma * (p0 - c0), z1 = c1 + mb * (p1 - c1);
            const float s0 = al * __builtin_amdgcn_rcpf(1.0f + __expf(be * z0)) + ga, s1 = al * __builtin_amdgcn_rcpf(1.0f + __expf(be * z1)) + ga;
            o[e] = cvtpk(plain ? z0 : s0, plain ? z1 : s1); }
        *(v4u*)(zs + (size_t)(b * T + t) * 256 + 8 * p) = o; }
}
__device__ __forceinline__ void rwkvc_unit(KP P, int l, LAS unsigned char* lds, int b, int hh) {
    const int tid = otid(), w = __builtin_amdgcn_readfirstlane(tid >> 6), lane = tid & 63, r32 = lane & 31, h = lane >> 5;
    const bf16* proj = (const bf16*)(P->ws + WS_BIG); bf16* mixo = (bf16*)(P->ws + WS_MIXO);
    const float* mu = P->in[I_MU] + l * RWC; const float* w0 = P->in[I_W0] + l * 512 + hh * 64; const float* a0 = P->in[I_A0] + l * 512 + hh * 64;
    const float* kkw = P->in[I_KK] + l * 512 + hh * 64; const float* kaw = P->in[I_KA] + l * 512 + hh * 64; const float* rkw = P->in[I_RK] + l * 512 + hh * 64;
    const float* lng = P->in[I_LNG] + l * 512 + hh * 64; const float* lnb = P->in[I_LNB] + l * 512 + hh * 64;
    __syncthreads();
    for (int i = tid; i < 448; i += 512) { const int p = i >> 3, e = i & 7; int col; if (p < 24) col = (p >> 3) * 512 + hh * 64 + (p & 7) * 8; else col = 1536 + (p - 24) * 8; ((LAS float*)(lds + RC_MU))[i] = mu[col + e]; }
    if (tid < 448) { const int a = tid >> 6, j = tid & 63; const float* src = a == 0 ? w0 : a == 1 ? a0 : a == 2 ? kkw : a == 3 ? kaw : a == 4 ? rkw : a == 5 ? lng : lnb; ((LAS float*)(lds + RC_CST))[tid] = src[j]; }
    bf16x8v wf[8];
    { const int jt = w & 1, j = hh * 64 + 32 * jt + r32;
#pragma unroll
      for (int s = 0; s < 8; ++s) { unsigned short e[8];
#pragma unroll
          for (int i = 0; i < 8; ++i) { float x; if (w < 4) { const int c = 16 * (s & 3) + 8 * h + i; x = (s < 4 ? P->in[I_W2] : P->in[I_A2])[(size_t)l * 64 * 512 + c * 512 + j]; } else { const int c = 16 * s + 8 * h + i; x = P->in[I_G2][(size_t)l * 128 * 512 + c * 512 + j]; }
              e[i] = (unsigned short)f2bf(x); }
          v4u pk; pk[0] = e[0] | ((unsigned)e[1] << 16); pk[1] = e[2] | ((unsigned)e[3] << 16); pk[2] = e[4] | ((unsigned)e[5] << 16); pk[3] = e[6] | ((unsigned)e[7] << 16);
          wf[s] = __builtin_bit_cast(bf16x8v, pk); } }
    f32x16 Sacc = rc_zero();
    v4u pc[3], pp[3], zc[4];
    const bf16* zs = (const bf16*)((const unsigned char*)P->out + OUT_ZS);
#define RC_LOADPIECES(T0) do { _Pragma("unroll") for (int it = 0; it < 3; ++it) { const int q_ = it * 8 + (tid >> 6), tt = 8 * (q_ / 3) + ((tid & 63) >> 3), t = (T0) + tt; \
            const size_t g = (size_t)(b * T + t) * NA + C_RW + (q_ % 3) * 512 + hh * 64 + (tid & 7) * 8; pc[it] = *(const v4u*)(proj + g); pp[it] = (v4u){0u, 0u, 0u, 0u}; if (t > 0) pp[it] = *(const v4u*)(proj + g - NA); } \
        _Pragma("unroll") for (int it = 0; it < 4; ++it) { const int q2 = it * 8 + (tid >> 6), tt = 8 * (q2 >> 2) + ((tid & 63) >> 3); zc[it] = *(const v4u*)(zs + (size_t)(b * T + (T0) + tt) * 256 + (8 * (q2 & 3) + (tid & 7)) * 8); } } while (0)
    RC_LOADPIECES(0);
#pragma unroll 1
    for (int t0 = 0; t0 < T; t0 += 64) {
        f32x16 xacc, yacc;
        RC_BAR();
        { const int tid = otid(), w = __builtin_amdgcn_readfirstlane(tid >> 6), lane = tid & 63, r32 = lane & 31, h = lane >> 5; (void)w; (void)lane; (void)r32; (void)h;
        if (w < 4) rc_store_t(Sacc, lds + RC_S, 32 * (w >> 1), 32 * (w & 1), r32, h);
#pragma unroll
        for (int it = 0; it < 3; ++it) { const int q_ = it * 8 + (tid >> 6), g = q_ % 3, p = 8 * g + (tid & 7), tt = 8 * (q_ / 3) + ((tid & 63) >> 3);
            const v4u hc = pc[it], hp = pp[it];
            const v4f m0 = *(const LAS v4f*)(lds + RC_MU + p * 32), m1 = *(const LAS v4f*)(lds + RC_MU + p * 32 + 16);
            v4u o;
#pragma unroll
            for (int e = 0; e < 4; ++e) { const float c0 = bflo(hc[e]), c1 = bfhi(hc[e]), p0 = bflo(hp[e]), p1 = bfhi(hp[e]); const float ma = e < 2 ? m0[2 * e] : m1[2 * e - 4], mb = e < 2 ? m0[2 * e + 1] : m1[2 * e - 3];
                o[e] = cvtpk(c0 + ma * (p0 - c0), c1 + mb * (p1 - c1)); }
            *(LAS v4u*)(lds + (g == 0 ? RC_R : (g == 1 ? RC_K : RC_V)) + tt * 144 + (tid & 7) * 16) = o; }
#pragma unroll
        for (int it = 0; it < 4; ++it) { const int q2 = it * 8 + (tid >> 6), qu = q2 & 3, tt = 8 * (q2 >> 2) + ((tid & 63) >> 3), pl = tid & 7;
            const int dst = qu == 0 ? RC_XW + tt * 144 + pl * 16 : (qu == 1 ? RC_XA + tt * 144 + pl * 16 : RC_XG + tt * 272 + ((qu - 2) * 8 + pl) * 16);
            *(LAS v4u*)(lds + dst) = zc[it]; }
        }
        RC_BAR();
        { const int tid = otid(), w = __builtin_amdgcn_readfirstlane(tid >> 6), lane = tid & 63, r32 = lane & 31, h = lane >> 5; (void)w; (void)lane; (void)r32; (void)h;
        { const int tt = (w >> 1) & 1, jt = w & 1;
          if (w < 4) { f32x16 aw = rc_zero(), aa = rc_zero();
#pragma unroll
              for (int s = 0; s < 4; ++s) { const bf16x8v xw = *(const LAS bf16x8v*)(lds + RC_XW + (32 * tt + r32) * 144 + (16 * s + 8 * h) * 2), xa = *(const LAS bf16x8v*)(lds + RC_XA + (32 * tt + r32) * 144 + (16 * s + 8 * h) * 2);
                  aw = __builtin_amdgcn_mfma_f32_32x32x16_bf16(wf[s], xw, aw, 0, 0, 0); aa = __builtin_amdgcn_mfma_f32_32x32x16_bf16(wf[4 + s], xa, aa, 0, 0, 0); }
#pragma unroll
              for (int q4 = 0; q4 < 4; ++q4) *(LAS v4f*)(lds + RC_WL + ((32 * tt + r32) * 64 + 32 * jt + 8 * q4 + 4 * h) * 4) = (v4f){aw[4 * q4], aw[4 * q4 + 1], aw[4 * q4 + 2], aw[4 * q4 + 3]};
              rc_store_t(aa, lds + RC_AL, 32 * jt, 32 * tt, r32, h); }
          else { f32x16 ag = rc_zero();
#pragma unroll
              for (int s = 0; s < 8; ++s) { const bf16x8v xg = *(const LAS bf16x8v*)(lds + RC_XG + (32 * tt + r32) * 272 + (16 * s + 8 * h) * 2); ag = __builtin_amdgcn_mfma_f32_32x32x16_bf16(wf[s], xg, ag, 0, 0, 0); }
              rc_store_t(ag, lds + RC_G, 32 * jt, 32 * tt, r32, h); } }
        }
        RC_BAR();
        { const int tid = otid(), w = __builtin_amdgcn_readfirstlane(tid >> 6), lane = tid & 63, r32 = lane & 31, h = lane >> 5; (void)w; (void)lane; (void)r32; (void)h;
        { const int t = tid >> 3, j0 = (tid & 7) * 8; const int ob = t * 144 + j0 * 2;
          const v4f wl0 = *(const LAS v4f*)(lds + RC_WL + (t * 64 + j0) * 4), wl1 = *(const LAS v4f*)(lds + RC_WL + (t * 64 + j0 + 4) * 4);
          const v4u alw = *(const LAS v4u*)(lds + RC_AL + ob), kw = *(const LAS v4u*)(lds + RC_K + ob), rw = *(const LAS v4u*)(lds + RC_R + ob);
          float lw[8], alp[8], kk0[8], km[8]; float ssq = 0.f, bsum = 0.f;
          v4f cst[5][2];
#pragma unroll
          for (int a = 0; a < 5; ++a) { cst[a][0] = *(const LAS v4f*)(lds + RC_CST + a * 256 + j0 * 4); cst[a][1] = *(const LAS v4f*)(lds + RC_CST + a * 256 + j0 * 4 + 16); }
#pragma unroll
          for (int e = 0; e < 8; ++e) { const float wl = e < 4 ? wl0[e & 3] : wl1[e & 3]; const float cw0 = cst[0][e >> 2][e & 3], ca0 = cst[1][e >> 2][e & 3];
              const float ckk = cst[2][e >> 2][e & 3], cka = cst[3][e >> 2][e & 3], crk = cst[4][e >> 2][e & 3];
              const float al = (e & 1) ? bfhi(alw[e >> 1]) : bflo(alw[e >> 1]), kr = (e & 1) ? bfhi(kw[e >> 1]) : bflo(kw[e >> 1]), rr = (e & 1) ? bfhi(rw[e >> 1]) : bflo(rw[e >> 1]);
              lw[e] = -0.60653066f * __builtin_amdgcn_rcpf(1.0f + __expf(-(wl + cw0)));
              alp[e] = __builtin_amdgcn_rcpf(1.0f + __expf(-(al + ca0)));
              kk0[e] = kr * ckk; ssq += kk0[e] * kk0[e]; km[e] = kr * (1.0f + (alp[e] - 1.0f) * cka); bsum += rr * km[e] * crk; }
          ssq = sum8(ssq); bsum = sum8(bsum);
          const float inv = __builtin_amdgcn_rcpf(fmaxf(__builtin_amdgcn_sqrtf(ssq), 1e-12f));
          v4u ao, bo, ko;
#pragma unroll
          for (int e = 0; e < 4; ++e) { const float ka = kk0[2 * e] * inv, kb = kk0[2 * e + 1] * inv; ao[e] = cvtpk(-ka, -kb); bo[e] = cvtpk(ka * alp[2 * e], kb * alp[2 * e + 1]); ko[e] = cvtpk(km[2 * e], km[2 * e + 1]); }
          *(LAS v4u*)(lds + RC_A + ob) = ao; *(LAS v4u*)(lds + RC_B + ob) = bo; *(LAS v4u*)(lds + RC_K + ob) = ko;
          *(LAS v4f*)(lds + RC_LW + (t * 64 + j0) * 4) = (v4f){lw[0], lw[1], lw[2], lw[3]}; *(LAS v4f*)(lds + RC_LW + (t * 64 + j0 + 4) * 4) = (v4f){lw[4], lw[5], lw[6], lw[7]};
          if ((tid & 7) == 0) *(LAS float*)(lds + RC_BS + t * 4) = bsum; }
        }
        RC_BAR();
        { const int tid = otid(), w = __builtin_amdgcn_readfirstlane(tid >> 6), lane = tid & 63, r32 = lane & 31, h = lane >> 5; (void)w; (void)lane; (void)r32; (void)h;
        { const int k = tid & 63, tq = tid >> 6; float c[8]; float run = 0.f;
#pragma unroll
          for (int i = 0; i < 8; ++i) { run += *(const LAS float*)(lds + RC_LW + ((8 * tq + i) * 64 + k) * 4); c[i] = run; }
          *(LAS float*)(lds + RC_PT + (tq * 64 + k) * 4) = run;
          RC_BAR();
          float base = 0.f;
#pragma unroll
          for (int q = 0; q < 7; ++q) { const float pv = *(const LAS float*)(lds + RC_PT + (q * 64 + k) * 4); base += (q < tq) ? pv : 0.f; }
#pragma unroll
          for (int i = 0; i < 8; ++i) *(LAS float*)(lds + RC_LW + ((8 * tq + i) * 64 + k) * 4) = c[i] + base;
          if (tq == 7) *(LAS float*)(lds + RC_GC + k * 4) = __expf(c[7] + base); }
        }
        RC_BAR();
        { const int tid = otid(), w = __builtin_amdgcn_readfirstlane(tid >> 6), lane = tid & 63, r32 = lane & 31, h = lane >> 5; (void)w; (void)lane; (void)r32; (void)h;
        { const int t = tid >> 3, j0 = (tid & 7) * 8; const int ob = t * 144 + j0 * 2;
          const v4f c0 = *(const LAS v4f*)(lds + RC_LW + (t * 64 + j0) * 4), c1 = *(const LAS v4f*)(lds + RC_LW + (t * 64 + j0 + 4) * 4);
          v4f p0 = (v4f){0.f, 0.f, 0.f, 0.f}, p1 = p0; if (t > 0) { p0 = *(const LAS v4f*)(lds + RC_LW + ((t - 1) * 64 + j0) * 4); p1 = *(const LAS v4f*)(lds + RC_LW + ((t - 1) * 64 + j0 + 4) * 4); }
          const v4u aw = *(const LAS v4u*)(lds + RC_A + ob), bw = *(const LAS v4u*)(lds + RC_B + ob), kw = *(const LAS v4u*)(lds + RC_K + ob), rw = *(const LAS v4u*)(lds + RC_R + ob);
          v4u ao, bo, ko, ro;
#pragma unroll
          for (int e = 0; e < 4; ++e) { const float cA = e < 2 ? c0[2 * e] : c1[2 * e - 4], cB = e < 2 ? c0[2 * e + 1] : c1[2 * e - 3], pA = e < 2 ? p0[2 * e] : p1[2 * e - 4], pB = e < 2 ? p0[2 * e + 1] : p1[2 * e - 3];
              const float e1a = __expf(cA), e1b = __expf(cB), e0a = __expf(pA), e0b = __expf(pB), eia = __builtin_amdgcn_rcpf(e1a), eib = __builtin_amdgcn_rcpf(e1b);
              ao[e] = cvtpk(bflo(aw[e]) * e0a, bfhi(aw[e]) * e0b); ro[e] = cvtpk(bflo(rw[e]) * e1a, bfhi(rw[e]) * e1b);
              bo[e] = cvtpk(bflo(bw[e]) * eia, bfhi(bw[e]) * eib); ko[e] = cvtpk(bflo(kw[e]) * eia, bfhi(kw[e]) * eib); }
          *(LAS v4u*)(lds + RC_A + ob) = ao; *(LAS v4u*)(lds + RC_B + ob) = bo; *(LAS v4u*)(lds + RC_K + ob) = ko; *(LAS v4u*)(lds + RC_R + ob) = ro; }
        }
        RC_BAR();
        { const int tid = otid(), w = __builtin_amdgcn_readfirstlane(tid >> 6), lane = tid & 63, r32 = lane & 31, h = lane >> 5; (void)w; (void)lane; (void)r32; (void)h;
        if (w == 0 || w == 3) { const int tq = w == 0 ? 0 : 1; f32x16 d = rc_zero(); d = rc_mm2<4>(d, lds + RC_B, 32 * tq, lds + RC_A, 32 * tq, r32, h);
            const int n = 32 * tq + r32;
#pragma unroll
            for (int i = 0; i < 16; ++i) { const int m = 32 * tq + 8 * (i >> 2) + 4 * h + (i & 3); if ((m >> 4) == (n >> 4)) *(LAS float*)(lds + RC_DIAG + ((n >> 4) * 256 + (m & 15) * 16 + (n & 15)) * 4) = (m < n) ? d[i] : 0.f; }
            asm volatile("s_waitcnt lgkmcnt(0)" ::: "memory");
            if (lane < 32) { const int blk = 2 * tq + (lane >> 4), c = lane & 15; float x[16];
#pragma unroll
                for (int t = 0; t < 16; ++t) x[t] = (t == c) ? 1.f : 0.f;
#pragma unroll
                for (int j = 0; j < 15; ++j) {
#pragma unroll
                    for (int q = (j + 1) >> 2; q < 4; ++q) { const v4f l4 = *(const LAS v4f*)(lds + RC_DIAG + (blk * 256 + j * 16 + 4 * q) * 4);
#pragma unroll
                        for (int e = 0; e < 4; ++e) { const int t = 4 * q + e; if (t > j) x[t] += l4[e] * x[j]; } } }
                asm volatile("s_waitcnt lgkmcnt(0)" ::: "memory");
                LAS unsigned char* cb = lds + RC_DIAG + blk * 1024;
#pragma unroll
                for (int t = 0; t < 16; ++t) *(LAS unsigned short*)(cb + (t * 16 + c) * 2) = (unsigned short)f2bf(x[t]);
                v4u o0, o1;
#pragma unroll
                for (int e = 0; e < 4; ++e) { o0[e] = cvtpk(x[2 * e], x[2 * e + 1]); o1[e] = cvtpk(x[8 + 2 * e], x[9 + 2 * e]); }
                *(LAS v4u*)(cb + 512 + c * 32) = o0; *(LAS v4u*)(cb + 512 + c * 32 + 16) = o1; } }
        else { const int slot = w < 3 ? w - 1 : w - 2;
#pragma unroll 1
            for (int q = slot; q < 16; q += 6) { const int blk = 1 + (q >> 2), ta = (q >> 1) & 1, tb = q & 1;
                const int ao = blk == 1 ? RC_A : blk == 2 ? RC_K : blk == 3 ? RC_B : RC_K, bo = blk == 1 ? RC_B : blk == 2 ? RC_A : RC_R;
                const int oo = blk == 1 ? RC_LABT : blk == 2 ? RC_LAK : blk == 3 ? RC_MRB : RC_MRK;
                f32x16 d = rc_zero();
                const bool dead = (blk == 1) ? (tb > ta) : (ta > tb);
                if (!dead) d = rc_mm2<4>(d, lds + ao, 32 * ta, lds + bo, 32 * tb, r32, h);
                if (ta == tb) { const int n = 32 * tb + r32;
#pragma unroll
                    for (int i = 0; i < 16; ++i) { const int m = 32 * ta + 8 * (i >> 2) + 4 * h + (i & 3); bool keep;
                        if (blk == 1) keep = (n < m) && ((n >> 4) != (m >> 4)); else if (blk < 3) keep = m < n; else keep = m <= n;
                        d[i] = keep ? d[i] : 0.f; } }
                rc_store_t(d, lds + oo, 32 * ta, 32 * tb, r32, h); } }
        }
        RC_BAR();
        { const int tid = otid(), w = __builtin_amdgcn_readfirstlane(tid >> 6), lane = tid & 63, r32 = lane & 31, h = lane >> 5; (void)w; (void)lane; (void)r32; (void)h;
        { const int ta = (w >> 1) & 1, tb = w & 1; f32x16 d = rc_zero();
          if (w < 4) { d = rc_mm_bd<false>(d, lds + RC_LABT, 32 * ta, lds + RC_DIAG, 32 * tb, r32, h); }
          else       { d = rc_mm_bd<true>(d, lds + RC_DIAG, 32 * ta, lds + RC_LABT, 32 * tb, r32, h); }
          rc_store_t(d, lds + (w < 4 ? RC_N : RC_NT), 32 * ta, 32 * tb, r32, h); }
        }
        RC_BAR();
        { const int tid = otid(), w = __builtin_amdgcn_readfirstlane(tid >> 6), lane = tid & 63, r32 = lane & 31, h = lane >> 5; (void)w; (void)lane; (void)r32; (void)h;
        xacc = rc_zero();
        if (w < 4) { const int ta = (w >> 1) & 1, tb = w & 1;
            xacc = rc_mm2<4>(xacc, lds + RC_NT, 32 * ta, lds + RC_N, 32 * tb, r32, h);
#pragma unroll
            for (int i = 0; i < 16; ++i) { const int m = 32 * ta + 8 * (i >> 2) + 4 * h + (i & 3), n = 32 * tb + r32; if (m == n) xacc[i] += 1.0f; } }
        if (w >= 4) { const int t4 = tid - 256, k = t4 >> 2, tg = t4 & 3; const float gc = *(const LAS float*)(lds + RC_GC + k * 4);
#pragma unroll
            for (int i = 0; i < 16; ++i) { const int t = tg + 4 * i;
                const float bt = bf2f(*(const LAS unsigned short*)(lds + RC_B + t * 144 + k * 2)), kt = bf2f(*(const LAS unsigned short*)(lds + RC_K + t * 144 + k * 2));
                *(LAS unsigned short*)(lds + RC_BHT + k * 144 + t * 2) = (unsigned short)f2bf(bt * gc); *(LAS unsigned short*)(lds + RC_KHT + k * 144 + t * 2) = (unsigned short)f2bf(kt * gc); } }
        if (w < 4) { const int ta = (w >> 1) & 1, tb = w & 1;
#pragma unroll
            for (int i = 0; i < 16; ++i) { const int m = 32 * ta + 8 * (i >> 2) + 4 * h + (i & 3), n = 32 * tb + r32; *(LAS unsigned short*)(lds + RC_N2 + m * 144 + n * 2) = (unsigned short)f2bf(xacc[i]); } }
        }
        RC_BAR();
        { const int tid = otid(), w = __builtin_amdgcn_readfirstlane(tid >> 6), lane = tid & 63, r32 = lane & 31, h = lane >> 5; (void)w; (void)lane; (void)r32; (void)h;
        if (w < 4) { const int ta = (w >> 1) & 1, tb = w & 1;
            xacc = rc_mm2<4>(xacc, lds + RC_N2, 32 * ta, lds + RC_N, 32 * tb, r32, h);
            rc_store_t(xacc, lds + RC_P, 32 * ta, 32 * tb, r32, h); }
        else { const int t4 = tid - 256, k = t4 >> 2, tg = t4 & 3;
#pragma unroll
            for (int i = 0; i < 16; ++i) { const int t = tg + 4 * i; *(LAS unsigned short*)(lds + RC_VT + k * 144 + t * 2) = *(const LAS unsigned short*)(lds + RC_V + t * 144 + k * 2); } }
        }
        RC_BAR();
        { const int tid = otid(), w = __builtin_amdgcn_readfirstlane(tid >> 6), lane = tid & 63, r32 = lane & 31, h = lane >> 5; (void)w; (void)lane; (void)r32; (void)h;
        { const int ta = (w >> 1) & 1, tb = w & 1; f32x16 d = rc_zero();
          if (w < 4) { d = rc_mm_bd<true>(d, lds + RC_DIAG + 512, 32 * ta, lds + RC_P, 32 * tb, r32, h); rc_store_t(d, lds + RC_TINV, 32 * ta, 32 * tb, r32, h); }
          else { d = rc_mm2<4>(d, lds + RC_A, 32 * ta, lds + RC_S, 32 * tb, r32, h); d = rc_mm2<4>(d, lds + RC_LAK, 32 * ta, lds + RC_VT, 32 * tb, r32, h); rc_store_t(d, lds + RC_RHST, 32 * ta, 32 * tb, r32, h); } }
        if (t0 + 64 < T) RC_LOADPIECES(t0 + 64);
        }
        RC_BAR();
        { const int tid = otid(), w = __builtin_amdgcn_readfirstlane(tid >> 6), lane = tid & 63, r32 = lane & 31, h = lane >> 5; (void)w; (void)lane; (void)r32; (void)h;
        if (w < 4) { const int ta = (w >> 1) & 1, tb = w & 1; f32x16 d = rc_zero(); d = rc_mm2<4>(d, lds + RC_TINV, 32 * ta, lds + RC_RHST, 32 * tb, r32, h); rc_store_t(d, lds + RC_UT, 32 * ta, 32 * tb, r32, h); }
        }
        RC_BAR();
        { const int tid = otid(), w = __builtin_amdgcn_readfirstlane(tid >> 6), lane = tid & 63, r32 = lane & 31, h = lane >> 5; (void)w; (void)lane; (void)r32; (void)h;
        yacc = rc_zero();
        { const int ta = (w >> 1) & 1, tb = w & 1;
          if (w < 4) {
#pragma unroll
              for (int i = 0; i < 16; ++i) Sacc[i] *= *(const LAS float*)(lds + RC_GC + (32 * ta + 8 * (i >> 2) + 4 * h + (i & 3)) * 4);
              Sacc = rc_mm2<4>(Sacc, lds + RC_BHT, 32 * ta, lds + RC_UT, 32 * tb, r32, h); Sacc = rc_mm2<4>(Sacc, lds + RC_KHT, 32 * ta, lds + RC_VT, 32 * tb, r32, h); }
          else { yacc = rc_mm2<4>(yacc, lds + RC_S, 32 * ta, lds + RC_R, 32 * tb, r32, h); yacc = rc_mm2<4>(yacc, lds + RC_UT, 32 * ta, lds + RC_MRB, 32 * tb, r32, h); yacc = rc_mm2<4>(yacc, lds + RC_VT, 32 * ta, lds + RC_MRK, 32 * tb, r32, h);
              float s1 = 0.f, s2 = 0.f;
#pragma unroll
              for (int i = 0; i < 16; ++i) { s1 += yacc[i]; s2 += yacc[i] * yacc[i]; }
              s1 += __shfl_xor(s1, 32); s2 += __shfl_xor(s2, 32);
              if (h == 0) { *(LAS float*)(lds + RC_SSB + ((w - 4) * 32 + r32) * 8) = s1; *(LAS float*)(lds + RC_SSB + ((w - 4) * 32 + r32) * 8 + 4) = s2; } } }
        }
        RC_BAR();
        { const int tid = otid(), w = __builtin_amdgcn_readfirstlane(tid >> 6), lane = tid & 63, r32 = lane & 31, h = lane >> 5; (void)w; (void)lane; (void)r32; (void)h;
        if (w >= 4) { const int ta = (w >> 1) & 1, tb = w & 1, t = 32 * tb + r32;
            const float a1 = *(const LAS float*)(lds + RC_SSB + ((w - 4) * 32 + r32) * 8), a2 = *(const LAS float*)(lds + RC_SSB + ((w - 4) * 32 + r32) * 8 + 4);
            const float b1 = *(const LAS float*)(lds + RC_SSB + (((w - 4) ^ 2) * 32 + r32) * 8), b2 = *(const LAS float*)(lds + RC_SSB + (((w - 4) ^ 2) * 32 + r32) * 8 + 4);
            const float mean = (a1 + b1) * (1.f / 64.f), var = fmaxf((a2 + b2) * (1.f / 64.f) - mean * mean, 0.f), rstd = rsqrtf(var + 64e-5f), bs = *(const LAS float*)(lds + RC_BS + t * 4);
#pragma unroll
            for (int q4 = 0; q4 < 4; ++q4) { const int v0 = 32 * ta + 8 * q4 + 4 * h; const v2u gw = *(const LAS v2u*)(lds + RC_G + t * 144 + v0 * 2);
                const v4f lg4 = *(const LAS v4f*)(lds + RC_CST + 1280 + v0 * 4), lb4 = *(const LAS v4f*)(lds + RC_CST + 1536 + v0 * 4); float o[4];
#pragma unroll
                for (int e = 0; e < 4; ++e) { const float vv = bf2f(*(const LAS unsigned short*)(lds + RC_VT + (v0 + e) * 144 + t * 2)); const float g = (e & 1) ? bfhi(gw[e >> 1]) : bflo(gw[e >> 1]);
                    o[e] = ((yacc[4 * q4 + e] - mean) * rstd * lg4[e] + lb4[e] + bs * vv) * g; }
                v2u ow; ow[0] = cvtpk(o[0], o[1]); ow[1] = cvtpk(o[2], o[3]);
                *(v2u*)(mixo + (size_t)(b * T + t0 + t) * NMIX + 512 + hh * 64 + v0) = ow; } }

        }
    }
    __syncthreads();
#undef RC_LOADPIECES
}
__device__ __forceinline__ void rwkvc_phase(KP P, int l, LAS unsigned char* lds, int vcu, int G) {
    for (int unit = vcu; unit < BATCH * 8; unit += G) rwkvc_unit(P, l, lds, unit >> 3, unit & 7);
}

#define XB_TMO      128
#define XB_XCNT(j)  (256  + 64 * (j))
#define XB_XSUB(j)  (1280 + 64 * (j))
#define XB_XGEN(j)  (2304 + 64 * (j))
#define XB_TOP      3328
#define XB_TOPGEN   3392
#define XCD_BAR_WORDS 3456
#define XB_SPIN_CAP (1u << 18)
__device__ __forceinline__ unsigned xb_ld(unsigned* p)              { return __hip_atomic_load(p, __ATOMIC_RELAXED, __HIP_MEMORY_SCOPE_AGENT); }
__device__ __forceinline__ unsigned xb_add(unsigned* p, unsigned v) { return __hip_atomic_fetch_add(p, v, __ATOMIC_RELAXED, __HIP_MEMORY_SCOPE_AGENT); }
__device__ __forceinline__ unsigned xb_xcc_id() { return (unsigned)__builtin_amdgcn_s_getreg((3 << 11) | 20) & 0xFu; }
#define XB_SPIN(cond, bar) do { unsigned _sp = 0; while (cond) { __builtin_amdgcn_s_sleep(1); \
    if ((++_sp & 255u) == 0u) { if (xb_ld(&(bar)[XB_TMO])) break; if (_sp > XB_SPIN_CAP) { atomicAdd(&(bar)[XB_TMO], 1u); break; } } } } while (0)
struct XcdBarrier {
    unsigned* bar; unsigned x;
    volatile LAS unsigned* st;
    unsigned n;
};
__device__ __forceinline__ XcdBarrier xcd_barrier_post(unsigned* bar, volatile LAS unsigned* st, unsigned n) {
    XcdBarrier b; b.bar = bar; b.x = xb_xcc_id(); b.st = st; b.n = n;
    if (threadIdx.x == 0) (void)xb_add(&bar[XB_XCNT(b.x)], 1u);
    return b;
}
__device__ __forceinline__ void xcd_barrier_complete(unsigned* bar, unsigned x, unsigned G, unsigned& nloc, unsigned& nx) {
    unsigned sum, cnt, mine, sp = 0u;
    for (;;) {
        sum = 0u; cnt = 0u; mine = 0u;
#pragma unroll
        for (unsigned j = 0; j < 16; ++j) { const unsigned c = xb_ld(&bar[XB_XCNT(j)]); sum += c; cnt += (c > 0u) ? 1u : 0u; mine = (j == x) ? c : mine; }
        if (sum == G) break;
        __builtin_amdgcn_s_sleep(1);
        if ((++sp & 255u) == 0u) { if (xb_ld(&bar[XB_TMO])) break; if (sp > XB_SPIN_CAP) { atomicAdd(&bar[XB_TMO], 1u); break; } }
    }
    nloc = mine > 0u ? mine : 1u; nx = cnt > 0u ? cnt : 1u;
}
template <bool LOCAL> __device__ __forceinline__ void xcd_barrier(const XcdBarrier& b) {
    asm volatile("s_waitcnt vmcnt(0)" ::: "memory");
    __syncthreads();
    if (threadIdx.x == 0) {
        unsigned* bar = b.bar;
        __builtin_amdgcn_s_waitcnt(0);
        unsigned nloc = b.st[0], nx = b.st[1];
        if (nloc == 0u) { xcd_barrier_complete(bar, b.x, b.n, nloc, nx); b.st[0] = nloc; b.st[1] = nx; }
        const bool one = LOCAL && nx == 1u;
        const unsigned old = xb_add(&bar[XB_XSUB(b.x)], 1u);
        const unsigned gen = old / nloc;
        if (old + 1u == (gen + 1u) * nloc) {
            if (!one) { __builtin_amdgcn_fence(__ATOMIC_RELEASE, "agent");
                        asm volatile("s_waitcnt vmcnt(0)" ::: "memory"); }
            const unsigned og = xb_add(&bar[XB_TOP], 1u);
            const unsigned tg = og / nx;
            if (og + 1u == (tg + 1u) * nx) xb_add(&bar[XB_TOPGEN], 1u);
            else XB_SPIN(xb_ld(&bar[XB_TOPGEN]) == tg, bar);
            if (!one) __builtin_amdgcn_fence(__ATOMIC_ACQUIRE, "agent");
            else asm volatile("buffer_inv sc0" ::: "memory");
            xb_add(&bar[XB_XGEN(b.x)], 1u);
            asm volatile("s_waitcnt vmcnt(0)" ::: "memory");
        } else {
            XB_SPIN(xb_ld(&bar[XB_XGEN(b.x)]) == gen, bar);
            if (!one) __builtin_amdgcn_fence(__ATOMIC_ACQUIRE, "agent");
            else asm volatile("buffer_inv sc0" ::: "memory");
            asm volatile("s_waitcnt vmcnt(0)" ::: "memory");
        }
    }
    __syncthreads();
}

constexpr int CW_BAR = 4096;
constexpr int MISC_OFF = 156928;
constexpr int CW_HB = 8192;
constexpr int CW_SEQ = 8192 + 512;
constexpr int CW_WDONE = 8192 + 1024;
constexpr int CW_GBAR = 65536;
__device__ __forceinline__ void half_barrier(unsigned* ctl, int cw, unsigned target) {
    asm volatile("s_waitcnt vmcnt(0) lgkmcnt(0)" ::: "memory");
    __syncthreads();
    if (threadIdx.x == 0) {
        (void)xb_add(&ctl[cw], 1u);
        unsigned sp = 0;
        while (xb_ld(&ctl[cw]) < target) { __builtin_amdgcn_s_sleep(2);
            if ((++sp & 255u) == 0u) { if (xb_ld(&ctl[CW_BAR + XB_TMO])) break; if (sp > XB_SPIN_CAP) { atomicAdd(&ctl[CW_BAR + XB_TMO], 1u); break; } } }
        asm volatile("" ::: "memory");
    }
    __syncthreads();
}
__device__ __forceinline__ void half_wait(unsigned* ctl, int cw, unsigned target) {
    if (threadIdx.x == 0) { unsigned sp = 0;
        while (xb_ld(&ctl[cw]) < target) { __builtin_amdgcn_s_sleep(2);
            if ((++sp & 255u) == 0u) { if (xb_ld(&ctl[CW_BAR + XB_TMO])) break; if (sp > XB_SPIN_CAP) { atomicAdd(&ctl[CW_BAR + XB_TMO], 1u); break; } } }
        asm volatile("" ::: "memory"); }
    __syncthreads();
}
__device__ __forceinline__ void pub_barrier(unsigned* ctl, int cw, unsigned target, bool one) {
    asm volatile("s_waitcnt vmcnt(0)" ::: "memory");
    __syncthreads();
    if (threadIdx.x == 0) {
        if (!one) { __builtin_amdgcn_fence(__ATOMIC_RELEASE, "agent"); asm volatile("s_waitcnt vmcnt(0)" ::: "memory"); }
        (void)xb_add(&ctl[cw], 1u);
        unsigned sp = 0;
        while (xb_ld(&ctl[cw]) < target) { __builtin_amdgcn_s_sleep(1);
            if ((++sp & 255u) == 0u) { if (xb_ld(&ctl[CW_BAR + XB_TMO])) break; if (sp > XB_SPIN_CAP) { atomicAdd(&ctl[CW_BAR + XB_TMO], 1u); break; } } }
        if (!one) __builtin_amdgcn_fence(__ATOMIC_ACQUIRE, "agent"); else asm volatile("buffer_inv sc0" ::: "memory");
        asm volatile("s_waitcnt vmcnt(0)" ::: "memory");
    }
    __syncthreads();
}
#ifndef NAIVE_ATTN
#define NAIVE_ATTN 0
#endif
#ifndef NAIVE_RET
#define NAIVE_RET 0
#endif
#ifndef NAIVE_RWKV
#define NAIVE_RWKV 0
#endif
#define RWKV_CHUNKED 1
#define GROUP_LOCAL 1
#define P1B_FIRST 0
#define ATT_FIRST 1
#ifndef REP_RWKV
#define REP_RWKV 1
#endif
#ifndef REP_ATTN
#define REP_ATTN 1
#endif
#ifndef REP_RET
#define REP_RET 1
#endif
#ifndef REP_G0
#define REP_G0 1
#endif
#ifndef REP_G1
#define REP_G1 1
#endif
#ifndef REP_G2
#define REP_G2 1
#endif
#ifndef REP_G4
#define REP_G4 1
#endif
__global__ void __launch_bounds__(512, 2) k_mega(Params Pv) {
    KP P = (KP)__builtin_amdgcn_kernarg_segment_ptr();
#define PFRESH() asm volatile("" : "+s"(P))
    extern __shared__ __attribute__((aligned(16))) unsigned char lds_[];
    LAS unsigned char* lds = (LAS unsigned char*)lds_;
    const int tid = threadIdx.x, G = gridDim.x, bx = blockIdx.x, vcu = (G % 8 == 0) ? (bx % 8) * (G / 8) + bx / 8 : bx;
    volatile LAS unsigned* MISC = (volatile LAS unsigned*)(lds + MISC_OFF);
    for (int u = tid; u < (LDS_BYTES - MISC_OFF) / 4; u += 512) ((LAS unsigned*)(lds + MISC_OFF))[u] = 0u;
    __syncthreads();
    const int GS = G / 8, grp = vcu / GS, rk = vcu % GS, GSH = GS / 2;
    XcdBarrier bar = xcd_barrier_post((unsigned*)(P->ws + WS_CTL) + CW_BAR, MISC + 8, (unsigned)G);
    { XcdBarrier gb0 = xcd_barrier_post((unsigned*)(P->ws + WS_CTL) + CW_GBAR + 4096 * grp, MISC + 12, (unsigned)GS); (void)gb0; }
#define GRID_BAR() do { asm volatile("" : "+s"(bar.x)); xcd_barrier<false>(bar); } while (0)
#define GROUP_BAR() do { int g_ = grp; asm volatile("" : "+s"(g_)); XcdBarrier gb_; gb_.bar = (unsigned*)(P->ws + WS_CTL) + CW_GBAR + 4096 * g_; gb_.x = xb_xcc_id(); gb_.st = MISC + 12; gb_.n = (unsigned)GS; xcd_barrier<GROUP_LOCAL != 0>(gb_); } while (0)
    PFRESH(); phase_x0(P, vcu, G);
    PFRESH(); phase_wconv_all(P, lds, vcu, G);
    GRID_BAR();
    for (int l = 0; l < DEPTH; ++l) {
        PFRESH(); gemm_phase_of<0>(P, l, lds, G, bx);
        GROUP_BAR();
        PFRESH();
        { unsigned* ctl = (unsigned*)(P->ws + WS_CTL); const int cw = CW_HB + 64 * grp;
          const bool loc = GROUP_LOCAL && MISC[13] == 1u;
          if (rk < GSH) { attn_phase(P, l, lds, 64 * grp + rk, GSH, 64 * grp + GSH * ATT_FIRST); half_barrier(ctl, cw, 0u); PFRESH();
                          { const int npb = GSH / 2; rwkv_prepass(P, l, 2 * grp + rk / npb, rk % npb, T / npb); }
                          pub_barrier(ctl, CW_SEQ + 64 * grp, (unsigned)GSH * (unsigned)(l + 1), loc); PFRESH();
                          for (int unit = 16 * grp + rk; unit < 16 * grp + 16; unit += GSH) rwkvc_unit(P, l, lds, unit >> 3, unit & 7);
                          if (P1B_FIRST > 0) { half_wait(ctl, cw, (unsigned)GS * (unsigned)(l + 1)); PFRESH(); gemm_phase_of<1>(P, l, lds, 8 * GSH, 8 * rk + grp, 12 - P1B_FIRST, P1B_FIRST); } }
          else { const int r2 = rk - GSH;
                 attn_phase(P, l, lds, 64 * grp + GSH * ATT_FIRST + r2, GS - GSH, 64 * grp + 64); __syncthreads();
                 for (int unit = 16 * grp + r2; unit < 16 * grp + 16; unit += GS - GSH) ret_unit(P, lds, unit >> 3, unit & 7);
                 half_barrier(ctl, cw, (unsigned)GS * (unsigned)(l + 1));
                 PFRESH(); gemm_phase_of<1>(P, l, lds, 8 * (GS - GSH), 8 * r2 + grp, 0, 12 - P1B_FIRST); } }
        GROUP_BAR();
        if (l == DEPTH - 1) { if (tid == 0) (void)xb_add((unsigned*)(P->ws + WS_CTL) + CW_WDONE, 1u); }
        PFRESH(); gemm_phase_of<2>(P, l, lds, G, bx);
        GROUP_BAR();
        PFRESH(); gemm_phase_of<3>(P, l, lds, G, bx);
        GROUP_BAR();
        PFRESH(); gemm_phase_of<4>(P, l, lds, G, bx);
        GROUP_BAR();
        if (l == DEPTH - 1) {
            unsigned* ctl = (unsigned*)(P->ws + WS_CTL);
            if (tid == 0) { unsigned sp = 0; while (xb_ld(&ctl[CW_WDONE]) < (unsigned)G) { __builtin_amdgcn_s_sleep(8);
                if ((++sp & 255u) == 0u) { if (xb_ld(&ctl[CW_BAR + XB_TMO])) break; if (sp > XB_SPIN_CAP) { atomicAdd(&ctl[CW_BAR + XB_TMO], 1u); break; } } } }
            __syncthreads(); }
        PFRESH(); gemm_phase_of<5>(P, l, lds, G, bx);
        if (l < DEPTH - 1) GROUP_BAR();
    }
#if PROBE_T
    if (vcu == 0 && tid == 0) { const unsigned long long tt_ = *(volatile unsigned long long*)(P->ws + WS_CTL + 65536) * 8ull; const unsigned long long t0_ = __builtin_amdgcn_s_memrealtime(); while (__builtin_amdgcn_s_memrealtime() - t0_ < tt_) __builtin_amdgcn_s_sleep(8); }
#endif
}

extern "C" void kernel_launch(void* const* d_in, const int* in_sizes, int n_in, void* d_out, int out_size, void* d_ws, size_t ws_size, hipStream_t stream) {
    static int grid = 0;
    if (grid == 0) {
        if (n_in != 25 || out_size != M * D || ws_size < WS_END) { fprintf(stderr, "kernel_launch: unexpected shapes (n_in %d, out %d, ws %zu)\n", n_in, out_size, ws_size); grid = -1; return; }
        int dev = 0, cus = 0, per_cu = 0; if (hipGetDevice(&dev) != hipSuccess || hipDeviceGetAttribute(&cus, hipDeviceAttributeMultiprocessorCount, dev) != hipSuccess) { grid = -1; return; }
        if (hipFuncSetAttribute((const void*)k_mega, hipFuncAttributeMaxDynamicSharedMemorySize, LDS_BYTES) != hipSuccess) { fprintf(stderr, "kernel_launch: hipFuncSetAttribute failed\n"); grid = -1; return; }
        if (hipOccupancyMaxActiveBlocksPerMultiprocessor(&per_cu, (const void*)k_mega, 512, LDS_BYTES) != hipSuccess || per_cu < 1) fprintf(stderr, "kernel_launch: occupancy query reports %d workgroups per CU\n", per_cu);
        (void)hipGetLastError();
        grid = cus - cus % 16;
        if (grid < 16) { grid = -1; return; }
    }
    if (grid < 0) return;
    Params p; memset(&p, 0, sizeof(p));
    for (int i = 0; i < 25; ++i) p.in[i] = (const float*)d_in[i];
    p.out = (float*)d_out; p.ws = (unsigned char*)d_ws;
    (void)hipMemsetAsync((char*)d_ws + WS_CTL, 0, CTL_BYTES, stream);
    hipLaunchKernelGGL(k_mega, dim3(grid), dim3(512), LDS_BYTES, stream, p);
}
```

```cpp
#include <hip/hip_runtime.h>
#include <cstdio>
#include <cstdint>
#include <cstring>

constexpr int D = 1024, BATCH = 16, T = 2048, DEPTH = 4, M = BATCH * T;
constexpr int HD = 64;
constexpr int NA = 4608;
constexpr int NG = 3072;
constexpr int INW = NA + NG;
constexpr int C_AQ = 0, C_AK = 512, C_AV = 640, C_RW = 768, C_RQ = 2560, C_RK = 3072, C_RV = 3584, C_RG = 4096;
constexpr int RWC = 1792;
constexpr int FF = 2816, FF2 = 2 * FF;
constexpr int NMIX = 1536;

constexpr size_t MiB = 1u << 20;
constexpr size_t WS_CTL = 0, CTL_BYTES = 1 * MiB;
constexpr size_t WS_WIN = 1 * MiB;
constexpr size_t WS_WMIX = WS_WIN + (size_t)INW * D * 2;
constexpr size_t WS_WOUT = WS_WMIX + (size_t)D * NMIX * 2;
constexpr size_t WS_WGU = WS_WOUT + (size_t)D * D * 2;
constexpr size_t WS_WDN = WS_WGU + (size_t)FF2 * D * 2;
constexpr size_t WS_XB = 38 * MiB;
constexpr size_t WS_MIXO = 102 * MiB;
constexpr size_t WS_BIG = 198 * MiB;
constexpr size_t WS_MIXED = WS_BIG + 192 * MiB;
constexpr size_t WS_RSS = 486 * MiB;
constexpr size_t WS_ROPE = 488 * MiB;
constexpr size_t WS_ROPE2 = WS_ROPE + 512 * 1024;
constexpr size_t WS_GX = 489 * MiB;
constexpr size_t WS_END = 505 * MiB;
static_assert(WS_WDN + (size_t)D * FF * 2 <= WS_XB && WS_WDN + (size_t)D * FF * 2 - WS_WIN <= 37 * MiB && 3 * 37 * MiB <= (size_t)M * D * 4, "weights fit");
static_assert(WS_BIG + (size_t)M * NA * 2 <= WS_RSS, "big region fits");

#define GAS __attribute__((address_space(1)))
#define LAS __attribute__((address_space(3)))
typedef unsigned short bf16;
typedef unsigned v4u __attribute__((ext_vector_type(4)));
typedef unsigned v2u __attribute__((ext_vector_type(2)));
typedef float v4f __attribute__((ext_vector_type(4)));
__device__ __forceinline__ unsigned f2bf(float f) { unsigned u = __builtin_bit_cast(unsigned, f); return (u + 0x7fffu + ((u >> 16) & 1u)) >> 16; }
__device__ __forceinline__ unsigned pk2(float lo, float hi) { return f2bf(lo) | (f2bf(hi) << 16); }
__device__ __forceinline__ float bf2f(unsigned short b) { return __builtin_bit_cast(float, (unsigned)b << 16); }
__device__ __forceinline__ float bflo(unsigned w) { return __builtin_bit_cast(float, w << 16); }
__device__ __forceinline__ float bfhi(unsigned w) { return __builtin_bit_cast(float, w & 0xffff0000u); }
__device__ __forceinline__ float wave_sum(float v) {
#pragma unroll
    for (int o = 1; o < 64; o <<= 1) v += __shfl_xor(v, o);
    return v;
}
__device__ __forceinline__ float wave_max(float v) {
#pragma unroll
    for (int o = 1; o < 64; o <<= 1) v = fmaxf(v, __shfl_xor(v, o));
    return v;
}
__device__ __forceinline__ float sigmoidf_(float x) { return 1.f / (1.f + __expf(-x)); }

__device__ __forceinline__ int otid() { int t = threadIdx.x; asm volatile("" : "+v"(t)); return t; }

struct Params {
    const float* in[25];
    float* out;
    unsigned char* ws;
    int layer; int pad;
};
typedef const __attribute__((address_space(4))) Params* KP;
constexpr size_t WL_STRIDE = 37 * MiB;
__device__ __forceinline__ unsigned char* wbase(KP P, int l) { return l == DEPTH - 1 ? P->ws : (unsigned char*)P->out + (size_t)l * WL_STRIDE - WS_WIN; }
constexpr size_t OUT_ZS = (DEPTH - 1) * WL_STRIDE;
static_assert(OUT_ZS + (size_t)M * 256 * 2 <= (size_t)M * D * 4, "zs fits in d_out");
enum { I_X = 0, I_N1G, I_WIN, I_QNG, I_KNG, I_SINK, I_WAO, I_MU, I_W0, I_W2, I_A0, I_A2, I_G2, I_KK, I_KA, I_RK, I_LNG, I_LNB, I_WRO, I_WTO, I_WOUT, I_N2G, I_WG, I_WU, I_WD };


namespace pg8 {
#define PG8_LAS __attribute__((address_space(3)))
typedef unsigned short bf16_t;
typedef short bf16x8 __attribute__((ext_vector_type(8)));
typedef float f32x4 __attribute__((ext_vector_type(4)));
typedef unsigned u32x4 __attribute__((ext_vector_type(4)));
constexpr int BM = 256, BK = 64, HALF = 128, HTB = HALF * BK * 2  , STAGE_BYTES = 8 * HTB, NXCD = 8, WGM = 8;

__host__ __device__ __forceinline__ int lds_byte(int r, int c) { const int st = (r >> 4) * 2 + (c >> 5), rr = r & 15, cc = c & 31, ob = rr * 64 + cc * 2; return st * 1024 + (ob ^ (((ob >> 9) & 1) << 5)); }
__host__ __device__ __forceinline__ void stage_rc(int b, int& R, int& C) { const int st = b / 1024, sb = b % 1024, swz = sb ^ (((sb >> 9) & 1) << 5); R = (st >> 1) * 16 + swz / 64; C = (st & 1) * 32 + (swz % 64) / 2; }
__host__ __device__ __forceinline__ int perm32(int rho) { const int n = rho >> 4, i = rho & 15; return 8 * (i >> 2) + 4 * n + (i & 3); }

struct Unit { int pm, pn; };
struct Gemm { const bf16_t* A; const bf16_t* Bt; int M, N, K, lda; };

struct StaticOrder {
    int nM, nN, nwg, G, c, i0, ni;
    __host__ __device__ void init(int M, int N, int G_, int c_) { nM = M / BM; nN = N / BM; nwg = nM * nN; G = G_; c = c_; i0 = 0; ni = 1 << 30; }
    __host__ __device__ bool next(int i, Unit& u) const {
        if (i >= ni) return false;
        const long L = (long)(i0 + i) * G + c; if (L >= nwg) return false;
        int wgid = (int)L; { const int q = nwg / NXCD, r = nwg % NXCD, xcd = wgid % NXCD, off = wgid / NXCD; wgid = (xcd < r ? xcd * (q + 1) : r * (q + 1) + (xcd - r) * q) + off; }
        const int nig = WGM * nN, gid = wgid / nig, fm = gid * WGM, gsz = (nM - fm) < WGM ? (nM - fm) : WGM;
        u.pm = fm + ((wgid % nig) % gsz); u.pn = (wgid % nig) / gsz; return true;
    }
    __device__ __forceinline__ void a_ready(const Unit&) const {}
    __device__ __forceinline__ void done(const Unit&) const {}
};


typedef float f32x2_ __attribute__((ext_vector_type(2))); typedef __bf16 bf16x2_ __attribute__((ext_vector_type(2)));
__device__ __forceinline__ unsigned cvt_pk_bf16(float lo, float hi) { const f32x2_ x = {lo, hi}; return __builtin_bit_cast(unsigned, __builtin_convertvector(x, bf16x2_)); }
__device__ __forceinline__ float clampg(float x) { return __builtin_amdgcn_fmed3f(x, -30.0f, 30.0f); }
__device__ __forceinline__ float row_rstd(const float* rss, int row) {
    const f32x4* p = (const f32x4*)(rss + (size_t)row * 16);
    const f32x4 a = p[0], b = p[1], c = p[2], d = p[3];
    const float s = (((a.x + a.y) + (a.z + a.w)) + ((b.x + b.y) + (b.z + b.w))) + (((c.x + c.y) + (c.z + c.w)) + ((d.x + d.y) + (d.z + d.w)));
    return rsqrtf(s * (1.0f / 1024.0f) + 1e-6f);
}
struct RowTab {
    const float* rss;
    __device__ __forceinline__ void tab_load(const Unit& u, int tid, f32x4& a, f32x4& b) const { const f32x4* p = (const f32x4*)(rss + ((size_t)u.pm * BM + (tid >> 1)) * 16 + (tid & 1) * 8); a = p[0]; b = p[1]; }
    __device__ __forceinline__ void tab_store(PG8_LAS float* tab, int tid, const f32x4& a, const f32x4& b) const {
        float s = ((a.x + a.y) + (a.z + a.w)) + ((b.x + b.y) + (b.z + b.w)); s += __shfl_xor(s, 1);
        if ((tid & 1) == 0) tab[tid >> 1] = rsqrtf(s * (1.0f / 1024.0f) + 1e-6f); }
};
struct EpiRowScale : RowTab {
    static constexpr bool PERM = true, AFTER_DRAIN = false, ROWTAB = true, ACCINIT = false; static constexpr int KSEG = 0;
    bf16_t* O; int ldc;
    __device__ __forceinline__ void operator()(const f32x4 (&acc)[2][2][4][2], const Unit& u, int wr, int wc, int fr, int fq, const PG8_LAS float* tab) const {
        const int row0 = u.pm * BM + wr * 64 + fr, col0 = u.pn * BM + wc * 32 + 8 * fq;
#pragma unroll
        for (int ai = 0; ai < 2; ++ai)
#pragma unroll
            for (int m = 0; m < 4; ++m) { const int row = row0 + ai * HALF + m * 16; const float rs = tab[wr * 64 + fr + ai * HALF + m * 16]; bf16_t* rowp = O + (size_t)row * ldc + col0;
#pragma unroll
                for (int bj = 0; bj < 2; ++bj) { const f32x4 v0 = acc[ai][bj][m][0] * rs, v1 = acc[ai][bj][m][1] * rs;
                    u32x4 w; w.x = cvt_pk_bf16(v0[0], v0[1]); w.y = cvt_pk_bf16(v0[2], v0[3]); w.z = cvt_pk_bf16(v1[0], v1[1]); w.w = cvt_pk_bf16(v1[2], v1[3]);
                    *(u32x4*)(rowp + bj * HALF) = w; } }
    }
};
struct GateMap { bf16_t* proj; bf16_t* gx;
    __device__ __forceinline__ bf16_t* tile(int gt, int& ld) const { if (gt < 11) { ld = 4608; return proj + (gt < 3 ? gt * 256 : 2560 + (gt - 3) * 256); } ld = 256; return gx; } };
struct EpiGates : RowTab {
    static constexpr bool PERM = true, AFTER_DRAIN = false, ROWTAB = true, ACCINIT = false; static constexpr int KSEG = 0;
    GateMap gm;
    __device__ __forceinline__ void operator()(const f32x4 (&acc)[2][2][4][2], const Unit& u, int wr, int wc, int fr, int fq, const PG8_LAS float* tab) const {
        int ld; bf16_t* base = gm.tile(u.pn, ld); const int row0 = u.pm * BM + wr * 64 + fr, col0 = wc * 32 + 8 * fq;
#pragma unroll
        for (int ai = 0; ai < 2; ++ai)
#pragma unroll
            for (int m = 0; m < 4; ++m) { const int row = row0 + ai * HALF + m * 16; const float rs = tab[wr * 64 + fr + ai * HALF + m * 16]; bf16_t* rowp = base + (size_t)row * ld + col0;
#pragma unroll
                for (int bj = 0; bj < 2; ++bj) { const f32x4 v0 = acc[ai][bj][m][0] * rs, v1 = acc[ai][bj][m][1] * rs;
                    u32x4 w; w.x = cvt_pk_bf16(v0[0], v0[1]); w.y = cvt_pk_bf16(v0[2], v0[3]); w.z = cvt_pk_bf16(v1[0], v1[1]); w.w = cvt_pk_bf16(v1[2], v1[3]);
                    *(u32x4*)(rowp + bj * HALF) = w; } }
    }
};
struct EpiSwiglu : RowTab {
    static constexpr bool PERM = true, AFTER_DRAIN = false, ROWTAB = true, ACCINIT = false; static constexpr int KSEG = 0;
    bf16_t* O; int ldc;
    __device__ __forceinline__ void operator()(const f32x4 (&acc)[2][2][4][2], const Unit& u, int wr, int wc, int fr, int fq, const PG8_LAS float* tab) const {
        const int row0 = u.pm * BM + wr * 64 + fr, col0 = u.pn * HALF + wc * 32 + 8 * fq;
#pragma unroll
        for (int ai = 0; ai < 2; ++ai)
#pragma unroll
            for (int m = 0; m < 4; ++m) { const int row = row0 + ai * HALF + m * 16; const float rs = tab[wr * 64 + fr + ai * HALF + m * 16]; bf16_t* rowp = O + (size_t)row * ldc + col0;
                float o[8];
#pragma unroll
                for (int n = 0; n < 2; ++n)
#pragma unroll
                    for (int j = 0; j < 4; ++j) { const float g = acc[ai][0][m][n][j] * rs, up = acc[ai][1][m][n][j] * rs; o[4 * n + j] = g * up * __builtin_amdgcn_rcpf(1.0f + __expf(-g)); }
                u32x4 w; w.x = cvt_pk_bf16(o[0], o[1]); w.y = cvt_pk_bf16(o[2], o[3]); w.z = cvt_pk_bf16(o[4], o[5]); w.w = cvt_pk_bf16(o[6], o[7]);
                *(u32x4*)rowp = w; }
    }
};
struct EpiResid {
    static constexpr bool PERM = true, AFTER_DRAIN = false, ROWTAB = false, ACCINIT = true; static constexpr int KSEG = 0;
    bf16_t* XB; float* rss; float* OUT;
    __device__ __forceinline__ void init(f32x4 (&acc)[2][2][4][2], const Unit& u, int wr, int wc, int fr, int fq) const {
        const int row0 = u.pm * BM + wr * 64 + fr, col0 = u.pn * BM + wc * 32 + 8 * fq;
#pragma unroll
        for (int ai = 0; ai < 2; ++ai) { u32x4 xin[4][2];
#pragma unroll
            for (int m = 0; m < 4; ++m)
#pragma unroll
                for (int bj = 0; bj < 2; ++bj) xin[m][bj] = *(const u32x4*)(XB + (size_t)(row0 + ai * HALF + m * 16) * 1024 + col0 + bj * HALF);
#pragma unroll
            for (int m = 0; m < 4; ++m)
#pragma unroll
                for (int bj = 0; bj < 2; ++bj)
#pragma unroll
                    for (int q = 0; q < 4; ++q) { const unsigned w = xin[m][bj][q]; acc[ai][bj][m][q >> 1][(q & 1) * 2] = __builtin_bit_cast(float, w << 16); acc[ai][bj][m][q >> 1][(q & 1) * 2 + 1] = __builtin_bit_cast(float, w & 0xffff0000u); } }
    }
    __device__ __forceinline__ void operator()(const f32x4 (&acc)[2][2][4][2], const Unit& u, int wr, int wc, int fr, int fq) const {
        const int row0 = u.pm * BM + wr * 64 + fr, col0 = u.pn * BM + wc * 32 + 8 * fq;
#pragma unroll
        for (int g = 0; g < 8; ++g) { const int ai = g >> 2, m = g & 3; const int row = row0 + ai * HALF + m * 16; const size_t off = (size_t)row * 1024 + col0; float ss = 0.f;
#pragma unroll
            for (int bj = 0; bj < 2; ++bj) { const f32x4 x0 = acc[ai][bj][m][0], x1 = acc[ai][bj][m][1];
                ss += ((x0[0] * x0[0] + x0[1] * x0[1]) + (x0[2] * x0[2] + x0[3] * x0[3])) + ((x1[0] * x1[0] + x1[1] * x1[1]) + (x1[2] * x1[2] + x1[3] * x1[3]));
                u32x4 w; w.x = cvt_pk_bf16(x0[0], x0[1]); w.y = cvt_pk_bf16(x0[2], x0[3]); w.z = cvt_pk_bf16(x1[0], x1[1]); w.w = cvt_pk_bf16(x1[2], x1[3]);
                *(u32x4*)(XB + off + bj * HALF) = w;
                if (OUT) { *(f32x4*)(OUT + off + bj * HALF) = x0; *(f32x4*)(OUT + off + bj * HALF + 4) = x1; } }
            ss += __shfl_xor(ss, 16); ss += __shfl_xor(ss, 32);
            if (fq == 0) rss[(size_t)row * 16 + u.pn * 4 + wc] = ss; }
    }
};
struct EpiGateMix {
    static constexpr bool PERM = true, AFTER_DRAIN = false, ROWTAB = false, ACCINIT = false; static constexpr int KSEG = 8;
    GateMap gm; bf16_t* O; int ldo;
    static constexpr int PF = 4;
    __device__ __forceinline__ void seg(f32x4 (&acc)[2][2][4][2], const Unit& u, int s, int wr, int wc, int fr, int fq) const {
        const int row0 = u.pm * BM + wr * 64 + fr, col0 = wc * 32 + 8 * fq; int ldl, ldh; const bf16_t* bl = gm.tile((s - 1) * 4 + u.pn, ldl); const bf16_t* bh = gm.tile(s * 4 + u.pn, ldh);
        u32x4 lo[PF][2], hi[PF][2];
#pragma unroll
        for (int g = 0; g < PF; ++g) { const size_t rown = (size_t)(row0 + (g >> 2) * HALF + (g & 3) * 16);
#pragma unroll
            for (int bj = 0; bj < 2; ++bj) { lo[g][bj] = *(const u32x4*)(bl + rown * ldl + col0 + bj * HALF); hi[g][bj] = *(const u32x4*)(bh + rown * ldh + col0 + bj * HALF); } }
#pragma unroll
        for (int g = 0; g < 8; ++g) { const int ai = g >> 2, m = g & 3, sl = g % PF;
#pragma unroll
            for (int bj = 0; bj < 2; ++bj)
#pragma unroll
                for (int q = 0; q < 4; ++q) { const unsigned wl = lo[sl][bj][q], wh = hi[sl][bj][q];
                    const float l0 = clampg(__builtin_bit_cast(float, wl << 16)), l1 = clampg(__builtin_bit_cast(float, wl & 0xffff0000u)), h0 = clampg(__builtin_bit_cast(float, wh << 16)), h1 = clampg(__builtin_bit_cast(float, wh & 0xffff0000u));
                    const float r0 = (1.0f + __expf(-h0)) * __builtin_amdgcn_rcpf(1.0f + __expf(-l0)), r1 = (1.0f + __expf(-h1)) * __builtin_amdgcn_rcpf(1.0f + __expf(-l1));
                    acc[ai][bj][m][q >> 1][(q & 1) * 2] *= r0; acc[ai][bj][m][q >> 1][(q & 1) * 2 + 1] *= r1; }
            if (g + PF < 8) { const size_t rown = (size_t)(row0 + ((g + PF) >> 2) * HALF + ((g + PF) & 3) * 16);
#pragma unroll
                for (int bj = 0; bj < 2; ++bj) { lo[sl][bj] = *(const u32x4*)(bl + rown * ldl + col0 + bj * HALF); hi[sl][bj] = *(const u32x4*)(bh + rown * ldh + col0 + bj * HALF); } } }
    }
    __device__ __forceinline__ void operator()(const f32x4 (&acc)[2][2][4][2], const Unit& u, int wr, int wc, int fr, int fq) const {
        const int row0 = u.pm * BM + wr * 64 + fr, col0 = wc * 32 + 8 * fq; int ldg; const bf16_t* bg = gm.tile(8 + u.pn, ldg);
        u32x4 gc[PF][2];
#pragma unroll
        for (int g = 0; g < PF; ++g) { const size_t rown = (size_t)(row0 + (g >> 2) * HALF + (g & 3) * 16);
#pragma unroll
            for (int bj = 0; bj < 2; ++bj) gc[g][bj] = *(const u32x4*)(bg + rown * ldg + col0 + bj * HALF); }
#pragma unroll
        for (int gi = 0; gi < 8; ++gi) { const int ai = gi >> 2, m = gi & 3, sl = gi % PF; const int row = row0 + ai * HALF + m * 16; bf16_t* rowp = O + (size_t)row * ldo + u.pn * BM + col0;
#pragma unroll
            for (int bj = 0; bj < 2; ++bj) { const u32x4 g = gc[sl][bj]; float o[8];
#pragma unroll
                for (int q = 0; q < 4; ++q) { const unsigned w = g[q]; const float g0 = clampg(__builtin_bit_cast(float, w << 16)), g1 = clampg(__builtin_bit_cast(float, w & 0xffff0000u));
                    o[2 * q] = acc[ai][bj][m][q >> 1][(q & 1) * 2] * __builtin_amdgcn_rcpf(1.0f + __expf(-g0)); o[2 * q + 1] = acc[ai][bj][m][q >> 1][(q & 1) * 2 + 1] * __builtin_amdgcn_rcpf(1.0f + __expf(-g1)); }
                u32x4 w; w.x = cvt_pk_bf16(o[0], o[1]); w.y = cvt_pk_bf16(o[2], o[3]); w.z = cvt_pk_bf16(o[4], o[5]); w.w = cvt_pk_bf16(o[6], o[7]);
                *(u32x4*)(rowp + bj * HALF) = w; }
            if (gi + PF < 8) { const size_t rown = (size_t)(row0 + ((gi + PF) >> 2) * HALF + ((gi + PF) & 3) * 16);
#pragma unroll
                for (int bj = 0; bj < 2; ++bj) gc[sl][bj] = *(const u32x4*)(bg + rown * ldg + col0 + bj * HALF); } }
    }
};


template <class Epi, class Sched, bool ALIGN_EPI = false, bool SP2 = false>
__device__ __forceinline__ void gemm_phase(PG8_LAS unsigned char* lds, const Gemm g, const Sched& S, const Epi& E) {
    int tid_ = threadIdx.x; asm volatile("" : "+v"(tid_));
    const int tid = tid_, wid = __builtin_amdgcn_readfirstlane(tid >> 6), lane = tid & 63, wr = wid >> 2, wc = wid & 3, fr = lane & 15, fq = lane >> 4;
    const int K = g.K, nt = K / BK;
    unsigned voffA[2], voffB[2];
#pragma unroll
    for (int i = 0; i < 2; ++i) { int R, C; stage_rc(tid * 16 + i * 8192, R, C); const int Rb = Epi::PERM ? ((R & ~31) + perm32(R & 31)) : R;
        voffA[i] = (unsigned)(R * g.lda + C) * 2u; voffB[i] = (unsigned)(Rb * K + C) * 2u; }
    const size_t kstep = (size_t)(BK * 2);
    const size_t hstepB = (size_t)HALF * K * 2, hstepA = (size_t)HALF * g.lda * 2;
    const size_t tstepB = 2 * hstepB, tstepA = 2 * hstepA;
    const unsigned ldsw = (unsigned)wid * 1024u;
    const int aoff = lds_byte(wr * 64 + fr, fq * 8), boff = lds_byte(wc * 32 + fr, fq * 8);
#define PG8_SA(b, h) (((b) * 2 + (h)) * HTB)
#define PG8_SB(b, h) ((4 + (b) * 2 + (h)) * HTB)
#define PG8_STAGE(bufoff, gbase, voff) do { _Pragma("unroll") for (int _i = 0; _i < 2; ++_i) \
        __builtin_amdgcn_global_load_lds((const unsigned*)((const char*)(gbase) + (voff)[_i]), (PG8_LAS unsigned*)(lds + (bufoff) + ldsw + _i * 8192), 16, 0, 0); } while (0)
#define PG8_LDA(dst, b, h) do { _Pragma("unroll") for (int m = 0; m < 4; ++m) _Pragma("unroll") for (int k = 0; k < 2; ++k) dst[m][k] = *(const PG8_LAS bf16x8*)(lds + PG8_SA(b, h) + aoff + m * 2048 + k * 1024); } while (0)
#define PG8_LDB(dst, b, h) do { _Pragma("unroll") for (int n = 0; n < 2; ++n) _Pragma("unroll") for (int k = 0; k < 2; ++k) dst[n][k] = *(const PG8_LAS bf16x8*)(lds + PG8_SB(b, h) + boff + n * 2048 + k * 1024); } while (0)
#define PG8_MMA(ai, bj, At, Bt) do { __builtin_amdgcn_s_setprio(1); _Pragma("unroll") for (int m = 0; m < 4; ++m) _Pragma("unroll") for (int n = 0; n < 2; ++n) _Pragma("unroll") for (int k = 0; k < 2; ++k) \
        acc[ai][bj][m][n] = __builtin_amdgcn_mfma_f32_16x16x32_bf16(Bt[n][k], At[m][k], acc[ai][bj][m][n], 0, 0, 0); __builtin_amdgcn_s_setprio(0); } while (0)
#define PG8_WAIT_V(n) asm volatile("s_waitcnt vmcnt(" #n ")" ::: "memory")
#define PG8_WAIT_L(n) asm volatile("s_waitcnt lgkmcnt(" #n ")" ::: "memory")
#define PG8_BAR __builtin_amdgcn_s_barrier()
#define PG8_SCHED __builtin_amdgcn_sched_barrier(0)
    Unit cur, nxt; int ui = 0;
    if (!S.next(0, cur)) return;
    f32x4 rt0 = (f32x4){0.f, 0.f, 0.f, 0.f}, rt1 = rt0;
    if constexpr (Epi::ROWTAB) { E.tab_load(cur, tid, rt0, rt1); E.tab_store((PG8_LAS float*)(lds + STAGE_BYTES), tid, rt0, rt1); }
    f32x4 acc[2][2][4][2];
#pragma unroll
    for (int a = 0; a < 2; ++a)
#pragma unroll
        for (int b = 0; b < 2; ++b)
#pragma unroll
            for (int m = 0; m < 4; ++m)
#pragma unroll
                for (int n = 0; n < 2; ++n) acc[a][b][m][n] = (f32x4){0.f, 0.f, 0.f, 0.f};
    if constexpr (Epi::ACCINIT) E.init(acc, cur, wr, wc, fr, fq);
    bf16x8 At[4][2], B0[2][2], B1[2][2];
    const char* cA = (const char*)g.A + (size_t)cur.pm * tstepA; const char* cB = (const char*)g.Bt + (size_t)cur.pn * tstepB;
    S.a_ready(cur);
    if constexpr (SP2) {
        PG8_STAGE(PG8_SB(0, 0), cB, voffB); PG8_STAGE(PG8_SB(0, 1), cB + hstepB, voffB); PG8_STAGE(PG8_SA(0, 0), cA, voffA); PG8_STAGE(PG8_SA(0, 1), cA + hstepA, voffA);
        if (wr == 1) PG8_BAR;
        PG8_WAIT_V(2); PG8_BAR;
        PG8_STAGE(PG8_SB(1, 0), cB + kstep, voffB); PG8_STAGE(PG8_SA(1, 0), cA + kstep, voffA); PG8_STAGE(PG8_SB(1, 1), cB + hstepB + kstep, voffB);
        PG8_WAIT_V(6); PG8_BAR;
    } else {
        PG8_STAGE(PG8_SB(0, 0), cB, voffB); PG8_STAGE(PG8_SA(0, 0), cA, voffA); PG8_STAGE(PG8_SB(0, 1), cB + hstepB, voffB); PG8_STAGE(PG8_SA(0, 1), cA + hstepA, voffA);
        if (wr == 1) PG8_BAR;
        PG8_WAIT_V(4); PG8_BAR;
        PG8_STAGE(PG8_SB(1, 0), cB + kstep, voffB); PG8_STAGE(PG8_SA(1, 0), cA + kstep, voffA); PG8_STAGE(PG8_SB(1, 1), cB + hstepB + kstep, voffB);
        PG8_WAIT_V(6); PG8_BAR;
    }
    for (;;) {
        const bool has_next = S.next(ui + 1, nxt);
        const char* nA = has_next ? (const char*)g.A + (size_t)nxt.pm * tstepA : cA; const char* nB = has_next ? (const char*)g.Bt + (size_t)nxt.pn * tstepB : cB;
        for (int t = 0; t < nt; t += 2) {
            const bool last = (t == nt - 2);
            const char* a1 = cA + (size_t)(t + 1) * kstep;
            const char* a2 = last ? nA : cA + (size_t)(t + 2) * kstep; const char* b2 = last ? nB : cB + (size_t)(t + 2) * kstep;
            const char* a3 = a2 + kstep; const char* b3 = b2 + kstep;
            if (last && has_next) S.a_ready(nxt);
            if constexpr (Epi::ROWTAB) { if (has_next) { if (t == nt - 4) E.tab_load(nxt, tid, rt0, rt1);
                                                         if (last) E.tab_store((PG8_LAS float*)(lds + STAGE_BYTES + ((ui + 1) & 1) * 1024), tid, rt0, rt1); } }
            if constexpr (Epi::KSEG > 0) { if (t != 0 && (t % Epi::KSEG) == 0) {
                if constexpr (ALIGN_EPI) { if (wr == 0) PG8_BAR; }
                E.seg(acc, cur, t / Epi::KSEG, wr, wc, fr, fq);
                if constexpr (ALIGN_EPI) { if (wr == 1) PG8_BAR; } } }
            if constexpr (SP2) {
            PG8_LDB(B0, 0, 0); PG8_LDB(B1, 0, 1); PG8_SCHED; PG8_LDA(At, 0, 0); PG8_STAGE(PG8_SA(1, 1), a1 + hstepA, voffA);
            PG8_WAIT_V(8); PG8_WAIT_L(0); PG8_BAR; PG8_MMA(0, 0, At, B0); PG8_MMA(0, 1, At, B1); PG8_BAR; PG8_SCHED;
            PG8_LDA(At, 0, 1); PG8_STAGE(PG8_SB(0, 0), b2, voffB); PG8_STAGE(PG8_SB(0, 1), b2 + hstepB, voffB); PG8_STAGE(PG8_SA(0, 0), a2, voffA);
            PG8_WAIT_V(8); PG8_WAIT_L(0); PG8_BAR; PG8_MMA(1, 0, At, B0); PG8_MMA(1, 1, At, B1); PG8_BAR; PG8_SCHED;
            PG8_LDB(B0, 1, 0); PG8_LDB(B1, 1, 1); PG8_SCHED; PG8_LDA(At, 1, 0); PG8_STAGE(PG8_SA(0, 1), a2 + hstepA, voffA);
            PG8_WAIT_V(8); PG8_WAIT_L(0); PG8_BAR; PG8_MMA(0, 0, At, B0); PG8_MMA(0, 1, At, B1); PG8_BAR; PG8_SCHED;
            PG8_LDA(At, 1, 1); PG8_STAGE(PG8_SB(1, 0), b3, voffB); PG8_STAGE(PG8_SB(1, 1), b3 + hstepB, voffB); PG8_STAGE(PG8_SA(1, 0), a3, voffA);
            PG8_WAIT_V(8); PG8_WAIT_L(0); PG8_BAR; PG8_MMA(1, 0, At, B0); PG8_MMA(1, 1, At, B1); PG8_BAR; PG8_SCHED;
            } else {
            PG8_LDB(B0, 0, 0); PG8_SCHED; PG8_LDA(At, 0, 0); PG8_STAGE(PG8_SA(1, 1), a1 + hstepA, voffA);
            PG8_WAIT_L(8); PG8_BAR; PG8_WAIT_L(0); PG8_MMA(0, 0, At, B0); PG8_BAR; PG8_SCHED;
            PG8_LDB(B1, 0, 1); PG8_STAGE(PG8_SB(0, 0), b2, voffB);
            PG8_BAR; PG8_WAIT_L(0); PG8_MMA(0, 1, At, B1); PG8_BAR;
            PG8_LDA(At, 0, 1); PG8_STAGE(PG8_SA(0, 0), a2, voffA);
            PG8_BAR; PG8_WAIT_L(0); PG8_MMA(1, 0, At, B0); PG8_BAR; PG8_SCHED;
            PG8_STAGE(PG8_SB(0, 1), b2 + hstepB, voffB);
            PG8_WAIT_V(6); PG8_BAR; PG8_MMA(1, 1, At, B1); PG8_BAR;
            PG8_LDB(B0, 1, 0); PG8_SCHED; PG8_LDA(At, 1, 0); PG8_STAGE(PG8_SA(0, 1), a2 + hstepA, voffA);
            PG8_WAIT_L(8); PG8_BAR; PG8_WAIT_L(0); PG8_MMA(0, 0, At, B0); PG8_BAR; PG8_SCHED;
            PG8_LDB(B1, 1, 1); PG8_STAGE(PG8_SB(1, 0), b3, voffB);
            PG8_BAR; PG8_WAIT_L(0); PG8_MMA(0, 1, At, B1); PG8_BAR;
            PG8_LDA(At, 1, 1); PG8_STAGE(PG8_SA(1, 0), a3, voffA);
            PG8_BAR; PG8_WAIT_L(0); PG8_MMA(1, 0, At, B0); PG8_BAR; PG8_SCHED;
            PG8_STAGE(PG8_SB(1, 1), b3 + hstepB, voffB);
            PG8_WAIT_V(6); PG8_BAR; PG8_MMA(1, 1, At, B1); PG8_BAR;
            }
        }
        if constexpr (ALIGN_EPI) { if (wr == 0) PG8_BAR; }
        if constexpr (!Epi::AFTER_DRAIN) { if constexpr (Epi::ROWTAB) E(acc, cur, wr, wc, fr, fq, (const PG8_LAS float*)(lds + STAGE_BYTES + (ui & 1) * 1024)); else E(acc, cur, wr, wc, fr, fq); S.done(cur); }
        if (!has_next) break;
#pragma unroll
        for (int a = 0; a < 2; ++a)
#pragma unroll
            for (int b = 0; b < 2; ++b)
#pragma unroll
                for (int m = 0; m < 4; ++m)
#pragma unroll
                    for (int n = 0; n < 2; ++n) acc[a][b][m][n] = (f32x4){0.f, 0.f, 0.f, 0.f};
        if constexpr (Epi::ACCINIT) E.init(acc, nxt, wr, wc, fr, fq);
        cur = nxt; cA = nA; cB = nB; ++ui;
        if constexpr (ALIGN_EPI) { if (wr == 1) PG8_BAR; }
    }
    PG8_WAIT_V(0);
    if constexpr (!ALIGN_EPI) { if (wr == 0) PG8_BAR; }
    PG8_BAR;
    if constexpr (Epi::AFTER_DRAIN) { E.fused(acc, cur, wr, wc, fr, fq, lds, wid, lane); S.done(cur); }
#undef PG8_SA
#undef PG8_SB
#undef PG8_STAGE
#undef PG8_LDA
#undef PG8_LDB
#undef PG8_MMA
#undef PG8_WAIT_V
#undef PG8_WAIT_L
#undef PG8_BAR
#undef PG8_SCHED
}
}


#define LDS_WAIT() asm volatile("s_waitcnt lgkmcnt(0)" ::: "memory")
constexpr int NWAVES = 8;
constexpr int LDS_BYTES = 157696;

struct WItem { const float* W; const float* scale; bf16* WT; int ldw, k0, n0, ldt, drow0, dcol0; };
constexpr int WI_IN = 16 * 240, WI_MIX = 3 * 8 * 32, WI_OUT = 16 * 32, WI_G = 16 * 88, WI_DN = 44 * 32;
constexpr int WI_TOTAL = WI_IN + WI_MIX + WI_OUT + 2 * WI_G + WI_DN;
__device__ __forceinline__ void witem_desc(KP P, int gi, WItem& d) {
    const int l = gi / WI_TOTAL; int it = gi - l * WI_TOTAL;
    unsigned char* ws = wbase(P, l);
    if (it < WI_IN) { const int kb = it / 240, nb = it % 240; d.W = P->in[I_WIN] + (size_t)l * D * INW; d.ldw = INW; d.k0 = 64 * kb; d.n0 = 32 * nb; d.scale = P->in[I_N1G] + l * D; d.WT = (bf16*)(ws + WS_WIN); d.ldt = D; d.drow0 = 32 * nb; d.dcol0 = 64 * kb; return; }
    it -= WI_IN;
    if (it < WI_MIX) { const int br = it / 256, r = it % 256, kb = r / 32, nb = r % 32; d.W = P->in[br == 0 ? I_WAO : (br == 1 ? I_WRO : I_WTO)] + (size_t)l * 512 * D;
        d.ldw = D; d.k0 = 64 * kb; d.n0 = 32 * nb; d.scale = nullptr; d.WT = (bf16*)(ws + WS_WMIX); d.ldt = NMIX; d.drow0 = 32 * nb; d.dcol0 = br * 512 + 64 * kb; return; }
    it -= WI_MIX;
    if (it < WI_OUT) { const int kb = it / 32, nb = it % 32; d.W = P->in[I_WOUT] + (size_t)l * D * D; d.ldw = D; d.k0 = 64 * kb; d.n0 = 32 * nb; d.scale = nullptr; d.WT = (bf16*)(ws + WS_WOUT); d.ldt = D; d.drow0 = 32 * nb; d.dcol0 = 64 * kb; return; }
    it -= WI_OUT;
    if (it < 2 * WI_G) { const int up = it / WI_G, r = it % WI_G, kb = r / 88, nb = r % 88, n0 = 32 * nb;
        d.W = P->in[up ? I_WU : I_WG] + (size_t)l * D * FF; d.ldw = FF; d.k0 = 64 * kb; d.n0 = n0; d.scale = P->in[I_N2G] + l * D; d.WT = (bf16*)(ws + WS_WGU); d.ldt = D; d.drow0 = (n0 / 128) * 256 + up * 128 + (n0 % 128); d.dcol0 = 64 * kb; return; }
    it -= 2 * WI_G;
    { const int kb = it / 32, nb = it % 32; d.W = P->in[I_WD] + (size_t)l * FF * D; d.ldw = D; d.k0 = 64 * kb; d.n0 = 32 * nb; d.scale = nullptr; d.WT = (bf16*)(ws + WS_WDN); d.ldt = FF; d.drow0 = 32 * nb; d.dcol0 = 64 * kb; }
}
__device__ __forceinline__ void witem_load(const WItem& d, int lane, v4f (&r)[8], v4f (&sc)[2]) {
    const float* src = d.W + (size_t)(d.k0 + (lane >> 3)) * d.ldw + d.n0 + 4 * (lane & 7);
#pragma unroll
    for (int i = 0; i < 8; ++i) r[i] = *(const v4f*)(src + (size_t)(8 * i) * d.ldw);
    sc[0] = (v4f){1.f, 1.f, 1.f, 1.f}; sc[1] = sc[0];
    if (d.scale) { const v4f* sp = (const v4f*)(d.scale + d.k0 + 8 * (lane & 7)); sc[0] = sp[0]; sc[1] = sp[1]; }
}
__device__ __forceinline__ void witem_store(const WItem& d, int lane, const v4f (&r)[8], const v4f (&sc)[2], LAS float* scr) {
    { LAS float* w = scr + (lane >> 3) * 33 + 4 * (lane & 7);
#pragma unroll
      for (int i = 0; i < 8; ++i) { w[(8 * i) * 33 + 0] = r[i].x; w[(8 * i) * 33 + 1] = r[i].y; w[(8 * i) * 33 + 2] = r[i].z; w[(8 * i) * 33 + 3] = r[i].w; } }
    LDS_WAIT(); asm volatile("" ::: "memory");
    const int c = lane & 7;
#pragma unroll
    for (int j = 0; j < 4; ++j) { const int n = (lane >> 3) + 8 * j; const LAS float* s = scr + (8 * c) * 33 + n;
        v4u o; o.x = pk2(s[0 * 33] * sc[0].x, s[1 * 33] * sc[0].y); o.y = pk2(s[2 * 33] * sc[0].z, s[3 * 33] * sc[0].w); o.z = pk2(s[4 * 33] * sc[1].x, s[5 * 33] * sc[1].y); o.w = pk2(s[6 * 33] * sc[1].z, s[7 * 33] * sc[1].w);
        *(v4u*)(d.WT + (size_t)(d.drow0 + n) * d.ldt + d.dcol0 + 8 * c) = o; }
    LDS_WAIT(); asm volatile("" ::: "memory");
}
__device__ __forceinline__ void phase_wconv_all(KP P, LAS unsigned char* lds, int vcu, int G) {
    const int otid_ = otid();
    const int wave = __builtin_amdgcn_readfirstlane(otid_ >> 6), lane = otid_ & 63;
    LAS float* scr = (LAS float*)(lds + wave * 16384);
    const int step = G * NWAVES, total = DEPTH * WI_TOTAL;
    int gi = vcu * NWAVES + wave;
    if (gi >= total) return;
    WItem cur, nxt; v4f rc[8], rn[8], sc[2], sn[2];
    witem_desc(P, gi, cur); witem_load(cur, lane, rc, sc);
#pragma unroll 1
    for (;;) {
        const int gn = gi + step; const bool has_next = gn < total;
        if (has_next) { witem_desc(P, gn, nxt); witem_load(nxt, lane, rn, sn); }
        witem_store(cur, lane, rc, sc, scr);
        if (!has_next) break;
        cur = nxt; gi = gn;
#pragma unroll
        for (int i = 0; i < 8; ++i) rc[i] = rn[i];
        sc[0] = sn[0]; sc[1] = sn[1];
    }
}
__device__ __forceinline__ void phase_x0(KP P, int vcu, int G) {
    const int otid_ = otid();
    const int wave = __builtin_amdgcn_readfirstlane(otid_ >> 6), lane = otid_ & 63;
    const float* x = P->in[I_X]; bf16* xb = (bf16*)(P->ws + WS_XB); float* rss = (float*)(P->ws + WS_RSS);
    for (int m0 = vcu * NWAVES + wave; m0 < M; m0 += 2 * G * NWAVES) {
        v4f v[2][4];
#pragma unroll
        for (int q = 0; q < 2; ++q) { const int m = m0 + q * G * NWAVES; const v4f* xr = (const v4f*)(x + (size_t)(m < M ? m : m0) * D) + lane;
#pragma unroll
            for (int j = 0; j < 4; ++j) v[q][j] = xr[64 * j]; }
#pragma unroll
        for (int q = 0; q < 2; ++q) { const int m = m0 + q * G * NWAVES; if (m < M) { unsigned long long* o8 = (unsigned long long*)(xb + (size_t)m * D) + lane; float s = 0.f;
#pragma unroll
            for (int j = 0; j < 4; ++j) s += (v[q][j].x * v[q][j].x + v[q][j].y * v[q][j].y) + (v[q][j].z * v[q][j].z + v[q][j].w * v[q][j].w);
            s = wave_sum(s);
#pragma unroll
            for (int j = 0; j < 4; ++j) { o8[64 * j] = (unsigned long long)pk2(v[q][j].x, v[q][j].y) | ((unsigned long long)pk2(v[q][j].z, v[q][j].w) << 32); }
            if (lane < 16) rss[(size_t)m * 16 + lane] = lane == 0 ? s : 0.f; } }
    }
    float* rope = (float*)(P->ws + WS_ROPE);
    for (int i = (vcu * NWAVES + wave) * 64 + lane; i < T * 32; i += G * NWAVES * 64) {
        const int t = i >> 5, j = i & 31; const float inv_freq = (float)exp(-((double)j / 32.0) * 9.210340371976184); const float ang = (float)t * inv_freq;
        const double xa = (double)ang, qd = rint(xa * 0.6366197723675814), fd = xa - qd * 1.5707963267948966; const int qi = (int)qd & 3;
        const float ff = (float)fd, f2 = ff * ff;
        const float sf = ff * (1.0f + f2 * (-1.6666667e-1f + f2 * (8.3333333e-3f + f2 * (-1.9841270e-4f + f2 * 2.7557319e-6f))));
        const float cf = 1.0f + f2 * (-0.5f + f2 * (4.1666667e-2f + f2 * (-1.3888889e-3f + f2 * (2.4801587e-5f + f2 * -2.7557319e-7f))));
        const float sn = (qi == 0) ? sf : (qi == 1) ? cf : (qi == 2) ? -sf : -cf, cs = (qi == 0) ? cf : (qi == 1) ? -sf : (qi == 2) ? -cf : sf;
        rope[2 * i] = cs; rope[2 * i + 1] = sn;
        { float* rope2 = (float*)(P->ws + WS_ROPE2); const int p = j >> 3, e = (j & 7) >> 1, o = j & 1;
          const size_t q = (((size_t)e * T + t) * 4 + p) * 4 + 2 * o; rope2[q] = cs; rope2[q + 1] = sn; }
    }
}


#define RESID_ALIGN true
#define STAGGER_US10 0
template <int PH> __device__ __forceinline__ void gemm_phase_of(KP P, int l, LAS unsigned char* lds, int G, int c, int i0 = 0, int ni = 1 << 30) {
    asm volatile("" : "+s"(l), "+s"(G), "+s"(c), "+s"(i0), "+s"(ni));
    const bool final_layer = (l == DEPTH - 1); const unsigned char* wb = wbase(P, l);
    unsigned char* ws = P->ws; const pg8::bf16_t* xb = (const pg8::bf16_t*)(ws + WS_XB); float* rss = (float*)(ws + WS_RSS);
    if constexpr (STAGGER_US10 > 0 && (PH == 0 || PH == 1 || PH == 4)) {
        if (otid() == 0) { const unsigned long long t0 = __builtin_amdgcn_s_memrealtime(), dt = (unsigned long long)(((unsigned)c >> 3) & 7u) * STAGGER_US10 * 10ull;
            while (__builtin_amdgcn_s_memrealtime() - t0 < dt) __builtin_amdgcn_s_sleep(8); }
        __syncthreads(); }
    pg8::StaticOrder S;
    if constexpr (PH == 0) { pg8::Gemm g{xb, (const pg8::bf16_t*)(wb + WS_WIN), M, NA, D, D}; S.init(M, NA, G, c); pg8::EpiRowScale E{{rss}, (pg8::bf16_t*)(ws + WS_BIG), NA};
        pg8::gemm_phase<pg8::EpiRowScale, pg8::StaticOrder, true, true>(lds, g, S, E); }
    if constexpr (PH == 1) { pg8::Gemm g{xb, (const pg8::bf16_t*)(wb + WS_WIN) + (size_t)NA * D, M, NG, D, D}; S.init(M, NG, G, c); S.i0 = i0; S.ni = ni; pg8::EpiGates E{{rss}, pg8::GateMap{(pg8::bf16_t*)(ws + WS_BIG), (pg8::bf16_t*)(ws + WS_GX)}};
        pg8::gemm_phase<pg8::EpiGates, pg8::StaticOrder, true, true>(lds, g, S, E); }
    if constexpr (PH == 2) { pg8::Gemm g{(const pg8::bf16_t*)(ws + WS_MIXO), (const pg8::bf16_t*)(wb + WS_WMIX), M, D, NMIX, NMIX}; S.init(M, D, G, c); pg8::EpiGateMix E{pg8::GateMap{(pg8::bf16_t*)(ws + WS_BIG), (pg8::bf16_t*)(ws + WS_GX)}, (pg8::bf16_t*)(ws + WS_BIG) + C_RW, NA};
        pg8::gemm_phase<pg8::EpiGateMix, pg8::StaticOrder, true, true>(lds, g, S, E); }
    if constexpr (PH == 3) { pg8::Gemm g{(const pg8::bf16_t*)(ws + WS_BIG) + C_RW, (const pg8::bf16_t*)(wb + WS_WOUT), M, D, D, NA}; S.init(M, D, G, c); pg8::EpiResid E{(pg8::bf16_t*)(ws + WS_XB), rss, nullptr};
        pg8::gemm_phase<pg8::EpiResid, pg8::StaticOrder, RESID_ALIGN, true>(lds, g, S, E); }
    if constexpr (PH == 4) { pg8::Gemm g{xb, (const pg8::bf16_t*)(wb + WS_WGU), M, FF2, D, D}; S.init(M, FF2, G, c); pg8::EpiSwiglu E{{rss}, (pg8::bf16_t*)(ws + WS_BIG), NA};
        pg8::gemm_phase<pg8::EpiSwiglu, pg8::StaticOrder, true, true>(lds, g, S, E); }
    if constexpr (PH == 5) { pg8::Gemm g{(const pg8::bf16_t*)(ws + WS_BIG), (const pg8::bf16_t*)(wb + WS_WDN), M, D, FF, NA}; S.init(M, D, G, c); pg8::EpiResid E{(pg8::bf16_t*)(ws + WS_XB), rss, final_layer ? P->out : nullptr};
        pg8::gemm_phase<pg8::EpiResid, pg8::StaticOrder, RESID_ALIGN, true>(lds, g, S, E); }
}

typedef float f32x16 __attribute__((ext_vector_type(16)));
typedef short bf16x8v __attribute__((ext_vector_type(8)));
constexpr int AT_KS = 144;
constexpr int AT_VS = 520;
constexpr int AT_KOFF = 0, AT_VOFF = 256 * AT_KS, AT_GOFF = AT_VOFF + 64 * AT_VS;
typedef float v2f_ __attribute__((ext_vector_type(2)));
typedef __bf16 v2bf_ __attribute__((ext_vector_type(2)));
__device__ __forceinline__ unsigned cvtpk(float lo, float hi) { const v2f_ x = {lo, hi}; return __builtin_bit_cast(unsigned, __builtin_convertvector(x, v2bf_)); }
#define LDS_BAR() do { asm volatile("s_waitcnt lgkmcnt(0)" ::: "memory"); __builtin_amdgcn_s_barrier(); asm volatile("" ::: "memory"); } while (0)
__device__ __forceinline__ void attn_phase(KP P, int l, LAS unsigned char* lds, int u0, int ustep, int uend) {
    const int tid = otid(), w = __builtin_amdgcn_readfirstlane(tid >> 6), lane = tid & 63, r32 = lane & 31, h = lane >> 5;
    const bf16* proj = (const bf16*)(P->ws + WS_BIG); bf16* mixo = (bf16*)(P->ws + WS_MIXO);
    const float* gq = P->in[I_QNG] + l * 64; const float* gk = P->in[I_KNG] + l * 64; const float* sinks = P->in[I_SINK] + l * 8;
    LAS float* gqs = (LAS float*)(lds + AT_GOFF);
    constexpr float LOG2E = 1.4426950408889634f;
    __syncthreads();
    if (tid < 64) { gqs[tid] = gq[tid] * (0.125f * LOG2E); gqs[64 + tid] = gk[tid]; }
    v4u kv[4], vv[4];
#define AT_LOAD(U) do { const int b_ = (U) >> 5, n_ = ((U) >> 1) & 15, kvh_ = (U) & 1, r_ = tid >> 1, hf_ = tid & 1; const size_t grow_ = (size_t)(b_ * T + n_ * 128 - 128 + r_) * NA; \
        _Pragma("unroll") for (int i = 0; i < 4; ++i) { kv[i] = (v4u){0u, 0u, 0u, 0u}; vv[i] = (v4u){0u, 0u, 0u, 0u}; } \
        if ((n_ > 0) || (r_ >= 128)) { _Pragma("unroll") for (int i = 0; i < 4; ++i) { kv[i] = *(const v4u*)(proj + grow_ + C_AK + kvh_ * 64 + hf_ * 32 + 8 * i); vv[i] = *(const v4u*)(proj + grow_ + C_AV + kvh_ * 64 + hf_ * 32 + 8 * i); } } } while (0)
    if (u0 < uend) AT_LOAD(u0);
    for (int unit = u0; unit < uend; unit += ustep) {
        const int b = unit >> 5, n = (unit >> 1) & 15, kvh = unit & 1;
        LDS_BAR();
        {
            const int r = tid >> 1, hf = tid & 1;
            float ss = 0.f;
#pragma unroll
            for (int i = 0; i < 4; ++i)
#pragma unroll
                for (int e = 0; e < 4; ++e) { const float k0 = bflo(kv[i][e]), k1 = bfhi(kv[i][e]); ss += k0 * k0 + k1 * k1; }
            ss += __shfl_xor(ss, 1);
            const float rs = rsqrtf(ss * (1.f / 64.f) + 1e-6f);
#pragma unroll
            for (int i = 0; i < 4; ++i) { v4u o;
#pragma unroll
                for (int e = 0; e < 4; ++e) { const int d = hf * 32 + 8 * i + 2 * e; o[e] = cvtpk(bflo(kv[i][e]) * rs * gqs[64 + d], bfhi(kv[i][e]) * rs * gqs[64 + d + 1]); }
                *(LAS v4u*)(lds + AT_KOFF + r * AT_KS + hf * 64 + 16 * i) = o; }
#pragma unroll
            for (int i = 0; i < 4; ++i)
#pragma unroll
                for (int e = 0; e < 4; ++e) { const int d = hf * 32 + 8 * i + 2 * e;
                    *(LAS unsigned short*)(lds + AT_VOFF + d * AT_VS + r * 2) = (unsigned short)(vv[i][e] & 0xffffu);
                    *(LAS unsigned short*)(lds + AT_VOFF + (d + 1) * AT_VS + r * 2) = (unsigned short)(vv[i][e] >> 16); }
        }
        LDS_BAR();
        if (unit + ustep < uend) AT_LOAD(unit + ustep);
#pragma unroll 1
        for (int gi = 0; gi < 2; ++gi) {
            const int g = w >> 1, sb = (w & 1) * 2 + gi, hq = kvh * 4 + g;
            const size_t qrow = (size_t)(b * T + n * 128 + 32 * sb + r32);
            v4u qr[4]; float ss = 0.f;
#pragma unroll
            for (int s = 0; s < 4; ++s) { qr[s] = *(const v4u*)(proj + qrow * NA + C_AQ + hq * 64 + 8 * h + 16 * s);
#pragma unroll
                for (int e = 0; e < 4; ++e) { const float q0 = bflo(qr[s][e]), q1 = bfhi(qr[s][e]); ss += q0 * q0 + q1 * q1; } }
            ss += __shfl_xor(ss, 32);
            const float rs = rsqrtf(ss * (1.f / 64.f) + 1e-6f);
            bf16x8v Qf[4];
#pragma unroll
            for (int s = 0; s < 4; ++s) { const v4f g0 = *(const LAS v4f*)(gqs + 8 * h + 16 * s), g1 = *(const LAS v4f*)(gqs + 8 * h + 16 * s + 4); v4u o;
                o[0] = cvtpk(bflo(qr[s][0]) * rs * g0[0], bfhi(qr[s][0]) * rs * g0[1]); o[1] = cvtpk(bflo(qr[s][1]) * rs * g0[2], bfhi(qr[s][1]) * rs * g0[3]);
                o[2] = cvtpk(bflo(qr[s][2]) * rs * g1[0], bfhi(qr[s][2]) * rs * g1[1]); o[3] = cvtpk(bflo(qr[s][3]) * rs * g1[2], bfhi(qr[s][3]) * rs * g1[3]);
                Qf[s] = __builtin_bit_cast(bf16x8v, o); }
            f32x16 S[5];
#pragma unroll
            for (int c5 = 0; c5 < 5; ++c5) { f32x16 acc;
#pragma unroll
                for (int i = 0; i < 16; ++i) acc[i] = 0.f;
#pragma unroll
                for (int s = 0; s < 4; ++s) { const bf16x8v kf = *(const LAS bf16x8v*)(lds + AT_KOFF + (32 * (sb + c5) + r32) * AT_KS + (8 * h + 16 * s) * 2);
                    acc = __builtin_amdgcn_mfma_f32_32x32x16_bf16(kf, Qf[s], acc, 0, 0, 0); }
                S[c5] = acc; }
            const int qi = 32 * sb + r32; float mx = -INFINITY;
#pragma unroll
            for (int c5 = 0; c5 < 5; ++c5)
#pragma unroll
                for (int i = 0; i < 16; ++i) { const int si = 32 * (sb + c5) + 8 * (i >> 2) + 4 * h + (i & 3);
                    bool ok = true; if (c5 == 0) ok = si > qi; if (c5 == 4) ok = si <= qi + 128; if (n == 0) ok = ok && (si >= 128);
                    const float v = ok ? S[c5][i] : -INFINITY; S[c5][i] = v; mx = fmaxf(mx, v); }
            mx = fmaxf(mx, __shfl_xor(mx, 32));
            const float sink = sinks[hq] * LOG2E; mx = fmaxf(mx, sink);
            float sum = 0.f;
#pragma unroll
            for (int c5 = 0; c5 < 5; ++c5)
#pragma unroll
                for (int i = 0; i < 16; ++i) { const float p = __builtin_amdgcn_exp2f(S[c5][i] - mx); S[c5][i] = p; sum += p; }
            sum += __shfl_xor(sum, 32);
            const float inv = 1.0f / (sum + __builtin_amdgcn_exp2f(sink - mx));
            f32x16 O[2];
#pragma unroll
            for (int dt = 0; dt < 2; ++dt)
#pragma unroll
                for (int i = 0; i < 16; ++i) O[dt][i] = 0.f;
#pragma unroll
            for (int c5 = 0; c5 < 5; ++c5)
#pragma unroll
                for (int s = 0; s < 2; ++s) { v4u pw; pw[0] = cvtpk(S[c5][8 * s], S[c5][8 * s + 1]); pw[1] = cvtpk(S[c5][8 * s + 2], S[c5][8 * s + 3]); pw[2] = cvtpk(S[c5][8 * s + 4], S[c5][8 * s + 5]); pw[3] = cvtpk(S[c5][8 * s + 6], S[c5][8 * s + 7]);
                    const bf16x8v pf = __builtin_bit_cast(bf16x8v, pw);
#pragma unroll
                    for (int dt = 0; dt < 2; ++dt) { const LAS unsigned char* vp = lds + AT_VOFF + (32 * dt + r32) * AT_VS + (32 * (sb + c5) + 16 * s + 4 * h) * 2;
                        const v2u lo = *(const LAS v2u*)vp, hi = *(const LAS v2u*)(vp + 16); v4u vw; vw[0] = lo[0]; vw[1] = lo[1]; vw[2] = hi[0]; vw[3] = hi[1];
                        O[dt] = __builtin_amdgcn_mfma_f32_32x32x16_bf16(__builtin_bit_cast(bf16x8v, vw), pf, O[dt], 0, 0, 0); } }
#pragma unroll
            for (int dt = 0; dt < 2; ++dt)
#pragma unroll
                for (int q4 = 0; q4 < 4; ++q4) { v2u o; o[0] = cvtpk(O[dt][4 * q4] * inv, O[dt][4 * q4 + 1] * inv); o[1] = cvtpk(O[dt][4 * q4 + 2] * inv, O[dt][4 * q4 + 3] * inv);
                    *(v2u*)(mixo + qrow * NMIX + hq * 64 + 32 * dt + 8 * q4 + 4 * h) = o; }
        }
    }
    __syncthreads();
#undef AT_LOAD
}

constexpr int RT_KS = 144, RT_TS = 272;
constexpr int RT_KOFF = 0, RT_KTOFF = 128 * RT_KS, RT_VTOFF = RT_KTOFF + 64 * RT_TS, RT_ROFF = RT_VTOFF + 64 * RT_TS, RT_SOFF = RT_ROFF + 64 * RT_KS, RT_QOFF = RT_SOFF + 1024, RT_GOFF = RT_QOFF + 128 * RT_KS, RT_END = RT_GOFF + 128 * RT_KS;
static_assert(RT_END <= 131072, "retention LDS");
__device__ __forceinline__ void ret_unit(KP P, LAS unsigned char* lds, int b, int hh) {
    const int tid = otid(), w = __builtin_amdgcn_readfirstlane(tid >> 6), lane = tid & 63, r32 = lane & 31, h = lane >> 5;
    const bf16* proj = (const bf16*)(P->ws + WS_BIG); bf16* mixo = (bf16*)(P->ws + WS_MIXO); const float* rope2 = (const float*)(P->ws + WS_ROPE2);
    const float lg = log2f(1.0f - exp2f(-5.0f - (float)hh));
    const float g128 = exp2f(128.0f * lg);
    const int qg = w >> 1, dt = w & 1;
    f32x16 Racc;
#pragma unroll
    for (int i = 0; i < 16; ++i) Racc[i] = 0.f;
    __syncthreads();
    for (int i = tid; i < 64 * RT_KS / 4; i += 512) ((LAS unsigned*)(lds + RT_ROFF))[i] = 0u;
    v4u pk1, pk2, pv1, pv2, pq1, pq2, pg1, pg2; v4f prk[4];
#define RT_PREFETCH(N) do { const int row_ = tid >> 2, p_ = tid & 3; const size_t g_ = ((size_t)(b * T + (N) * 128) + row_) * NA + hh * 64 + 8 * p_; \
        pk1 = *(const v4u*)(proj + g_ + C_RK); pk2 = *(const v4u*)(proj + g_ + C_RK + 32); pv1 = *(const v4u*)(proj + g_ + C_RV); pv2 = *(const v4u*)(proj + g_ + C_RV + 32); \
        pq1 = *(const v4u*)(proj + g_ + C_RQ); pq2 = *(const v4u*)(proj + g_ + C_RQ + 32); pg1 = *(const v4u*)(proj + g_ + C_RG); pg2 = *(const v4u*)(proj + g_ + C_RG + 32); \
        _Pragma("unroll") for (int e_ = 0; e_ < 4; ++e_) prk[e_] = *(const v4f*)(rope2 + (((size_t)e_ * T + (N) * 128 + row_) * 4 + p_) * 4); } while (0)
    RT_PREFETCH(0);
#pragma unroll 1
    for (int n = 0; n < 16; ++n) {
        const size_t tok0 = (size_t)(b * T + n * 128);
        LDS_BAR();
        {
            const int row = tid >> 2, p = tid & 3;
            const v4u k1 = pk1, k2 = pk2, v1 = pv1, v2 = pv2, q1 = pq1, q2 = pq2;
            const float sc = 0.125f * exp2f(-(float)(row + 1) * lg);
            v4u w1, w2, x1, x2;
#pragma unroll
            for (int e = 0; e < 4; ++e) { const v4f cs = prk[e];
                { const float a1 = bflo(k1[e]), a2 = bflo(k2[e]), b1 = bfhi(k1[e]), b2 = bfhi(k2[e]);
                  w1[e] = cvtpk((a1 * cs[0] - a2 * cs[1]) * sc, (b1 * cs[2] - b2 * cs[3]) * sc); w2[e] = cvtpk((a2 * cs[0] + a1 * cs[1]) * sc, (b2 * cs[2] + b1 * cs[3]) * sc); }
                { const float a1 = bflo(q1[e]), a2 = bflo(q2[e]), b1 = bfhi(q1[e]), b2 = bfhi(q2[e]);
                  x1[e] = cvtpk(a1 * cs[0] - a2 * cs[1], b1 * cs[2] - b2 * cs[3]); x2[e] = cvtpk(a2 * cs[0] + a1 * cs[1], b2 * cs[2] + b1 * cs[3]); } }
            *(LAS v4u*)(lds + RT_KOFF + row * RT_KS + 16 * p) = w1; *(LAS v4u*)(lds + RT_KOFF + row * RT_KS + 64 + 16 * p) = w2;
            *(LAS v4u*)(lds + RT_QOFF + row * RT_KS + 16 * p) = x1; *(LAS v4u*)(lds + RT_QOFF + row * RT_KS + 64 + 16 * p) = x2;
            *(LAS v4u*)(lds + RT_GOFF + row * RT_KS + 16 * p) = pg1; *(LAS v4u*)(lds + RT_GOFF + row * RT_KS + 64 + 16 * p) = pg2;
#pragma unroll
            for (int e = 0; e < 4; ++e) { const int d = 8 * p + 2 * e;
                *(LAS unsigned short*)(lds + RT_KTOFF + d * RT_TS + row * 2) = (unsigned short)(w1[e] & 0xffffu); *(LAS unsigned short*)(lds + RT_KTOFF + (d + 1) * RT_TS + row * 2) = (unsigned short)(w1[e] >> 16);
                *(LAS unsigned short*)(lds + RT_KTOFF + (d + 32) * RT_TS + row * 2) = (unsigned short)(w2[e] & 0xffffu); *(LAS unsigned short*)(lds + RT_KTOFF + (d + 33) * RT_TS + row * 2) = (unsigned short)(w2[e] >> 16);
                *(LAS unsigned short*)(lds + RT_VTOFF + d * RT_TS + row * 2) = (unsigned short)(v1[e] & 0xffffu); *(LAS unsigned short*)(lds + RT_VTOFF + (d + 1) * RT_TS + row * 2) = (unsigned short)(v1[e] >> 16);
                *(LAS unsigned short*)(lds + RT_VTOFF + (d + 32) * RT_TS + row * 2) = (unsigned short)(v2[e] & 0xffffu); *(LAS unsigned short*)(lds + RT_VTOFF + (d + 33) * RT_TS + row * 2) = (unsigned short)(v2[e] >> 16); }
        }
        LDS_BAR();
        if (n + 1 < 16) RT_PREFETCH(n + 1);
        bf16x8v Qf[4];
        const size_t qtok = tok0 + 32 * qg + r32;
#pragma unroll
        for (int s = 0; s < 4; ++s) Qf[s] = *(const LAS bf16x8v*)(lds + RT_QOFF + (32 * qg + r32) * RT_KS + (8 * h + 16 * s) * 2);
        f32x16 O;
#pragma unroll
        for (int i = 0; i < 16; ++i) O[i] = 0.f;
#pragma unroll
        for (int s = 0; s < 4; ++s) { const bf16x8v rf = *(const LAS bf16x8v*)(lds + RT_ROFF + (32 * dt + r32) * RT_KS + (8 * h + 16 * s) * 2);
            O = __builtin_amdgcn_mfma_f32_32x32x16_bf16(rf, Qf[s], O, 0, 0, 0); }
#pragma unroll
        for (int c = 0; c < 4; ++c) { if (c <= qg) {
            f32x16 S;
#pragma unroll
            for (int i = 0; i < 16; ++i) S[i] = 0.f;
#pragma unroll
            for (int s = 0; s < 4; ++s) { const bf16x8v kf = *(const LAS bf16x8v*)(lds + RT_KOFF + (32 * c + r32) * RT_KS + (8 * h + 16 * s) * 2);
                S = __builtin_amdgcn_mfma_f32_32x32x16_bf16(kf, Qf[s], S, 0, 0, 0); }
            if (c == qg) {
#pragma unroll
                for (int i = 0; i < 16; ++i) { const int j = 8 * (i >> 2) + 4 * h + (i & 3); S[i] = (j <= r32) ? S[i] : 0.f; } }
#pragma unroll
            for (int s = 0; s < 2; ++s) { v4u pw; pw[0] = cvtpk(S[8 * s], S[8 * s + 1]); pw[1] = cvtpk(S[8 * s + 2], S[8 * s + 3]); pw[2] = cvtpk(S[8 * s + 4], S[8 * s + 5]); pw[3] = cvtpk(S[8 * s + 6], S[8 * s + 7]);
                const LAS unsigned char* vp = lds + RT_VTOFF + (32 * dt + r32) * RT_TS + (32 * c + 16 * s + 4 * h) * 2;
                const v2u lo = *(const LAS v2u*)vp, hi = *(const LAS v2u*)(vp + 16); v4u vw; vw[0] = lo[0]; vw[1] = lo[1]; vw[2] = hi[0]; vw[3] = hi[1];
                O = __builtin_amdgcn_mfma_f32_32x32x16_bf16(__builtin_bit_cast(bf16x8v, vw), __builtin_bit_cast(bf16x8v, pw), O, 0, 0, 0); } } }
        if (w < 4) { const int et = w >> 1, dtile = w & 1;
#pragma unroll
            for (int s = 0; s < 8; ++s) { const bf16x8v vf = *(const LAS bf16x8v*)(lds + RT_VTOFF + (32 * et + r32) * RT_TS + (16 * s + 8 * h) * 2);
                const bf16x8v kf = *(const LAS bf16x8v*)(lds + RT_KTOFF + (32 * dtile + r32) * RT_TS + (16 * s + 8 * h) * 2);
                Racc = __builtin_amdgcn_mfma_f32_32x32x16_bf16(vf, kf, Racc, 0, 0, 0); }
#pragma unroll
            for (int i = 0; i < 16; ++i) Racc[i] *= g128; }
        const float xi = exp2f((float)(32 * qg + r32 + 1) * lg); float ss = 0.f;
#pragma unroll
        for (int i = 0; i < 16; ++i) { O[i] *= xi; ss += O[i] * O[i]; }
        ss += __shfl_xor(ss, 32);
        LAS float* ssb = (LAS float*)(lds + RT_SOFF);
        if (h == 0) ssb[(qg * 2 + dt) * 32 + r32] = ss;
        LDS_BAR();
        const float rstd = rsqrtf((ss + ssb[(qg * 2 + (dt ^ 1)) * 32 + r32]) * (1.f / 64.f) + 1e-6f);
        if (w < 4) { const int et = w >> 1, dtile = w & 1;
#pragma unroll
            for (int i = 0; i < 16; ++i) { const int e = 32 * et + 8 * (i >> 2) + 4 * h + (i & 3); *(LAS unsigned short*)(lds + RT_ROFF + e * RT_KS + (32 * dtile + r32) * 2) = (unsigned short)f2bf(Racc[i]); } }
#pragma unroll
        for (int q4 = 0; q4 < 4; ++q4) { const int e0 = 32 * dt + 8 * q4 + 4 * h; const v2u gw = *(const LAS v2u*)(lds + RT_GOFF + (32 * qg + r32) * RT_KS + e0 * 2);
            const float g0 = bflo(gw[0]), g1 = bfhi(gw[0]), g2 = bflo(gw[1]), g3 = bfhi(gw[1]);
            v2u o; o[0] = cvtpk(O[4 * q4] * rstd * g0 / (1.0f + __expf(-g0)), O[4 * q4 + 1] * rstd * g1 / (1.0f + __expf(-g1)));
            o[1] = cvtpk(O[4 * q4 + 2] * rstd * g2 / (1.0f + __expf(-g2)), O[4 * q4 + 3] * rstd * g3 / (1.0f + __expf(-g3)));
            *(v2u*)(mixo + qtok * NMIX + 1024 + hh * 64 + e0) = o; }
    }
    __syncthreads();
#undef RT_PREFETCH
}
__device__ __forceinline__ void ret_phase(KP P, LAS unsigned char* lds, int vcu, int G) {
    for (int unit = vcu; unit < BATCH * 8; unit += G) ret_unit(P, lds, unit >> 3, unit & 7);
}

template <int CTRL> __device__ __forceinline__ float dppf(float x) { return __builtin_bit_cast(float, __builtin_amdgcn_mov_dpp(__builtin_bit_cast(int, x), CTRL, 0xf, 0xf, true)); }
constexpr int DPP_X1 = 0xB1, DPP_X2 = 0x4E, DPP_X7 = 0x141, DPP_X8 = 0x128;
__device__ __forceinline__ float sum8(float x) { x += dppf<DPP_X1>(x); x += dppf<DPP_X2>(x); x += dppf<DPP_X7>(x); return x; }
__device__ __forceinline__ float sum16(float x) { x = sum8(x); x += dppf<DPP_X8>(x); return x; }
#define PROBE_SCAN2 0
constexpr int RS_TT = 32;
constexpr int RS_W2T = 0, RS_A2T = 9216, RS_G2T = 18432, RS_XW = 35840, RS_XA = RS_XW + RS_TT * 144, RS_XG = RS_XA + RS_TT * 144, RS_F0 = RS_XG + RS_TT * 272;
constexpr int RS_FA = RS_TT * 64 * 4;
constexpr int RS_ZR = RS_F0, RS_ZK = RS_F0 + RS_FA, RS_ZV = RS_F0 + 2 * RS_FA, RS_WL = RS_F0 + 3 * RS_FA, RS_AL = RS_F0 + 4 * RS_FA, RS_GL = RS_F0 + 5 * RS_FA, RS_AV = RS_F0 + 6 * RS_FA, RS_YS = RS_F0 + 7 * RS_FA, RS_BS = RS_F0 + 8 * RS_FA;
constexpr int RS_MU = RS_BS + RS_TT * 4, RS_CST = RS_MU + 448 * 4;
static_assert(RS_CST + 7 * 256 <= 131072, "rwkv LDS");
constexpr int RS_NP = (RS_TT * 56 + 511) / 512;
typedef float v2f __attribute__((ext_vector_type(2)));
__device__ __forceinline__ void rwkv_unit(KP P, int l, LAS unsigned char* lds, int b, int hh) {
    const int tid = otid(), w = __builtin_amdgcn_readfirstlane(tid >> 6), lane = tid & 63, r32 = lane & 31, h2 = lane >> 5;
    const bf16* proj = (const bf16*)(P->ws + WS_BIG); bf16* mixo = (bf16*)(P->ws + WS_MIXO);
    const float* mu = P->in[I_MU] + l * RWC; const float* w0 = P->in[I_W0] + l * 512 + hh * 64; const float* a0 = P->in[I_A0] + l * 512 + hh * 64;
    const float* kkw = P->in[I_KK] + l * 512 + hh * 64; const float* kaw = P->in[I_KA] + l * 512 + hh * 64; const float* rkw = P->in[I_RK] + l * 512 + hh * 64;
    const float* lng = P->in[I_LNG] + l * 512 + hh * 64; const float* lnb = P->in[I_LNB] + l * 512 + hh * 64;
    __syncthreads();
    for (int i = tid; i < 64 * 64; i += 512) { const int c = i >> 6, j = i & 63;
        *(LAS unsigned short*)(lds + RS_W2T + j * 144 + c * 2) = (unsigned short)f2bf(P->in[I_W2][(size_t)l * 64 * 512 + c * 512 + hh * 64 + j]);
        *(LAS unsigned short*)(lds + RS_A2T + j * 144 + c * 2) = (unsigned short)f2bf(P->in[I_A2][(size_t)l * 64 * 512 + c * 512 + hh * 64 + j]); }
    for (int i = tid; i < 128 * 64; i += 512) { const int c = i >> 6, j = i & 63;
        *(LAS unsigned short*)(lds + RS_G2T + j * 272 + c * 2) = (unsigned short)f2bf(P->in[I_G2][(size_t)l * 128 * 512 + c * 512 + hh * 64 + j]); }
    for (int i = tid; i < 448; i += 512) { const int p = i >> 3, e = i & 7; int col; if (p < 24) col = (p >> 3) * 512 + hh * 64 + (p & 7) * 8; else col = 1536 + (p - 24) * 8; ((LAS float*)(lds + RS_MU))[i] = mu[col + e]; }
    if (tid < 448) { const int a = tid >> 6, j = tid & 63; const float* src = a == 0 ? w0 : a == 1 ? a0 : a == 2 ? kkw : a == 3 ? kaw : a == 4 ? rkw : a == 5 ? lng : lnb; ((LAS float*)(lds + RS_CST))[tid] = src[j]; }
    v2f S2[4];
#pragma unroll
    for (int i = 0; i < 4; ++i) S2[i] = (v2f){0.f, 0.f};
    v4u pc[RS_NP], pp[RS_NP];
#define RS_LOADPIECES(T0) do { _Pragma("unroll") for (int it = 0; it < RS_NP; ++it) { const int idx = tid + it * 512; pc[it] = (v4u){0u, 0u, 0u, 0u}; pp[it] = (v4u){0u, 0u, 0u, 0u}; \
        if (idx < RS_TT * 56) { const int p = idx / RS_TT, tt = idx % RS_TT, t = (T0) + tt; int col; if (p < 24) col = (p >> 3) * 512 + hh * 64 + (p & 7) * 8; else col = 1536 + (p - 24) * 8; \
            const size_t g = (size_t)(b * T + t) * NA + C_RW + col; pc[it] = *(const v4u*)(proj + g); if (t > 0) pp[it] = *(const v4u*)(proj + g - NA); } } } while (0)
    RS_LOADPIECES(0);
#pragma unroll 1
    for (int t0 = 0; t0 < T; t0 += RS_TT) {
        __syncthreads();
#pragma unroll
        for (int it = 0; it < RS_NP; ++it) { const int idx = tid + it * 512; if (idx < RS_TT * 56) { const int p = idx / RS_TT, tt = idx % RS_TT;
            const v4u hc = pc[it], hp = pp[it];
            const v4f m0 = *(const LAS v4f*)(lds + RS_MU + p * 32), m1 = *(const LAS v4f*)(lds + RS_MU + p * 32 + 16);
            float z[8];
#pragma unroll
            for (int e = 0; e < 4; ++e) { const float c0 = bflo(hc[e]), c1 = bfhi(hc[e]), p0 = bflo(hp[e]), p1 = bfhi(hp[e]); const float ma = e < 2 ? m0[2 * e] : m1[2 * e - 4], mb = e < 2 ? m0[2 * e + 1] : m1[2 * e - 3];
                z[2 * e] = c0 + ma * (p0 - c0); z[2 * e + 1] = c1 + mb * (p1 - c1); }
            if (p < 24) { LAS float* dst = (LAS float*)(lds + (p < 8 ? RS_ZR : (p < 16 ? RS_ZK : RS_ZV)) + (tt * 64 + (p & 7) * 8) * 4);
                *(LAS v4f*)dst = (v4f){z[0], z[1], z[2], z[3]}; *(LAS v4f*)(dst + 4) = (v4f){z[4], z[5], z[6], z[7]}; }
            else { v4u o;
                if (p < 32) {
#pragma unroll
                    for (int e = 0; e < 4; ++e) o[e] = cvtpk(1.0f - 2.0f * __builtin_amdgcn_rcpf(1.0f + __expf(2.0f * z[2 * e])), 1.0f - 2.0f * __builtin_amdgcn_rcpf(1.0f + __expf(2.0f * z[2 * e + 1])));
                    *(LAS v4u*)(lds + RS_XW + tt * 144 + (p - 24) * 16) = o; }
                else if (p < 40) {
#pragma unroll
                    for (int e = 0; e < 4; ++e) o[e] = cvtpk(z[2 * e], z[2 * e + 1]);
                    *(LAS v4u*)(lds + RS_XA + tt * 144 + (p - 32) * 16) = o; }
                else {
#pragma unroll
                    for (int e = 0; e < 4; ++e) o[e] = cvtpk(__builtin_amdgcn_rcpf(1.0f + __expf(-z[2 * e])), __builtin_amdgcn_rcpf(1.0f + __expf(-z[2 * e + 1])));
                    *(LAS v4u*)(lds + RS_XG + tt * 272 + (p - 40) * 16) = o; } }
        } }
        __syncthreads();
        if (w < 6) { const int which = w >> 1, jt = w & 1; f32x16 acc;
#pragma unroll
            for (int i = 0; i < 16; ++i) acc[i] = 0.f;
            if (which < 2) { const int wo = which == 0 ? RS_W2T : RS_A2T, xo = which == 0 ? RS_XW : RS_XA;
#pragma unroll
                for (int s = 0; s < 4; ++s) { const bf16x8v af = *(const LAS bf16x8v*)(lds + wo + (32 * jt + r32) * 144 + (16 * s + 8 * h2) * 2), bfr = *(const LAS bf16x8v*)(lds + xo + r32 * 144 + (16 * s + 8 * h2) * 2);
                    acc = __builtin_amdgcn_mfma_f32_32x32x16_bf16(af, bfr, acc, 0, 0, 0); } }
            else {
#pragma unroll
                for (int s = 0; s < 8; ++s) { const bf16x8v af = *(const LAS bf16x8v*)(lds + RS_G2T + (32 * jt + r32) * 272 + (16 * s + 8 * h2) * 2), bfr = *(const LAS bf16x8v*)(lds + RS_XG + r32 * 272 + (16 * s + 8 * h2) * 2);
                    acc = __builtin_amdgcn_mfma_f32_32x32x16_bf16(af, bfr, acc, 0, 0, 0); } }
            const int oo = which == 0 ? RS_WL : (which == 1 ? RS_AL : RS_GL);
#pragma unroll
            for (int q4 = 0; q4 < 4; ++q4) *(LAS v4f*)(lds + oo + (r32 * 64 + 32 * jt + 8 * q4 + 4 * h2) * 4) = (v4f){acc[4 * q4], acc[4 * q4 + 1], acc[4 * q4 + 2], acc[4 * q4 + 3]}; }
        __syncthreads();
        { const int tt = tid >> 4, j0 = (tid & 15) * 4; const int o4 = (tt * 64 + j0) * 4;
          const v4f wl = *(const LAS v4f*)(lds + RS_WL + o4), al = *(const LAS v4f*)(lds + RS_AL + o4), zk = *(const LAS v4f*)(lds + RS_ZK + o4), zr = *(const LAS v4f*)(lds + RS_ZR + o4);
          const v4f w0v = *(const LAS v4f*)(lds + RS_CST + j0 * 4), a0v = *(const LAS v4f*)(lds + RS_CST + 256 + j0 * 4), kkv = *(const LAS v4f*)(lds + RS_CST + 512 + j0 * 4), kav = *(const LAS v4f*)(lds + RS_CST + 768 + j0 * 4), rkv = *(const LAS v4f*)(lds + RS_CST + 1024 + j0 * 4);
          v4f dcy, alp, kk0, km; float ssq = 0.f, bsum = 0.f;
#pragma unroll
          for (int e = 0; e < 4; ++e) { const float x = -(wl[e] + w0v[e]); const float sp = fmaxf(x, 0.f) + __logf(1.0f + __expf(-fabsf(x)));
              dcy[e] = __expf(-__expf(-sp - 0.5f)); alp[e] = __builtin_amdgcn_rcpf(1.0f + __expf(-(al[e] + a0v[e])));
              kk0[e] = zk[e] * kkv[e]; ssq += kk0[e] * kk0[e]; km[e] = zk[e] * (1.0f + (alp[e] - 1.0f) * kav[e]); bsum += zr[e] * km[e] * rkv[e]; }
          ssq = sum16(ssq); bsum = sum16(bsum);
          const float inv = __builtin_amdgcn_rcpf(fmaxf(__builtin_amdgcn_sqrtf(ssq), 1e-12f));
          v4f avv, bvv;
#pragma unroll
          for (int e = 0; e < 4; ++e) { const float kk = kk0[e] * inv; avv[e] = -kk; bvv[e] = kk * alp[e]; }
          *(LAS v4f*)(lds + RS_WL + o4) = dcy; *(LAS v4f*)(lds + RS_AL + o4) = bvv; *(LAS v4f*)(lds + RS_AV + o4) = avv; *(LAS v4f*)(lds + RS_ZK + o4) = km;
          if ((tid & 15) == 0) *(LAS float*)(lds + RS_BS + tt * 4) = bsum; }
        __syncthreads();
        if (t0 + RS_TT < T) RS_LOADPIECES(t0 + RS_TT);
#if PROBE_SCAN2
        v2f Ssave[4];
#pragma unroll
        for (int i = 0; i < 4; ++i) Ssave[i] = S2[i];
        for (int rep_ = 0; rep_ < 2; ++rep_) { if (rep_ == 1) {
#pragma unroll
            for (int i = 0; i < 4; ++i) S2[i] = Ssave[i]; }
#endif
        { const int v_ = tid >> 3, ks = tid & 7; LAS unsigned char* sb = lds + ks * 32; LAS unsigned char* vb = lds + RS_ZV + v_ * 4; LAS unsigned char* yb = lds + RS_YS + v_ * 4;
#pragma unroll
          for (int tt = 0; tt < RS_TT; ++tt) { const int o8 = tt * 256;
              const v4f a0_ = *(const LAS v4f*)(sb + RS_AV + o8), a1_ = *(const LAS v4f*)(sb + RS_AV + o8 + 16);
              const v4f d0_ = *(const LAS v4f*)(sb + RS_WL + o8), d1_ = *(const LAS v4f*)(sb + RS_WL + o8 + 16);
              const v4f b0_ = *(const LAS v4f*)(sb + RS_AL + o8), b1_ = *(const LAS v4f*)(sb + RS_AL + o8 + 16);
              const v4f k0_ = *(const LAS v4f*)(sb + RS_ZK + o8), k1_ = *(const LAS v4f*)(sb + RS_ZK + o8 + 16);
              const v4f r0_ = *(const LAS v4f*)(sb + RS_ZR + o8), r1_ = *(const LAS v4f*)(sb + RS_ZR + o8 + 16);
              const float vv = *(const LAS float*)(vb + o8);
              v2f ac = S2[0] * a0_.xy; ac = __builtin_elementwise_fma(S2[1], a0_.zw, ac); ac = __builtin_elementwise_fma(S2[2], a1_.xy, ac); ac = __builtin_elementwise_fma(S2[3], a1_.zw, ac);
              const float sa = sum8(ac.x + ac.y); const v2f sa2 = (v2f){sa, sa}, vv2 = (v2f){vv, vv};
              S2[0] = __builtin_elementwise_fma(S2[0], d0_.xy, __builtin_elementwise_fma(k0_.xy, vv2, b0_.xy * sa2));
              S2[1] = __builtin_elementwise_fma(S2[1], d0_.zw, __builtin_elementwise_fma(k0_.zw, vv2, b0_.zw * sa2));
              S2[2] = __builtin_elementwise_fma(S2[2], d1_.xy, __builtin_elementwise_fma(k1_.xy, vv2, b1_.xy * sa2));
              S2[3] = __builtin_elementwise_fma(S2[3], d1_.zw, __builtin_elementwise_fma(k1_.zw, vv2, b1_.zw * sa2));
              v2f yc = S2[0] * r0_.xy; yc = __builtin_elementwise_fma(S2[1], r0_.zw, yc); yc = __builtin_elementwise_fma(S2[2], r1_.xy, yc); yc = __builtin_elementwise_fma(S2[3], r1_.zw, yc);
              const float y = sum8(yc.x + yc.y);
              if (ks == 0) *(LAS float*)(yb + o8) = y; } }
#if PROBE_SCAN2
        }
#endif
        __syncthreads();
        { const int tt = tid >> 4, v0 = (tid & 15) * 4; const int o4 = (tt * 64 + v0) * 4;
          const v4f y4 = *(const LAS v4f*)(lds + RS_YS + o4), zv = *(const LAS v4f*)(lds + RS_ZV + o4), gl = *(const LAS v4f*)(lds + RS_GL + o4);
          const float mean = sum16((y4[0] + y4[1]) + (y4[2] + y4[3])) * (1.f / 64.f);
          const v4f d = y4 - mean; const float var = sum16((d[0] * d[0] + d[1] * d[1]) + (d[2] * d[2] + d[3] * d[3])) * (1.f / 64.f);
          const float rstd = rsqrtf(var + 64e-5f), bs = *(const LAS float*)(lds + RS_BS + tt * 4);
          const v4f lg4 = *(const LAS v4f*)(lds + RS_CST + 1280 + v0 * 4), lb4 = *(const LAS v4f*)(lds + RS_CST + 1536 + v0 * 4);
          float o[4];
#pragma unroll
          for (int e = 0; e < 4; ++e) o[e] = (d[e] * rstd * lg4[e] + lb4[e] + bs * zv[e]) * gl[e];
          v2u ow; ow[0] = cvtpk(o[0], o[1]); ow[1] = cvtpk(o[2], o[3]);
          *(v2u*)(mixo + (size_t)(b * T + t0 + tt) * NMIX + 512 + hh * 64 + v0) = ow; }
    }
    __syncthreads();
#undef RS_LOADPIECES
}
__device__ __forceinline__ void rwkv_phase(KP P, int l, LAS unsigned char* lds, int vcu, int G) {
    for (int unit = vcu; unit < BATCH * 8; unit += G) rwkv_unit(P, l, lds, unit >> 3, unit & 7);
}

#define RC_BAR() do { asm volatile("s_waitcnt lgkmcnt(0)" ::: "memory"); __builtin_amdgcn_s_barrier(); asm volatile("" ::: "memory"); } while (0)
constexpr int RC_SL = 9216;
constexpr int RC_A = 0 * RC_SL, RC_B = 1 * RC_SL, RC_K = 2 * RC_SL, RC_R = 3 * RC_SL, RC_V = 4 * RC_SL, RC_G = 5 * RC_SL, RC_S = 6 * RC_SL;
constexpr int RC_XW = 7 * RC_SL, RC_XA = 8 * RC_SL, RC_XG = 9 * RC_SL, RC_WL = 11 * RC_SL, RC_AL = 13 * RC_SL, RC_LW = 14 * RC_SL;
constexpr int RC_DINV = RC_B, RC_DINVT = RC_K, RC_NT = 9 * RC_SL, RC_P = RC_B, RC_UT = RC_V, RC_BHT = RC_XW, RC_KHT = RC_XA, RC_VT = 9 * RC_SL, RC_LAB = 10 * RC_SL, RC_N = RC_LAB, RC_TINV = RC_LAB;
constexpr int RC_LABT = 11 * RC_SL, RC_N2 = RC_LABT, RC_RHST = RC_LABT, RC_LAK = 12 * RC_SL, RC_MRB = 13 * RC_SL, RC_MRK = RC_LW;
constexpr int RC_SM = RC_LW + 16384, RC_BS = RC_SM, RC_GC = RC_SM + 256, RC_PT = RC_SM + 512, RC_SSB = RC_PT + 2048, RC_DIAG = RC_SSB + 1024, RC_MU = RC_DIAG + 4096, RC_CST = RC_MU + 1792, RC_END = RC_CST + 1792;
static_assert(RC_END <= 156928, "chunked rwkv LDS");
template <int KSTEPS, int SA = 144, int SB = 144> __device__ __forceinline__ f32x16 rc_mm(f32x16 acc, const LAS unsigned char* A, int arow0, const LAS unsigned char* B, int brow0, int r32, int h, int kofs = 0) {
#pragma unroll
    for (int s = 0; s < KSTEPS; ++s) { const bf16x8v af = *(const LAS bf16x8v*)(A + (arow0 + r32) * SA + (kofs + 16 * s + 8 * h) * 2), bfr = *(const LAS bf16x8v*)(B + (brow0 + r32) * SB + (kofs + 16 * s + 8 * h) * 2);
        acc = __builtin_amdgcn_mfma_f32_32x32x16_bf16(af, bfr, acc, 0, 0, 0); }
    return acc;
}
__device__ __forceinline__ f32x16 rc_zero() { f32x16 z;
#pragma unroll
    for (int i = 0; i < 16; ++i) z[i] = 0.f;
    return z; }
template <int KSTEPS> __device__ __forceinline__ f32x16 rc_mm2(f32x16 acc, const LAS unsigned char* A, int arow0, const LAS unsigned char* B, int brow0, int r32, int h) {
    f32x16 a1 = rc_zero();
#pragma unroll
    for (int s = 0; s < KSTEPS; ++s) { const bf16x8v af = *(const LAS bf16x8v*)(A + (arow0 + r32) * 144 + (16 * s + 8 * h) * 2), bfr = *(const LAS bf16x8v*)(B + (brow0 + r32) * 144 + (16 * s + 8 * h) * 2);
        if (s & 1) a1 = __builtin_amdgcn_mfma_f32_32x32x16_bf16(af, bfr, a1, 0, 0, 0); else acc = __builtin_amdgcn_mfma_f32_32x32x16_bf16(af, bfr, acc, 0, 0, 0); }
#pragma unroll
    for (int i = 0; i < 16; ++i) acc[i] += a1[i];
    return acc;
}
__device__ __forceinline__ bf16x8v rc_frag_bd(const LAS unsigned char* cb, int row, int s, int h) {
    v4u z = (v4u){0u, 0u, 0u, 0u}; if ((row >> 4) == s) z = *(const LAS v4u*)(cb + (row >> 4) * 1024 + ((row & 15) * 16 + 8 * h) * 2); return __builtin_bit_cast(bf16x8v, z); }
template <bool BD_A> __device__ __forceinline__ f32x16 rc_mm_bd(f32x16 acc, const LAS unsigned char* A, int arow0, const LAS unsigned char* B, int brow0, int r32, int h) {
    f32x16 a1 = rc_zero();
#pragma unroll
    for (int s = 0; s < 4; ++s) { const bf16x8v af = BD_A ? rc_frag_bd(A, arow0 + r32, s, h) : *(const LAS bf16x8v*)(A + (arow0 + r32) * 144 + (16 * s + 8 * h) * 2);
        const bf16x8v bfr = BD_A ? *(const LAS bf16x8v*)(B + (brow0 + r32) * 144 + (16 * s + 8 * h) * 2) : rc_frag_bd(B, brow0 + r32, s, h);
        if (s & 1) a1 = __builtin_amdgcn_mfma_f32_32x32x16_bf16(af, bfr, a1, 0, 0, 0); else acc = __builtin_amdgcn_mfma_f32_32x32x16_bf16(af, bfr, acc, 0, 0, 0); }
#pragma unroll
    for (int i = 0; i < 16; ++i) acc[i] += a1[i];
    return acc;
}
__device__ __forceinline__ void rc_store_t(const f32x16& d, LAS unsigned char* O, int arow0, int brow0, int r32, int h) {
#pragma unroll
    for (int q4 = 0; q4 < 4; ++q4) { v2u o; o[0] = cvtpk(d[4 * q4], d[4 * q4 + 1]); o[1] = cvtpk(d[4 * q4 + 2], d[4 * q4 + 3]); *(LAS v2u*)(O + (brow0 + r32) * 144 + (arow0 + 8 * q4 + 4 * h) * 2) = o; }
}
__device__ __forceinline__ void rwkv_prepass(KP P, int l, int b, int j, int rows) {
    const int tid = otid(), p = tid & 31;
    const bf16* proj = (const bf16*)(P->ws + WS_BIG); bf16* zs = (bf16*)((unsigned char*)P->out + OUT_ZS);
    const v4f* mup = (const v4f*)(P->in[I_MU] + l * RWC + 1536 + 8 * p); const v4f m0 = mup[0], m1 = mup[1];
    const float be = p < 8 ? -2.f : -1.f, al = p < 8 ? 2.f : 1.f, ga = p < 8 ? -1.f : 0.f; const bool plain = (p >= 8 && p < 16);
#pragma unroll 4
    for (int r = tid >> 5; r < rows; r += 16) { const int t = j * rows + r; const size_t g = (size_t)(b * T + t) * NA + C_RW + 1536 + 8 * p;
        const v4u hc = *(const v4u*)(proj + g); v4u hp = (v4u){0u, 0u, 0u, 0u}; if (t > 0) hp = *(const v4u*)(proj + g - NA);
        v4u o;
#pragma unroll
        for (int e = 0; e < 4; ++e) { const float c0 = bflo(hc[e]), c1 = bfhi(hc[e]), p0 = bflo(hp[e]), p1 = bfhi(hp[e]); const float ma = e < 2 ? m0[2 * e] : m1[2 * e - 4], mb = e < 2 ? m0[2 * e + 1] : m1[2 * e - 3];
            const float z0 = c0 + ma * (p0 - c0), z1 = c1 + mb * (p1 - c1);
            const float s0 = al * __builtin_amdgcn_rcpf(1.0f + __expf(be * z0)) + ga, s1 = al * __builtin_amdgcn_rcpf(1.0f + __expf(be * z1)) + ga;
            o[e] = cvtpk(plain ? z0 : s0, plain ? z1 : s1); }
        *(v4u*)(zs + (size_t)(b * T + t) * 256 + 8 * p) = o; }
}
__device__ __forceinline__ void rwkvc_unit(KP P, int l, LAS unsigned char* lds, int b, int hh) {
    const int tid = otid(), w = __builtin_amdgcn_readfirstlane(tid >> 6), lane = tid & 63, r32 = lane & 31, h = lane >> 5;
    const bf16* proj = (const bf16*)(P->ws + WS_BIG); bf16* mixo = (bf16*)(P->ws + WS_MIXO);
    const float* mu = P->in[I_MU] + l * RWC; const float* w0 = P->in[I_W0] + l * 512 + hh * 64; const float* a0 = P->in[I_A0] + l * 512 + hh * 64;
    const float* kkw = P->in[I_KK] + l * 512 + hh * 64; const float* kaw = P->in[I_KA] + l * 512 + hh * 64; const float* rkw = P->in[I_RK] + l * 512 + hh * 64;
    const float* lng = P->in[I_LNG] + l * 512 + hh * 64; const float* lnb = P->in[I_LNB] + l * 512 + hh * 64;
    __syncthreads();
    for (int i = tid; i < 448; i += 512) { const int p = i >> 3, e = i & 7; int col; if (p < 24) col = (p >> 3) * 512 + hh * 64 + (p & 7) * 8; else col = 1536 + (p - 24) * 8; ((LAS float*)(lds + RC_MU))[i] = mu[col + e]; }
    if (tid < 448) { const int a = tid >> 6, j = tid & 63; const float* src = a == 0 ? w0 : a == 1 ? a0 : a == 2 ? kkw : a == 3 ? kaw : a == 4 ? rkw : a == 5 ? lng : lnb; ((LAS float*)(lds + RC_CST))[tid] = src[j]; }
    bf16x8v wf[8];
    { const int jt = w & 1, j = hh * 64 + 32 * jt + r32;
#pragma unroll
      for (int s = 0; s < 8; ++s) { unsigned short e[8];
#pragma unroll
          for (int i = 0; i < 8; ++i) { float x; if (w < 4) { const int c = 16 * (s & 3) + 8 * h + i; x = (s < 4 ? P->in[I_W2] : P->in[I_A2])[(size_t)l * 64 * 512 + c * 512 + j]; } else { const int c = 16 * s + 8 * h + i; x = P->in[I_G2][(size_t)l * 128 * 512 + c * 512 + j]; }
              e[i] = (unsigned short)f2bf(x); }
          v4u pk; pk[0] = e[0] | ((unsigned)e[1] << 16); pk[1] = e[2] | ((unsigned)e[3] << 16); pk[2] = e[4] | ((unsigned)e[5] << 16); pk[3] = e[6] | ((unsigned)e[7] << 16);
          wf[s] = __builtin_bit_cast(bf16x8v, pk); } }
    f32x16 Sacc = rc_zero();
    v4u pc[3], pp[3], zc[4];
    const bf16* zs = (const bf16*)((const unsigned char*)P->out + OUT_ZS);
#define RC_LOADPIECES(T0) do { _Pragma("unroll") for (int it = 0; it < 3; ++it) { const int q_ = it * 8 + (tid >> 6), tt = 8 * (q_ / 3) + ((tid & 63) >> 3), t = (T0) + tt; \
            const size_t g = (size_t)(b * T + t) * NA + C_RW + (q_ % 3) * 512 + hh * 64 + (tid & 7) * 8; pc[it] = *(const v4u*)(proj + g); pp[it] = (v4u){0u, 0u, 0u, 0u}; if (t > 0) pp[it] = *(const v4u*)(proj + g - NA); } \
        _Pragma("unroll") for (int it = 0; it < 4; ++it) { const int q2 = it * 8 + (tid >> 6), tt = 8 * (q2 >> 2) + ((tid & 63) >> 3); zc[it] = *(const v4u*)(zs + (size_t)(b * T + (T0) + tt) * 256 + (8 * (q2 & 3) + (tid & 7)) * 8); } } while (0)
    RC_LOADPIECES(0);
#pragma unroll 1
    for (int t0 = 0; t0 < T; t0 += 64) {
        f32x16 xacc, yacc;
        RC_BAR();
        { const int tid = otid(), w = __builtin_amdgcn_readfirstlane(tid >> 6), lane = tid & 63, r32 = lane & 31, h = lane >> 5; (void)w; (void)lane; (void)r32; (void)h;
        if (w < 4) rc_store_t(Sacc, lds + RC_S, 32 * (w >> 1), 32 * (w & 1), r32, h);
#pragma unroll
        for (int it = 0; it < 3; ++it) { const int q_ = it * 8 + (tid >> 6), g = q_ % 3, p = 8 * g + (tid & 7), tt = 8 * (q_ / 3) + ((tid & 63) >> 3);
            const v4u hc = pc[it], hp = pp[it];
            const v4f m0 = *(const LAS v4f*)(lds + RC_MU + p * 32), m1 = *(const LAS v4f*)(lds + RC_MU + p * 32 + 16);
            v4u o;
#pragma unroll
            for (int e = 0; e < 4; ++e) { const float c0 = bflo(hc[e]), c1 = bfhi(hc[e]), p0 = bflo(hp[e]), p1 = bfhi(hp[e]); const float ma = e < 2 ? m0[2 * e] : m1[2 * e - 4], mb = e < 2 ? m0[2 * e + 1] : m1[2 * e - 3];
                o[e] = cvtpk(c0 + ma * (p0 - c0), c1 + mb * (p1 - c1)); }
            *(LAS v4u*)(lds + (g == 0 ? RC_R : (g == 1 ? RC_K : RC_V)) + tt * 144 + (tid & 7) * 16) = o; }
#pragma unroll
        for (int it = 0; it < 4; ++it) { const int q2 = it * 8 + (tid >> 6), qu = q2 & 3, tt = 8 * (q2 >> 2) + ((tid & 63) >> 3), pl = tid & 7;
            const int dst = qu == 0 ? RC_XW + tt * 144 + pl * 16 : (qu == 1 ? RC_XA + tt * 144 + pl * 16 : RC_XG + tt * 272 + ((qu - 2) * 8 + pl) * 16);
            *(LAS v4u*)(lds + dst) = zc[it]; }
        }
        RC_BAR();
        { const int tid = otid(), w = __builtin_amdgcn_readfirstlane(tid >> 6), lane = tid & 63, r32 = lane & 31, h = lane >> 5; (void)w; (void)lane; (void)r32; (void)h;
        { const int tt = (w >> 1) & 1, jt = w & 1;
          if (w < 4) { f32x16 aw = rc_zero(), aa = rc_zero();
#pragma unroll
              for (int s = 0; s < 4; ++s) { const bf16x8v xw = *(const LAS bf16x8v*)(lds + RC_XW + (32 * tt + r32) * 144 + (16 * s + 8 * h) * 2), xa = *(const LAS bf16x8v*)(lds + RC_XA + (32 * tt + r32) * 144 + (16 * s + 8 * h) * 2);
                  aw = __builtin_amdgcn_mfma_f32_32x32x16_bf16(wf[s], xw, aw, 0, 0, 0); aa = __builtin_amdgcn_mfma_f32_32x32x16_bf16(wf[4 + s], xa, aa, 0, 0, 0); }
#pragma unroll
              for (int q4 = 0; q4 < 4; ++q4) *(LAS v4f*)(lds + RC_WL + ((32 * tt + r32) * 64 + 32 * jt + 8 * q4 + 4 * h) * 4) = (v4f){aw[4 * q4], aw[4 * q4 + 1], aw[4 * q4 + 2], aw[4 * q4 + 3]};
              rc_store_t(aa, lds + RC_AL, 32 * jt, 32 * tt, r32, h); }
          else { f32x16 ag = rc_zero();
#pragma unroll
              for (int s = 0; s < 8; ++s) { const bf16x8v xg = *(const LAS bf16x8v*)(lds + RC_XG + (32 * tt + r32) * 272 + (16 * s + 8 * h) * 2); ag = __builtin_amdgcn_mfma_f32_32x32x16_bf16(wf[s], xg, ag, 0, 0, 0); }
              rc_store_t(ag, lds + RC_G, 32 * jt, 32 * tt, r32, h); } }
        }
        RC_BAR();
        { const int tid = otid(), w = __builtin_amdgcn_readfirstlane(tid >> 6), lane = tid & 63, r32 = lane & 31, h = lane >> 5; (void)w; (void)lane; (void)r32; (void)h;
        { const int t = tid >> 3, j0 = (tid & 7) * 8; const int ob = t * 144 + j0 * 2;
          const v4f wl0 = *(const LAS v4f*)(lds + RC_WL + (t * 64 + j0) * 4), wl1 = *(const LAS v4f*)(lds + RC_WL + (t * 64 + j0 + 4) * 4);
          const v4u alw = *(const LAS v4u*)(lds + RC_AL + ob), kw = *(const LAS v4u*)(lds + RC_K + ob), rw = *(const LAS v4u*)(lds + RC_R + ob);
          float lw[8], alp[8], kk0[8], km[8]; float ssq = 0.f, bsum = 0.f;
          v4f cst[5][2];
#pragma unroll
          for (int a = 0; a < 5; ++a) { cst[a][0] = *(const LAS v4f*)(lds + RC_CST + a * 256 + j0 * 4); cst[a][1] = *(const LAS v4f*)(lds + RC_CST + a * 256 + j0 * 4 + 16); }
#pragma unroll
          for (int e = 0; e < 8; ++e) { const float wl = e < 4 ? wl0[e & 3] : wl1[e & 3]; const float cw0 = cst[0][e >> 2][e & 3], ca0 = cst[1][e >> 2][e & 3];
              const float ckk = cst[2][e >> 2][e & 3], cka = cst[3][e >> 2][e & 3], crk = cst[4][e >> 2][e & 3];
              const float al = (e & 1) ? bfhi(alw[e >> 1]) : bflo(alw[e >> 1]), kr = (e & 1) ? bfhi(kw[e >> 1]) : bflo(kw[e >> 1]), rr = (e & 1) ? bfhi(rw[e >> 1]) : bflo(rw[e >> 1]);
              lw[e] = -0.60653066f * __builtin_amdgcn_rcpf(1.0f + __expf(-(wl + cw0)));
              alp[e] = __builtin_amdgcn_rcpf(1.0f + __expf(-(al + ca0)));
              kk0[e] = kr * ckk; ssq += kk0[e] * kk0[e]; km[e] = kr * (1.0f + (alp[e] - 1.0f) * cka); bsum += rr * km[e] * crk; }
          ssq = sum8(ssq); bsum = sum8(bsum);
          const float inv = __builtin_amdgcn_rcpf(fmaxf(__builtin_amdgcn_sqrtf(ssq), 1e-12f));
          v4u ao, bo, ko;
#pragma unroll
          for (int e = 0; e < 4; ++e) { const float ka = kk0[2 * e] * inv, kb = kk0[2 * e + 1] * inv; ao[e] = cvtpk(-ka, -kb); bo[e] = cvtpk(ka * alp[2 * e], kb * alp[2 * e + 1]); ko[e] = cvtpk(km[2 * e], km[2 * e + 1]); }
          *(LAS v4u*)(lds + RC_A + ob) = ao; *(LAS v4u*)(lds + RC_B + ob) = bo; *(LAS v4u*)(lds + RC_K + ob) = ko;
          *(LAS v4f*)(lds + RC_LW + (t * 64 + j0) * 4) = (v4f){lw[0], lw[1], lw[2], lw[3]}; *(LAS v4f*)(lds + RC_LW + (t * 64 + j0 + 4) * 4) = (v4f){lw[4], lw[5], lw[6], lw[7]};
          if ((tid & 7) == 0) *(LAS float*)(lds + RC_BS + t * 4) = bsum; }
        }
        RC_BAR();
        { const int tid = otid(), w = __builtin_amdgcn_readfirstlane(tid >> 6), lane = tid & 63, r32 = lane & 31, h = lane >> 5; (void)w; (void)lane; (void)r32; (void)h;
        { const int k = tid & 63, tq = tid >> 6; float c[8]; float run = 0.f;
#pragma unroll
          for (int i = 0; i < 8; ++i) { run += *(const LAS float*)(lds + RC_LW + ((8 * tq + i) * 64 + k) * 4); c[i] = run; }
          *(LAS float*)(lds + RC_PT + (tq * 64 + k) * 4) = run;
          RC_BAR();
          float base = 0.f;
#pragma unroll
          for (int q = 0; q < 7; ++q) { const float pv = *(const LAS float*)(lds + RC_PT + (q * 64 + k) * 4); base += (q < tq) ? pv : 0.f; }
#pragma unroll
          for (int i = 0; i < 8; ++i) *(LAS float*)(lds + RC_LW + ((8 * tq + i) * 64 + k) * 4) = c[i] + base;
          if (tq == 7) *(LAS float*)(lds + RC_GC + k * 4) = __expf(c[7] + base); }
        }
        RC_BAR();
        { const int tid = otid(), w = __builtin_amdgcn_readfirstlane(tid >> 6), lane = tid & 63, r32 = lane & 31, h = lane >> 5; (void)w; (void)lane; (void)r32; (void)h;
        { const int t = tid >> 3, j0 = (tid & 7) * 8; const int ob = t * 144 + j0 * 2;
          const v4f c0 = *(const LAS v4f*)(lds + RC_LW + (t * 64 + j0) * 4), c1 = *(const LAS v4f*)(lds + RC_LW + (t * 64 + j0 + 4) * 4);
          v4f p0 = (v4f){0.f, 0.f, 0.f, 0.f}, p1 = p0; if (t > 0) { p0 = *(const LAS v4f*)(lds + RC_LW + ((t - 1) * 64 + j0) * 4); p1 = *(const LAS v4f*)(lds + RC_LW + ((t - 1) * 64 + j0 + 4) * 4); }
          const v4u aw = *(const LAS v4u*)(lds + RC_A + ob), bw = *(const LAS v4u*)(lds + RC_B + ob), kw = *(const LAS v4u*)(lds + RC_K + ob), rw = *(const LAS v4u*)(lds + RC_R + ob);
          v4u ao, bo, ko, ro;
#pragma unroll
          for (int e = 0; e < 4; ++e) { const float cA = e < 2 ? c0[2 * e] : c1[2 * e - 4], cB = e < 2 ? c0[2 * e + 1] : c1[2 * e - 3], pA = e < 2 ? p0[2 * e] : p1[2 * e - 4], pB = e < 2 ? p0[2 * e + 1] : p1[2 * e - 3];
              const float e1a = __expf(cA), e1b = __expf(cB), e0a = __expf(pA), e0b = __expf(pB), eia = __builtin_amdgcn_rcpf(e1a), eib = __builtin_amdgcn_rcpf(e1b);
              ao[e] = cvtpk(bflo(aw[e]) * e0a, bfhi(aw[e]) * e0b); ro[e] = cvtpk(bflo(rw[e]) * e1a, bfhi(rw[e]) * e1b);
              bo[e] = cvtpk(bflo(bw[e]) * eia, bfhi(bw[e]) * eib); ko[e] = cvtpk(bflo(kw[e]) * eia, bfhi(kw[e]) * eib); }
          *(LAS v4u*)(lds + RC_A + ob) = ao; *(LAS v4u*)(lds + RC_B + ob) = bo; *(LAS v4u*)(lds + RC_K + ob) = ko; *(LAS v4u*)(lds + RC_R + ob) = ro; }
        }
        RC_BAR();
        { const int tid = otid(), w = __builtin_amdgcn_readfirstlane(tid >> 6), lane = tid & 63, r32 = lane & 31, h = lane >> 5; (void)w; (void)lane; (void)r32; (void)h;
        if (w == 0 || w == 3) { const int tq = w == 0 ? 0 : 1; f32x16 d = rc_zero(); d = rc_mm2<4>(d, lds + RC_B, 32 * tq, lds + RC_A, 32 * tq, r32, h);
            const int n = 32 * tq + r32;
#pragma unroll
            for (int i = 0; i < 16; ++i) { const int m = 32 * tq + 8 * (i >> 2) + 4 * h + (i & 3); if ((m >> 4) == (n >> 4)) *(LAS float*)(lds + RC_DIAG + ((n >> 4) * 256 + (m & 15) * 16 + (n & 15)) * 4) = (m < n) ? d[i] : 0.f; }
            asm volatile("s_waitcnt lgkmcnt(0)" ::: "memory");
            if (lane < 32) { const int blk = 2 * tq + (lane >> 4), c = lane & 15; float x[16];
#pragma unroll
                for (int t = 0; t < 16; ++t) x[t] = (t == c) ? 1.f : 0.f;
#pragma unroll
                for (int j = 0; j < 15; ++j) {
#pragma unroll
                    for (int q = (j + 1) >> 2; q < 4; ++q) { const v4f l4 = *(const LAS v4f*)(lds + RC_DIAG + (blk * 256 + j * 16 + 4 * q) * 4);
#pragma unroll
                        for (int e = 0; e < 4; ++e) { const int t = 4 * q + e; if (t > j) x[t] += l4[e] * x[j]; } } }
                asm volatile("s_waitcnt lgkmcnt(0)" ::: "memory");
                LAS unsigned char* cb = lds + RC_DIAG + blk * 1024;
#pragma unroll
                for (int t = 0; t < 16; ++t) *(LAS unsigned short*)(cb + (t * 16 + c) * 2) = (unsigned short)f2bf(x[t]);
                v4u o0, o1;
#pragma unroll
                for (int e = 0; e < 4; ++e) { o0[e] = cvtpk(x[2 * e], x[2 * e + 1]); o1[e] = cvtpk(x[8 + 2 * e], x[9 + 2 * e]); }
                *(LAS v4u*)(cb + 512 + c * 32) = o0; *(LAS v4u*)(cb + 512 + c * 32 + 16) = o1; } }
        else { const int slot = w < 3 ? w - 1 : w - 2;
#pragma unroll 1
            for (int kq = 0; kq < 3; ++kq) { const int q = (slot == 4 && kq == 2) ? 15 : slot + 6 * kq; if (q >= 16 || (slot == 3 && kq == 2)) break;
                const int blk = 1 + (q >> 2), ta = (q >> 1) & 1, tb = q & 1;
                const int ao = blk == 1 ? RC_A : blk == 2 ? RC_K : blk == 3 ? RC_B : RC_K, bo = blk == 1 ? RC_B : blk == 2 ? RC_A : RC_R;
                const int oo = blk == 1 ? RC_LABT : blk == 2 ? RC_LAK : blk == 3 ? RC_MRB : RC_MRK;
                f32x16 d = rc_zero();
                const bool dead = (blk == 1) ? (tb > ta) : (ta > tb);
                if (!dead) d = rc_mm2<4>(d, lds + ao, 32 * ta, lds + bo, 32 * tb, r32, h);
                if (ta == tb) { const int n = 32 * tb + r32;
#pragma unroll
                    for (int i = 0; i < 16; ++i) { const int m = 32 * ta + 8 * (i >> 2) + 4 * h + (i & 3); bool keep;
                        if (blk == 1) keep = (n < m) && ((n >> 4) != (m >> 4)); else if (blk < 3) keep = m < n; else keep = m <= n;
                        d[i] = keep ? d[i] : 0.f; } }
                rc_store_t(d, lds + oo, 32 * ta, 32 * tb, r32, h); } }
        }
        RC_BAR();
        { const int tid = otid(), w = __builtin_amdgcn_readfirstlane(tid >> 6), lane = tid & 63, r32 = lane & 31, h = lane >> 5; (void)w; (void)lane; (void)r32; (void)h;
        { const int ta = (w >> 1) & 1, tb = w & 1; f32x16 d = rc_zero();
          if (w < 4) { d = rc_mm_bd<false>(d, lds + RC_LABT, 32 * ta, lds + RC_DIAG, 32 * tb, r32, h); }
          else       { d = rc_mm_bd<true>(d, lds + RC_DIAG, 32 * ta, lds + RC_LABT, 32 * tb, r32, h); }
          rc_store_t(d, lds + (w < 4 ? RC_N : RC_NT), 32 * ta, 32 * tb, r32, h); }
        }
        RC_BAR();
        { const int tid = otid(), w = __builtin_amdgcn_readfirstlane(tid >> 6), lane = tid & 63, r32 = lane & 31, h = lane >> 5; (void)w; (void)lane; (void)r32; (void)h;
        xacc = rc_zero();
        if (w < 4) { const int ta = (w >> 1) & 1, tb = w & 1;
            xacc = rc_mm2<4>(xacc, lds + RC_NT, 32 * ta, lds + RC_N, 32 * tb, r32, h);
#pragma unroll
            for (int i = 0; i < 16; ++i) { const int m = 32 * ta + 8 * (i >> 2) + 4 * h + (i & 3), n = 32 * tb + r32; if (m == n) xacc[i] += 1.0f; } }
        if (w >= 4) { const int t4 = tid - 256, k = t4 >> 2, tg = t4 & 3; const float gc = *(const LAS float*)(lds + RC_GC + k * 4);
#pragma unroll
            for (int i = 0; i < 16; ++i) { const int t = tg + 4 * i;
                const float bt = bf2f(*(const LAS unsigned short*)(lds + RC_B + t * 144 + k * 2)), kt = bf2f(*(const LAS unsigned short*)(lds + RC_K + t * 144 + k * 2));
                *(LAS unsigned short*)(lds + RC_BHT + k * 144 + t * 2) = (unsigned short)f2bf(bt * gc); *(LAS unsigned short*)(lds + RC_KHT + k * 144 + t * 2) = (unsigned short)f2bf(kt * gc); } }
        if (w < 4) { const int ta = (w >> 1) & 1, tb = w & 1;
#pragma unroll
            for (int i = 0; i < 16; ++i) { const int m = 32 * ta + 8 * (i >> 2) + 4 * h + (i & 3), n = 32 * tb + r32; *(LAS unsigned short*)(lds + RC_N2 + m * 144 + n * 2) = (unsigned short)f2bf(xacc[i]); } }
        }
        RC_BAR();
        { const int tid = otid(), w = __builtin_amdgcn_readfirstlane(tid >> 6), lane = tid & 63, r32 = lane & 31, h = lane >> 5; (void)w; (void)lane; (void)r32; (void)h;
        if (w < 4) { const int ta = (w >> 1) & 1, tb = w & 1;
            xacc = rc_mm2<4>(xacc, lds + RC_N2, 32 * ta, lds + RC_N, 32 * tb, r32, h);
            rc_store_t(xacc, lds + RC_P, 32 * ta, 32 * tb, r32, h); }
        else { const int t4 = tid - 256, k = t4 >> 2, tg = t4 & 3;
#pragma unroll
            for (int i = 0; i < 16; ++i) { const int t = tg + 4 * i; *(LAS unsigned short*)(lds + RC_VT + k * 144 + t * 2) = *(const LAS unsigned short*)(lds + RC_V + t * 144 + k * 2); } }
        }
        RC_BAR();
        { const int tid = otid(), w = __builtin_amdgcn_readfirstlane(tid >> 6), lane = tid & 63, r32 = lane & 31, h = lane >> 5; (void)w; (void)lane; (void)r32; (void)h;
        { const int ta = (w >> 1) & 1, tb = w & 1; f32x16 d = rc_zero();
          if (w < 4) { d = rc_mm_bd<true>(d, lds + RC_DIAG + 512, 32 * ta, lds + RC_P, 32 * tb, r32, h); rc_store_t(d, lds + RC_TINV, 32 * ta, 32 * tb, r32, h); }
          else { d = rc_mm2<4>(d, lds + RC_A, 32 * ta, lds + RC_S, 32 * tb, r32, h); d = rc_mm2<4>(d, lds + RC_LAK, 32 * ta, lds + RC_VT, 32 * tb, r32, h); rc_store_t(d, lds + RC_RHST, 32 * ta, 32 * tb, r32, h); } }
        if (t0 + 64 < T) RC_LOADPIECES(t0 + 64);
        }
        RC_BAR();
        { const int tid = otid(), w = __builtin_amdgcn_readfirstlane(tid >> 6), lane = tid & 63, r32 = lane & 31, h = lane >> 5; (void)w; (void)lane; (void)r32; (void)h;
        if (w < 4) { const int ta = (w >> 1) & 1, tb = w & 1; f32x16 d = rc_zero(); d = rc_mm2<4>(d, lds + RC_TINV, 32 * ta, lds + RC_RHST, 32 * tb, r32, h); rc_store_t(d, lds + RC_UT, 32 * ta, 32 * tb, r32, h); }
        }
        RC_BAR();
        { const int tid = otid(), w = __builtin_amdgcn_readfirstlane(tid >> 6), lane = tid & 63, r32 = lane & 31, h = lane >> 5; (void)w; (void)lane; (void)r32; (void)h;
        yacc = rc_zero();
        { const int ta = (w >> 1) & 1, tb = w & 1;
          if (w < 4) {
#pragma unroll
              for (int i = 0; i < 16; ++i) Sacc[i] *= *(const LAS float*)(lds + RC_GC + (32 * ta + 8 * (i >> 2) + 4 * h + (i & 3)) * 4);
              Sacc = rc_mm2<4>(Sacc, lds + RC_BHT, 32 * ta, lds + RC_UT, 32 * tb, r32, h); Sacc = rc_mm2<4>(Sacc, lds + RC_KHT, 32 * ta, lds + RC_VT, 32 * tb, r32, h); }
          else { yacc = rc_mm2<4>(yacc, lds + RC_S, 32 * ta, lds + RC_R, 32 * tb, r32, h); yacc = rc_mm2<4>(yacc, lds + RC_UT, 32 * ta, lds + RC_MRB, 32 * tb, r32, h); yacc = rc_mm2<4>(yacc, lds + RC_VT, 32 * ta, lds + RC_MRK, 32 * tb, r32, h);
              float s1 = 0.f, s2 = 0.f;
#pragma unroll
              for (int i = 0; i < 16; ++i) { s1 += yacc[i]; s2 += yacc[i] * yacc[i]; }
              s1 += __shfl_xor(s1, 32); s2 += __shfl_xor(s2, 32);
              if (h == 0) { *(LAS float*)(lds + RC_SSB + ((w - 4) * 32 + r32) * 8) = s1; *(LAS float*)(lds + RC_SSB + ((w - 4) * 32 + r32) * 8 + 4) = s2; } } }
        }
        RC_BAR();
        { const int tid = otid(), w = __builtin_amdgcn_readfirstlane(tid >> 6), lane = tid & 63, r32 = lane & 31, h = lane >> 5; (void)w; (void)lane; (void)r32; (void)h;
        if (w >= 4) { const int ta = (w >> 1) & 1, tb = w & 1, t = 32 * tb + r32;
            const float a1 = *(const LAS float*)(lds + RC_SSB + ((w - 4) * 32 + r32) * 8), a2 = *(const LAS float*)(lds + RC_SSB + ((w - 4) * 32 + r32) * 8 + 4);
            const float b1 = *(const LAS float*)(lds + RC_SSB + (((w - 4) ^ 2) * 32 + r32) * 8), b2 = *(const LAS float*)(lds + RC_SSB + (((w - 4) ^ 2) * 32 + r32) * 8 + 4);
            const float mean = (a1 + b1) * (1.f / 64.f), var = fmaxf((a2 + b2) * (1.f / 64.f) - mean * mean, 0.f), rstd = rsqrtf(var + 64e-5f), bs = *(const LAS float*)(lds + RC_BS + t * 4);
#pragma unroll
            for (int q4 = 0; q4 < 4; ++q4) { const int v0 = 32 * ta + 8 * q4 + 4 * h; const v2u gw = *(const LAS v2u*)(lds + RC_G + t * 144 + v0 * 2);
                const v4f lg4 = *(const LAS v4f*)(lds + RC_CST + 1280 + v0 * 4), lb4 = *(const LAS v4f*)(lds + RC_CST + 1536 + v0 * 4); float o[4];
#pragma unroll
                for (int e = 0; e < 4; ++e) { const float vv = bf2f(*(const LAS unsigned short*)(lds + RC_VT + (v0 + e) * 144 + t * 2)); const float g = (e & 1) ? bfhi(gw[e >> 1]) : bflo(gw[e >> 1]);
                    o[e] = ((yacc[4 * q4 + e] - mean) * rstd * lg4[e] + lb4[e] + bs * vv) * g; }
                v2u ow; ow[0] = cvtpk(o[0], o[1]); ow[1] = cvtpk(o[2], o[3]);
                *(v2u*)(mixo + (size_t)(b * T + t0 + t) * NMIX + 512 + hh * 64 + v0) = ow; } }

        }
    }
    __syncthreads();
#undef RC_LOADPIECES
}
__device__ __forceinline__ void rwkvc_phase(KP P, int l, LAS unsigned char* lds, int vcu, int G) {
    for (int unit = vcu; unit < BATCH * 8; unit += G) rwkvc_unit(P, l, lds, unit >> 3, unit & 7);
}

#define XB_TMO      128
#define XB_XCNT(j)  (256  + 64 * (j))
#define XB_XSUB(j)  (1280 + 64 * (j))
#define XB_XGEN(j)  (2304 + 64 * (j))
#define XB_TOP      3328
#define XB_TOPGEN   3392
#define XCD_BAR_WORDS 3456
#define XB_SPIN_CAP (1u << 18)
__device__ __forceinline__ unsigned xb_ld(unsigned* p)              { return __hip_atomic_load(p, __ATOMIC_RELAXED, __HIP_MEMORY_SCOPE_AGENT); }
__device__ __forceinline__ unsigned xb_add(unsigned* p, unsigned v) { return __hip_atomic_fetch_add(p, v, __ATOMIC_RELAXED, __HIP_MEMORY_SCOPE_AGENT); }
__device__ __forceinline__ unsigned xb_xcc_id() { return (unsigned)__builtin_amdgcn_s_getreg((3 << 11) | 20) & 0xFu; }
#define XB_SPIN(cond, bar) do { unsigned _sp = 0; while (cond) { __builtin_amdgcn_s_sleep(1); \
    if ((++_sp & 255u) == 0u) { if (xb_ld(&(bar)[XB_TMO])) break; if (_sp > XB_SPIN_CAP) { atomicAdd(&(bar)[XB_TMO], 1u); break; } } } } while (0)
struct XcdBarrier {
    unsigned* bar; unsigned x;
    volatile LAS unsigned* st;
    unsigned n;
};
__device__ __forceinline__ XcdBarrier xcd_barrier_post(unsigned* bar, volatile LAS unsigned* st, unsigned n) {
    XcdBarrier b; b.bar = bar; b.x = xb_xcc_id(); b.st = st; b.n = n;
    if (threadIdx.x == 0) (void)xb_add(&bar[XB_XCNT(b.x)], 1u);
    return b;
}
__device__ __forceinline__ void xcd_barrier_complete(unsigned* bar, unsigned x, unsigned G, unsigned& nloc, unsigned& nx) {
    unsigned sum, cnt, mine, sp = 0u;
    for (;;) {
        sum = 0u; cnt = 0u; mine = 0u;
#pragma unroll
        for (unsigned j = 0; j < 16; ++j) { const unsigned c = xb_ld(&bar[XB_XCNT(j)]); sum += c; cnt += (c > 0u) ? 1u : 0u; mine = (j == x) ? c : mine; }
        if (sum == G) break;
        __builtin_amdgcn_s_sleep(1);
        if ((++sp & 255u) == 0u) { if (xb_ld(&bar[XB_TMO])) break; if (sp > XB_SPIN_CAP) { atomicAdd(&bar[XB_TMO], 1u); break; } }
    }
    nloc = mine > 0u ? mine : 1u; nx = cnt > 0u ? cnt : 1u;
}
template <bool LOCAL> __device__ __forceinline__ void xcd_barrier(const XcdBarrier& b) {
    asm volatile("s_waitcnt vmcnt(0)" ::: "memory");
    __syncthreads();
    if (threadIdx.x == 0) {
        unsigned* bar = b.bar;
        __builtin_amdgcn_s_waitcnt(0);
        unsigned nloc = b.st[0], nx = b.st[1];
        if (nloc == 0u) { xcd_barrier_complete(bar, b.x, b.n, nloc, nx); b.st[0] = nloc; b.st[1] = nx; }
        const bool one = LOCAL && nx == 1u;
        const unsigned old = xb_add(&bar[XB_XSUB(b.x)], 1u);
        const unsigned gen = old / nloc;
        if (old + 1u == (gen + 1u) * nloc) {
            if (!one) { __builtin_amdgcn_fence(__ATOMIC_RELEASE, "agent");
                        asm volatile("s_waitcnt vmcnt(0)" ::: "memory"); }
            const unsigned og = xb_add(&bar[XB_TOP], 1u);
            const unsigned tg = og / nx;
            if (og + 1u == (tg + 1u) * nx) xb_add(&bar[XB_TOPGEN], 1u);
            else XB_SPIN(xb_ld(&bar[XB_TOPGEN]) == tg, bar);
            if (!one) __builtin_amdgcn_fence(__ATOMIC_ACQUIRE, "agent");
            else asm volatile("buffer_inv sc0" ::: "memory");
            xb_add(&bar[XB_XGEN(b.x)], 1u);
            asm volatile("s_waitcnt vmcnt(0)" ::: "memory");
        } else {
            XB_SPIN(xb_ld(&bar[XB_XGEN(b.x)]) == gen, bar);
            if (!one) __builtin_amdgcn_fence(__ATOMIC_ACQUIRE, "agent");
            else asm volatile("buffer_inv sc0" ::: "memory");
            asm volatile("s_waitcnt vmcnt(0)" ::: "memory");
        }
    }
    __syncthreads();
}

constexpr int CW_BAR = 4096;
constexpr int MISC_OFF = 156928;
constexpr int CW_HB = 8192;
constexpr int CW_SEQ = 8192 + 512;
constexpr int CW_WDONE = 8192 + 1024;
constexpr int CW_GBAR = 65536;
__device__ __forceinline__ void half_barrier(unsigned* ctl, int cw, unsigned target) {
    asm volatile("s_waitcnt vmcnt(0) lgkmcnt(0)" ::: "memory");
    __syncthreads();
    if (threadIdx.x == 0) {
        (void)xb_add(&ctl[cw], 1u);
        unsigned sp = 0;
        while (xb_ld(&ctl[cw]) < target) { __builtin_amdgcn_s_sleep(2);
            if ((++sp & 255u) == 0u) { if (xb_ld(&ctl[CW_BAR + XB_TMO])) break; if (sp > XB_SPIN_CAP) { atomicAdd(&ctl[CW_BAR + XB_TMO], 1u); break; } } }
        asm volatile("" ::: "memory");
    }
    __syncthreads();
}
__device__ __forceinline__ void half_wait(unsigned* ctl, int cw, unsigned target) {
    if (threadIdx.x == 0) { unsigned sp = 0;
        while (xb_ld(&ctl[cw]) < target) { __builtin_amdgcn_s_sleep(2);
            if ((++sp & 255u) == 0u) { if (xb_ld(&ctl[CW_BAR + XB_TMO])) break; if (sp > XB_SPIN_CAP) { atomicAdd(&ctl[CW_BAR + XB_TMO], 1u); break; } } }
        asm volatile("" ::: "memory"); }
    __syncthreads();
}
__device__ __forceinline__ void pub_barrier(unsigned* ctl, int cw, unsigned target, bool one) {
    asm volatile("s_waitcnt vmcnt(0)" ::: "memory");
    __syncthreads();
    if (threadIdx.x == 0) {
        if (!one) { __builtin_amdgcn_fence(__ATOMIC_RELEASE, "agent"); asm volatile("s_waitcnt vmcnt(0)" ::: "memory"); }
        (void)xb_add(&ctl[cw], 1u);
        unsigned sp = 0;
        while (xb_ld(&ctl[cw]) < target) { __builtin_amdgcn_s_sleep(1);
            if ((++sp & 255u) == 0u) { if (xb_ld(&ctl[CW_BAR + XB_TMO])) break; if (sp > XB_SPIN_CAP) { atomicAdd(&ctl[CW_BAR + XB_TMO], 1u); break; } } }
        if (!one) __builtin_amdgcn_fence(__ATOMIC_ACQUIRE, "agent"); else asm volatile("buffer_inv sc0" ::: "memory");
        asm volatile("s_waitcnt vmcnt(0)" ::: "memory");
    }
    __syncthreads();
}
#ifndef NAIVE_ATTN
#define NAIVE_ATTN 0
#endif
#ifndef NAIVE_RET
#define NAIVE_RET 0
#endif
#ifndef NAIVE_RWKV
#define NAIVE_RWKV 0
#endif
#define RWKV_CHUNKED 1
#define GROUP_LOCAL 1
#define P1B_FIRST 0
#define ATT_FIRST 0
#ifndef REP_RWKV
#define REP_RWKV 1
#endif
#ifndef REP_ATTN
#define REP_ATTN 1
#endif
#ifndef REP_RET
#define REP_RET 1
#endif
#ifndef REP_G0
#define REP_G0 1
#endif
#ifndef REP_G1
#define REP_G1 1
#endif
#ifndef REP_G2
#define REP_G2 1
#endif
#ifndef REP_G4
#define REP_G4 1
#endif
__global__ void __launch_bounds__(512, 2) k_mega(Params Pv) {
    KP P = (KP)__builtin_amdgcn_kernarg_segment_ptr();
#define PFRESH() asm volatile("" : "+s"(P))
    extern __shared__ __attribute__((aligned(16))) unsigned char lds_[];
    LAS unsigned char* lds = (LAS unsigned char*)lds_;
    const int tid = threadIdx.x, G = gridDim.x, bx = blockIdx.x, vcu = (G % 8 == 0) ? (bx % 8) * (G / 8) + bx / 8 : bx;
    volatile LAS unsigned* MISC = (volatile LAS unsigned*)(lds + MISC_OFF);
    for (int u = tid; u < (LDS_BYTES - MISC_OFF) / 4; u += 512) ((LAS unsigned*)(lds + MISC_OFF))[u] = 0u;
    __syncthreads();
    const int GS = G / 8, grp = vcu / GS, rk = vcu % GS, GSH = GS / 2;
    XcdBarrier bar = xcd_barrier_post((unsigned*)(P->ws + WS_CTL) + CW_BAR, MISC + 8, (unsigned)G);
    { XcdBarrier gb0 = xcd_barrier_post((unsigned*)(P->ws + WS_CTL) + CW_GBAR + 4096 * grp, MISC + 12, (unsigned)GS); (void)gb0; }
#define GRID_BAR() do { asm volatile("" : "+s"(bar.x)); xcd_barrier<false>(bar); } while (0)
#define GROUP_BAR() do { int g_ = grp; asm volatile("" : "+s"(g_)); XcdBarrier gb_; gb_.bar = (unsigned*)(P->ws + WS_CTL) + CW_GBAR + 4096 * g_; gb_.x = xb_xcc_id(); gb_.st = MISC + 12; gb_.n = (unsigned)GS; xcd_barrier<GROUP_LOCAL != 0>(gb_); } while (0)
    PFRESH(); phase_x0(P, vcu, G);
    PFRESH(); phase_wconv_all(P, lds, vcu, G);
    GRID_BAR();
    for (int l = 0; l < DEPTH; ++l) {
        PFRESH(); gemm_phase_of<0>(P, l, lds, G, bx);
        GROUP_BAR();
        PFRESH();
        { unsigned* ctl = (unsigned*)(P->ws + WS_CTL); const int cw = CW_HB + 64 * grp;
          const bool loc = GROUP_LOCAL && MISC[13] == 1u;
          if (rk < GSH) { attn_phase(P, l, lds, 64 * grp + rk, GSH, 64 * grp + GSH * ATT_FIRST); half_barrier(ctl, cw, 0u); PFRESH();
                          { const int npb = GSH / 2; rwkv_prepass(P, l, 2 * grp + rk / npb, rk % npb, T / npb); }
                          pub_barrier(ctl, CW_SEQ + 64 * grp, (unsigned)GSH * (unsigned)(l + 1), loc); PFRESH();
                          for (int unit = 16 * grp + rk; unit < 16 * grp + 16; unit += GSH) rwkvc_unit(P, l, lds, unit >> 3, unit & 7);
                          if (P1B_FIRST > 0) { half_wait(ctl, cw, (unsigned)GS * (unsigned)(l + 1)); PFRESH(); gemm_phase_of<1>(P, l, lds, 8 * GSH, 8 * rk + grp, 12 - P1B_FIRST, P1B_FIRST); } }
          else { const int r2 = rk - GSH;
                 attn_phase(P, l, lds, 64 * grp + GSH * ATT_FIRST + r2, GS - GSH, 64 * grp + 64); __syncthreads();
                 for (int unit = 16 * grp + r2; unit < 16 * grp + 16; unit += GS - GSH) ret_unit(P, lds, unit >> 3, unit & 7);
                 half_barrier(ctl, cw, (unsigned)GS * (unsigned)(l + 1));
                 PFRESH(); gemm_phase_of<1>(P, l, lds, 8 * (GS - GSH), 8 * r2 + grp, 0, 12 - P1B_FIRST); } }
        GROUP_BAR();
        if (l == DEPTH - 1) { if (tid == 0) (void)xb_add((unsigned*)(P->ws + WS_CTL) + CW_WDONE, 1u); }
        PFRESH(); gemm_phase_of<2>(P, l, lds, G, bx);
        GROUP_BAR();
        PFRESH(); gemm_phase_of<3>(P, l, lds, G, bx);
        GROUP_BAR();
        PFRESH(); gemm_phase_of<4>(P, l, lds, G, bx);
        GROUP_BAR();
        if (l == DEPTH - 1) {
            unsigned* ctl = (unsigned*)(P->ws + WS_CTL);
            if (tid == 0) { unsigned sp = 0; while (xb_ld(&ctl[CW_WDONE]) < (unsigned)G) { __builtin_amdgcn_s_sleep(8);
                if ((++sp & 255u) == 0u) { if (xb_ld(&ctl[CW_BAR + XB_TMO])) break; if (sp > XB_SPIN_CAP) { atomicAdd(&ctl[CW_BAR + XB_TMO], 1u); break; } } } }
            __syncthreads(); }
        PFRESH(); gemm_phase_of<5>(P, l, lds, G, bx);
        if (l < DEPTH - 1) GROUP_BAR();
    }
#if PROBE_T
    if (vcu == 0 && tid == 0) { const unsigned long long tt_ = *(volatile unsigned long long*)(P->ws + WS_CTL + 65536) * 8ull; const unsigned long long t0_ = __builtin_amdgcn_s_memrealtime(); while (__builtin_amdgcn_s_memrealtime() - t0_ < tt_) __builtin_amdgcn_s_sleep(8); }
#endif
}

extern "C" void kernel_launch(void* const* d_in, const int* in_sizes, int n_in, void* d_out, int out_size, void* d_ws, size_t ws_size, hipStream_t stream) {
    static int grid = 0;
    if (grid == 0) {
        if (n_in != 25 || out_size != M * D || ws_size < WS_END) { fprintf(stderr, "kernel_launch: unexpected shapes (n_in %d, out %d, ws %zu)\n", n_in, out_size, ws_size); grid = -1; return; }
        int dev = 0, cus = 0, per_cu = 0; if (hipGetDevice(&dev) != hipSuccess || hipDeviceGetAttribute(&cus, hipDeviceAttributeMultiprocessorCount, dev) != hipSuccess) { grid = -1; return; }
        if (hipFuncSetAttribute((const void*)k_mega, hipFuncAttributeMaxDynamicSharedMemorySize, LDS_BYTES) != hipSuccess) { fprintf(stderr, "kernel_launch: hipFuncSetAttribute failed\n"); grid = -1; return; }
        if (hipOccupancyMaxActiveBlocksPerMultiprocessor(&per_cu, (const void*)k_mega, 512, LDS_BYTES) != hipSuccess || per_cu < 1) fprintf(stderr, "kernel_launch: occupancy query reports %d workgroups per CU\n", per_cu);
        (void)hipGetLastError();
        grid = cus - cus % 16;
        if (grid < 16) { grid = -1; return; }
    }
    if (grid < 0) return;
    Params p; memset(&p, 0, sizeof(p));
    for (int i = 0; i < 25; ++i) p.in[i] = (const float*)d_in[i];
    p.out = (float*)d_out; p.ws = (unsigned char*)d_ws;
    (void)hipMemsetAsync((char*)d_ws + WS_CTL, 0, CTL_BYTES, stream);
    hipLaunchKernelGGL(k_mega, dim3(grid), dim3(512), LDS_BYTES, stream, p);
}
```

```cpp
#include <hip/hip_runtime.h>
#include <cstdio>
#include <cstdint>
#include <cstring>

constexpr int D = 1024, BATCH = 16, T = 2048, DEPTH = 4, M = BATCH * T;
constexpr int HD = 64;
constexpr int NA = 4608;
constexpr int NG = 3072;
constexpr int INW = NA + NG;
constexpr int C_AQ = 0, C_AK = 512, C_AV = 640, C_RW = 768, C_RQ = 2560, C_RK = 3072, C_RV = 3584, C_RG = 4096;
constexpr int RWC = 1792;
constexpr int FF = 2816, FF2 = 2 * FF;
constexpr int NMIX = 1536;

constexpr size_t MiB = 1u << 20;
constexpr size_t WS_CTL = 0, CTL_BYTES = 1 * MiB;
constexpr size_t WS_WIN = 1 * MiB;
constexpr size_t WS_WMIX = WS_WIN + (size_t)INW * D * 2;
constexpr size_t WS_WOUT = WS_WMIX + (size_t)D * NMIX * 2;
constexpr size_t WS_WGU = WS_WOUT + (size_t)D * D * 2;
constexpr size_t WS_WDN = WS_WGU + (size_t)FF2 * D * 2;
constexpr size_t WS_XB = 38 * MiB;
constexpr size_t WS_MIXO = 102 * MiB;
constexpr size_t WS_BIG = 198 * MiB;
constexpr size_t WS_MIXED = WS_BIG + 192 * MiB;
constexpr size_t WS_RSS = 486 * MiB;
constexpr size_t WS_ROPE = 488 * MiB;
constexpr size_t WS_ROPE2 = WS_ROPE + 512 * 1024;
constexpr size_t WS_GX = 489 * MiB;
constexpr size_t WS_END = 505 * MiB;
static_assert(WS_WDN + (size_t)D * FF * 2 <= WS_XB && WS_WDN + (size_t)D * FF * 2 - WS_WIN <= 37 * MiB && 3 * 37 * MiB <= (size_t)M * D * 4, "weights fit");
static_assert(WS_BIG + (size_t)M * NA * 2 <= WS_RSS, "big region fits");

#define GAS __attribute__((address_space(1)))
#define LAS __attribute__((address_space(3)))
typedef unsigned short bf16;
typedef unsigned v4u __attribute__((ext_vector_type(4)));
typedef unsigned v2u __attribute__((ext_vector_type(2)));
typedef float v4f __attribute__((ext_vector_type(4)));
__device__ __forceinline__ unsigned f2bf(float f) { unsigned u = __builtin_bit_cast(unsigned, f); return (u + 0x7fffu + ((u >> 16) & 1u)) >> 16; }
__device__ __forceinline__ unsigned pk2(float lo, float hi) { return f2bf(lo) | (f2bf(hi) << 16); }
__device__ __forceinline__ float bf2f(unsigned short b) { return __builtin_bit_cast(float, (unsigned)b << 16); }
__device__ __forceinline__ float bflo(unsigned w) { return __builtin_bit_cast(float, w << 16); }
__device__ __forceinline__ float bfhi(unsigned w) { return __builtin_bit_cast(float, w & 0xffff0000u); }
__device__ __forceinline__ float wave_sum(float v) {
#pragma unroll
    for (int o = 1; o < 64; o <<= 1) v += __shfl_xor(v, o);
    return v;
}
__device__ __forceinline__ float wave_max(float v) {
#pragma unroll
    for (int o = 1; o < 64; o <<= 1) v = fmaxf(v, __shfl_xor(v, o));
    return v;
}
__device__ __forceinline__ float sigmoidf_(float x) { return 1.f / (1.f + __expf(-x)); }

__device__ __forceinline__ int otid() { int t = threadIdx.x; asm volatile("" : "+v"(t)); return t; }

struct Params {
    const float* in[25];
    float* out;
    unsigned char* ws;
    int layer; int pad;
};
typedef const __attribute__((address_space(4))) Params* KP;
constexpr size_t WL_STRIDE = 37 * MiB;
__device__ __forceinline__ unsigned char* wbase(KP P, int l) { return l == DEPTH - 1 ? P->ws : (unsigned char*)P->out + (size_t)l * WL_STRIDE - WS_WIN; }
constexpr size_t OUT_ZS = (DEPTH - 1) * WL_STRIDE;
static_assert(OUT_ZS + (size_t)M * 256 * 2 <= (size_t)M * D * 4, "zs fits in d_out");
enum { I_X = 0, I_N1G, I_WIN, I_QNG, I_KNG, I_SINK, I_WAO, I_MU, I_W0, I_W2, I_A0, I_A2, I_G2, I_KK, I_KA, I_RK, I_LNG, I_LNB, I_WRO, I_WTO, I_WOUT, I_N2G, I_WG, I_WU, I_WD };


namespace pg8 {
#define PG8_LAS __attribute__((address_space(3)))
typedef unsigned short bf16_t;
typedef short bf16x8 __attribute__((ext_vector_type(8)));
typedef float f32x4 __attribute__((ext_vector_type(4)));
typedef unsigned u32x4 __attribute__((ext_vector_type(4)));
constexpr int BM = 256, BK = 64, HALF = 128, HTB = HALF * BK * 2  , STAGE_BYTES = 8 * HTB, NXCD = 8, WGM = 8;

__host__ __device__ __forceinline__ int lds_byte(int r, int c) { const int st = (r >> 4) * 2 + (c >> 5), rr = r & 15, cc = c & 31, ob = rr * 64 + cc * 2; return st * 1024 + (ob ^ (((ob >> 9) & 1) << 5)); }
__host__ __device__ __forceinline__ void stage_rc(int b, int& R, int& C) { const int st = b / 1024, sb = b % 1024, swz = sb ^ (((sb >> 9) & 1) << 5); R = (st >> 1) * 16 + swz / 64; C = (st & 1) * 32 + (swz % 64) / 2; }
__host__ __device__ __forceinline__ int perm32(int rho) { const int n = rho >> 4, i = rho & 15; return 8 * (i >> 2) + 4 * n + (i & 3); }

struct Unit { int pm, pn; };
struct Gemm { const bf16_t* A; const bf16_t* Bt; int M, N, K, lda; };

struct StaticOrder {
    int nM, nN, nwg, G, c, i0, ni;
    __host__ __device__ void init(int M, int N, int G_, int c_) { nM = M / BM; nN = N / BM; nwg = nM * nN; G = G_; c = c_; i0 = 0; ni = 1 << 30; }
    __host__ __device__ bool next(int i, Unit& u) const {
        if (i >= ni) return false;
        const long L = (long)(i0 + i) * G + c; if (L >= nwg) return false;
        int wgid = (int)L; { const int q = nwg / NXCD, r = nwg % NXCD, xcd = wgid % NXCD, off = wgid / NXCD; wgid = (xcd < r ? xcd * (q + 1) : r * (q + 1) + (xcd - r) * q) + off; }
        const int nig = WGM * nN, gid = wgid / nig, fm = gid * WGM, gsz = (nM - fm) < WGM ? (nM - fm) : WGM;
        u.pm = fm + ((wgid % nig) % gsz); u.pn = (wgid % nig) / gsz; return true;
    }
    __device__ __forceinline__ void a_ready(const Unit&) const {}
    __device__ __forceinline__ void done(const Unit&) const {}
};


typedef float f32x2_ __attribute__((ext_vector_type(2))); typedef __bf16 bf16x2_ __attribute__((ext_vector_type(2)));
__device__ __forceinline__ unsigned cvt_pk_bf16(float lo, float hi) { const f32x2_ x = {lo, hi}; return __builtin_bit_cast(unsigned, __builtin_convertvector(x, bf16x2_)); }
__device__ __forceinline__ float clampg(float x) { return __builtin_amdgcn_fmed3f(x, -30.0f, 30.0f); }
__device__ __forceinline__ float row_rstd(const float* rss, int row) {
    const f32x4* p = (const f32x4*)(rss + (size_t)row * 16);
    const f32x4 a = p[0], b = p[1], c = p[2], d = p[3];
    const float s = (((a.x + a.y) + (a.z + a.w)) + ((b.x + b.y) + (b.z + b.w))) + (((c.x + c.y) + (c.z + c.w)) + ((d.x + d.y) + (d.z + d.w)));
    return rsqrtf(s * (1.0f / 1024.0f) + 1e-6f);
}
struct RowTab {
    const float* rss;
    __device__ __forceinline__ void tab_load(const Unit& u, int tid, f32x4& a, f32x4& b) const { const f32x4* p = (const f32x4*)(rss + ((size_t)u.pm * BM + (tid >> 1)) * 16 + (tid & 1) * 8); a = p[0]; b = p[1]; }
    __device__ __forceinline__ void tab_store(PG8_LAS float* tab, int tid, const f32x4& a, const f32x4& b) const {
        float s = ((a.x + a.y) + (a.z + a.w)) + ((b.x + b.y) + (b.z + b.w)); s += __shfl_xor(s, 1);
        if ((tid & 1) == 0) tab[tid >> 1] = rsqrtf(s * (1.0f / 1024.0f) + 1e-6f); }
};
struct EpiRowScale : RowTab {
    static constexpr bool PERM = true, AFTER_DRAIN = false, ROWTAB = true, ACCINIT = false; static constexpr int KSEG = 0;
    bf16_t* O; int ldc;
    __device__ __forceinline__ void operator()(const f32x4 (&acc)[2][2][4][2], const Unit& u, int wr, int wc, int fr, int fq, const PG8_LAS float* tab) const {
        const int row0 = u.pm * BM + wr * 64 + fr, col0 = u.pn * BM + wc * 32 + 8 * fq;
#pragma unroll
        for (int ai = 0; ai < 2; ++ai)
#pragma unroll
            for (int m = 0; m < 4; ++m) { const int row = row0 + ai * HALF + m * 16; const float rs = tab[wr * 64 + fr + ai * HALF + m * 16]; bf16_t* rowp = O + (size_t)row * ldc + col0;
#pragma unroll
                for (int bj = 0; bj < 2; ++bj) { const f32x4 v0 = acc[ai][bj][m][0] * rs, v1 = acc[ai][bj][m][1] * rs;
                    u32x4 w; w.x = cvt_pk_bf16(v0[0], v0[1]); w.y = cvt_pk_bf16(v0[2], v0[3]); w.z = cvt_pk_bf16(v1[0], v1[1]); w.w = cvt_pk_bf16(v1[2], v1[3]);
                    *(u32x4*)(rowp + bj * HALF) = w; } }
    }
};
struct GateMap { bf16_t* proj; bf16_t* gx;
    __device__ __forceinline__ bf16_t* tile(int gt, int& ld) const { if (gt < 11) { ld = 4608; return proj + (gt < 3 ? gt * 256 : 2560 + (gt - 3) * 256); } ld = 256; return gx; } };
struct EpiGates : RowTab {
    static constexpr bool PERM = true, AFTER_DRAIN = false, ROWTAB = true, ACCINIT = false; static constexpr int KSEG = 0;
    GateMap gm;
    __device__ __forceinline__ void operator()(const f32x4 (&acc)[2][2][4][2], const Unit& u, int wr, int wc, int fr, int fq, const PG8_LAS float* tab) const {
        int ld; bf16_t* base = gm.tile(u.pn, ld); const int row0 = u.pm * BM + wr * 64 + fr, col0 = wc * 32 + 8 * fq;
#pragma unroll
        for (int ai = 0; ai < 2; ++ai)
#pragma unroll
            for (int m = 0; m < 4; ++m) { const int row = row0 + ai * HALF + m * 16; const float rs = tab[wr * 64 + fr + ai * HALF + m * 16]; bf16_t* rowp = base + (size_t)row * ld + col0;
#pragma unroll
                for (int bj = 0; bj < 2; ++bj) { const f32x4 v0 = acc[ai][bj][m][0] * rs, v1 = acc[ai][bj][m][1] * rs;
                    u32x4 w; w.x = cvt_pk_bf16(v0[0], v0[1]); w.y = cvt_pk_bf16(v0[2], v0[3]); w.z = cvt_pk_bf16(v1[0], v1[1]); w.w = cvt_pk_bf16(v1[2], v1[3]);
                    *(u32x4*)(rowp + bj * HALF) = w; } }
    }
};
struct EpiSwiglu : RowTab {
    static constexpr bool PERM = true, AFTER_DRAIN = false, ROWTAB = true, ACCINIT = false; static constexpr int KSEG = 0;
    bf16_t* O; int ldc;
    __device__ __forceinline__ void operator()(const f32x4 (&acc)[2][2][4][2], const Unit& u, int wr, int wc, int fr, int fq, const PG8_LAS float* tab) const {
        const int row0 = u.pm * BM + wr * 64 + fr, col0 = u.pn * HALF + wc * 32 + 8 * fq;
#pragma unroll
        for (int ai = 0; ai < 2; ++ai)
#pragma unroll
            for (int m = 0; m < 4; ++m) { const int row = row0 + ai * HALF + m * 16; const float rs = tab[wr * 64 + fr + ai * HALF + m * 16]; bf16_t* rowp = O + (size_t)row * ldc + col0;
                float o[8];
#pragma unroll
                for (int n = 0; n < 2; ++n)
#pragma unroll
                    for (int j = 0; j < 4; ++j) { const float g = acc[ai][0][m][n][j] * rs, up = acc[ai][1][m][n][j] * rs; o[4 * n + j] = g * up * __builtin_amdgcn_rcpf(1.0f + __expf(-g)); }
                u32x4 w; w.x = cvt_pk_bf16(o[0], o[1]); w.y = cvt_pk_bf16(o[2], o[3]); w.z = cvt_pk_bf16(o[4], o[5]); w.w = cvt_pk_bf16(o[6], o[7]);
                *(u32x4*)rowp = w; }
    }
};
struct EpiResid {
    static constexpr bool PERM = true, AFTER_DRAIN = false, ROWTAB = false, ACCINIT = true; static constexpr int KSEG = 0;
    bf16_t* XB; float* rss; float* OUT;
    __device__ __forceinline__ void init(f32x4 (&acc)[2][2][4][2], const Unit& u, int wr, int wc, int fr, int fq) const {
        const int row0 = u.pm * BM + wr * 64 + fr, col0 = u.pn * BM + wc * 32 + 8 * fq;
#pragma unroll
        for (int ai = 0; ai < 2; ++ai) { u32x4 xin[4][2];
#pragma unroll
            for (int m = 0; m < 4; ++m)
#pragma unroll
                for (int bj = 0; bj < 2; ++bj) xin[m][bj] = *(const u32x4*)(XB + (size_t)(row0 + ai * HALF + m * 16) * 1024 + col0 + bj * HALF);
#pragma unroll
            for (int m = 0; m < 4; ++m)
#pragma unroll
                for (int bj = 0; bj < 2; ++bj)
#pragma unroll
                    for (int q = 0; q < 4; ++q) { const unsigned w = xin[m][bj][q]; acc[ai][bj][m][q >> 1][(q & 1) * 2] = __builtin_bit_cast(float, w << 16); acc[ai][bj][m][q >> 1][(q & 1) * 2 + 1] = __builtin_bit_cast(float, w & 0xffff0000u); } }
    }
    __device__ __forceinline__ void operator()(const f32x4 (&acc)[2][2][4][2], const Unit& u, int wr, int wc, int fr, int fq) const {
        const int row0 = u.pm * BM + wr * 64 + fr, col0 = u.pn * BM + wc * 32 + 8 * fq;
#pragma unroll
        for (int g = 0; g < 8; ++g) { const int ai = g >> 2, m = g & 3; const int row = row0 + ai * HALF + m * 16; const size_t off = (size_t)row * 1024 + col0; float ss = 0.f;
#pragma unroll
            for (int bj = 0; bj < 2; ++bj) { const f32x4 x0 = acc[ai][bj][m][0], x1 = acc[ai][bj][m][1];
                ss += ((x0[0] * x0[0] + x0[1] * x0[1]) + (x0[2] * x0[2] + x0[3] * x0[3])) + ((x1[0] * x1[0] + x1[1] * x1[1]) + (x1[2] * x1[2] + x1[3] * x1[3]));
                u32x4 w; w.x = cvt_pk_bf16(x0[0], x0[1]); w.y = cvt_pk_bf16(x0[2], x0[3]); w.z = cvt_pk_bf16(x1[0], x1[1]); w.w = cvt_pk_bf16(x1[2], x1[3]);
                *(u32x4*)(XB + off + bj * HALF) = w;
                if (OUT) { *(f32x4*)(OUT + off + bj * HALF) = x0; *(f32x4*)(OUT + off + bj * HALF + 4) = x1; } }
            ss += __shfl_xor(ss, 16); ss += __shfl_xor(ss, 32);
            if (fq == 0) rss[(size_t)row * 16 + u.pn * 4 + wc] = ss; }
    }
};
struct EpiGateMix {
    static constexpr bool PERM = true, AFTER_DRAIN = false, ROWTAB = false, ACCINIT = false; static constexpr int KSEG = 8;
    GateMap gm; bf16_t* O; int ldo;
    static constexpr int PF = 4;
    __device__ __forceinline__ void seg(f32x4 (&acc)[2][2][4][2], const Unit& u, int s, int wr, int wc, int fr, int fq) const {
        const int row0 = u.pm * BM + wr * 64 + fr, col0 = wc * 32 + 8 * fq; int ldl, ldh; const bf16_t* bl = gm.tile((s - 1) * 4 + u.pn, ldl); const bf16_t* bh = gm.tile(s * 4 + u.pn, ldh);
        u32x4 lo[PF][2], hi[PF][2];
#pragma unroll
        for (int g = 0; g < PF; ++g) { const size_t rown = (size_t)(row0 + (g >> 2) * HALF + (g & 3) * 16);
#pragma unroll
            for (int bj = 0; bj < 2; ++bj) { lo[g][bj] = *(const u32x4*)(bl + rown * ldl + col0 + bj * HALF); hi[g][bj] = *(const u32x4*)(bh + rown * ldh + col0 + bj * HALF); } }
#pragma unroll
        for (int g = 0; g < 8; ++g) { const int ai = g >> 2, m = g & 3, sl = g % PF;
#pragma unroll
            for (int bj = 0; bj < 2; ++bj)
#pragma unroll
                for (int q = 0; q < 4; ++q) { const unsigned wl = lo[sl][bj][q], wh = hi[sl][bj][q];
                    const float l0 = clampg(__builtin_bit_cast(float, wl << 16)), l1 = clampg(__builtin_bit_cast(float, wl & 0xffff0000u)), h0 = clampg(__builtin_bit_cast(float, wh << 16)), h1 = clampg(__builtin_bit_cast(float, wh & 0xffff0000u));
                    const float r0 = (1.0f + __expf(-h0)) * __builtin_amdgcn_rcpf(1.0f + __expf(-l0)), r1 = (1.0f + __expf(-h1)) * __builtin_amdgcn_rcpf(1.0f + __expf(-l1));
                    acc[ai][bj][m][q >> 1][(q & 1) * 2] *= r0; acc[ai][bj][m][q >> 1][(q & 1) * 2 + 1] *= r1; }
            if (g + PF < 8) { const size_t rown = (size_t)(row0 + ((g + PF) >> 2) * HALF + ((g + PF) & 3) * 16);
#pragma unroll
                for (int bj = 0; bj < 2; ++bj) { lo[sl][bj] = *(const u32x4*)(bl + rown * ldl + col0 + bj * HALF); hi[sl][bj] = *(const u32x4*)(bh + rown * ldh + col0 + bj * HALF); } } }
    }
    __device__ __forceinline__ void operator()(const f32x4 (&acc)[2][2][4][2], const Unit& u, int wr, int wc, int fr, int fq) const {
        const int row0 = u.pm * BM + wr * 64 + fr, col0 = wc * 32 + 8 * fq; int ldg; const bf16_t* bg = gm.tile(8 + u.pn, ldg);
        u32x4 gc[PF][2];
#pragma unroll
        for (int g = 0; g < PF; ++g) { const size_t rown = (size_t)(row0 + (g >> 2) * HALF + (g & 3) * 16);
#pragma unroll
            for (int bj = 0; bj < 2; ++bj) gc[g][bj] = *(const u32x4*)(bg + rown * ldg + col0 + bj * HALF); }
#pragma unroll
        for (int gi = 0; gi < 8; ++gi) { const int ai = gi >> 2, m = gi & 3, sl = gi % PF; const int row = row0 + ai * HALF + m * 16; bf16_t* rowp = O + (size_t)row * ldo + u.pn * BM + col0;
#pragma unroll
            for (int bj = 0; bj < 2; ++bj) { const u32x4 g = gc[sl][bj]; float o[8];
#pragma unroll
                for (int q = 0; q < 4; ++q) { const unsigned w = g[q]; const float g0 = clampg(__builtin_bit_cast(float, w << 16)), g1 = clampg(__builtin_bit_cast(float, w & 0xffff0000u));
                    o[2 * q] = acc[ai][bj][m][q >> 1][(q & 1) * 2] * __builtin_amdgcn_rcpf(1.0f + __expf(-g0)); o[2 * q + 1] = acc[ai][bj][m][q >> 1][(q & 1) * 2 + 1] * __builtin_amdgcn_rcpf(1.0f + __expf(-g1)); }
                u32x4 w; w.x = cvt_pk_bf16(o[0], o[1]); w.y = cvt_pk_bf16(o[2], o[3]); w.z = cvt_pk_bf16(o[4], o[5]); w.w = cvt_pk_bf16(o[6], o[7]);
                *(u32x4*)(rowp + bj * HALF) = w; }
            if (gi + PF < 8) { const size_t rown = (size_t)(row0 + ((gi + PF) >> 2) * HALF + ((gi + PF) & 3) * 16);
#pragma unroll
                for (int bj = 0; bj < 2; ++bj) gc[sl][bj] = *(const u32x4*)(bg + rown * ldg + col0 + bj * HALF); } }
    }
};


template <class Epi, class Sched, bool ALIGN_EPI = false, bool SP2 = false>
__device__ __forceinline__ void gemm_phase(PG8_LAS unsigned char* lds, const Gemm g, const Sched& S, const Epi& E) {
    int tid_ = threadIdx.x; asm volatile("" : "+v"(tid_));
    const int tid = tid_, wid = __builtin_amdgcn_readfirstlane(tid >> 6), lane = tid & 63, wr = wid >> 2, wc = wid & 3, fr = lane & 15, fq = lane >> 4;
    const int K = g.K, nt = K / BK;
    unsigned voffA[2], voffB[2];
#pragma unroll
    for (int i = 0; i < 2; ++i) { int R, C; stage_rc(tid * 16 + i * 8192, R, C); const int Rb = Epi::PERM ? ((R & ~31) + perm32(R & 31)) : R;
        voffA[i] = (unsigned)(R * g.lda + C) * 2u; voffB[i] = (unsigned)(Rb * K + C) * 2u; }
    const size_t kstep = (size_t)(BK * 2);
    const size_t hstepB = (size_t)HALF * K * 2, hstepA = (size_t)HALF * g.lda * 2;
    const size_t tstepB = 2 * hstepB, tstepA = 2 * hstepA;
    const unsigned ldsw = (unsigned)wid * 1024u;
    const int aoff = lds_byte(wr * 64 + fr, fq * 8), boff = lds_byte(wc * 32 + fr, fq * 8);
#define PG8_SA(b, h) (((b) * 2 + (h)) * HTB)
#define PG8_SB(b, h) ((4 + (b) * 2 + (h)) * HTB)
#define PG8_STAGE(bufoff, gbase, voff) do { _Pragma("unroll") for (int _i = 0; _i < 2; ++_i) \
        __builtin_amdgcn_global_load_lds((const unsigned*)((const char*)(gbase) + (voff)[_i]), (PG8_LAS unsigned*)(lds + (bufoff) + ldsw + _i * 8192), 16, 0, 0); } while (0)
#define PG8_LDA(dst, b, h) do { _Pragma("unroll") for (int m = 0; m < 4; ++m) _Pragma("unroll") for (int k = 0; k < 2; ++k) dst[m][k] = *(const PG8_LAS bf16x8*)(lds + PG8_SA(b, h) + aoff + m * 2048 + k * 1024); } while (0)
#define PG8_LDB(dst, b, h) do { _Pragma("unroll") for (int n = 0; n < 2; ++n) _Pragma("unroll") for (int k = 0; k < 2; ++k) dst[n][k] = *(const PG8_LAS bf16x8*)(lds + PG8_SB(b, h) + boff + n * 2048 + k * 1024); } while (0)
#define PG8_MMA(ai, bj, At, Bt) do { __builtin_amdgcn_s_setprio(1); _Pragma("unroll") for (int m = 0; m < 4; ++m) _Pragma("unroll") for (int n = 0; n < 2; ++n) _Pragma("unroll") for (int k = 0; k < 2; ++k) \
        acc[ai][bj][m][n] = __builtin_amdgcn_mfma_f32_16x16x32_bf16(Bt[n][k], At[m][k], acc[ai][bj][m][n], 0, 0, 0); __builtin_amdgcn_s_setprio(0); } while (0)
#define PG8_WAIT_V(n) asm volatile("s_waitcnt vmcnt(" #n ")" ::: "memory")
#define PG8_WAIT_L(n) asm volatile("s_waitcnt lgkmcnt(" #n ")" ::: "memory")
#define PG8_BAR __builtin_amdgcn_s_barrier()
#define PG8_SCHED __builtin_amdgcn_sched_barrier(0)
    Unit cur, nxt; int ui = 0;
    if (!S.next(0, cur)) return;
    f32x4 rt0 = (f32x4){0.f, 0.f, 0.f, 0.f}, rt1 = rt0;
    if constexpr (Epi::ROWTAB) { E.tab_load(cur, tid, rt0, rt1); E.tab_store((PG8_LAS float*)(lds + STAGE_BYTES), tid, rt0, rt1); }
    f32x4 acc[2][2][4][2];
#pragma unroll
    for (int a = 0; a < 2; ++a)
#pragma unroll
        for (int b = 0; b < 2; ++b)
#pragma unroll
            for (int m = 0; m < 4; ++m)
#pragma unroll
                for (int n = 0; n < 2; ++n) acc[a][b][m][n] = (f32x4){0.f, 0.f, 0.f, 0.f};
    if constexpr (Epi::ACCINIT) E.init(acc, cur, wr, wc, fr, fq);
    bf16x8 At[4][2], B0[2][2], B1[2][2];
    const char* cA = (const char*)g.A + (size_t)cur.pm * tstepA; const char* cB = (const char*)g.Bt + (size_t)cur.pn * tstepB;
    S.a_ready(cur);
    if constexpr (SP2) {
        PG8_STAGE(PG8_SB(0, 0), cB, voffB); PG8_STAGE(PG8_SB(0, 1), cB + hstepB, voffB); PG8_STAGE(PG8_SA(0, 0), cA, voffA); PG8_STAGE(PG8_SA(0, 1), cA + hstepA, voffA);
        if (wr == 1) PG8_BAR;
        PG8_WAIT_V(2); PG8_BAR;
        PG8_STAGE(PG8_SB(1, 0), cB + kstep, voffB); PG8_STAGE(PG8_SA(1, 0), cA + kstep, voffA); PG8_STAGE(PG8_SB(1, 1), cB + hstepB + kstep, voffB);
        PG8_WAIT_V(6); PG8_BAR;
    } else {
        PG8_STAGE(PG8_SB(0, 0), cB, voffB); PG8_STAGE(PG8_SA(0, 0), cA, voffA); PG8_STAGE(PG8_SB(0, 1), cB + hstepB, voffB); PG8_STAGE(PG8_SA(0, 1), cA + hstepA, voffA);
        if (wr == 1) PG8_BAR;
        PG8_WAIT_V(4); PG8_BAR;
        PG8_STAGE(PG8_SB(1, 0), cB + kstep, voffB); PG8_STAGE(PG8_SA(1, 0), cA + kstep, voffA); PG8_STAGE(PG8_SB(1, 1), cB + hstepB + kstep, voffB);
        PG8_WAIT_V(6); PG8_BAR;
    }
    for (;;) {
        const bool has_next = S.next(ui + 1, nxt);
        const char* nA = has_next ? (const char*)g.A + (size_t)nxt.pm * tstepA : cA; const char* nB = has_next ? (const char*)g.Bt + (size_t)nxt.pn * tstepB : cB;
        for (int t = 0; t < nt; t += 2) {
            const bool last = (t == nt - 2);
            const char* a1 = cA + (size_t)(t + 1) * kstep;
            const char* a2 = last ? nA : cA + (size_t)(t + 2) * kstep; const char* b2 = last ? nB : cB + (size_t)(t + 2) * kstep;
            const char* a3 = a2 + kstep; const char* b3 = b2 + kstep;
            if (last && has_next) S.a_ready(nxt);
            if constexpr (Epi::ROWTAB) { if (has_next) { if (t == nt - 4) E.tab_load(nxt, tid, rt0, rt1);
                                                         if (last) E.tab_store((PG8_LAS float*)(lds + STAGE_BYTES + ((ui + 1) & 1) * 1024), tid, rt0, rt1); } }
            if constexpr (Epi::KSEG > 0) { if (t != 0 && (t % Epi::KSEG) == 0) {
                if constexpr (ALIGN_EPI) { if (wr == 0) PG8_BAR; }
                E.seg(acc, cur, t / Epi::KSEG, wr, wc, fr, fq);
                if constexpr (ALIGN_EPI) { if (wr == 1) PG8_BAR; } } }
            if constexpr (SP2) {
            PG8_LDB(B0, 0, 0); PG8_LDB(B1, 0, 1); PG8_SCHED; PG8_LDA(At, 0, 0); PG8_STAGE(PG8_SA(1, 1), a1 + hstepA, voffA);
            PG8_WAIT_V(8); PG8_WAIT_L(0); PG8_BAR; PG8_MMA(0, 0, At, B0); PG8_MMA(0, 1, At, B1); PG8_BAR; PG8_SCHED;
            PG8_LDA(At, 0, 1); PG8_STAGE(PG8_SB(0, 0), b2, voffB); PG8_STAGE(PG8_SB(0, 1), b2 + hstepB, voffB); PG8_STAGE(PG8_SA(0, 0), a2, voffA);
            PG8_WAIT_V(8); PG8_WAIT_L(0); PG8_BAR; PG8_MMA(1, 0, At, B0); PG8_MMA(1, 1, At, B1); PG8_BAR; PG8_SCHED;
            PG8_LDB(B0, 1, 0); PG8_LDB(B1, 1, 1); PG8_SCHED; PG8_LDA(At, 1, 0); PG8_STAGE(PG8_SA(0, 1), a2 + hstepA, voffA);
            PG8_WAIT_V(8); PG8_WAIT_L(0); PG8_BAR; PG8_MMA(0, 0, At, B0); PG8_MMA(0, 1, At, B1); PG8_BAR; PG8_SCHED;
            PG8_LDA(At, 1, 1); PG8_STAGE(PG8_SB(1, 0), b3, voffB); PG8_STAGE(PG8_SB(1, 1), b3 + hstepB, voffB); PG8_STAGE(PG8_SA(1, 0), a3, voffA);
            PG8_WAIT_V(8); PG8_WAIT_L(0); PG8_BAR; PG8_MMA(1, 0, At, B0); PG8_MMA(1, 1, At, B1); PG8_BAR; PG8_SCHED;
            } else {
            PG8_LDB(B0, 0, 0); PG8_SCHED; PG8_LDA(At, 0, 0); PG8_STAGE(PG8_SA(1, 1), a1 + hstepA, voffA);
            PG8_WAIT_L(8); PG8_BAR; PG8_WAIT_L(0); PG8_MMA(0, 0, At, B0); PG8_BAR; PG8_SCHED;
            PG8_LDB(B1, 0, 1); PG8_STAGE(PG8_SB(0, 0), b2, voffB);
            PG8_BAR; PG8_WAIT_L(0); PG8_MMA(0, 1, At, B1); PG8_BAR;
            PG8_LDA(At, 0, 1); PG8_STAGE(PG8_SA(0, 0), a2, voffA);
            PG8_BAR; PG8_WAIT_L(0); PG8_MMA(1, 0, At, B0); PG8_BAR; PG8_SCHED;
            PG8_STAGE(PG8_SB(0, 1), b2 + hstepB, voffB);
            PG8_WAIT_V(6); PG8_BAR; PG8_MMA(1, 1, At, B1); PG8_BAR;
            PG8_LDB(B0, 1, 0); PG8_SCHED; PG8_LDA(At, 1, 0); PG8_STAGE(PG8_SA(0, 1), a2 + hstepA, voffA);
            PG8_WAIT_L(8); PG8_BAR; PG8_WAIT_L(0); PG8_MMA(0, 0, At, B0); PG8_BAR; PG8_SCHED;
            PG8_LDB(B1, 1, 1); PG8_STAGE(PG8_SB(1, 0), b3, voffB);
            PG8_BAR; PG8_WAIT_L(0); PG8_MMA(0, 1, At, B1); PG8_BAR;
            PG8_LDA(At, 1, 1); PG8_STAGE(PG8_SA(1, 0), a3, voffA);
            PG8_BAR; PG8_WAIT_L(0); PG8_MMA(1, 0, At, B0); PG8_BAR; PG8_SCHED;
            PG8_STAGE(PG8_SB(1, 1), b3 + hstepB, voffB);
            PG8_WAIT_V(6); PG8_BAR; PG8_MMA(1, 1, At, B1); PG8_BAR;
            }
        }
        if constexpr (ALIGN_EPI) { if (wr == 0) PG8_BAR; }
        if constexpr (!Epi::AFTER_DRAIN) { if constexpr (Epi::ROWTAB) E(acc, cur, wr, wc, fr, fq, (const PG8_LAS float*)(lds + STAGE_BYTES + (ui & 1) * 1024)); else E(acc, cur, wr, wc, fr, fq); S.done(cur); }
        if (!has_next) break;
#pragma unroll
        for (int a = 0; a < 2; ++a)
#pragma unroll
            for (int b = 0; b < 2; ++b)
#pragma unroll
                for (int m = 0; m < 4; ++m)
#pragma unroll
                    for (int n = 0; n < 2; ++n) acc[a][b][m][n] = (f32x4){0.f, 0.f, 0.f, 0.f};
        if constexpr (Epi::ACCINIT) E.init(acc, nxt, wr, wc, fr, fq);
        cur = nxt; cA = nA; cB = nB; ++ui;
        if constexpr (ALIGN_EPI) { if (wr == 1) PG8_BAR; }
    }
    PG8_WAIT_V(0);
    if constexpr (!ALIGN_EPI) { if (wr == 0) PG8_BAR; }
    PG8_BAR;
    if constexpr (Epi::AFTER_DRAIN) { E.fused(acc, cur, wr, wc, fr, fq, lds, wid, lane); S.done(cur); }
#undef PG8_SA
#undef PG8_SB
#undef PG8_STAGE
#undef PG8_LDA
#undef PG8_LDB
#undef PG8_MMA
#undef PG8_WAIT_V
#undef PG8_WAIT_L
#undef PG8_BAR
#undef PG8_SCHED
}
}


#define LDS_WAIT() asm volatile("s_waitcnt lgkmcnt(0)" ::: "memory")
constexpr int NWAVES = 8;
constexpr int LDS_BYTES = 157696;

struct WItem { const float* W; const float* scale; bf16* WT; int ldw, k0, n0, ldt, drow0, dcol0; };
constexpr int WI_IN = 16 * 240, WI_MIX = 3 * 8 * 32, WI_OUT = 16 * 32, WI_G = 16 * 88, WI_DN = 44 * 32;
constexpr int WI_TOTAL = WI_IN + WI_MIX + WI_OUT + 2 * WI_G + WI_DN;
__device__ __forceinline__ void witem_desc(KP P, int gi, WItem& d) {
    const int l = gi / WI_TOTAL; int it = gi - l * WI_TOTAL;
    unsigned char* ws = wbase(P, l);
    if (it < WI_IN) { const int kb = it / 240, nb = it % 240; d.W = P->in[I_WIN] + (size_t)l * D * INW; d.ldw = INW; d.k0 = 64 * kb; d.n0 = 32 * nb; d.scale = P->in[I_N1G] + l * D; d.WT = (bf16*)(ws + WS_WIN); d.ldt = D; d.drow0 = 32 * nb; d.dcol0 = 64 * kb; return; }
    it -= WI_IN;
    if (it < WI_MIX) { const int br = it / 256, r = it % 256, kb = r / 32, nb = r % 32; d.W = P->in[br == 0 ? I_WAO : (br == 1 ? I_WRO : I_WTO)] + (size_t)l * 512 * D;
        d.ldw = D; d.k0 = 64 * kb; d.n0 = 32 * nb; d.scale = nullptr; d.WT = (bf16*)(ws + WS_WMIX); d.ldt = NMIX; d.drow0 = 32 * nb; d.dcol0 = br * 512 + 64 * kb; return; }
    it -= WI_MIX;
    if (it < WI_OUT) { const int kb = it / 32, nb = it % 32; d.W = P->in[I_WOUT] + (size_t)l * D * D; d.ldw = D; d.k0 = 64 * kb; d.n0 = 32 * nb; d.scale = nullptr; d.WT = (bf16*)(ws + WS_WOUT); d.ldt = D; d.drow0 = 32 * nb; d.dcol0 = 64 * kb; return; }
    it -= WI_OUT;
    if (it < 2 * WI_G) { const int up = it / WI_G, r = it % WI_G, kb = r / 88, nb = r % 88, n0 = 32 * nb;
        d.W = P->in[up ? I_WU : I_WG] + (size_t)l * D * FF; d.ldw = FF; d.k0 = 64 * kb; d.n0 = n0; d.scale = P->in[I_N2G] + l * D; d.WT = (bf16*)(ws + WS_WGU); d.ldt = D; d.drow0 = (n0 / 128) * 256 + up * 128 + (n0 % 128); d.dcol0 = 64 * kb; return; }
    it -= 2 * WI_G;
    { const int kb = it / 32, nb = it % 32; d.W = P->in[I_WD] + (size_t)l * FF * D; d.ldw = D; d.k0 = 64 * kb; d.n0 = 32 * nb; d.scale = nullptr; d.WT = (bf16*)(ws + WS_WDN); d.ldt = FF; d.drow0 = 32 * nb; d.dcol0 = 64 * kb; }
}
__device__ __forceinline__ void witem_load(const WItem& d, int lane, v4f (&r)[8], v4f (&sc)[2]) {
    const float* src = d.W + (size_t)(d.k0 + (lane >> 3)) * d.ldw + d.n0 + 4 * (lane & 7);
#pragma unroll
    for (int i = 0; i < 8; ++i) r[i] = *(const v4f*)(src + (size_t)(8 * i) * d.ldw);
    sc[0] = (v4f){1.f, 1.f, 1.f, 1.f}; sc[1] = sc[0];
    if (d.scale) { const v4f* sp = (const v4f*)(d.scale + d.k0 + 8 * (lane & 7)); sc[0] = sp[0]; sc[1] = sp[1]; }
}
__device__ __forceinline__ void witem_store(const WItem& d, int lane, const v4f (&r)[8], const v4f (&sc)[2], LAS float* scr) {
    { LAS float* w = scr + (lane >> 3) * 33 + 4 * (lane & 7);
#pragma unroll
      for (int i = 0; i < 8; ++i) { w[(8 * i) * 33 + 0] = r[i].x; w[(8 * i) * 33 + 1] = r[i].y; w[(8 * i) * 33 + 2] = r[i].z; w[(8 * i) * 33 + 3] = r[i].w; } }
    LDS_WAIT(); asm volatile("" ::: "memory");
    const int c = lane & 7;
#pragma unroll
    for (int j = 0; j < 4; ++j) { const int n = (lane >> 3) + 8 * j; const LAS float* s = scr + (8 * c) * 33 + n;
        v4u o; o.x = pk2(s[0 * 33] * sc[0].x, s[1 * 33] * sc[0].y); o.y = pk2(s[2 * 33] * sc[0].z, s[3 * 33] * sc[0].w); o.z = pk2(s[4 * 33] * sc[1].x, s[5 * 33] * sc[1].y); o.w = pk2(s[6 * 33] * sc[1].z, s[7 * 33] * sc[1].w);
        *(v4u*)(d.WT + (size_t)(d.drow0 + n) * d.ldt + d.dcol0 + 8 * c) = o; }
    LDS_WAIT(); asm volatile("" ::: "memory");
}
__device__ __forceinline__ void phase_wconv_all(KP P, LAS unsigned char* lds, int vcu, int G) {
    const int otid_ = otid();
    const int wave = __builtin_amdgcn_readfirstlane(otid_ >> 6), lane = otid_ & 63;
    LAS float* scr = (LAS float*)(lds + wave * 16384);
    const int step = G * NWAVES, total = DEPTH * WI_TOTAL;
    int gi = vcu * NWAVES + wave;
    if (gi >= total) return;
    WItem cur, nxt; v4f rc[8], rn[8], sc[2], sn[2];
    witem_desc(P, gi, cur); witem_load(cur, lane, rc, sc);
#pragma unroll 1
    for (;;) {
        const int gn = gi + step; const bool has_next = gn < total;
        if (has_next) { witem_desc(P, gn, nxt); witem_load(nxt, lane, rn, sn); }
        witem_store(cur, lane, rc, sc, scr);
        if (!has_next) break;
        cur = nxt; gi = gn;
#pragma unroll
        for (int i = 0; i < 8; ++i) rc[i] = rn[i];
        sc[0] = sn[0]; sc[1] = sn[1];
    }
}
__device__ __forceinline__ void phase_x0(KP P, int vcu, int G) {
    const int otid_ = otid();
    const int wave = __builtin_amdgcn_readfirstlane(otid_ >> 6), lane = otid_ & 63;
    const float* x = P->in[I_X]; bf16* xb = (bf16*)(P->ws + WS_XB); float* rss = (float*)(P->ws + WS_RSS);
    for (int m0 = vcu * NWAVES + wave; m0 < M; m0 += 2 * G * NWAVES) {
        v4f v[2][4];
#pragma unroll
        for (int q = 0; q < 2; ++q) { const int m = m0 + q * G * NWAVES; const v4f* xr = (const v4f*)(x + (size_t)(m < M ? m : m0) * D) + lane;
#pragma unroll
            for (int j = 0; j < 4; ++j) v[q][j] = xr[64 * j]; }
#pragma unroll
        for (int q = 0; q < 2; ++q) { const int m = m0 + q * G * NWAVES; if (m < M) { unsigned long long* o8 = (unsigned long long*)(xb + (size_t)m * D) + lane; float s = 0.f;
#pragma unroll
            for (int j = 0; j < 4; ++j) s += (v[q][j].x * v[q][j].x + v[q][j].y * v[q][j].y) + (v[q][j].z * v[q][j].z + v[q][j].w * v[q][j].w);
            s = wave_sum(s);
#pragma unroll
            for (int j = 0; j < 4; ++j) { o8[64 * j] = (unsigned long long)pk2(v[q][j].x, v[q][j].y) | ((unsigned long long)pk2(v[q][j].z, v[q][j].w) << 32); }
            if (lane < 16) rss[(size_t)m * 16 + lane] = lane == 0 ? s : 0.f; } }
    }
    float* rope = (float*)(P->ws + WS_ROPE);
    for (int i = (vcu * NWAVES + wave) * 64 + lane; i < T * 32; i += G * NWAVES * 64) {
        const int t = i >> 5, j = i & 31; const float inv_freq = (float)exp(-((double)j / 32.0) * 9.210340371976184); const float ang = (float)t * inv_freq;
        const double xa = (double)ang, qd = rint(xa * 0.6366197723675814), fd = xa - qd * 1.5707963267948966; const int qi = (int)qd & 3;
        const float ff = (float)fd, f2 = ff * ff;
        const float sf = ff * (1.0f + f2 * (-1.6666667e-1f + f2 * (8.3333333e-3f + f2 * (-1.9841270e-4f + f2 * 2.7557319e-6f))));
        const float cf = 1.0f + f2 * (-0.5f + f2 * (4.1666667e-2f + f2 * (-1.3888889e-3f + f2 * (2.4801587e-5f + f2 * -2.7557319e-7f))));
        const float sn = (qi == 0) ? sf : (qi == 1) ? cf : (qi == 2) ? -sf : -cf, cs = (qi == 0) ? cf : (qi == 1) ? -sf : (qi == 2) ? -cf : sf;
        rope[2 * i] = cs; rope[2 * i + 1] = sn;
        { float* rope2 = (float*)(P->ws + WS_ROPE2); const int p = j >> 3, e = (j & 7) >> 1, o = j & 1;
          const size_t q = (((size_t)e * T + t) * 4 + p) * 4 + 2 * o; rope2[q] = cs; rope2[q + 1] = sn; }
    }
}


#define RESID_ALIGN true
#define STAGGER_US10 0
template <int PH> __device__ __forceinline__ void gemm_phase_of(KP P, int l, LAS unsigned char* lds, int G, int c, int i0 = 0, int ni = 1 << 30) {
    asm volatile("" : "+s"(l), "+s"(G), "+s"(c), "+s"(i0), "+s"(ni));
    const bool final_layer = (l == DEPTH - 1); const unsigned char* wb = wbase(P, l);
    unsigned char* ws = P->ws; const pg8::bf16_t* xb = (const pg8::bf16_t*)(ws + WS_XB); float* rss = (float*)(ws + WS_RSS);
    if constexpr (STAGGER_US10 > 0 && (PH == 0 || PH == 1 || PH == 4)) {
        if (otid() == 0) { const unsigned long long t0 = __builtin_amdgcn_s_memrealtime(), dt = (unsigned long long)(((unsigned)c >> 3) & 7u) * STAGGER_US10 * 10ull;
            while (__builtin_amdgcn_s_memrealtime() - t0 < dt) __builtin_amdgcn_s_sleep(8); }
        __syncthreads(); }
    pg8::StaticOrder S;
    if constexpr (PH == 0) { pg8::Gemm g{xb, (const pg8::bf16_t*)(wb + WS_WIN), M, NA, D, D}; S.init(M, NA, G, c); pg8::EpiRowScale E{{rss}, (pg8::bf16_t*)(ws + WS_BIG), NA};
        pg8::gemm_phase<pg8::EpiRowScale, pg8::StaticOrder, true, true>(lds, g, S, E); }
    if constexpr (PH == 1) { pg8::Gemm g{xb, (const pg8::bf16_t*)(wb + WS_WIN) + (size_t)NA * D, M, NG, D, D}; S.init(M, NG, G, c); S.i0 = i0; S.ni = ni; pg8::EpiGates E{{rss}, pg8::GateMap{(pg8::bf16_t*)(ws + WS_BIG), (pg8::bf16_t*)(ws + WS_GX)}};
        pg8::gemm_phase<pg8::EpiGates, pg8::StaticOrder, true, true>(lds, g, S, E); }
    if constexpr (PH == 2) { pg8::Gemm g{(const pg8::bf16_t*)(ws + WS_MIXO), (const pg8::bf16_t*)(wb + WS_WMIX), M, D, NMIX, NMIX}; S.init(M, D, G, c); pg8::EpiGateMix E{pg8::GateMap{(pg8::bf16_t*)(ws + WS_BIG), (pg8::bf16_t*)(ws + WS_GX)}, (pg8::bf16_t*)(ws + WS_BIG) + C_RW, NA};
        pg8::gemm_phase<pg8::EpiGateMix, pg8::StaticOrder, true, true>(lds, g, S, E); }
    if constexpr (PH == 3) { pg8::Gemm g{(const pg8::bf16_t*)(ws + WS_BIG) + C_RW, (const pg8::bf16_t*)(wb + WS_WOUT), M, D, D, NA}; S.init(M, D, G, c); pg8::EpiResid E{(pg8::bf16_t*)(ws + WS_XB), rss, nullptr};
        pg8::gemm_phase<pg8::EpiResid, pg8::StaticOrder, RESID_ALIGN, true>(lds, g, S, E); }
    if constexpr (PH == 4) { pg8::Gemm g{xb, (const pg8::bf16_t*)(wb + WS_WGU), M, FF2, D, D}; S.init(M, FF2, G, c); pg8::EpiSwiglu E{{rss}, (pg8::bf16_t*)(ws + WS_BIG), NA};
        pg8::gemm_phase<pg8::EpiSwiglu, pg8::StaticOrder, true, true>(lds, g, S, E); }
    if constexpr (PH == 5) { pg8::Gemm g{(const pg8::bf16_t*)(ws + WS_BIG), (const pg8::bf16_t*)(wb + WS_WDN), M, D, FF, NA}; S.init(M, D, G, c); pg8::EpiResid E{(pg8::bf16_t*)(ws + WS_XB), rss, final_layer ? P->out : nullptr};
        pg8::gemm_phase<pg8::EpiResid, pg8::StaticOrder, RESID_ALIGN, true>(lds, g, S, E); }
}

typedef float f32x16 __attribute__((ext_vector_type(16)));
typedef short bf16x8v __attribute__((ext_vector_type(8)));
constexpr int AT_KS = 144;
constexpr int AT_VS = 520;
constexpr int AT_KOFF = 0, AT_VOFF = 256 * AT_KS, AT_GOFF = AT_VOFF + 64 * AT_VS;
typedef float v2f_ __attribute__((ext_vector_type(2)));
typedef __bf16 v2bf_ __attribute__((ext_vector_type(2)));
__device__ __forceinline__ unsigned cvtpk(float lo, float hi) { const v2f_ x = {lo, hi}; return __builtin_bit_cast(unsigned, __builtin_convertvector(x, v2bf_)); }
#define LDS_BAR() do { asm volatile("s_waitcnt lgkmcnt(0)" ::: "memory"); __builtin_amdgcn_s_barrier(); asm volatile("" ::: "memory"); } while (0)
__device__ __forceinline__ void attn_phase(KP P, int l, LAS unsigned char* lds, int u0, int ustep, int uend) {
    const int tid = otid(), w = __builtin_amdgcn_readfirstlane(tid >> 6), lane = tid & 63, r32 = lane & 31, h = lane >> 5;
    const bf16* proj = (const bf16*)(P->ws + WS_BIG); bf16* mixo = (bf16*)(P->ws + WS_MIXO);
    const float* gq = P->in[I_QNG] + l * 64; const float* gk = P->in[I_KNG] + l * 64; const float* sinks = P->in[I_SINK] + l * 8;
    LAS float* gqs = (LAS float*)(lds + AT_GOFF);
    constexpr float LOG2E = 1.4426950408889634f;
    __syncthreads();
    if (tid < 64) { gqs[tid] = gq[tid] * (0.125f * LOG2E); gqs[64 + tid] = gk[tid]; }
    v4u kv[4], vv[4];
#define AT_LOAD(U) do { const int b_ = (U) >> 5, n_ = ((U) >> 1) & 15, kvh_ = (U) & 1, r_ = tid >> 1, hf_ = tid & 1; const size_t grow_ = (size_t)(b_ * T + n_ * 128 - 128 + r_) * NA; \
        _Pragma("unroll") for (int i = 0; i < 4; ++i) { kv[i] = (v4u){0u, 0u, 0u, 0u}; vv[i] = (v4u){0u, 0u, 0u, 0u}; } \
        if ((n_ > 0) || (r_ >= 128)) { _Pragma("unroll") for (int i = 0; i < 4; ++i) { kv[i] = *(const v4u*)(proj + grow_ + C_AK + kvh_ * 64 + hf_ * 32 + 8 * i); vv[i] = *(const v4u*)(proj + grow_ + C_AV + kvh_ * 64 + hf_ * 32 + 8 * i); } } } while (0)
    if (u0 < uend) AT_LOAD(u0);
    for (int unit = u0; unit < uend; unit += ustep) {
        const int b = unit >> 5, n = (unit >> 1) & 15, kvh = unit & 1;
        LDS_BAR();
        {
            const int r = tid >> 1, hf = tid & 1;
            float ss = 0.f;
#pragma unroll
            for (int i = 0; i < 4; ++i)
#pragma unroll
                for (int e = 0; e < 4; ++e) { const float k0 = bflo(kv[i][e]), k1 = bfhi(kv[i][e]); ss += k0 * k0 + k1 * k1; }
            ss += __shfl_xor(ss, 1);
            const float rs = rsqrtf(ss * (1.f / 64.f) + 1e-6f);
#pragma unroll
            for (int i = 0; i < 4; ++i) { v4u o;
#pragma unroll
                for (int e = 0; e < 4; ++e) { const int d = hf * 32 + 8 * i + 2 * e; o[e] = cvtpk(bflo(kv[i][e]) * rs * gqs[64 + d], bfhi(kv[i][e]) * rs * gqs[64 + d + 1]); }
                *(LAS v4u*)(lds + AT_KOFF + r * AT_KS + hf * 64 + 16 * i) = o; }
#pragma unroll
            for (int i = 0; i < 4; ++i)
#pragma unroll
                for (int e = 0; e < 4; ++e) { const int d = hf * 32 + 8 * i + 2 * e;
                    *(LAS unsigned short*)(lds + AT_VOFF + d * AT_VS + r * 2) = (unsigned short)(vv[i][e] & 0xffffu);
                    *(LAS unsigned short*)(lds + AT_VOFF + (d + 1) * AT_VS + r * 2) = (unsigned short)(vv[i][e] >> 16); }
        }
        LDS_BAR();
        if (unit + ustep < uend) AT_LOAD(unit + ustep);
#pragma unroll 1
        for (int gi = 0; gi < 2; ++gi) {
            const int g = w >> 1, sb = (w & 1) * 2 + gi, hq = kvh * 4 + g;
            const size_t qrow = (size_t)(b * T + n * 128 + 32 * sb + r32);
            v4u qr[4]; float ss = 0.f;
#pragma unroll
            for (int s = 0; s < 4; ++s) { qr[s] = *(const v4u*)(proj + qrow * NA + C_AQ + hq * 64 + 8 * h + 16 * s);
#pragma unroll
                for (int e = 0; e < 4; ++e) { const float q0 = bflo(qr[s][e]), q1 = bfhi(qr[s][e]); ss += q0 * q0 + q1 * q1; } }
            ss += __shfl_xor(ss, 32);
            const float rs = rsqrtf(ss * (1.f / 64.f) + 1e-6f);
            bf16x8v Qf[4];
#pragma unroll
            for (int s = 0; s < 4; ++s) { const v4f g0 = *(const LAS v4f*)(gqs + 8 * h + 16 * s), g1 = *(const LAS v4f*)(gqs + 8 * h + 16 * s + 4); v4u o;
                o[0] = cvtpk(bflo(qr[s][0]) * rs * g0[0], bfhi(qr[s][0]) * rs * g0[1]); o[1] = cvtpk(bflo(qr[s][1]) * rs * g0[2], bfhi(qr[s][1]) * rs * g0[3]);
                o[2] = cvtpk(bflo(qr[s][2]) * rs * g1[0], bfhi(qr[s][2]) * rs * g1[1]); o[3] = cvtpk(bflo(qr[s][3]) * rs * g1[2], bfhi(qr[s][3]) * rs * g1[3]);
                Qf[s] = __builtin_bit_cast(bf16x8v, o); }
            f32x16 S[5];
#pragma unroll
            for (int c5 = 0; c5 < 5; ++c5) { f32x16 acc;
#pragma unroll
                for (int i = 0; i < 16; ++i) acc[i] = 0.f;
#pragma unroll
                for (int s = 0; s < 4; ++s) { const bf16x8v kf = *(const LAS bf16x8v*)(lds + AT_KOFF + (32 * (sb + c5) + r32) * AT_KS + (8 * h + 16 * s) * 2);
                    acc = __builtin_amdgcn_mfma_f32_32x32x16_bf16(kf, Qf[s], acc, 0, 0, 0); }
                S[c5] = acc; }
            const int qi = 32 * sb + r32; float mx = -INFINITY;
#pragma unroll
            for (int c5 = 0; c5 < 5; ++c5)
#pragma unroll
                for (int i = 0; i < 16; ++i) { const int si = 32 * (sb + c5) + 8 * (i >> 2) + 4 * h + (i & 3);
                    bool ok = true; if (c5 == 0) ok = si > qi; if (c5 == 4) ok = si <= qi + 128; if (n == 0) ok = ok && (si >= 128);
                    const float v = ok ? S[c5][i] : -INFINITY; S[c5][i] = v; mx = fmaxf(mx, v); }
            mx = fmaxf(mx, __shfl_xor(mx, 32));
            const float sink = sinks[hq] * LOG2E; mx = fmaxf(mx, sink);
            float sum = 0.f;
#pragma unroll
            for (int c5 = 0; c5 < 5; ++c5)
#pragma unroll
                for (int i = 0; i < 16; ++i) { const float p = __builtin_amdgcn_exp2f(S[c5][i] - mx); S[c5][i] = p; sum += p; }
            sum += __shfl_xor(sum, 32);
            const float inv = 1.0f / (sum + __builtin_amdgcn_exp2f(sink - mx));
            f32x16 O[2];
#pragma unroll
            for (int dt = 0; dt < 2; ++dt)
#pragma unroll
                for (int i = 0; i < 16; ++i) O[dt][i] = 0.f;
#pragma unroll
            for (int c5 = 0; c5 < 5; ++c5)
#pragma unroll
                for (int s = 0; s < 2; ++s) { v4u pw; pw[0] = cvtpk(S[c5][8 * s], S[c5][8 * s + 1]); pw[1] = cvtpk(S[c5][8 * s + 2], S[c5][8 * s + 3]); pw[2] = cvtpk(S[c5][8 * s + 4], S[c5][8 * s + 5]); pw[3] = cvtpk(S[c5][8 * s + 6], S[c5][8 * s + 7]);
                    const bf16x8v pf = __builtin_bit_cast(bf16x8v, pw);
#pragma unroll
                    for (int dt = 0; dt < 2; ++dt) { const LAS unsigned char* vp = lds + AT_VOFF + (32 * dt + r32) * AT_VS + (32 * (sb + c5) + 16 * s + 4 * h) * 2;
                        const v2u lo = *(const LAS v2u*)vp, hi = *(const LAS v2u*)(vp + 16); v4u vw; vw[0] = lo[0]; vw[1] = lo[1]; vw[2] = hi[0]; vw[3] = hi[1];
                        O[dt] = __builtin_amdgcn_mfma_f32_32x32x16_bf16(__builtin_bit_cast(bf16x8v, vw), pf, O[dt], 0, 0, 0); } }
#pragma unroll
            for (int dt = 0; dt < 2; ++dt)
#pragma unroll
                for (int q4 = 0; q4 < 4; ++q4) { v2u o; o[0] = cvtpk(O[dt][4 * q4] * inv, O[dt][4 * q4 + 1] * inv); o[1] = cvtpk(O[dt][4 * q4 + 2] * inv, O[dt][4 * q4 + 3] * inv);
                    *(v2u*)(mixo + qrow * NMIX + hq * 64 + 32 * dt + 8 * q4 + 4 * h) = o; }
        }
    }
    __syncthreads();
#undef AT_LOAD
}

constexpr int RT_KS = 144, RT_TS = 272;
constexpr int RT_KOFF = 0, RT_KTOFF = 128 * RT_KS, RT_VTOFF = RT_KTOFF + 64 * RT_TS, RT_ROFF = RT_VTOFF + 64 * RT_TS, RT_SOFF = RT_ROFF + 64 * RT_KS, RT_QOFF = RT_SOFF + 1024, RT_GOFF = RT_QOFF + 128 * RT_KS, RT_END = RT_GOFF + 128 * RT_KS;
static_assert(RT_END <= 131072, "retention LDS");
__device__ __forceinline__ void ret_unit(KP P, LAS unsigned char* lds, int b, int hh) {
    const int tid = otid(), w = __builtin_amdgcn_readfirstlane(tid >> 6), lane = tid & 63, r32 = lane & 31, h = lane >> 5;
    const bf16* proj = (const bf16*)(P->ws + WS_BIG); bf16* mixo = (bf16*)(P->ws + WS_MIXO); const float* rope2 = (const float*)(P->ws + WS_ROPE2);
    const float lg = log2f(1.0f - exp2f(-5.0f - (float)hh));
    const float g128 = exp2f(128.0f * lg);
    const int qg = w >> 1, dt = w & 1;
    f32x16 Racc;
#pragma unroll
    for (int i = 0; i < 16; ++i) Racc[i] = 0.f;
    __syncthreads();
    for (int i = tid; i < 64 * RT_KS / 4; i += 512) ((LAS unsigned*)(lds + RT_ROFF))[i] = 0u;
    v4u pk1, pk2, pv1, pv2, pq1, pq2, pg1, pg2; v4f prk[4];
#define RT_PREFETCH(N) do { const int row_ = tid >> 2, p_ = tid & 3; const size_t g_ = ((size_t)(b * T + (N) * 128) + row_) * NA + hh * 64 + 8 * p_; \
        pk1 = *(const v4u*)(proj + g_ + C_RK); pk2 = *(const v4u*)(proj + g_ + C_RK + 32); pv1 = *(const v4u*)(proj + g_ + C_RV); pv2 = *(const v4u*)(proj + g_ + C_RV + 32); \
        pq1 = *(const v4u*)(proj + g_ + C_RQ); pq2 = *(const v4u*)(proj + g_ + C_RQ + 32); pg1 = *(const v4u*)(proj + g_ + C_RG); pg2 = *(const v4u*)(proj + g_ + C_RG + 32); \
        _Pragma("unroll") for (int e_ = 0; e_ < 4; ++e_) prk[e_] = *(const v4f*)(rope2 + (((size_t)e_ * T + (N) * 128 + row_) * 4 + p_) * 4); } while (0)
    RT_PREFETCH(0);
#pragma unroll 1
    for (int n = 0; n < 16; ++n) {
        const size_t tok0 = (size_t)(b * T + n * 128);
        LDS_BAR();
        {
            const int row = tid >> 2, p = tid & 3;
            const v4u k1 = pk1, k2 = pk2, v1 = pv1, v2 = pv2, q1 = pq1, q2 = pq2;
            const float sc = 0.125f * exp2f(-(float)(row + 1) * lg);
            v4u w1, w2, x1, x2;
#pragma unroll
            for (int e = 0; e < 4; ++e) { const v4f cs = prk[e];
                { const float a1 = bflo(k1[e]), a2 = bflo(k2[e]), b1 = bfhi(k1[e]), b2 = bfhi(k2[e]);
                  w1[e] = cvtpk((a1 * cs[0] - a2 * cs[1]) * sc, (b1 * cs[2] - b2 * cs[3]) * sc); w2[e] = cvtpk((a2 * cs[0] + a1 * cs[1]) * sc, (b2 * cs[2] + b1 * cs[3]) * sc); }
                { const float a1 = bflo(q1[e]), a2 = bflo(q2[e]), b1 = bfhi(q1[e]), b2 = bfhi(q2[e]);
                  x1[e] = cvtpk(a1 * cs[0] - a2 * cs[1], b1 * cs[2] - b2 * cs[3]); x2[e] = cvtpk(a2 * cs[0] + a1 * cs[1], b2 * cs[2] + b1 * cs[3]); } }
            *(LAS v4u*)(lds + RT_KOFF + row * RT_KS + 16 * p) = w1; *(LAS v4u*)(lds + RT_KOFF + row * RT_KS + 64 + 16 * p) = w2;
            *(LAS v4u*)(lds + RT_QOFF + row * RT_KS + 16 * p) = x1; *(LAS v4u*)(lds + RT_QOFF + row * RT_KS + 64 + 16 * p) = x2;
            *(LAS v4u*)(lds + RT_GOFF + row * RT_KS + 16 * p) = pg1; *(LAS v4u*)(lds + RT_GOFF + row * RT_KS + 64 + 16 * p) = pg2;
#pragma unroll
            for (int e = 0; e < 4; ++e) { const int d = 8 * p + 2 * e;
                *(LAS unsigned short*)(lds + RT_KTOFF + d * RT_TS + row * 2) = (unsigned short)(w1[e] & 0xffffu); *(LAS unsigned short*)(lds + RT_KTOFF + (d + 1) * RT_TS + row * 2) = (unsigned short)(w1[e] >> 16);
                *(LAS unsigned short*)(lds + RT_KTOFF + (d + 32) * RT_TS + row * 2) = (unsigned short)(w2[e] & 0xffffu); *(LAS unsigned short*)(lds + RT_KTOFF + (d + 33) * RT_TS + row * 2) = (unsigned short)(w2[e] >> 16);
                *(LAS unsigned short*)(lds + RT_VTOFF + d * RT_TS + row * 2) = (unsigned short)(v1[e] & 0xffffu); *(LAS unsigned short*)(lds + RT_VTOFF + (d + 1) * RT_TS + row * 2) = (unsigned short)(v1[e] >> 16);
                *(LAS unsigned short*)(lds + RT_VTOFF + (d + 32) * RT_TS + row * 2) = (unsigned short)(v2[e] & 0xffffu); *(LAS unsigned short*)(lds + RT_VTOFF + (d + 33) * RT_TS + row * 2) = (unsigned short)(v2[e] >> 16); }
        }
        LDS_BAR();
        if (n + 1 < 16) RT_PREFETCH(n + 1);
        bf16x8v Qf[4];
        const size_t qtok = tok0 + 32 * qg + r32;
#pragma unroll
        for (int s = 0; s < 4; ++s) Qf[s] = *(const LAS bf16x8v*)(lds + RT_QOFF + (32 * qg + r32) * RT_KS + (8 * h + 16 * s) * 2);
        f32x16 O;
#pragma unroll
        for (int i = 0; i < 16; ++i) O[i] = 0.f;
#pragma unroll
        for (int s = 0; s < 4; ++s) { const bf16x8v rf = *(const LAS bf16x8v*)(lds + RT_ROFF + (32 * dt + r32) * RT_KS + (8 * h + 16 * s) * 2);
            O = __builtin_amdgcn_mfma_f32_32x32x16_bf16(rf, Qf[s], O, 0, 0, 0); }
#pragma unroll
        for (int c = 0; c < 4; ++c) { if (c <= qg) {
            f32x16 S;
#pragma unroll
            for (int i = 0; i < 16; ++i) S[i] = 0.f;
#pragma unroll
            for (int s = 0; s < 4; ++s) { const bf16x8v kf = *(const LAS bf16x8v*)(lds + RT_KOFF + (32 * c + r32) * RT_KS + (8 * h + 16 * s) * 2);
                S = __builtin_amdgcn_mfma_f32_32x32x16_bf16(kf, Qf[s], S, 0, 0, 0); }
            if (c == qg) {
#pragma unroll
                for (int i = 0; i < 16; ++i) { const int j = 8 * (i >> 2) + 4 * h + (i & 3); S[i] = (j <= r32) ? S[i] : 0.f; } }
#pragma unroll
            for (int s = 0; s < 2; ++s) { v4u pw; pw[0] = cvtpk(S[8 * s], S[8 * s + 1]); pw[1] = cvtpk(S[8 * s + 2], S[8 * s + 3]); pw[2] = cvtpk(S[8 * s + 4], S[8 * s + 5]); pw[3] = cvtpk(S[8 * s + 6], S[8 * s + 7]);
                const LAS unsigned char* vp = lds + RT_VTOFF + (32 * dt + r32) * RT_TS + (32 * c + 16 * s + 4 * h) * 2;
                const v2u lo = *(const LAS v2u*)vp, hi = *(const LAS v2u*)(vp + 16); v4u vw; vw[0] = lo[0]; vw[1] = lo[1]; vw[2] = hi[0]; vw[3] = hi[1];
                O = __builtin_amdgcn_mfma_f32_32x32x16_bf16(__builtin_bit_cast(bf16x8v, vw), __builtin_bit_cast(bf16x8v, pw), O, 0, 0, 0); } } }
        if (w < 4) { const int et = w >> 1, dtile = w & 1;
#pragma unroll
            for (int s = 0; s < 8; ++s) { const bf16x8v vf = *(const LAS bf16x8v*)(lds + RT_VTOFF + (32 * et + r32) * RT_TS + (16 * s + 8 * h) * 2);
                const bf16x8v kf = *(const LAS bf16x8v*)(lds + RT_KTOFF + (32 * dtile + r32) * RT_TS + (16 * s + 8 * h) * 2);
                Racc = __builtin_amdgcn_mfma_f32_32x32x16_bf16(vf, kf, Racc, 0, 0, 0); }
#pragma unroll
            for (int i = 0; i < 16; ++i) Racc[i] *= g128; }
        const float xi = exp2f((float)(32 * qg + r32 + 1) * lg); float ss = 0.f;
#pragma unroll
        for (int i = 0; i < 16; ++i) { O[i] *= xi; ss += O[i] * O[i]; }
        ss += __shfl_xor(ss, 32);
        LAS float* ssb = (LAS float*)(lds + RT_SOFF);
        if (h == 0) ssb[(qg * 2 + dt) * 32 + r32] = ss;
        LDS_BAR();
        const float rstd = rsqrtf((ss + ssb[(qg * 2 + (dt ^ 1)) * 32 + r32]) * (1.f / 64.f) + 1e-6f);
        if (w < 4) { const int et = w >> 1, dtile = w & 1;
#pragma unroll
            for (int i = 0; i < 16; ++i) { const int e = 32 * et + 8 * (i >> 2) + 4 * h + (i & 3); *(LAS unsigned short*)(lds + RT_ROFF + e * RT_KS + (32 * dtile + r32) * 2) = (unsigned short)f2bf(Racc[i]); } }
#pragma unroll
        for (int q4 = 0; q4 < 4; ++q4) { const int e0 = 32 * dt + 8 * q4 + 4 * h; const v2u gw = *(const LAS v2u*)(lds + RT_GOFF + (32 * qg + r32) * RT_KS + e0 * 2);
            const float g0 = bflo(gw[0]), g1 = bfhi(gw[0]), g2 = bflo(gw[1]), g3 = bfhi(gw[1]);
            v2u o; o[0] = cvtpk(O[4 * q4] * rstd * g0 / (1.0f + __expf(-g0)), O[4 * q4 + 1] * rstd * g1 / (1.0f + __expf(-g1)));
            o[1] = cvtpk(O[4 * q4 + 2] * rstd * g2 / (1.0f + __expf(-g2)), O[4 * q4 + 3] * rstd * g3 / (1.0f + __expf(-g3)));
            *(v2u*)(mixo + qtok * NMIX + 1024 + hh * 64 + e0) = o; }
    }
    __syncthreads();
#undef RT_PREFETCH
}
__device__ __forceinline__ void ret_phase(KP P, LAS unsigned char* lds, int vcu, int G) {
    for (int unit = vcu; unit < BATCH * 8; unit += G) ret_unit(P, lds, unit >> 3, unit & 7);
}

template <int CTRL> __device__ __forceinline__ float dppf(float x) { return __builtin_bit_cast(float, __builtin_amdgcn_mov_dpp(__builtin_bit_cast(int, x), CTRL, 0xf, 0xf, true)); }
constexpr int DPP_X1 = 0xB1, DPP_X2 = 0x4E, DPP_X7 = 0x141, DPP_X8 = 0x128;
__device__ __forceinline__ float sum8(float x) { x += dppf<DPP_X1>(x); x += dppf<DPP_X2>(x); x += dppf<DPP_X7>(x); return x; }
__device__ __forceinline__ float sum16(float x) { x = sum8(x); x += dppf<DPP_X8>(x); return x; }
#define PROBE_SCAN2 0
constexpr int RS_TT = 32;
constexpr int RS_W2T = 0, RS_A2T = 9216, RS_G2T = 18432, RS_XW = 35840, RS_XA = RS_XW + RS_TT * 144, RS_XG = RS_XA + RS_TT * 144, RS_F0 = RS_XG + RS_TT * 272;
constexpr int RS_FA = RS_TT * 64 * 4;
constexpr int RS_ZR = RS_F0, RS_ZK = RS_F0 + RS_FA, RS_ZV = RS_F0 + 2 * RS_FA, RS_WL = RS_F0 + 3 * RS_FA, RS_AL = RS_F0 + 4 * RS_FA, RS_GL = RS_F0 + 5 * RS_FA, RS_AV = RS_F0 + 6 * RS_FA, RS_YS = RS_F0 + 7 * RS_FA, RS_BS = RS_F0 + 8 * RS_FA;
constexpr int RS_MU = RS_BS + RS_TT * 4, RS_CST = RS_MU + 448 * 4;
static_assert(RS_CST + 7 * 256 <= 131072, "rwkv LDS");
constexpr int RS_NP = (RS_TT * 56 + 511) / 512;
typedef float v2f __attribute__((ext_vector_type(2)));
__device__ __forceinline__ void rwkv_unit(KP P, int l, LAS unsigned char* lds, int b, int hh) {
    const int tid = otid(), w = __builtin_amdgcn_readfirstlane(tid >> 6), lane = tid & 63, r32 = lane & 31, h2 = lane >> 5;
    const bf16* proj = (const bf16*)(P->ws + WS_BIG); bf16* mixo = (bf16*)(P->ws + WS_MIXO);
    const float* mu = P->in[I_MU] + l * RWC; const float* w0 = P->in[I_W0] + l * 512 + hh * 64; const float* a0 = P->in[I_A0] + l * 512 + hh * 64;
    const float* kkw = P->in[I_KK] + l * 512 + hh * 64; const float* kaw = P->in[I_KA] + l * 512 + hh * 64; const float* rkw = P->in[I_RK] + l * 512 + hh * 64;
    const float* lng = P->in[I_LNG] + l * 512 + hh * 64; const float* lnb = P->in[I_LNB] + l * 512 + hh * 64;
    __syncthreads();
    for (int i = tid; i < 64 * 64; i += 512) { const int c = i >> 6, j = i & 63;
        *(LAS unsigned short*)(lds + RS_W2T + j * 144 + c * 2) = (unsigned short)f2bf(P->in[I_W2][(size_t)l * 64 * 512 + c * 512 + hh * 64 + j]);
        *(LAS unsigned short*)(lds + RS_A2T + j * 144 + c * 2) = (unsigned short)f2bf(P->in[I_A2][(size_t)l * 64 * 512 + c * 512 + hh * 64 + j]); }
    for (int i = tid; i < 128 * 64; i += 512) { const int c = i >> 6, j = i & 63;
        *(LAS unsigned short*)(lds + RS_G2T + j * 272 + c * 2) = (unsigned short)f2bf(P->in[I_G2][(size_t)l * 128 * 512 + c * 512 + hh * 64 + j]); }
    for (int i = tid; i < 448; i += 512) { const int p = i >> 3, e = i & 7; int col; if (p < 24) col = (p >> 3) * 512 + hh * 64 + (p & 7) * 8; else col = 1536 + (p - 24) * 8; ((LAS float*)(lds + RS_MU))[i] = mu[col + e]; }
    if (tid < 448) { const int a = tid >> 6, j = tid & 63; const float* src = a == 0 ? w0 : a == 1 ? a0 : a == 2 ? kkw : a == 3 ? kaw : a == 4 ? rkw : a == 5 ? lng : lnb; ((LAS float*)(lds + RS_CST))[tid] = src[j]; }
    v2f S2[4];
#pragma unroll
    for (int i = 0; i < 4; ++i) S2[i] = (v2f){0.f, 0.f};
    v4u pc[RS_NP], pp[RS_NP];
#define RS_LOADPIECES(T0) do { _Pragma("unroll") for (int it = 0; it < RS_NP; ++it) { const int idx = tid + it * 512; pc[it] = (v4u){0u, 0u, 0u, 0u}; pp[it] = (v4u){0u, 0u, 0u, 0u}; \
        if (idx < RS_TT * 56) { const int p = idx / RS_TT, tt = idx % RS_TT, t = (T0) + tt; int col; if (p < 24) col = (p >> 3) * 512 + hh * 64 + (p & 7) * 8; else col = 1536 + (p - 24) * 8; \
            const size_t g = (size_t)(b * T + t) * NA + C_RW + col; pc[it] = *(const v4u*)(proj + g); if (t > 0) pp[it] = *(const v4u*)(proj + g - NA); } } } while (0)
    RS_LOADPIECES(0);
#pragma unroll 1
    for (int t0 = 0; t0 < T; t0 += RS_TT) {
        __syncthreads();
#pragma unroll
        for (int it = 0; it < RS_NP; ++it) { const int idx = tid + it * 512; if (idx < RS_TT * 56) { const int p = idx / RS_TT, tt = idx % RS_TT;
            const v4u hc = pc[it], hp = pp[it];
            const v4f m0 = *(const LAS v4f*)(lds + RS_MU + p * 32), m1 = *(const LAS v4f*)(lds + RS_MU + p * 32 + 16);
            float z[8];
#pragma unroll
            for (int e = 0; e < 4; ++e) { const float c0 = bflo(hc[e]), c1 = bfhi(hc[e]), p0 = bflo(hp[e]), p1 = bfhi(hp[e]); const float ma = e < 2 ? m0[2 * e] : m1[2 * e - 4], mb = e < 2 ? m0[2 * e + 1] : m1[2 * e - 3];
                z[2 * e] = c0 + ma * (p0 - c0); z[2 * e + 1] = c1 + mb * (p1 - c1); }
            if (p < 24) { LAS float* dst = (LAS float*)(lds + (p < 8 ? RS_ZR : (p < 16 ? RS_ZK : RS_ZV)) + (tt * 64 + (p & 7) * 8) * 4);
                *(LAS v4f*)dst = (v4f){z[0], z[1], z[2], z[3]}; *(LAS v4f*)(dst + 4) = (v4f){z[4], z[5], z[6], z[7]}; }
            else { v4u o;
                if (p < 32) {
#pragma unroll
                    for (int e = 0; e < 4; ++e) o[e] = cvtpk(1.0f - 2.0f * __builtin_amdgcn_rcpf(1.0f + __expf(2.0f * z[2 * e])), 1.0f - 2.0f * __builtin_amdgcn_rcpf(1.0f + __expf(2.0f * z[2 * e + 1])));
                    *(LAS v4u*)(lds + RS_XW + tt * 144 + (p - 24) * 16) = o; }
                else if (p < 40) {
#pragma unroll
                    for (int e = 0; e < 4; ++e) o[e] = cvtpk(z[2 * e], z[2 * e + 1]);
                    *(LAS v4u*)(lds + RS_XA + tt * 144 + (p - 32) * 16) = o; }
                else {
#pragma unroll
                    for (int e = 0; e < 4; ++e) o[e] = cvtpk(__builtin_amdgcn_rcpf(1.0f + __expf(-z[2 * e])), __builtin_amdgcn_rcpf(1.0f + __expf(-z[2 * e + 1])));
                    *(LAS v4u*)(lds + RS_XG + tt * 272 + (p - 40) * 16) = o; } }
        } }
        __syncthreads();
        if (w < 6) { const int which = w >> 1, jt = w & 1; f32x16 acc;
#pragma unroll
            for (int i = 0; i < 16; ++i) acc[i] = 0.f;
            if (which < 2) { const int wo = which == 0 ? RS_W2T : RS_A2T, xo = which == 0 ? RS_XW : RS_XA;
#pragma unroll
                for (int s = 0; s < 4; ++s) { const bf16x8v af = *(const LAS bf16x8v*)(lds + wo + (32 * jt + r32) * 144 + (16 * s + 8 * h2) * 2), bfr = *(const LAS bf16x8v*)(lds + xo + r32 * 144 + (16 * s + 8 * h2) * 2);
                    acc = __builtin_amdgcn_mfma_f32_32x32x16_bf16(af, bfr, acc, 0, 0, 0); } }
            else {
#pragma unroll
                for (int s = 0; s < 8; ++s) { const bf16x8v af = *(const LAS bf16x8v*)(lds + RS_G2T + (32 * jt + r32) * 272 + (16 * s + 8 * h2) * 2), bfr = *(const LAS bf16x8v*)(lds + RS_XG + r32 * 272 + (16 * s + 8 * h2) * 2);
                    acc = __builtin_amdgcn_mfma_f32_32x32x16_bf16(af, bfr, acc, 0, 0, 0); } }
            const int oo = which == 0 ? RS_WL : (which == 1 ? RS_AL : RS_GL);
#pragma unroll
            for (int q4 = 0; q4 < 4; ++q4) *(LAS v4f*)(lds + oo + (r32 * 64 + 32 * jt + 8 * q4 + 4 * h2) * 4) = (v4f){acc[4 * q4], acc[4 * q4 + 1], acc[4 * q4 + 2], acc[4 * q4 + 3]}; }
        __syncthreads();
        { const int tt = tid >> 4, j0 = (tid & 15) * 4; const int o4 = (tt * 64 + j0) * 4;
          const v4f wl = *(const LAS v4f*)(lds + RS_WL + o4), al = *(const LAS v4f*)(lds + RS_AL + o4), zk = *(const LAS v4f*)(lds + RS_ZK + o4), zr = *(const LAS v4f*)(lds + RS_ZR + o4);
          const v4f w0v = *(const LAS v4f*)(lds + RS_CST + j0 * 4), a0v = *(const LAS v4f*)(lds + RS_CST + 256 + j0 * 4), kkv = *(const LAS v4f*)(lds + RS_CST + 512 + j0 * 4), kav = *(const LAS v4f*)(lds + RS_CST + 768 + j0 * 4), rkv = *(const LAS v4f*)(lds + RS_CST + 1024 + j0 * 4);
          v4f dcy, alp, kk0, km; float ssq = 0.f, bsum = 0.f;
#pragma unroll
          for (int e = 0; e < 4; ++e) { const float x = -(wl[e] + w0v[e]); const float sp = fmaxf(x, 0.f) + __logf(1.0f + __expf(-fabsf(x)));
              dcy[e] = __expf(-__expf(-sp - 0.5f)); alp[e] = __builtin_amdgcn_rcpf(1.0f + __expf(-(al[e] + a0v[e])));
              kk0[e] = zk[e] * kkv[e]; ssq += kk0[e] * kk0[e]; km[e] = zk[e] * (1.0f + (alp[e] - 1.0f) * kav[e]); bsum += zr[e] * km[e] * rkv[e]; }
          ssq = sum16(ssq); bsum = sum16(bsum);
          const float inv = __builtin_amdgcn_rcpf(fmaxf(__builtin_amdgcn_sqrtf(ssq), 1e-12f));
          v4f avv, bvv;
#pragma unroll
          for (int e = 0; e < 4; ++e) { const float kk = kk0[e] * inv; avv[e] = -kk; bvv[e] = kk * alp[e]; }
          *(LAS v4f*)(lds + RS_WL + o4) = dcy; *(LAS v4f*)(lds + RS_AL + o4) = bvv; *(LAS v4f*)(lds + RS_AV + o4) = avv; *(LAS v4f*)(lds + RS_ZK + o4) = km;
          if ((tid & 15) == 0) *(LAS float*)(lds + RS_BS + tt * 4) = bsum; }
        __syncthreads();
        if (t0 + RS_TT < T) RS_LOADPIECES(t0 + RS_TT);
#if PROBE_SCAN2
        v2f Ssave[4];
#pragma unroll
        for (int i = 0; i < 4; ++i) Ssave[i] = S2[i];
        for (int rep_ = 0; rep_ < 2; ++rep_) { if (rep_ == 1) {
#pragma unroll
            for (int i = 0; i < 4; ++i) S2[i] = Ssave[i]; }
#endif
        { const int v_ = tid >> 3, ks = tid & 7; LAS unsigned char* sb = lds + ks * 32; LAS unsigned char* vb = lds + RS_ZV + v_ * 4; LAS unsigned char* yb = lds + RS_YS + v_ * 4;
#pragma unroll
          for (int tt = 0; tt < RS_TT; ++tt) { const int o8 = tt * 256;
              const v4f a0_ = *(const LAS v4f*)(sb + RS_AV + o8), a1_ = *(const LAS v4f*)(sb + RS_AV + o8 + 16);
              const v4f d0_ = *(const LAS v4f*)(sb + RS_WL + o8), d1_ = *(const LAS v4f*)(sb + RS_WL + o8 + 16);
              const v4f b0_ = *(const LAS v4f*)(sb + RS_AL + o8), b1_ = *(const LAS v4f*)(sb + RS_AL + o8 + 16);
              const v4f k0_ = *(const LAS v4f*)(sb + RS_ZK + o8), k1_ = *(const LAS v4f*)(sb + RS_ZK + o8 + 16);
              const v4f r0_ = *(const LAS v4f*)(sb + RS_ZR + o8), r1_ = *(const LAS v4f*)(sb + RS_ZR + o8 + 16);
              const float vv = *(const LAS float*)(vb + o8);
              v2f ac = S2[0] * a0_.xy; ac = __builtin_elementwise_fma(S2[1], a0_.zw, ac); ac = __builtin_elementwise_fma(S2[2], a1_.xy, ac); ac = __builtin_elementwise_fma(S2[3], a1_.zw, ac);
              const float sa = sum8(ac.x + ac.y); const v2f sa2 = (v2f){sa, sa}, vv2 = (v2f){vv, vv};
              S2[0] = __builtin_elementwise_fma(S2[0], d0_.xy, __builtin_elementwise_fma(k0_.xy, vv2, b0_.xy * sa2));
              S2[1] = __builtin_elementwise_fma(S2[1], d0_.zw, __builtin_elementwise_fma(k0_.zw, vv2, b0_.zw * sa2));
              S2[2] = __builtin_elementwise_fma(S2[2], d1_.xy, __builtin_elementwise_fma(k1_.xy, vv2, b1_.xy * sa2));
              S2[3] = __builtin_elementwise_fma(S2[3], d1_.zw, __builtin_elementwise_fma(k1_.zw, vv2, b1_.zw * sa2));
              v2f yc = S2[0] * r0_.xy; yc = __builtin_elementwise_fma(S2[1], r0_.zw, yc); yc = __builtin_elementwise_fma(S2[2], r1_.xy, yc); yc = __builtin_elementwise_fma(S2[3], r1_.zw, yc);
              const float y = sum8(yc.x + yc.y);
              if (ks == 0) *(LAS float*)(yb + o8) = y; } }
#if PROBE_SCAN2
        }
#endif
        __syncthreads();
        { const int tt = tid >> 4, v0 = (tid & 15) * 4; const int o4 = (tt * 64 + v0) * 4;
          const v4f y4 = *(const LAS v4f*)(lds + RS_YS + o4), zv = *(const LAS v4f*)(lds + RS_ZV + o4), gl = *(const LAS v4f*)(lds + RS_GL + o4);
          const float mean = sum16((y4[0] + y4[1]) + (y4[2] + y4[3])) * (1.f / 64.f);
          const v4f d = y4 - mean; const float var = sum16((d[0] * d[0] + d[1] * d[1]) + (d[2] * d[2] + d[3] * d[3])) * (1.f / 64.f);
          const float rstd = rsqrtf(var + 64e-5f), bs = *(const LAS float*)(lds + RS_BS + tt * 4);
          const v4f lg4 = *(const LAS v4f*)(lds + RS_CST + 1280 + v0 * 4), lb4 = *(const LAS v4f*)(lds + RS_CST + 1536 + v0 * 4);
          float o[4];
#pragma unroll
          for (int e = 0; e < 4; ++e) o[e] = (d[e] * rstd * lg4[e] + lb4[e] + bs * zv[e]) * gl[e];
          v2u ow; ow[0] = cvtpk(o[0], o[1]); ow[1] = cvtpk(o[2], o[3]);
          *(v2u*)(mixo + (size_t)(b * T + t0 + tt) * NMIX + 512 + hh * 64 + v0) = ow; }
    }
    __syncthreads();
#undef RS_LOADPIECES
}
__device__ __forceinline__ void rwkv_phase(KP P, int l, LAS unsigned char* lds, int vcu, int G) {
    for (int unit = vcu; unit < BATCH * 8; unit += G) rwkv_unit(P, l, lds, unit >> 3, unit & 7);
}

#define RC_BAR() do { asm volatile("s_waitcnt lgkmcnt(0)" ::: "memory"); __builtin_amdgcn_s_barrier(); asm volatile("" ::: "memory"); } while (0)
constexpr int RC_SL = 9216;
constexpr int RC_A = 0 * RC_SL, RC_B = 1 * RC_SL, RC_K = 2 * RC_SL, RC_R = 3 * RC_SL, RC_V = 4 * RC_SL, RC_G = 5 * RC_SL, RC_S = 6 * RC_SL;
constexpr int RC_XW = 7 * RC_SL, RC_XA = 8 * RC_SL, RC_XG = 9 * RC_SL, RC_WL = 11 * RC_SL, RC_AL = 13 * RC_SL, RC_LW = 14 * RC_SL;
constexpr int RC_DINV = RC_B, RC_DINVT = RC_K, RC_NT = 9 * RC_SL, RC_P = RC_B, RC_UT = RC_V, RC_BHT = RC_XW, RC_KHT = RC_XA, RC_VT = 9 * RC_SL, RC_LAB = 10 * RC_SL, RC_N = RC_LAB, RC_TINV = RC_LAB;
constexpr int RC_LABT = 11 * RC_SL, RC_N2 = RC_LABT, RC_RHST = RC_LABT, RC_LAK = 12 * RC_SL, RC_MRB = 13 * RC_SL, RC_MRK = RC_LW;
constexpr int RC_SM = RC_LW + 16384, RC_BS = RC_SM, RC_GC = RC_SM + 256, RC_PT = RC_SM + 512, RC_SSB = RC_PT + 2048, RC_DIAG = RC_SSB + 1024, RC_MU = RC_DIAG + 4096, RC_CST = RC_MU + 1792, RC_END = RC_CST + 1792, RC_MK = RC_MU + 768;
static_assert(RC_END <= 156928, "chunked rwkv LDS");
template <int KSTEPS, int SA = 144, int SB = 144> __device__ __forceinline__ f32x16 rc_mm(f32x16 acc, const LAS unsigned char* A, int arow0, const LAS unsigned char* B, int brow0, int r32, int h, int kofs = 0) {
#pragma unroll
    for (int s = 0; s < KSTEPS; ++s) { const bf16x8v af = *(const LAS bf16x8v*)(A + (arow0 + r32) * SA + (kofs + 16 * s + 8 * h) * 2), bfr = *(const LAS bf16x8v*)(B + (brow0 + r32) * SB + (kofs + 16 * s + 8 * h) * 2);
        acc = __builtin_amdgcn_mfma_f32_32x32x16_bf16(af, bfr, acc, 0, 0, 0); }
    return acc;
}
__device__ __forceinline__ f32x16 rc_zero() { f32x16 z;
#pragma unroll
    for (int i = 0; i < 16; ++i) z[i] = 0.f;
    return z; }
template <int KSTEPS> __device__ __forceinline__ f32x16 rc_mm2(f32x16 acc, const LAS unsigned char* A, int arow0, const LAS unsigned char* B, int brow0, int r32, int h) {
    f32x16 a1 = rc_zero();
#pragma unroll
    for (int s = 0; s < KSTEPS; ++s) { const bf16x8v af = *(const LAS bf16x8v*)(A + (arow0 + r32) * 144 + (16 * s + 8 * h) * 2), bfr = *(const LAS bf16x8v*)(B + (brow0 + r32) * 144 + (16 * s + 8 * h) * 2);
        if (s & 1) a1 = __builtin_amdgcn_mfma_f32_32x32x16_bf16(af, bfr, a1, 0, 0, 0); else acc = __builtin_amdgcn_mfma_f32_32x32x16_bf16(af, bfr, acc, 0, 0, 0); }
#pragma unroll
    for (int i = 0; i < 16; ++i) acc[i] += a1[i];
    return acc;
}
__device__ __forceinline__ bf16x8v rc_frag_bd(const LAS unsigned char* cb, int row, int s, int h) {
    v4u z = (v4u){0u, 0u, 0u, 0u}; if ((row >> 4) == s) z = *(const LAS v4u*)(cb + (row >> 4) * 1024 + ((row & 15) * 16 + 8 * h) * 2); return __builtin_bit_cast(bf16x8v, z); }
template <bool BD_A> __device__ __forceinline__ f32x16 rc_mm_bd(f32x16 acc, const LAS unsigned char* A, int arow0, const LAS unsigned char* B, int brow0, int r32, int h) {
    f32x16 a1 = rc_zero();
#pragma unroll
    for (int s = 0; s < 4; ++s) { const bf16x8v af = BD_A ? rc_frag_bd(A, arow0 + r32, s, h) : *(const LAS bf16x8v*)(A + (arow0 + r32) * 144 + (16 * s + 8 * h) * 2);
        const bf16x8v bfr = BD_A ? *(const LAS bf16x8v*)(B + (brow0 + r32) * 144 + (16 * s + 8 * h) * 2) : rc_frag_bd(B, brow0 + r32, s, h);
        if (s & 1) a1 = __builtin_amdgcn_mfma_f32_32x32x16_bf16(af, bfr, a1, 0, 0, 0); else acc = __builtin_amdgcn_mfma_f32_32x32x16_bf16(af, bfr, acc, 0, 0, 0); }
#pragma unroll
    for (int i = 0; i < 16; ++i) acc[i] += a1[i];
    return acc;
}
__device__ __forceinline__ void rc_store_t(const f32x16& d, LAS unsigned char* O, int arow0, int brow0, int r32, int h) {
#pragma unroll
    for (int q4 = 0; q4 < 4; ++q4) { v2u o; o[0] = cvtpk(d[4 * q4], d[4 * q4 + 1]); o[1] = cvtpk(d[4 * q4 + 2], d[4 * q4 + 3]); *(LAS v2u*)(O + (brow0 + r32) * 144 + (arow0 + 8 * q4 + 4 * h) * 2) = o; }
}
__device__ __forceinline__ void rwkv_prepass(KP P, int l, int b, int j, int rows) {
    const int tid = otid(), p = tid & 31;
    const bf16* proj = (const bf16*)(P->ws + WS_BIG); bf16* zs = (bf16*)((unsigned char*)P->out + OUT_ZS);
    const v4f* mup = (const v4f*)(P->in[I_MU] + l * RWC + 1536 + 8 * p); const v4f m0 = mup[0], m1 = mup[1];
    const float be = p < 8 ? -2.f : -1.f, al = p < 8 ? 2.f : 1.f, ga = p < 8 ? -1.f : 0.f; const bool plain = (p >= 8 && p < 16);
#pragma unroll 4
    for (int r = tid >> 5; r < rows; r += 16) { const int t = j * rows + r; const size_t g = (size_t)(b * T + t) * NA + C_RW + 1536 + 8 * p;
        const v4u hc = *(const v4u*)(proj + g); v4u hp = (v4u){0u, 0u, 0u, 0u}; if (t > 0) hp = *(const v4u*)(proj + g - NA);
        v4u o;
#pragma unroll
        for (int e = 0; e < 4; ++e) { const float c0 = bflo(hc[e]), c1 = bfhi(hc[e]), p0 = bflo(hp[e]), p1 = bfhi(hp[e]); const float ma = e < 2 ? m0[2 * e] : m1[2 * e - 4], mb = e < 2 ? m0[2 * e + 1] : m1[2 * e - 3];
            const float z0 = c0 + ma * (p0 - c0), z1 = c1 + mb * (p1 - c1);
            const float s0 = al * __builtin_amdgcn_rcpf(1.0f + __expf(be * z0)) + ga, s1 = al * __builtin_amdgcn_rcpf(1.0f + __expf(be * z1)) + ga;
            o[e] = cvtpk(plain ? z0 : s0, plain ? z1 : s1); }
        *(v4u*)(zs + (size_t)(b * T + t) * 256 + 8 * p) = o; }
}
__device__ __forceinline__ void rwkvc_unit(KP P, int l, LAS unsigned char* lds, int b, int hh) {
    const int tid = otid(), w = __builtin_amdgcn_readfirstlane(tid >> 6), lane = tid & 63, r32 = lane & 31, h = lane >> 5;
    const bf16* proj = (const bf16*)(P->ws + WS_BIG); bf16* mixo = (bf16*)(P->ws + WS_MIXO);
    const float* mu = P->in[I_MU] + l * RWC; const float* w0 = P->in[I_W0] + l * 512 + hh * 64; const float* a0 = P->in[I_A0] + l * 512 + hh * 64;
    const float* kkw = P->in[I_KK] + l * 512 + hh * 64; const float* kaw = P->in[I_KA] + l * 512 + hh * 64; const float* rkw = P->in[I_RK] + l * 512 + hh * 64;
    const float* lng = P->in[I_LNG] + l * 512 + hh * 64; const float* lnb = P->in[I_LNB] + l * 512 + hh * 64;
    __syncthreads();
    if (tid < 192) { const int p = tid >> 3, e = tid & 7; ((LAS float*)(lds + RC_MU))[tid] = mu[(p >> 3) * 512 + hh * 64 + (p & 7) * 8 + e]; }
    if (tid < 448) { const int a = tid >> 6, j = tid & 63; const float* src = a == 0 ? w0 : a == 1 ? a0 : a == 2 ? kkw : a == 3 ? kaw : a == 4 ? rkw : a == 5 ? lng : lnb; ((LAS float*)(lds + RC_CST))[tid] = src[j]; }
    bf16x8v wf[8];
    { const int jt = w & 1, j = hh * 64 + 32 * jt + r32;
#pragma unroll
      for (int s = 0; s < 8; ++s) { unsigned short e[8];
#pragma unroll
          for (int i = 0; i < 8; ++i) { float x; if (w < 4) { const int c = 16 * (s & 3) + 8 * h + i; x = (s < 4 ? P->in[I_W2] : P->in[I_A2])[(size_t)l * 64 * 512 + c * 512 + j]; } else { const int c = 16 * s + 8 * h + i; x = P->in[I_G2][(size_t)l * 128 * 512 + c * 512 + j]; }
              e[i] = (unsigned short)f2bf(x); }
          v4u pk; pk[0] = e[0] | ((unsigned)e[1] << 16); pk[1] = e[2] | ((unsigned)e[3] << 16); pk[2] = e[4] | ((unsigned)e[5] << 16); pk[3] = e[6] | ((unsigned)e[7] << 16);
          wf[s] = __builtin_bit_cast(bf16x8v, pk); } }
    if (tid < 64) { unsigned mkAB = 0u, mkC = 0u;
#pragma unroll
        for (int i = 0; i < 16; ++i) { const int m = 8 * (i >> 2) + 4 * h + (i & 3), n = r32;
            mkAB |= (((n < m) && ((n >> 4) != (m >> 4))) ? 1u : 0u) << i; mkAB |= ((m < n) ? 1u : 0u) << (16 + i); mkC |= ((m <= n) ? 1u : 0u) << i; }
        v2u mv; mv[0] = mkAB; mv[1] = mkC; *(LAS v2u*)(lds + RC_MK + tid * 8) = mv; }
    f32x16 Sacc = rc_zero();
    v4u pc[3], pp[3], zc[4];
    const bf16* zs = (const bf16*)((const unsigned char*)P->out + OUT_ZS);
#define RC_LOADPIECES(T0) do { _Pragma("unroll") for (int it = 0; it < 3; ++it) { const int q_ = it * 8 + (tid >> 6), tt = 8 * (q_ / 3) + ((tid & 63) >> 3), t = (T0) + tt; \
            const size_t g = (size_t)(b * T + t) * NA + C_RW + (q_ % 3) * 512 + hh * 64 + (tid & 7) * 8; pc[it] = *(const v4u*)(proj + g); pp[it] = (v4u){0u, 0u, 0u, 0u}; if (t > 0) pp[it] = *(const v4u*)(proj + g - NA); } \
        _Pragma("unroll") for (int it = 0; it < 4; ++it) { const int q2 = it * 8 + (tid >> 6), tt = 8 * (q2 >> 2) + ((tid & 63) >> 3); zc[it] = *(const v4u*)(zs + (size_t)(b * T + (T0) + tt) * 256 + (8 * (q2 & 3) + (tid & 7)) * 8); } } while (0)
    RC_LOADPIECES(0);
#pragma unroll 1
    for (int t0 = 0; t0 < T; t0 += 64) {
        f32x16 xacc, yacc;
        RC_BAR();
        { const int tid = otid(), w = __builtin_amdgcn_readfirstlane(tid >> 6), lane = tid & 63, r32 = lane & 31, h = lane >> 5; (void)w; (void)lane; (void)r32; (void)h;
        if (w < 4) rc_store_t(Sacc, lds + RC_S, 32 * (w >> 1), 32 * (w & 1), r32, h);
#pragma unroll
        for (int it = 0; it < 3; ++it) { const int q_ = it * 8 + (tid >> 6), g = q_ % 3, p = 8 * g + (tid & 7), tt = 8 * (q_ / 3) + ((tid & 63) >> 3);
            const v4u hc = pc[it], hp = pp[it];
            const v4f m0 = *(const LAS v4f*)(lds + RC_MU + p * 32), m1 = *(const LAS v4f*)(lds + RC_MU + p * 32 + 16);
            v4u o;
#pragma unroll
            for (int e = 0; e < 4; ++e) { const float c0 = bflo(hc[e]), c1 = bfhi(hc[e]), p0 = bflo(hp[e]), p1 = bfhi(hp[e]); const float ma = e < 2 ? m0[2 * e] : m1[2 * e - 4], mb = e < 2 ? m0[2 * e + 1] : m1[2 * e - 3];
                o[e] = cvtpk(c0 + ma * (p0 - c0), c1 + mb * (p1 - c1)); }
            *(LAS v4u*)(lds + (g == 0 ? RC_R : (g == 1 ? RC_K : RC_V)) + tt * 144 + (tid & 7) * 16) = o; }
#pragma unroll
        for (int it = 0; it < 4; ++it) { const int q2 = it * 8 + (tid >> 6), qu = q2 & 3, tt = 8 * (q2 >> 2) + ((tid & 63) >> 3), pl = tid & 7;
            const int dst = qu == 0 ? RC_XW + tt * 144 + pl * 16 : (qu == 1 ? RC_XA + tt * 144 + pl * 16 : RC_XG + tt * 272 + ((qu - 2) * 8 + pl) * 16);
            *(LAS v4u*)(lds + dst) = zc[it]; }
        }
        RC_BAR();
        { const int tid = otid(), w = __builtin_amdgcn_readfirstlane(tid >> 6), lane = tid & 63, r32 = lane & 31, h = lane >> 5; (void)w; (void)lane; (void)r32; (void)h;
        { const int tt = (w >> 1) & 1, jt = w & 1;
          if (w < 4) { f32x16 aw = rc_zero(), aa = rc_zero();
#pragma unroll
              for (int s = 0; s < 4; ++s) { const bf16x8v xw = *(const LAS bf16x8v*)(lds + RC_XW + (32 * tt + r32) * 144 + (16 * s + 8 * h) * 2), xa = *(const LAS bf16x8v*)(lds + RC_XA + (32 * tt + r32) * 144 + (16 * s + 8 * h) * 2);
                  aw = __builtin_amdgcn_mfma_f32_32x32x16_bf16(wf[s], xw, aw, 0, 0, 0); aa = __builtin_amdgcn_mfma_f32_32x32x16_bf16(wf[4 + s], xa, aa, 0, 0, 0); }
#pragma unroll
              for (int q4 = 0; q4 < 4; ++q4) *(LAS v4f*)(lds + RC_WL + ((32 * tt + r32) * 64 + 32 * jt + 8 * q4 + 4 * h) * 4) = (v4f){aw[4 * q4], aw[4 * q4 + 1], aw[4 * q4 + 2], aw[4 * q4 + 3]};
              rc_store_t(aa, lds + RC_AL, 32 * jt, 32 * tt, r32, h); }
          else { f32x16 ag = rc_zero();
#pragma unroll
              for (int s = 0; s < 8; ++s) { const bf16x8v xg = *(const LAS bf16x8v*)(lds + RC_XG + (32 * tt + r32) * 272 + (16 * s + 8 * h) * 2); ag = __builtin_amdgcn_mfma_f32_32x32x16_bf16(wf[s], xg, ag, 0, 0, 0); }
              rc_store_t(ag, lds + RC_G, 32 * jt, 32 * tt, r32, h); } }
        }
        RC_BAR();
        { const int tid = otid(), w = __builtin_amdgcn_readfirstlane(tid >> 6), lane = tid & 63, r32 = lane & 31, h = lane >> 5; (void)w; (void)lane; (void)r32; (void)h;
        { const int t = tid >> 3, j0 = (tid & 7) * 8; const int ob = t * 144 + j0 * 2;
          const v4f wl0 = *(const LAS v4f*)(lds + RC_WL + (t * 64 + j0) * 4), wl1 = *(const LAS v4f*)(lds + RC_WL + (t * 64 + j0 + 4) * 4);
          const v4u alw = *(const LAS v4u*)(lds + RC_AL + ob), kw = *(const LAS v4u*)(lds + RC_K + ob), rw = *(const LAS v4u*)(lds + RC_R + ob);
          float lw[8], alp[8], kk0[8], km[8]; float ssq = 0.f, bsum = 0.f;
          v4f cst[5][2];
#pragma unroll
          for (int a = 0; a < 5; ++a) { cst[a][0] = *(const LAS v4f*)(lds + RC_CST + a * 256 + j0 * 4); cst[a][1] = *(const LAS v4f*)(lds + RC_CST + a * 256 + j0 * 4 + 16); }
#pragma unroll
          for (int e = 0; e < 8; ++e) { const float wl = e < 4 ? wl0[e & 3] : wl1[e & 3]; const float cw0 = cst[0][e >> 2][e & 3], ca0 = cst[1][e >> 2][e & 3];
              const float ckk = cst[2][e >> 2][e & 3], cka = cst[3][e >> 2][e & 3], crk = cst[4][e >> 2][e & 3];
              const float al = (e & 1) ? bfhi(alw[e >> 1]) : bflo(alw[e >> 1]), kr = (e & 1) ? bfhi(kw[e >> 1]) : bflo(kw[e >> 1]), rr = (e & 1) ? bfhi(rw[e >> 1]) : bflo(rw[e >> 1]);
              lw[e] = -0.60653066f * __builtin_amdgcn_rcpf(1.0f + __expf(-(wl + cw0)));
              alp[e] = __builtin_amdgcn_rcpf(1.0f + __expf(-(al + ca0)));
              kk0[e] = kr * ckk; ssq += kk0[e] * kk0[e]; km[e] = kr * (1.0f + (alp[e] - 1.0f) * cka); bsum += rr * km[e] * crk; }
          ssq = sum8(ssq); bsum = sum8(bsum);
          const float inv = __builtin_amdgcn_rcpf(fmaxf(__builtin_amdgcn_sqrtf(ssq), 1e-12f));
          v4u ao, bo, ko;
#pragma unroll
          for (int e = 0; e < 4; ++e) { const float ka = kk0[2 * e] * inv, kb = kk0[2 * e + 1] * inv; ao[e] = cvtpk(-ka, -kb); bo[e] = cvtpk(ka * alp[2 * e], kb * alp[2 * e + 1]); ko[e] = cvtpk(km[2 * e], km[2 * e + 1]); }
          *(LAS v4u*)(lds + RC_A + ob) = ao; *(LAS v4u*)(lds + RC_B + ob) = bo; *(LAS v4u*)(lds + RC_K + ob) = ko;
          *(LAS v4f*)(lds + RC_LW + (t * 64 + j0) * 4) = (v4f){lw[0], lw[1], lw[2], lw[3]}; *(LAS v4f*)(lds + RC_LW + (t * 64 + j0 + 4) * 4) = (v4f){lw[4], lw[5], lw[6], lw[7]};
          if ((tid & 7) == 0) *(LAS float*)(lds + RC_BS + t * 4) = bsum; }
        }
        RC_BAR();
        { const int tid = otid(), w = __builtin_amdgcn_readfirstlane(tid >> 6), lane = tid & 63, r32 = lane & 31, h = lane >> 5; (void)w; (void)lane; (void)r32; (void)h;
        { const int k = tid & 63, tq = tid >> 6; float c[8]; float run = 0.f;
#pragma unroll
          for (int i = 0; i < 8; ++i) { run += *(const LAS float*)(lds + RC_LW + ((8 * tq + i) * 64 + k) * 4); c[i] = run; }
          *(LAS float*)(lds + RC_PT + (tq * 64 + k) * 4) = run;
          RC_BAR();
          float base = 0.f;
#pragma unroll
          for (int q = 0; q < 7; ++q) { const float pv = *(const LAS float*)(lds + RC_PT + (q * 64 + k) * 4); base += (q < tq) ? pv : 0.f; }
#pragma unroll
          for (int i = 0; i < 8; ++i) *(LAS float*)(lds + RC_LW + ((8 * tq + i) * 64 + k) * 4) = c[i] + base;
          if (tq == 7) *(LAS float*)(lds + RC_GC + k * 4) = __expf(c[7] + base); }
        }
        RC_BAR();
        { const int tid = otid(), w = __builtin_amdgcn_readfirstlane(tid >> 6), lane = tid & 63, r32 = lane & 31, h = lane >> 5; (void)w; (void)lane; (void)r32; (void)h;
        { const int t = tid >> 3, j0 = (tid & 7) * 8; const int ob = t * 144 + j0 * 2;
          const v4f c0 = *(const LAS v4f*)(lds + RC_LW + (t * 64 + j0) * 4), c1 = *(const LAS v4f*)(lds + RC_LW + (t * 64 + j0 + 4) * 4);
          v4f p0 = (v4f){0.f, 0.f, 0.f, 0.f}, p1 = p0; if (t > 0) { p0 = *(const LAS v4f*)(lds + RC_LW + ((t - 1) * 64 + j0) * 4); p1 = *(const LAS v4f*)(lds + RC_LW + ((t - 1) * 64 + j0 + 4) * 4); }
          const v4u aw = *(const LAS v4u*)(lds + RC_A + ob), bw = *(const LAS v4u*)(lds + RC_B + ob), kw = *(const LAS v4u*)(lds + RC_K + ob), rw = *(const LAS v4u*)(lds + RC_R + ob);
          v4u ao, bo, ko, ro;
#pragma unroll
          for (int e = 0; e < 4; ++e) { const float cA = e < 2 ? c0[2 * e] : c1[2 * e - 4], cB = e < 2 ? c0[2 * e + 1] : c1[2 * e - 3], pA = e < 2 ? p0[2 * e] : p1[2 * e - 4], pB = e < 2 ? p0[2 * e + 1] : p1[2 * e - 3];
              const float e1a = __expf(cA), e1b = __expf(cB), e0a = __expf(pA), e0b = __expf(pB), eia = __builtin_amdgcn_rcpf(e1a), eib = __builtin_amdgcn_rcpf(e1b);
              ao[e] = cvtpk(bflo(aw[e]) * e0a, bfhi(aw[e]) * e0b); ro[e] = cvtpk(bflo(rw[e]) * e1a, bfhi(rw[e]) * e1b);
              bo[e] = cvtpk(bflo(bw[e]) * eia, bfhi(bw[e]) * eib); ko[e] = cvtpk(bflo(kw[e]) * eia, bfhi(kw[e]) * eib); }
          *(LAS v4u*)(lds + RC_A + ob) = ao; *(LAS v4u*)(lds + RC_B + ob) = bo; *(LAS v4u*)(lds + RC_K + ob) = ko; *(LAS v4u*)(lds + RC_R + ob) = ro; }
        }
        RC_BAR();
        { const int tid = otid(), w = __builtin_amdgcn_readfirstlane(tid >> 6), lane = tid & 63, r32 = lane & 31, h = lane >> 5; (void)w; (void)lane; (void)r32; (void)h;
        if (w == 0 || w == 3) { const int tq = w == 0 ? 0 : 1; f32x16 d = rc_zero(); d = rc_mm2<4>(d, lds + RC_B, 32 * tq, lds + RC_A, 32 * tq, r32, h);
            const int n = 32 * tq + r32;
#pragma unroll
            for (int i = 0; i < 16; ++i) { const int m = 32 * tq + 8 * (i >> 2) + 4 * h + (i & 3); if ((m >> 4) == (n >> 4)) *(LAS float*)(lds + RC_DIAG + ((n >> 4) * 256 + (m & 15) * 16 + (n & 15)) * 4) = (m < n) ? d[i] : 0.f; }
            asm volatile("s_waitcnt lgkmcnt(0)" ::: "memory");
            if (lane < 32) { const int blk = 2 * tq + (lane >> 4), c = lane & 15; float x[16];
#pragma unroll
                for (int t = 0; t < 16; ++t) x[t] = (t == c) ? 1.f : 0.f;
#pragma unroll
                for (int j = 0; j < 15; ++j) {
#pragma unroll
                    for (int q = (j + 1) >> 2; q < 4; ++q) { const v4f l4 = *(const LAS v4f*)(lds + RC_DIAG + (blk * 256 + j * 16 + 4 * q) * 4);
#pragma unroll
                        for (int e = 0; e < 4; ++e) { const int t = 4 * q + e; if (t > j) x[t] += l4[e] * x[j]; } } }
                asm volatile("s_waitcnt lgkmcnt(0)" ::: "memory");
                LAS unsigned char* cb = lds + RC_DIAG + blk * 1024;
#pragma unroll
                for (int t = 0; t < 16; ++t) *(LAS unsigned short*)(cb + (t * 16 + c) * 2) = (unsigned short)f2bf(x[t]);
                v4u o0, o1;
#pragma unroll
                for (int e = 0; e < 4; ++e) { o0[e] = cvtpk(x[2 * e], x[2 * e + 1]); o1[e] = cvtpk(x[8 + 2 * e], x[9 + 2 * e]); }
                *(LAS v4u*)(cb + 512 + c * 32) = o0; *(LAS v4u*)(cb + 512 + c * 32 + 16) = o1; } }
        else { const int slot = w < 3 ? w - 1 : w - 2;
#pragma unroll 1
            for (int kq = 0; kq < 3; ++kq) { const int q = (slot == 4 && kq == 2) ? 15 : slot + 6 * kq; if (q >= 16 || (slot == 3 && kq == 2)) break;
                const int blk = 1 + (q >> 2), ta = (q >> 1) & 1, tb = q & 1;
                const int ao = blk == 1 ? RC_A : blk == 2 ? RC_K : blk == 3 ? RC_B : RC_K, bo = blk == 1 ? RC_B : blk == 2 ? RC_A : RC_R;
                const int oo = blk == 1 ? RC_LABT : blk == 2 ? RC_LAK : blk == 3 ? RC_MRB : RC_MRK;
                f32x16 d = rc_zero();
                const bool dead = (blk == 1) ? (tb > ta) : (ta > tb);
                if (!dead) d = rc_mm2<4>(d, lds + ao, 32 * ta, lds + bo, 32 * tb, r32, h);
                { unsigned mk = 0xffffu; if (ta == tb) { const v2u mv = *(const LAS v2u*)(lds + RC_MK + lane * 8); mk = blk == 1 ? (mv[0] & 0xffffu) : (blk == 2 ? (mv[0] >> 16) : mv[1]); }
#pragma unroll
                  for (int i = 0; i < 16; ++i) d[i] = ((mk >> i) & 1u) ? d[i] : 0.f; }
                rc_store_t(d, lds + oo, 32 * ta, 32 * tb, r32, h); } }
        }
        RC_BAR();
        { const int tid = otid(), w = __builtin_amdgcn_readfirstlane(tid >> 6), lane = tid & 63, r32 = lane & 31, h = lane >> 5; (void)w; (void)lane; (void)r32; (void)h;
        { const int ta = (w >> 1) & 1, tb = w & 1; f32x16 d = rc_zero();
          if (w < 4) { d = rc_mm_bd<false>(d, lds + RC_LABT, 32 * ta, lds + RC_DIAG, 32 * tb, r32, h); }
          else       { d = rc_mm_bd<true>(d, lds + RC_DIAG, 32 * ta, lds + RC_LABT, 32 * tb, r32, h); }
          rc_store_t(d, lds + (w < 4 ? RC_N : RC_NT), 32 * ta, 32 * tb, r32, h); }
        }
        RC_BAR();
        { const int tid = otid(), w = __builtin_amdgcn_readfirstlane(tid >> 6), lane = tid & 63, r32 = lane & 31, h = lane >> 5; (void)w; (void)lane; (void)r32; (void)h;
        xacc = rc_zero();
        if (w < 4) { const int ta = (w >> 1) & 1, tb = w & 1;
            xacc = rc_mm2<4>(xacc, lds + RC_NT, 32 * ta, lds + RC_N, 32 * tb, r32, h);
#pragma unroll
            for (int i = 0; i < 16; ++i) { const int m = 32 * ta + 8 * (i >> 2) + 4 * h + (i & 3), n = 32 * tb + r32; if (m == n) xacc[i] += 1.0f; } }
        if (w >= 4) { const int t4 = tid - 256, k = t4 >> 2, tg = t4 & 3; const float gc = *(const LAS float*)(lds + RC_GC + k * 4);
#pragma unroll
            for (int i = 0; i < 16; ++i) { const int t = tg + 4 * i;
                const float bt = bf2f(*(const LAS unsigned short*)(lds + RC_B + t * 144 + k * 2)), kt = bf2f(*(const LAS unsigned short*)(lds + RC_K + t * 144 + k * 2));
                *(LAS unsigned short*)(lds + RC_BHT + k * 144 + t * 2) = (unsigned short)f2bf(bt * gc); *(LAS unsigned short*)(lds + RC_KHT + k * 144 + t * 2) = (unsigned short)f2bf(kt * gc); } }
        if (w < 4) { const int ta = (w >> 1) & 1, tb = w & 1;
#pragma unroll
            for (int i = 0; i < 16; ++i) { const int m = 32 * ta + 8 * (i >> 2) + 4 * h + (i & 3), n = 32 * tb + r32; *(LAS unsigned short*)(lds + RC_N2 + m * 144 + n * 2) = (unsigned short)f2bf(xacc[i]); } }
        }
        RC_BAR();
        { const int tid = otid(), w = __builtin_amdgcn_readfirstlane(tid >> 6), lane = tid & 63, r32 = lane & 31, h = lane >> 5; (void)w; (void)lane; (void)r32; (void)h;
        if (w < 4) { const int ta = (w >> 1) & 1, tb = w & 1;
            xacc = rc_mm2<4>(xacc, lds + RC_N2, 32 * ta, lds + RC_N, 32 * tb, r32, h);
            rc_store_t(xacc, lds + RC_P, 32 * ta, 32 * tb, r32, h); }
        else { const int t4 = tid - 256, k = t4 >> 2, tg = t4 & 3;
#pragma unroll
            for (int i = 0; i < 16; ++i) { const int t = tg + 4 * i; *(LAS unsigned short*)(lds + RC_VT + k * 144 + t * 2) = *(const LAS unsigned short*)(lds + RC_V + t * 144 + k * 2); } }
        }
        RC_BAR();
        { const int tid = otid(), w = __builtin_amdgcn_readfirstlane(tid >> 6), lane = tid & 63, r32 = lane & 31, h = lane >> 5; (void)w; (void)lane; (void)r32; (void)h;
        { const int ta = (w >> 1) & 1, tb = w & 1; f32x16 d = rc_zero();
          if (w < 4) { d = rc_mm_bd<true>(d, lds + RC_DIAG + 512, 32 * ta, lds + RC_P, 32 * tb, r32, h); rc_store_t(d, lds + RC_TINV, 32 * ta, 32 * tb, r32, h); }
          else { d = rc_mm2<4>(d, lds + RC_A, 32 * ta, lds + RC_S, 32 * tb, r32, h); d = rc_mm2<4>(d, lds + RC_LAK, 32 * ta, lds + RC_VT, 32 * tb, r32, h); rc_store_t(d, lds + RC_RHST, 32 * ta, 32 * tb, r32, h); } }
        if (t0 + 64 < T) RC_LOADPIECES(t0 + 64);
        }
        RC_BAR();
        { const int tid = otid(), w = __builtin_amdgcn_readfirstlane(tid >> 6), lane = tid & 63, r32 = lane & 31, h = lane >> 5; (void)w; (void)lane; (void)r32; (void)h;
        if (w < 4) { const int ta = (w >> 1) & 1, tb = w & 1; f32x16 d = rc_zero(); d = rc_mm2<4>(d, lds + RC_TINV, 32 * ta, lds + RC_RHST, 32 * tb, r32, h); rc_store_t(d, lds + RC_UT, 32 * ta, 32 * tb, r32, h); }
        }
        RC_BAR();
        { const int tid = otid(), w = __builtin_amdgcn_readfirstlane(tid >> 6), lane = tid & 63, r32 = lane & 31, h = lane >> 5; (void)w; (void)lane; (void)r32; (void)h;
        yacc = rc_zero();
        { const int ta = (w >> 1) & 1, tb = w & 1;
          if (w < 4) {
#pragma unroll
              for (int i = 0; i < 16; ++i) Sacc[i] *= *(const LAS float*)(lds + RC_GC + (32 * ta + 8 * (i >> 2) + 4 * h + (i & 3)) * 4);
              Sacc = rc_mm2<4>(Sacc, lds + RC_BHT, 32 * ta, lds + RC_UT, 32 * tb, r32, h); Sacc = rc_mm2<4>(Sacc, lds + RC_KHT, 32 * ta, lds + RC_VT, 32 * tb, r32, h); }
          else { yacc = rc_mm2<4>(yacc, lds + RC_S, 32 * ta, lds + RC_R, 32 * tb, r32, h); yacc = rc_mm2<4>(yacc, lds + RC_UT, 32 * ta, lds + RC_MRB, 32 * tb, r32, h); yacc = rc_mm2<4>(yacc, lds + RC_VT, 32 * ta, lds + RC_MRK, 32 * tb, r32, h);
              float s1 = 0.f, s2 = 0.f;
#pragma unroll
              for (int i = 0; i < 16; ++i) { s1 += yacc[i]; s2 += yacc[i] * yacc[i]; }
              s1 += __shfl_xor(s1, 32); s2 += __shfl_xor(s2, 32);
              if (h == 0) { *(LAS float*)(lds + RC_SSB + ((w - 4) * 32 + r32) * 8) = s1; *(LAS float*)(lds + RC_SSB + ((w - 4) * 32 + r32) * 8 + 4) = s2; } } }
        }
        RC_BAR();
        { const int tid = otid(), w = __builtin_amdgcn_readfirstlane(tid >> 6), lane = tid & 63, r32 = lane & 31, h = lane >> 5; (void)w; (void)lane; (void)r32; (void)h;
        if (w >= 4) { const int ta = (w >> 1) & 1, tb = w & 1, t = 32 * tb + r32;
            const float a1 = *(const LAS float*)(lds + RC_SSB + ((w - 4) * 32 + r32) * 8), a2 = *(const LAS float*)(lds + RC_SSB + ((w - 4) * 32 + r32) * 8 + 4);
            const float b1 = *(const LAS float*)(lds + RC_SSB + (((w - 4) ^ 2) * 32 + r32) * 8), b2 = *(const LAS float*)(lds + RC_SSB + (((w - 4) ^ 2) * 32 + r32) * 8 + 4);
            const float mean = (a1 + b1) * (1.f / 64.f), var = fmaxf((a2 + b2) * (1.f / 64.f) - mean * mean, 0.f), rstd = rsqrtf(var + 64e-5f), bs = *(const LAS float*)(lds + RC_BS + t * 4);
#pragma unroll
            for (int q4 = 0; q4 < 4; ++q4) { const int v0 = 32 * ta + 8 * q4 + 4 * h; const v2u gw = *(const LAS v2u*)(lds + RC_G + t * 144 + v0 * 2);
                const v4f lg4 = *(const LAS v4f*)(lds + RC_CST + 1280 + v0 * 4), lb4 = *(const LAS v4f*)(lds + RC_CST + 1536 + v0 * 4); float o[4];
#pragma unroll
                for (int e = 0; e < 4; ++e) { const float vv = bf2f(*(const LAS unsigned short*)(lds + RC_VT + (v0 + e) * 144 + t * 2)); const float g = (e & 1) ? bfhi(gw[e >> 1]) : bflo(gw[e >> 1]);
                    o[e] = ((yacc[4 * q4 + e] - mean) * rstd * lg4[e] + lb4[e] + bs * vv) * g; }
                v2u ow; ow[0] = cvtpk(o[0], o[1]); ow[1] = cvtpk(o[2], o[3]);
                *(v2u*)(mixo + (size_t)(b * T + t0 + t) * NMIX + 512 + hh * 64 + v0) = ow; } }

        }
    }
    __syncthreads();
#undef RC_LOADPIECES
}
__device__ __forceinline__ void rwkvc_phase(KP P, int l, LAS unsigned char* lds, int vcu, int G) {
    for (int unit = vcu; unit < BATCH * 8; unit += G) rwkvc_unit(P, l, lds, unit >> 3, unit & 7);
}

#define XB_TMO      128
#define XB_XCNT(j)  (256  + 64 * (j))
#define XB_XSUB(j)  (1280 + 64 * (j))
#define XB_XGEN(j)  (2304 + 64 * (j))
#define XB_TOP      3328
#define XB_TOPGEN   3392
#define XCD_BAR_WORDS 3456
#define XB_SPIN_CAP (1u << 18)
__device__ __forceinline__ unsigned xb_ld(unsigned* p)              { return __hip_atomic_load(p, __ATOMIC_RELAXED, __HIP_MEMORY_SCOPE_AGENT); }
__device__ __forceinline__ unsigned xb_add(unsigned* p, unsigned v) { return __hip_atomic_fetch_add(p, v, __ATOMIC_RELAXED, __HIP_MEMORY_SCOPE_AGENT); }
__device__ __forceinline__ unsigned xb_xcc_id() { return (unsigned)__builtin_amdgcn_s_getreg((3 << 11) | 20) & 0xFu; }
#define XB_SPIN(cond, bar) do { unsigned _sp = 0; while (cond) { __builtin_amdgcn_s_sleep(1); \
    if ((++_sp & 255u) == 0u) { if (xb_ld(&(bar)[XB_TMO])) break; if (_sp > XB_SPIN_CAP) { atomicAdd(&(bar)[XB_TMO], 1u); break; } } } } while (0)
struct XcdBarrier {
    unsigned* bar; unsigned x;
    volatile LAS unsigned* st;
    unsigned n;
};
__device__ __forceinline__ XcdBarrier xcd_barrier_post(unsigned* bar, volatile LAS unsigned* st, unsigned n) {
    XcdBarrier b; b.bar = bar; b.x = xb_xcc_id(); b.st = st; b.n = n;
    if (threadIdx.x == 0) (void)xb_add(&bar[XB_XCNT(b.x)], 1u);
    return b;
}
__device__ __forceinline__ void xcd_barrier_complete(unsigned* bar, unsigned x, unsigned G, unsigned& nloc, unsigned& nx) {
    unsigned sum, cnt, mine, sp = 0u;
    for (;;) {
        sum = 0u; cnt = 0u; mine = 0u;
#pragma unroll
        for (unsigned j = 0; j < 16; ++j) { const unsigned c = xb_ld(&bar[XB_XCNT(j)]); sum += c; cnt += (c > 0u) ? 1u : 0u; mine = (j == x) ? c : mine; }
        if (sum == G) break;
        __builtin_amdgcn_s_sleep(1);
        if ((++sp & 255u) == 0u) { if (xb_ld(&bar[XB_TMO])) break; if (sp > XB_SPIN_CAP) { atomicAdd(&bar[XB_TMO], 1u); break; } }
    }
    nloc = mine > 0u ? mine : 1u; nx = cnt > 0u ? cnt : 1u;
}
template <bool LOCAL> __device__ __forceinline__ void xcd_barrier(const XcdBarrier& b) {
    asm volatile("s_waitcnt vmcnt(0)" ::: "memory");
    __syncthreads();
    if (threadIdx.x == 0) {
        unsigned* bar = b.bar;
        __builtin_amdgcn_s_waitcnt(0);
        unsigned nloc = b.st[0], nx = b.st[1];
        if (nloc == 0u) { xcd_barrier_complete(bar, b.x, b.n, nloc, nx); b.st[0] = nloc; b.st[1] = nx; }
        const bool one = LOCAL && nx == 1u;
        const unsigned old = xb_add(&bar[XB_XSUB(b.x)], 1u);
        const unsigned gen = old / nloc;
        if (old + 1u == (gen + 1u) * nloc) {
            if (!one) { __builtin_amdgcn_fence(__ATOMIC_RELEASE, "agent");
                        asm volatile("s_waitcnt vmcnt(0)" ::: "memory"); }
            const unsigned og = xb_add(&bar[XB_TOP], 1u);
            const unsigned tg = og / nx;
            if (og + 1u == (tg + 1u) * nx) xb_add(&bar[XB_TOPGEN], 1u);
            else XB_SPIN(xb_ld(&bar[XB_TOPGEN]) == tg, bar);
            if (!one) __builtin_amdgcn_fence(__ATOMIC_ACQUIRE, "agent");
            else asm volatile("buffer_inv sc0" ::: "memory");
            xb_add(&bar[XB_XGEN(b.x)], 1u);
            asm volatile("s_waitcnt vmcnt(0)" ::: "memory");
        } else {
            XB_SPIN(xb_ld(&bar[XB_XGEN(b.x)]) == gen, bar);
            if (!one) __builtin_amdgcn_fence(__ATOMIC_ACQUIRE, "agent");
            else asm volatile("buffer_inv sc0" ::: "memory");
            asm volatile("s_waitcnt vmcnt(0)" ::: "memory");
        }
    }
    __syncthreads();
}

constexpr int CW_BAR = 4096;
constexpr int MISC_OFF = 156928;
constexpr int CW_HB = 8192;
constexpr int CW_SEQ = 8192 + 512;
constexpr int CW_WDONE = 8192 + 1024;
constexpr int CW_GBAR = 65536;
__device__ __forceinline__ void half_barrier(unsigned* ctl, int cw, unsigned target) {
    asm volatile("s_waitcnt vmcnt(0) lgkmcnt(0)" ::: "memory");
    __syncthreads();
    if (threadIdx.x == 0) {
        (void)xb_add(&ctl[cw], 1u);
        unsigned sp = 0;
        while (xb_ld(&ctl[cw]) < target) { __builtin_amdgcn_s_sleep(2);
            if ((++sp & 255u) == 0u) { if (xb_ld(&ctl[CW_BAR + XB_TMO])) break; if (sp > XB_SPIN_CAP) { atomicAdd(&ctl[CW_BAR + XB_TMO], 1u); break; } } }
        asm volatile("" ::: "memory");
    }
    __syncthreads();
}
__device__ __forceinline__ void half_wait(unsigned* ctl, int cw, unsigned target) {
    if (threadIdx.x == 0) { unsigned sp = 0;
        while (xb_ld(&ctl[cw]) < target) { __builtin_amdgcn_s_sleep(2);
            if ((++sp & 255u) == 0u) { if (xb_ld(&ctl[CW_BAR + XB_TMO])) break; if (sp > XB_SPIN_CAP) { atomicAdd(&ctl[CW_BAR + XB_TMO], 1u); break; } } }
        asm volatile("" ::: "memory"); }
    __syncthreads();
}
__device__ __forceinline__ void pub_barrier(unsigned* ctl, int cw, unsigned target, bool one) {
    asm volatile("s_waitcnt vmcnt(0)" ::: "memory");
    __syncthreads();
    if (threadIdx.x == 0) {
        if (!one) { __builtin_amdgcn_fence(__ATOMIC_RELEASE, "agent"); asm volatile("s_waitcnt vmcnt(0)" ::: "memory"); }
        (void)xb_add(&ctl[cw], 1u);
        unsigned sp = 0;
        while (xb_ld(&ctl[cw]) < target) { __builtin_amdgcn_s_sleep(1);
            if ((++sp & 255u) == 0u) { if (xb_ld(&ctl[CW_BAR + XB_TMO])) break; if (sp > XB_SPIN_CAP) { atomicAdd(&ctl[CW_BAR + XB_TMO], 1u); break; } } }
        if (!one) __builtin_amdgcn_fence(__ATOMIC_ACQUIRE, "agent"); else asm volatile("buffer_inv sc0" ::: "memory");
        asm volatile("s_waitcnt vmcnt(0)" ::: "memory");
    }
    __syncthreads();
}
#ifndef NAIVE_ATTN
#define NAIVE_ATTN 0
#endif
#ifndef NAIVE_RET
#define NAIVE_RET 0
#endif
#ifndef NAIVE_RWKV
#define NAIVE_RWKV 0
#endif
#define RWKV_CHUNKED 1
#define GROUP_LOCAL 1
#define PROBE_H 0
#define P1B_FIRST 0
#define ATT_FIRST 1
#ifndef REP_RWKV
#define REP_RWKV 1
#endif
#ifndef REP_ATTN
#define REP_ATTN 1
#endif
#ifndef REP_RET
#define REP_RET 1
#endif
#ifndef REP_G0
#define REP_G0 1
#endif
#ifndef REP_G1
#define REP_G1 1
#endif
#ifndef REP_G2
#define REP_G2 1
#endif
#ifndef REP_G4
#define REP_G4 1
#endif
__global__ void __launch_bounds__(512, 2) k_mega(Params Pv) {
    KP P = (KP)__builtin_amdgcn_kernarg_segment_ptr();
#define PFRESH() asm volatile("" : "+s"(P))
    extern __shared__ __attribute__((aligned(16))) unsigned char lds_[];
    LAS unsigned char* lds = (LAS unsigned char*)lds_;
    const int tid = threadIdx.x, G = gridDim.x, bx = blockIdx.x, vcu = (G % 8 == 0) ? (bx % 8) * (G / 8) + bx / 8 : bx;
    volatile LAS unsigned* MISC = (volatile LAS unsigned*)(lds + MISC_OFF);
    for (int u = tid; u < (LDS_BYTES - MISC_OFF) / 4; u += 512) ((LAS unsigned*)(lds + MISC_OFF))[u] = 0u;
    __syncthreads();
    const int GS = G / 8, grp = vcu / GS, rk = vcu % GS, GSH = GS / 2;
    XcdBarrier bar = xcd_barrier_post((unsigned*)(P->ws + WS_CTL) + CW_BAR, MISC + 8, (unsigned)G);
    { XcdBarrier gb0 = xcd_barrier_post((unsigned*)(P->ws + WS_CTL) + CW_GBAR + 4096 * grp, MISC + 12, (unsigned)GS); (void)gb0; }
#define GRID_BAR() do { asm volatile("" : "+s"(bar.x)); xcd_barrier<false>(bar); } while (0)
#define GROUP_BAR() do { int g_ = grp; asm volatile("" : "+s"(g_)); XcdBarrier gb_; gb_.bar = (unsigned*)(P->ws + WS_CTL) + CW_GBAR + 4096 * g_; gb_.x = xb_xcc_id(); gb_.st = MISC + 12; gb_.n = (unsigned)GS; xcd_barrier<GROUP_LOCAL != 0>(gb_); } while (0)
    PFRESH(); phase_x0(P, vcu, G);
    PFRESH(); phase_wconv_all(P, lds, vcu, G);
    GRID_BAR();
    for (int l = 0; l < DEPTH; ++l) {
        PFRESH(); gemm_phase_of<0>(P, l, lds, G, bx);
        GROUP_BAR();
        PFRESH();
#if PROBE_H
        const unsigned long long th0_ = __builtin_amdgcn_s_memrealtime();
#endif
        { unsigned* ctl = (unsigned*)(P->ws + WS_CTL); const int cw = CW_HB + 64 * grp;
          const bool loc = GROUP_LOCAL && MISC[13] == 1u;
          if (rk < GSH) { attn_phase(P, l, lds, 64 * grp + rk, GSH, 64 * grp + GSH * ATT_FIRST); half_barrier(ctl, cw, 0u); PFRESH();
                          { const int npb = GSH / 2; rwkv_prepass(P, l, 2 * grp + rk / npb, rk % npb, T / npb); }
                          pub_barrier(ctl, CW_SEQ + 64 * grp, (unsigned)GSH * (unsigned)(l + 1), loc); PFRESH();
#if PROBE_H == 3
                          if (tid == 0 && grp == 0 && rk == 0) { unsigned long long* ts_ = (unsigned long long*)(P->ws + WS_CTL + 65536); *ts_ += __builtin_amdgcn_s_memrealtime() - th0_; }
#endif
                          for (int unit = 16 * grp + rk; unit < 16 * grp + 16; unit += GSH) rwkvc_unit(P, l, lds, unit >> 3, unit & 7);
                          if (P1B_FIRST > 0) { half_wait(ctl, cw, (unsigned)GS * (unsigned)(l + 1)); PFRESH(); gemm_phase_of<1>(P, l, lds, 8 * GSH, 8 * rk + grp, 12 - P1B_FIRST, P1B_FIRST); } }
          else { const int r2 = rk - GSH;
                 attn_phase(P, l, lds, 64 * grp + GSH * ATT_FIRST + r2, GS - GSH, 64 * grp + 64); __syncthreads();
                 for (int unit = 16 * grp + r2; unit < 16 * grp + 16; unit += GS - GSH) ret_unit(P, lds, unit >> 3, unit & 7);
                 half_barrier(ctl, cw, (unsigned)GS * (unsigned)(l + 1));
                 PFRESH(); gemm_phase_of<1>(P, l, lds, 8 * (GS - GSH), 8 * r2 + grp, 0, 12 - P1B_FIRST); } }
#if PROBE_H
        if (PROBE_H < 3 && tid == 0 && grp == 0 && rk == (PROBE_H == 1 ? 0 : GSH)) { unsigned long long* ts_ = (unsigned long long*)(P->ws + WS_CTL + 65536); *ts_ += __builtin_amdgcn_s_memrealtime() - th0_; }
#endif
        GROUP_BAR();
        if (l == DEPTH - 1) { if (tid == 0) (void)xb_add((unsigned*)(P->ws + WS_CTL) + CW_WDONE, 1u); }
        PFRESH(); gemm_phase_of<2>(P, l, lds, G, bx);
        GROUP_BAR();
        PFRESH(); gemm_phase_of<3>(P, l, lds, G, bx);
        GROUP_BAR();
        PFRESH(); gemm_phase_of<4>(P, l, lds, G, bx);
        GROUP_BAR();
        if (l == DEPTH - 1) {
            unsigned* ctl = (unsigned*)(P->ws + WS_CTL);
            if (tid == 0) { unsigned sp = 0; while (xb_ld(&ctl[CW_WDONE]) < (unsigned)G) { __builtin_amdgcn_s_sleep(8);
                if ((++sp & 255u) == 0u) { if (xb_ld(&ctl[CW_BAR + XB_TMO])) break; if (sp > XB_SPIN_CAP) { atomicAdd(&ctl[CW_BAR + XB_TMO], 1u); break; } } } }
            __syncthreads(); }
        PFRESH(); gemm_phase_of<5>(P, l, lds, G, bx);
        if (l < DEPTH - 1) GROUP_BAR();
    }
#if PROBE_H
    if (grp == 0 && rk == 0 && tid == 0) { const unsigned long long tt_ = __hip_atomic_load((unsigned long long*)(P->ws + WS_CTL + 65536), __ATOMIC_RELAXED, __HIP_MEMORY_SCOPE_AGENT) * 4ull; const unsigned long long t0_ = __builtin_amdgcn_s_memrealtime(); while (__builtin_amdgcn_s_memrealtime() - t0_ < tt_) __builtin_amdgcn_s_sleep(8); }
#endif
#if PROBE_T
    if (vcu == 0 && tid == 0) { const unsigned long long tt_ = *(volatile unsigned long long*)(P->ws + WS_CTL + 65536) * 8ull; const unsigned long long t0_ = __builtin_amdgcn_s_memrealtime(); while (__builtin_amdgcn_s_memrealtime() - t0_ < tt_) __builtin_amdgcn_s_sleep(8); }
#endif
}

extern "C" void kernel_launch(void* const* d_in, const int* in_sizes, int n_in, void* d_out, int out_size, void* d_ws, size_t ws_size, hipStream_t stream) {
    static int grid = 0;
    if (grid == 0) {
        if (n_in != 25 || out_size != M * D || ws_size < WS_END) { fprintf(stderr, "kernel_launch: unexpected shapes (n_in %d, out %d, ws %zu)\n", n_in, out_size, ws_size); grid = -1; return; }
        int dev = 0, cus = 0, per_cu = 0; if (hipGetDevice(&dev) != hipSuccess || hipDeviceGetAttribute(&cus, hipDeviceAttributeMultiprocessorCount, dev) != hipSuccess) { grid = -1; return; }
        if (hipFuncSetAttribute((const void*)k_mega, hipFuncAttributeMaxDynamicSharedMemorySize, LDS_BYTES) != hipSuccess) { fprintf(stderr, "kernel_launch: hipFuncSetAttribute failed\n"); grid = -1; return; }
        if (hipOccupancyMaxActiveBlocksPerMultiprocessor(&per_cu, (const void*)k_mega, 512, LDS_BYTES) != hipSuccess || per_cu < 1) fprintf(stderr, "kernel_launch: occupancy query reports %d workgroups per CU\n", per_cu);
        (void)hipGetLastError();
        grid = cus - cus % 16;
        if (grid < 16) { grid = -1; return; }
    }
    if (grid < 0) return;
    Params p; memset(&p, 0, sizeof(p));
    for (int i = 0; i < 25; ++i) p.in[i] = (const float*)d_in[i];
    p.out = (float*)d_out; p.ws = (unsigned char*)d_ws;
    (void)hipMemsetAsync((char*)d_ws + WS_CTL, 0, CTL_BYTES, stream);
    hipLaunchKernelGGL(k_mega, dim3(grid), dim3(512), LDS_BYTES, stream, p);
}
```

```cpp
#include <hip/hip_runtime.h>
#include <cstdio>
#include <cstdint>
#include <cstring>

constexpr int D = 1024, BATCH = 16, T = 2048, DEPTH = 4, M = BATCH * T;
constexpr int HD = 64;
constexpr int NA = 4608;
constexpr int NG = 3072;
constexpr int INW = NA + NG;
constexpr int C_AQ = 0, C_AK = 512, C_AV = 640, C_RW = 768, C_RQ = 2560, C_RK = 3072, C_RV = 3584, C_RG = 4096;
constexpr int RWC = 1792;
constexpr int FF = 2816, FF2 = 2 * FF;
constexpr int NMIX = 1536;

constexpr size_t MiB = 1u << 20;
constexpr size_t WS_CTL = 0, CTL_BYTES = 1 * MiB;
constexpr size_t WS_WIN = 1 * MiB;
constexpr size_t WS_WMIX = WS_WIN + (size_t)INW * D * 2;
constexpr size_t WS_WOUT = WS_WMIX + (size_t)D * NMIX * 2;
constexpr size_t WS_WGU = WS_WOUT + (size_t)D * D * 2;
constexpr size_t WS_WDN = WS_WGU + (size_t)FF2 * D * 2;
constexpr size_t WS_XB = 38 * MiB;
constexpr size_t WS_MIXO = 102 * MiB;
constexpr size_t WS_BIG = 198 * MiB;
constexpr size_t WS_MIXED = WS_BIG + 192 * MiB;
constexpr size_t WS_RSS = 486 * MiB;
constexpr size_t WS_ROPE = 488 * MiB;
constexpr size_t WS_ROPE2 = WS_ROPE + 512 * 1024;
constexpr size_t WS_GX = 489 * MiB;
constexpr size_t WS_END = 505 * MiB;
static_assert(WS_WDN + (size_t)D * FF * 2 <= WS_XB && WS_WDN + (size_t)D * FF * 2 - WS_WIN <= 37 * MiB && 3 * 37 * MiB <= (size_t)M * D * 4, "weights fit");
static_assert(WS_BIG + (size_t)M * NA * 2 <= WS_RSS, "big region fits");

#define GAS __attribute__((address_space(1)))
#define LAS __attribute__((address_space(3)))
typedef unsigned short bf16;
typedef unsigned v4u __attribute__((ext_vector_type(4)));
typedef unsigned v2u __attribute__((ext_vector_type(2)));
typedef float v4f __attribute__((ext_vector_type(4)));
__device__ __forceinline__ unsigned f2bf(float f) { unsigned u = __builtin_bit_cast(unsigned, f); return (u + 0x7fffu + ((u >> 16) & 1u)) >> 16; }
__device__ __forceinline__ unsigned pk2(float lo, float hi) { return f2bf(lo) | (f2bf(hi) << 16); }
__device__ __forceinline__ float bf2f(unsigned short b) { return __builtin_bit_cast(float, (unsigned)b << 16); }
__device__ __forceinline__ float bflo(unsigned w) { return __builtin_bit_cast(float, w << 16); }
__device__ __forceinline__ float bfhi(unsigned w) { return __builtin_bit_cast(float, w & 0xffff0000u); }
__device__ __forceinline__ float wave_sum(float v) {
#pragma unroll
    for (int o = 1; o < 64; o <<= 1) v += __shfl_xor(v, o);
    return v;
}
__device__ __forceinline__ float wave_max(float v) {
#pragma unroll
    for (int o = 1; o < 64; o <<= 1) v = fmaxf(v, __shfl_xor(v, o));
    return v;
}
__device__ __forceinline__ float sigmoidf_(float x) { return 1.f / (1.f + __expf(-x)); }

__device__ __forceinline__ int otid() { int t = threadIdx.x; asm volatile("" : "+v"(t)); return t; }

struct Params {
    const float* in[25];
    float* out;
    unsigned char* ws;
    int layer; int pad;
};
typedef const __attribute__((address_space(4))) Params* KP;
constexpr size_t WL_STRIDE = 37 * MiB;
__device__ __forceinline__ unsigned char* wbase(KP P, int l) { return l == DEPTH - 1 ? P->ws : (unsigned char*)P->out + (size_t)l * WL_STRIDE - WS_WIN; }
constexpr size_t OUT_ZS = (DEPTH - 1) * WL_STRIDE;
static_assert(OUT_ZS + (size_t)M * 256 * 2 <= (size_t)M * D * 4, "zs fits in d_out");
enum { I_X = 0, I_N1G, I_WIN, I_QNG, I_KNG, I_SINK, I_WAO, I_MU, I_W0, I_W2, I_A0, I_A2, I_G2, I_KK, I_KA, I_RK, I_LNG, I_LNB, I_WRO, I_WTO, I_WOUT, I_N2G, I_WG, I_WU, I_WD };


namespace pg8 {
#define PG8_LAS __attribute__((address_space(3)))
typedef unsigned short bf16_t;
typedef short bf16x8 __attribute__((ext_vector_type(8)));
typedef float f32x4 __attribute__((ext_vector_type(4)));
typedef unsigned u32x4 __attribute__((ext_vector_type(4)));
constexpr int BM = 256, BK = 64, HALF = 128, HTB = HALF * BK * 2  , STAGE_BYTES = 8 * HTB, NXCD = 8, WGM = 8;

__host__ __device__ __forceinline__ int lds_byte(int r, int c) { const int st = (r >> 4) * 2 + (c >> 5), rr = r & 15, cc = c & 31, ob = rr * 64 + cc * 2; return st * 1024 + (ob ^ (((ob >> 9) & 1) << 5)); }
__host__ __device__ __forceinline__ void stage_rc(int b, int& R, int& C) { const int st = b / 1024, sb = b % 1024, swz = sb ^ (((sb >> 9) & 1) << 5); R = (st >> 1) * 16 + swz / 64; C = (st & 1) * 32 + (swz % 64) / 2; }
__host__ __device__ __forceinline__ int perm32(int rho) { const int n = rho >> 4, i = rho & 15; return 8 * (i >> 2) + 4 * n + (i & 3); }

struct Unit { int pm, pn; };
struct Gemm { const bf16_t* A; const bf16_t* Bt; int M, N, K, lda; };

struct StaticOrder {
    int nM, nN, nwg, G, c, i0, ni;
    __host__ __device__ void init(int M, int N, int G_, int c_) { nM = M / BM; nN = N / BM; nwg = nM * nN; G = G_; c = c_; i0 = 0; ni = 1 << 30; }
    __host__ __device__ bool next(int i, Unit& u) const {
        if (i >= ni) return false;
        const long L = (long)(i0 + i) * G + c; if (L >= nwg) return false;
        int wgid = (int)L; { const int q = nwg / NXCD, r = nwg % NXCD, xcd = wgid % NXCD, off = wgid / NXCD; wgid = (xcd < r ? xcd * (q + 1) : r * (q + 1) + (xcd - r) * q) + off; }
        const int nig = WGM * nN, gid = wgid / nig, fm = gid * WGM, gsz = (nM - fm) < WGM ? (nM - fm) : WGM;
        u.pm = fm + ((wgid % nig) % gsz); u.pn = (wgid % nig) / gsz; return true;
    }
    __device__ __forceinline__ void a_ready(const Unit&) const {}
    __device__ __forceinline__ void done(const Unit&) const {}
};


typedef float f32x2_ __attribute__((ext_vector_type(2))); typedef __bf16 bf16x2_ __attribute__((ext_vector_type(2)));
__device__ __forceinline__ unsigned cvt_pk_bf16(float lo, float hi) { const f32x2_ x = {lo, hi}; return __builtin_bit_cast(unsigned, __builtin_convertvector(x, bf16x2_)); }
__device__ __forceinline__ float clampg(float x) { return __builtin_amdgcn_fmed3f(x, -30.0f, 30.0f); }
__device__ __forceinline__ float row_rstd(const float* rss, int row) {
    const f32x4* p = (const f32x4*)(rss + (size_t)row * 16);
    const f32x4 a = p[0], b = p[1], c = p[2], d = p[3];
    const float s = (((a.x + a.y) + (a.z + a.w)) + ((b.x + b.y) + (b.z + b.w))) + (((c.x + c.y) + (c.z + c.w)) + ((d.x + d.y) + (d.z + d.w)));
    return rsqrtf(s * (1.0f / 1024.0f) + 1e-6f);
}
struct RowTab {
    const float* rss;
    __device__ __forceinline__ void tab_load(const Unit& u, int tid, f32x4& a, f32x4& b) const { const f32x4* p = (const f32x4*)(rss + ((size_t)u.pm * BM + (tid >> 1)) * 16 + (tid & 1) * 8); a = p[0]; b = p[1]; }
    __device__ __forceinline__ void tab_store(PG8_LAS float* tab, int tid, const f32x4& a, const f32x4& b) const {
        float s = ((a.x + a.y) + (a.z + a.w)) + ((b.x + b.y) + (b.z + b.w)); s += __shfl_xor(s, 1);
        if ((tid & 1) == 0) tab[tid >> 1] = rsqrtf(s * (1.0f / 1024.0f) + 1e-6f); }
};
struct EpiRowScale : RowTab {
    static constexpr bool PERM = true, AFTER_DRAIN = false, ROWTAB = true, ACCINIT = false; static constexpr int KSEG = 0;
    bf16_t* O; int ldc;
    __device__ __forceinline__ void operator()(const f32x4 (&acc)[2][2][4][2], const Unit& u, int wr, int wc, int fr, int fq, const PG8_LAS float* tab) const {
        const int row0 = u.pm * BM + wr * 64 + fr, col0 = u.pn * BM + wc * 32 + 8 * fq;
#pragma unroll
        for (int ai = 0; ai < 2; ++ai)
#pragma unroll
            for (int m = 0; m < 4; ++m) { const int row = row0 + ai * HALF + m * 16; const float rs = tab[wr * 64 + fr + ai * HALF + m * 16]; bf16_t* rowp = O + (size_t)row * ldc + col0;
#pragma unroll
                for (int bj = 0; bj < 2; ++bj) { const f32x4 v0 = acc[ai][bj][m][0] * rs, v1 = acc[ai][bj][m][1] * rs;
                    u32x4 w; w.x = cvt_pk_bf16(v0[0], v0[1]); w.y = cvt_pk_bf16(v0[2], v0[3]); w.z = cvt_pk_bf16(v1[0], v1[1]); w.w = cvt_pk_bf16(v1[2], v1[3]);
                    *(u32x4*)(rowp + bj * HALF) = w; } }
    }
};
struct GateMap { bf16_t* proj; bf16_t* gx;
    __device__ __forceinline__ bf16_t* tile(int gt, int& ld) const { if (gt < 11) { ld = 4608; return proj + (gt < 3 ? gt * 256 : 2560 + (gt - 3) * 256); } ld = 256; return gx; } };
struct EpiGates : RowTab {
    static constexpr bool PERM = true, AFTER_DRAIN = false, ROWTAB = true, ACCINIT = false; static constexpr int KSEG = 0;
    GateMap gm;
    __device__ __forceinline__ void operator()(const f32x4 (&acc)[2][2][4][2], const Unit& u, int wr, int wc, int fr, int fq, const PG8_LAS float* tab) const {
        int ld; bf16_t* base = gm.tile(u.pn, ld); const int row0 = u.pm * BM + wr * 64 + fr, col0 = wc * 32 + 8 * fq;
#pragma unroll
        for (int ai = 0; ai < 2; ++ai)
#pragma unroll
            for (int m = 0; m < 4; ++m) { const int row = row0 + ai * HALF + m * 16; const float rs = tab[wr * 64 + fr + ai * HALF + m * 16]; bf16_t* rowp = base + (size_t)row * ld + col0;
#pragma unroll
                for (int bj = 0; bj < 2; ++bj) { const f32x4 v0 = acc[ai][bj][m][0] * rs, v1 = acc[ai][bj][m][1] * rs;
                    u32x4 w; w.x = cvt_pk_bf16(v0[0], v0[1]); w.y = cvt_pk_bf16(v0[2], v0[3]); w.z = cvt_pk_bf16(v1[0], v1[1]); w.w = cvt_pk_bf16(v1[2], v1[3]);
                    *(u32x4*)(rowp + bj * HALF) = w; } }
    }
};
struct EpiSwiglu : RowTab {
    static constexpr bool PERM = true, AFTER_DRAIN = false, ROWTAB = true, ACCINIT = false; static constexpr int KSEG = 0;
    bf16_t* O; int ldc;
    __device__ __forceinline__ void operator()(const f32x4 (&acc)[2][2][4][2], const Unit& u, int wr, int wc, int fr, int fq, const PG8_LAS float* tab) const {
        const int row0 = u.pm * BM + wr * 64 + fr, col0 = u.pn * HALF + wc * 32 + 8 * fq;
#pragma unroll
        for (int ai = 0; ai < 2; ++ai)
#pragma unroll
            for (int m = 0; m < 4; ++m) { const int row = row0 + ai * HALF + m * 16; const float rs = tab[wr * 64 + fr + ai * HALF + m * 16]; bf16_t* rowp = O + (size_t)row * ldc + col0;
                float o[8];
#pragma unroll
                for (int n = 0; n < 2; ++n)
#pragma unroll
                    for (int j = 0; j < 4; ++j) { const float g = acc[ai][0][m][n][j] * rs, up = acc[ai][1][m][n][j] * rs; o[4 * n + j] = g * up * __builtin_amdgcn_rcpf(1.0f + __expf(-g)); }
                u32x4 w; w.x = cvt_pk_bf16(o[0], o[1]); w.y = cvt_pk_bf16(o[2], o[3]); w.z = cvt_pk_bf16(o[4], o[5]); w.w = cvt_pk_bf16(o[6], o[7]);
                *(u32x4*)rowp = w; }
    }
};
struct EpiResid {
    static constexpr bool PERM = true, AFTER_DRAIN = false, ROWTAB = false, ACCINIT = true; static constexpr int KSEG = 0;
    bf16_t* XB; float* rss; float* OUT;
    __device__ __forceinline__ void init(f32x4 (&acc)[2][2][4][2], const Unit& u, int wr, int wc, int fr, int fq) const {
        const int row0 = u.pm * BM + wr * 64 + fr, col0 = u.pn * BM + wc * 32 + 8 * fq;
#pragma unroll
        for (int ai = 0; ai < 2; ++ai) { u32x4 xin[4][2];
#pragma unroll
            for (int m = 0; m < 4; ++m)
#pragma unroll
                for (int bj = 0; bj < 2; ++bj) xin[m][bj] = *(const u32x4*)(XB + (size_t)(row0 + ai * HALF + m * 16) * 1024 + col0 + bj * HALF);
#pragma unroll
            for (int m = 0; m < 4; ++m)
#pragma unroll
                for (int bj = 0; bj < 2; ++bj)
#pragma unroll
                    for (int q = 0; q < 4; ++q) { const unsigned w = xin[m][bj][q]; acc[ai][bj][m][q >> 1][(q & 1) * 2] = __builtin_bit_cast(float, w << 16); acc[ai][bj][m][q >> 1][(q & 1) * 2 + 1] = __builtin_bit_cast(float, w & 0xffff0000u); } }
    }
    __device__ __forceinline__ void operator()(const f32x4 (&acc)[2][2][4][2], const Unit& u, int wr, int wc, int fr, int fq) const {
        const int row0 = u.pm * BM + wr * 64 + fr, col0 = u.pn * BM + wc * 32 + 8 * fq;
#pragma unroll
        for (int g = 0; g < 8; ++g) { const int ai = g >> 2, m = g & 3; const int row = row0 + ai * HALF + m * 16; const size_t off = (size_t)row * 1024 + col0; float ss = 0.f;
#pragma unroll
            for (int bj = 0; bj < 2; ++bj) { const f32x4 x0 = acc[ai][bj][m][0], x1 = acc[ai][bj][m][1];
                ss += ((x0[0] * x0[0] + x0[1] * x0[1]) + (x0[2] * x0[2] + x0[3] * x0[3])) + ((x1[0] * x1[0] + x1[1] * x1[1]) + (x1[2] * x1[2] + x1[3] * x1[3]));
                u32x4 w; w.x = cvt_pk_bf16(x0[0], x0[1]); w.y = cvt_pk_bf16(x0[2], x0[3]); w.z = cvt_pk_bf16(x1[0], x1[1]); w.w = cvt_pk_bf16(x1[2], x1[3]);
                *(u32x4*)(XB + off + bj * HALF) = w;
                if (OUT) { *(f32x4*)(OUT + off + bj * HALF) = x0; *(f32x4*)(OUT + off + bj * HALF + 4) = x1; } }
            ss += __shfl_xor(ss, 16); ss += __shfl_xor(ss, 32);
            if (fq == 0) rss[(size_t)row * 16 + u.pn * 4 + wc] = ss; }
    }
};
struct EpiGateMix {
    static constexpr bool PERM = true, AFTER_DRAIN = false, ROWTAB = false, ACCINIT = false; static constexpr int KSEG = 8;
    GateMap gm; bf16_t* O; int ldo;
    static constexpr int PF = 4;
    __device__ __forceinline__ void seg(f32x4 (&acc)[2][2][4][2], const Unit& u, int s, int wr, int wc, int fr, int fq) const {
        const int row0 = u.pm * BM + wr * 64 + fr, col0 = wc * 32 + 8 * fq; int ldl, ldh; const bf16_t* bl = gm.tile((s - 1) * 4 + u.pn, ldl); const bf16_t* bh = gm.tile(s * 4 + u.pn, ldh);
        u32x4 lo[PF][2], hi[PF][2];
#pragma unroll
        for (int g = 0; g < PF; ++g) { const size_t rown = (size_t)(row0 + (g >> 2) * HALF + (g & 3) * 16);
#pragma unroll
            for (int bj = 0; bj < 2; ++bj) { lo[g][bj] = *(const u32x4*)(bl + rown * ldl + col0 + bj * HALF); hi[g][bj] = *(const u32x4*)(bh + rown * ldh + col0 + bj * HALF); } }
#pragma unroll
        for (int g = 0; g < 8; ++g) { const int ai = g >> 2, m = g & 3, sl = g % PF;
#pragma unroll
            for (int bj = 0; bj < 2; ++bj)
#pragma unroll
                for (int q = 0; q < 4; ++q) { const unsigned wl = lo[sl][bj][q], wh = hi[sl][bj][q];
                    const float l0 = clampg(__builtin_bit_cast(float, wl << 16)), l1 = clampg(__builtin_bit_cast(float, wl & 0xffff0000u)), h0 = clampg(__builtin_bit_cast(float, wh << 16)), h1 = clampg(__builtin_bit_cast(float, wh & 0xffff0000u));
                    const float r0 = (1.0f + __expf(-h0)) * __builtin_amdgcn_rcpf(1.0f + __expf(-l0)), r1 = (1.0f + __expf(-h1)) * __builtin_amdgcn_rcpf(1.0f + __expf(-l1));
                    acc[ai][bj][m][q >> 1][(q & 1) * 2] *= r0; acc[ai][bj][m][q >> 1][(q & 1) * 2 + 1] *= r1; }
            if (g + PF < 8) { const size_t rown = (size_t)(row0 + ((g + PF) >> 2) * HALF + ((g + PF) & 3) * 16);
#pragma unroll
                for (int bj = 0; bj < 2; ++bj) { lo[sl][bj] = *(const u32x4*)(bl + rown * ldl + col0 + bj * HALF); hi[sl][bj] = *(const u32x4*)(bh + rown * ldh + col0 + bj * HALF); } } }
    }
    __device__ __forceinline__ void operator()(const f32x4 (&acc)[2][2][4][2], const Unit& u, int wr, int wc, int fr, int fq) const {
        const int row0 = u.pm * BM + wr * 64 + fr, col0 = wc * 32 + 8 * fq; int ldg; const bf16_t* bg = gm.tile(8 + u.pn, ldg);
        u32x4 gc[PF][2];
#pragma unroll
        for (int g = 0; g < PF; ++g) { const size_t rown = (size_t)(row0 + (g >> 2) * HALF + (g & 3) * 16);
#pragma unroll
            for (int bj = 0; bj < 2; ++bj) gc[g][bj] = *(const u32x4*)(bg + rown * ldg + col0 + bj * HALF); }
#pragma unroll
        for (int gi = 0; gi < 8; ++gi) { const int ai = gi >> 2, m = gi & 3, sl = gi % PF; const int row = row0 + ai * HALF + m * 16; bf16_t* rowp = O + (size_t)row * ldo + u.pn * BM + col0;
#pragma unroll
            for (int bj = 0; bj < 2; ++bj) { const u32x4 g = gc[sl][bj]; float o[8];
#pragma unroll
                for (int q = 0; q < 4; ++q) { const unsigned w = g[q]; const float g0 = clampg(__builtin_bit_cast(float, w << 16)), g1 = clampg(__builtin_bit_cast(float, w & 0xffff0000u));
                    o[2 * q] = acc[ai][bj][m][q >> 1][(q & 1) * 2] * __builtin_amdgcn_rcpf(1.0f + __expf(-g0)); o[2 * q + 1] = acc[ai][bj][m][q >> 1][(q & 1) * 2 + 1] * __builtin_amdgcn_rcpf(1.0f + __expf(-g1)); }
                u32x4 w; w.x = cvt_pk_bf16(o[0], o[1]); w.y = cvt_pk_bf16(o[2], o[3]); w.z = cvt_pk_bf16(o[4], o[5]); w.w = cvt_pk_bf16(o[6], o[7]);
                *(u32x4*)(rowp + bj * HALF) = w; }
            if (gi + PF < 8) { const size_t rown = (size_t)(row0 + ((gi + PF) >> 2) * HALF + ((gi + PF) & 3) * 16);
#pragma unroll
                for (int bj = 0; bj < 2; ++bj) gc[sl][bj] = *(const u32x4*)(bg + rown * ldg + col0 + bj * HALF); } }
    }
};


template <class Epi, class Sched, bool ALIGN_EPI = false, bool SP2 = false>
__device__ __forceinline__ void gemm_phase(PG8_LAS unsigned char* lds, const Gemm g, const Sched& S, const Epi& E) {
    int tid_ = threadIdx.x; asm volatile("" : "+v"(tid_));
    const int tid = tid_, wid = __builtin_amdgcn_readfirstlane(tid >> 6), lane = tid & 63, wr = wid >> 2, wc = wid & 3, fr = lane & 15, fq = lane >> 4;
    const int K = g.K, nt = K / BK;
    unsigned voffA[2], voffB[2];
#pragma unroll
    for (int i = 0; i < 2; ++i) { int R, C; stage_rc(tid * 16 + i * 8192, R, C); const int Rb = Epi::PERM ? ((R & ~31) + perm32(R & 31)) : R;
        voffA[i] = (unsigned)(R * g.lda + C) * 2u; voffB[i] = (unsigned)(Rb * K + C) * 2u; }
    const size_t kstep = (size_t)(BK * 2);
    const size_t hstepB = (size_t)HALF * K * 2, hstepA = (size_t)HALF * g.lda * 2;
    const size_t tstepB = 2 * hstepB, tstepA = 2 * hstepA;
    const unsigned ldsw = (unsigned)wid * 1024u;
    const int aoff = lds_byte(wr * 64 + fr, fq * 8), boff = lds_byte(wc * 32 + fr, fq * 8);
#define PG8_SA(b, h) (((b) * 2 + (h)) * HTB)
#define PG8_SB(b, h) ((4 + (b) * 2 + (h)) * HTB)
#define PG8_STAGE(bufoff, gbase, voff) do { _Pragma("unroll") for (int _i = 0; _i < 2; ++_i) \
        __builtin_amdgcn_global_load_lds((const unsigned*)((const char*)(gbase) + (voff)[_i]), (PG8_LAS unsigned*)(lds + (bufoff) + ldsw + _i * 8192), 16, 0, 0); } while (0)
#define PG8_LDA(dst, b, h) do { _Pragma("unroll") for (int m = 0; m < 4; ++m) _Pragma("unroll") for (int k = 0; k < 2; ++k) dst[m][k] = *(const PG8_LAS bf16x8*)(lds + PG8_SA(b, h) + aoff + m * 2048 + k * 1024); } while (0)
#define PG8_LDB(dst, b, h) do { _Pragma("unroll") for (int n = 0; n < 2; ++n) _Pragma("unroll") for (int k = 0; k < 2; ++k) dst[n][k] = *(const PG8_LAS bf16x8*)(lds + PG8_SB(b, h) + boff + n * 2048 + k * 1024); } while (0)
#define PG8_MMA(ai, bj, At, Bt) do { __builtin_amdgcn_s_setprio(1); _Pragma("unroll") for (int m = 0; m < 4; ++m) _Pragma("unroll") for (int n = 0; n < 2; ++n) _Pragma("unroll") for (int k = 0; k < 2; ++k) \
        acc[ai][bj][m][n] = __builtin_amdgcn_mfma_f32_16x16x32_bf16(Bt[n][k], At[m][k], acc[ai][bj][m][n], 0, 0, 0); __builtin_amdgcn_s_setprio(0); } while (0)
#define PG8_WAIT_V(n) asm volatile("s_waitcnt vmcnt(" #n ")" ::: "memory")
#define PG8_WAIT_L(n) asm volatile("s_waitcnt lgkmcnt(" #n ")" ::: "memory")
#define PG8_BAR __builtin_amdgcn_s_barrier()
#define PG8_SCHED __builtin_amdgcn_sched_barrier(0)
    Unit cur, nxt; int ui = 0;
    if (!S.next(0, cur)) return;
    f32x4 rt0 = (f32x4){0.f, 0.f, 0.f, 0.f}, rt1 = rt0;
    if constexpr (Epi::ROWTAB) { E.tab_load(cur, tid, rt0, rt1); E.tab_store((PG8_LAS float*)(lds + STAGE_BYTES), tid, rt0, rt1); }
    f32x4 acc[2][2][4][2];
#pragma unroll
    for (int a = 0; a < 2; ++a)
#pragma unroll
        for (int b = 0; b < 2; ++b)
#pragma unroll
            for (int m = 0; m < 4; ++m)
#pragma unroll
                for (int n = 0; n < 2; ++n) acc[a][b][m][n] = (f32x4){0.f, 0.f, 0.f, 0.f};
    if constexpr (Epi::ACCINIT) E.init(acc, cur, wr, wc, fr, fq);
    bf16x8 At[4][2], B0[2][2], B1[2][2];
    const char* cA = (const char*)g.A + (size_t)cur.pm * tstepA; const char* cB = (const char*)g.Bt + (size_t)cur.pn * tstepB;
    S.a_ready(cur);
    if constexpr (SP2) {
        PG8_STAGE(PG8_SB(0, 0), cB, voffB); PG8_STAGE(PG8_SB(0, 1), cB + hstepB, voffB); PG8_STAGE(PG8_SA(0, 0), cA, voffA); PG8_STAGE(PG8_SA(0, 1), cA + hstepA, voffA);
        if (wr == 1) PG8_BAR;
        PG8_WAIT_V(2); PG8_BAR;
        PG8_STAGE(PG8_SB(1, 0), cB + kstep, voffB); PG8_STAGE(PG8_SA(1, 0), cA + kstep, voffA); PG8_STAGE(PG8_SB(1, 1), cB + hstepB + kstep, voffB);
        PG8_WAIT_V(6); PG8_BAR;
    } else {
        PG8_STAGE(PG8_SB(0, 0), cB, voffB); PG8_STAGE(PG8_SA(0, 0), cA, voffA); PG8_STAGE(PG8_SB(0, 1), cB + hstepB, voffB); PG8_STAGE(PG8_SA(0, 1), cA + hstepA, voffA);
        if (wr == 1) PG8_BAR;
        PG8_WAIT_V(4); PG8_BAR;
        PG8_STAGE(PG8_SB(1, 0), cB + kstep, voffB); PG8_STAGE(PG8_SA(1, 0), cA + kstep, voffA); PG8_STAGE(PG8_SB(1, 1), cB + hstepB + kstep, voffB);
        PG8_WAIT_V(6); PG8_BAR;
    }
    for (;;) {
        const bool has_next = S.next(ui + 1, nxt);
        const char* nA = has_next ? (const char*)g.A + (size_t)nxt.pm * tstepA : cA; const char* nB = has_next ? (const char*)g.Bt + (size_t)nxt.pn * tstepB : cB;
        for (int t = 0; t < nt; t += 2) {
            const bool last = (t == nt - 2);
            const char* a1 = cA + (size_t)(t + 1) * kstep;
            const char* a2 = last ? nA : cA + (size_t)(t + 2) * kstep; const char* b2 = last ? nB : cB + (size_t)(t + 2) * kstep;
            const char* a3 = a2 + kstep; const char* b3 = b2 + kstep;
            if (last && has_next) S.a_ready(nxt);
            if constexpr (Epi::ROWTAB) { if (has_next) { if (t == nt - 4) E.tab_load(nxt, tid, rt0, rt1);
                                                         if (last) E.tab_store((PG8_LAS float*)(lds + STAGE_BYTES + ((ui + 1) & 1) * 1024), tid, rt0, rt1); } }
            if constexpr (Epi::KSEG > 0) { if (t != 0 && (t % Epi::KSEG) == 0) {
                if constexpr (ALIGN_EPI) { if (wr == 0) PG8_BAR; }
                E.seg(acc, cur, t / Epi::KSEG, wr, wc, fr, fq);
                if constexpr (ALIGN_EPI) { if (wr == 1) PG8_BAR; } } }
            if constexpr (SP2) {
            PG8_LDB(B0, 0, 0); PG8_LDB(B1, 0, 1); PG8_SCHED; PG8_LDA(At, 0, 0); PG8_STAGE(PG8_SA(1, 1), a1 + hstepA, voffA);
            PG8_WAIT_V(8); PG8_WAIT_L(0); PG8_BAR; PG8_MMA(0, 0, At, B0); PG8_MMA(0, 1, At, B1); PG8_BAR; PG8_SCHED;
            PG8_LDA(At, 0, 1); PG8_STAGE(PG8_SB(0, 0), b2, voffB); PG8_STAGE(PG8_SB(0, 1), b2 + hstepB, voffB); PG8_STAGE(PG8_SA(0, 0), a2, voffA);
            PG8_WAIT_V(8); PG8_WAIT_L(0); PG8_BAR; PG8_MMA(1, 0, At, B0); PG8_MMA(1, 1, At, B1); PG8_BAR; PG8_SCHED;
            PG8_LDB(B0, 1, 0); PG8_LDB(B1, 1, 1); PG8_SCHED; PG8_LDA(At, 1, 0); PG8_STAGE(PG8_SA(0, 1), a2 + hstepA, voffA);
            PG8_WAIT_V(8); PG8_WAIT_L(0); PG8_BAR; PG8_MMA(0, 0, At, B0); PG8_MMA(0, 1, At, B1); PG8_BAR; PG8_SCHED;
            PG8_LDA(At, 1, 1); PG8_STAGE(PG8_SB(1, 0), b3, voffB); PG8_STAGE(PG8_SB(1, 1), b3 + hstepB, voffB); PG8_STAGE(PG8_SA(1, 0), a3, voffA);
            PG8_WAIT_V(8); PG8_WAIT_L(0); PG8_BAR; PG8_MMA(1, 0, At, B0); PG8_MMA(1, 1, At, B1); PG8_BAR; PG8_SCHED;
            } else {
            PG8_LDB(B0, 0, 0); PG8_SCHED; PG8_LDA(At, 0, 0); PG8_STAGE(PG8_SA(1, 1), a1 + hstepA, voffA);
            PG8_WAIT_L(8); PG8_BAR; PG8_WAIT_L(0); PG8_MMA(0, 0, At, B0); PG8_BAR; PG8_SCHED;
            PG8_LDB(B1, 0, 1); PG8_STAGE(PG8_SB(0, 0), b2, voffB);
            PG8_BAR; PG8_WAIT_L(0); PG8_MMA(0, 1, At, B1); PG8_BAR;
            PG8_LDA(At, 0, 1); PG8_STAGE(PG8_SA(0, 0), a2, voffA);
            PG8_BAR; PG8_WAIT_L(0); PG8_MMA(1, 0, At, B0); PG8_BAR; PG8_SCHED;
            PG8_STAGE(PG8_SB(0, 1), b2 + hstepB, voffB);
            PG8_WAIT_V(6); PG8_BAR; PG8_MMA(1, 1, At, B1); PG8_BAR;
            PG8_LDB(B0, 1, 0); PG8_SCHED; PG8_LDA(At, 1, 0); PG8_STAGE(PG8_SA(0, 1), a2 + hstepA, voffA);
            PG8_WAIT_L(8); PG8_BAR; PG8_WAIT_L(0); PG8_MMA(0, 0, At, B0); PG8_BAR; PG8_SCHED;
            PG8_LDB(B1, 1, 1); PG8_STAGE(PG8_SB(1, 0), b3, voffB);
            PG8_BAR; PG8_WAIT_L(0); PG8_MMA(0, 1, At, B1); PG8_BAR;
            PG8_LDA(At, 1, 1); PG8_STAGE(PG8_SA(1, 0), a3, voffA);
            PG8_BAR; PG8_WAIT_L(0); PG8_MMA(1, 0, At, B0); PG8_BAR; PG8_SCHED;
            PG8_STAGE(PG8_SB(1, 1), b3 + hstepB, voffB);
            PG8_WAIT_V(6); PG8_BAR; PG8_MMA(1, 1, At, B1); PG8_BAR;
            }
        }
        if constexpr (ALIGN_EPI) { if (wr == 0) PG8_BAR; }
        if constexpr (!Epi::AFTER_DRAIN) { if constexpr (Epi::ROWTAB) E(acc, cur, wr, wc, fr, fq, (const PG8_LAS float*)(lds + STAGE_BYTES + (ui & 1) * 1024)); else E(acc, cur, wr, wc, fr, fq); S.done(cur); }
        if (!has_next) break;
#pragma unroll
        for (int a = 0; a < 2; ++a)
#pragma unroll
            for (int b = 0; b < 2; ++b)
#pragma unroll
                for (int m = 0; m < 4; ++m)
#pragma unroll
                    for (int n = 0; n < 2; ++n) acc[a][b][m][n] = (f32x4){0.f, 0.f, 0.f, 0.f};
        if constexpr (Epi::ACCINIT) E.init(acc, nxt, wr, wc, fr, fq);
        cur = nxt; cA = nA; cB = nB; ++ui;
        if constexpr (ALIGN_EPI) { if (wr == 1) PG8_BAR; }
    }
    PG8_WAIT_V(0);
    if constexpr (!ALIGN_EPI) { if (wr == 0) PG8_BAR; }
    PG8_BAR;
    if constexpr (Epi::AFTER_DRAIN) { E.fused(acc, cur, wr, wc, fr, fq, lds, wid, lane); S.done(cur); }
#undef PG8_SA
#undef PG8_SB
#undef PG8_STAGE
#undef PG8_LDA
#undef PG8_LDB
#undef PG8_MMA
#undef PG8_WAIT_V
#undef PG8_WAIT_L
#undef PG8_BAR
#undef PG8_SCHED
}
}


#define LDS_WAIT() asm volatile("s_waitcnt lgkmcnt(0)" ::: "memory")
constexpr int NWAVES = 8;
constexpr int LDS_BYTES = 157696;

struct WItem { const float* W; const float* scale; bf16* WT; int ldw, k0, n0, ldt, drow0, dcol0; };
constexpr int WI_IN = 16 * 240, WI_MIX = 3 * 8 * 32, WI_OUT = 16 * 32, WI_G = 16 * 88, WI_DN = 44 * 32;
constexpr int WI_TOTAL = WI_IN + WI_MIX + WI_OUT + 2 * WI_G + WI_DN;
__device__ __forceinline__ void witem_desc(KP P, int gi, WItem& d) {
    const int l = gi / WI_TOTAL; int it = gi - l * WI_TOTAL;
    unsigned char* ws = wbase(P, l);
    if (it < WI_IN) { const int kb = it / 240, nb = it % 240; d.W = P->in[I_WIN] + (size_t)l * D * INW; d.ldw = INW; d.k0 = 64 * kb; d.n0 = 32 * nb; d.scale = P->in[I_N1G] + l * D; d.WT = (bf16*)(ws + WS_WIN); d.ldt = D; d.drow0 = 32 * nb; d.dcol0 = 64 * kb; return; }
    it -= WI_IN;
    if (it < WI_MIX) { const int br = it / 256, r = it % 256, kb = r / 32, nb = r % 32; d.W = P->in[br == 0 ? I_WAO : (br == 1 ? I_WRO : I_WTO)] + (size_t)l * 512 * D;
        d.ldw = D; d.k0 = 64 * kb; d.n0 = 32 * nb; d.scale = nullptr; d.WT = (bf16*)(ws + WS_WMIX); d.ldt = NMIX; d.drow0 = 32 * nb; d.dcol0 = br * 512 + 64 * kb; return; }
    it -= WI_MIX;
    if (it < WI_OUT) { const int kb = it / 32, nb = it % 32; d.W = P->in[I_WOUT] + (size_t)l * D * D; d.ldw = D; d.k0 = 64 * kb; d.n0 = 32 * nb; d.scale = nullptr; d.WT = (bf16*)(ws + WS_WOUT); d.ldt = D; d.drow0 = 32 * nb; d.dcol0 = 64 * kb; return; }
    it -= WI_OUT;
    if (it < 2 * WI_G) { const int up = it / WI_G, r = it % WI_G, kb = r / 88, nb = r % 88, n0 = 32 * nb;
        d.W = P->in[up ? I_WU : I_WG] + (size_t)l * D * FF; d.ldw = FF; d.k0 = 64 * kb; d.n0 = n0; d.scale = P->in[I_N2G] + l * D; d.WT = (bf16*)(ws + WS_WGU); d.ldt = D; d.drow0 = (n0 / 128) * 256 + up * 128 + (n0 % 128); d.dcol0 = 64 * kb; return; }
    it -= 2 * WI_G;
    { const int kb = it / 32, nb = it % 32; d.W = P->in[I_WD] + (size_t)l * FF * D; d.ldw = D; d.k0 = 64 * kb; d.n0 = 32 * nb; d.scale = nullptr; d.WT = (bf16*)(ws + WS_WDN); d.ldt = FF; d.drow0 = 32 * nb; d.dcol0 = 64 * kb; }
}
__device__ __forceinline__ void witem_load(const WItem& d, int lane, v4f (&r)[8], v4f (&sc)[2]) {
    const float* src = d.W + (size_t)(d.k0 + (lane >> 3)) * d.ldw + d.n0 + 4 * (lane & 7);
#pragma unroll
    for (int i = 0; i < 8; ++i) r[i] = *(const v4f*)(src + (size_t)(8 * i) * d.ldw);
    sc[0] = (v4f){1.f, 1.f, 1.f, 1.f}; sc[1] = sc[0];
    if (d.scale) { const v4f* sp = (const v4f*)(d.scale + d.k0 + 8 * (lane & 7)); sc[0] = sp[0]; sc[1] = sp[1]; }
}
__device__ __forceinline__ void witem_store(const WItem& d, int lane, const v4f (&r)[8], const v4f (&sc)[2], LAS float* scr) {
    { LAS float* w = scr + (lane >> 3) * 33 + 4 * (lane & 7);
#pragma unroll
      for (int i = 0; i < 8; ++i) { w[(8 * i) * 33 + 0] = r[i].x; w[(8 * i) * 33 + 1] = r[i].y; w[(8 * i) * 33 + 2] = r[i].z; w[(8 * i) * 33 + 3] = r[i].w; } }
    LDS_WAIT(); asm volatile("" ::: "memory");
    const int c = lane & 7;
#pragma unroll
    for (int j = 0; j < 4; ++j) { const int n = (lane >> 3) + 8 * j; const LAS float* s = scr + (8 * c) * 33 + n;
        v4u o; o.x = pk2(s[0 * 33] * sc[0].x, s[1 * 33] * sc[0].y); o.y = pk2(s[2 * 33] * sc[0].z, s[3 * 33] * sc[0].w); o.z = pk2(s[4 * 33] * sc[1].x, s[5 * 33] * sc[1].y); o.w = pk2(s[6 * 33] * sc[1].z, s[7 * 33] * sc[1].w);
        *(v4u*)(d.WT + (size_t)(d.drow0 + n) * d.ldt + d.dcol0 + 8 * c) = o; }
    LDS_WAIT(); asm volatile("" ::: "memory");
}
__device__ __forceinline__ void phase_wconv_all(KP P, LAS unsigned char* lds, int vcu, int G) {
    const int otid_ = otid();
    const int wave = __builtin_amdgcn_readfirstlane(otid_ >> 6), lane = otid_ & 63;
    LAS float* scr = (LAS float*)(lds + wave * 16384);
    const int step = G * NWAVES, total = DEPTH * WI_TOTAL;
    int gi = vcu * NWAVES + wave;
    if (gi >= total) return;
    WItem cur, nxt; v4f rc[8], rn[8], sc[2], sn[2];
    witem_desc(P, gi, cur); witem_load(cur, lane, rc, sc);
#pragma unroll 1
    for (;;) {
        const int gn = gi + step; const bool has_next = gn < total;
        if (has_next) { witem_desc(P, gn, nxt); witem_load(nxt, lane, rn, sn); }
        witem_store(cur, lane, rc, sc, scr);
        if (!has_next) break;
        cur = nxt; gi = gn;
#pragma unroll
        for (int i = 0; i < 8; ++i) rc[i] = rn[i];
        sc[0] = sn[0]; sc[1] = sn[1];
    }
}
__device__ __forceinline__ void phase_x0(KP P, int vcu, int G) {
    const int otid_ = otid();
    const int wave = __builtin_amdgcn_readfirstlane(otid_ >> 6), lane = otid_ & 63;
    const float* x = P->in[I_X]; bf16* xb = (bf16*)(P->ws + WS_XB); float* rss = (float*)(P->ws + WS_RSS);
    for (int m0 = vcu * NWAVES + wave; m0 < M; m0 += 2 * G * NWAVES) {
        v4f v[2][4];
#pragma unroll
        for (int q = 0; q < 2; ++q) { const int m = m0 + q * G * NWAVES; const v4f* xr = (const v4f*)(x + (size_t)(m < M ? m : m0) * D) + lane;
#pragma unroll
            for (int j = 0; j < 4; ++j) v[q][j] = xr[64 * j]; }
#pragma unroll
        for (int q = 0; q < 2; ++q) { const int m = m0 + q * G * NWAVES; if (m < M) { unsigned long long* o8 = (unsigned long long*)(xb + (size_t)m * D) + lane; float s = 0.f;
#pragma unroll
            for (int j = 0; j < 4; ++j) s += (v[q][j].x * v[q][j].x + v[q][j].y * v[q][j].y) + (v[q][j].z * v[q][j].z + v[q][j].w * v[q][j].w);
            s = wave_sum(s);
#pragma unroll
            for (int j = 0; j < 4; ++j) { o8[64 * j] = (unsigned long long)pk2(v[q][j].x, v[q][j].y) | ((unsigned long long)pk2(v[q][j].z, v[q][j].w) << 32); }
            if (lane < 16) rss[(size_t)m * 16 + lane] = lane == 0 ? s : 0.f; } }
    }
    float* rope = (float*)(P->ws + WS_ROPE);
    for (int i = (vcu * NWAVES + wave) * 64 + lane; i < T * 32; i += G * NWAVES * 64) {
        const int t = i >> 5, j = i & 31; const float inv_freq = (float)exp(-((double)j / 32.0) * 9.210340371976184); const float ang = (float)t * inv_freq;
        const double xa = (double)ang, qd = rint(xa * 0.6366197723675814), fd = xa - qd * 1.5707963267948966; const int qi = (int)qd & 3;
        const float ff = (float)fd, f2 = ff * ff;
        const float sf = ff * (1.0f + f2 * (-1.6666667e-1f + f2 * (8.3333333e-3f + f2 * (-1.9841270e-4f + f2 * 2.7557319e-6f))));
        const float cf = 1.0f + f2 * (-0.5f + f2 * (4.1666667e-2f + f2 * (-1.3888889e-3f + f2 * (2.4801587e-5f + f2 * -2.7557319e-7f))));
        const float sn = (qi == 0) ? sf : (qi == 1) ? cf : (qi == 2) ? -sf : -cf, cs = (qi == 0) ? cf : (qi == 1) ? -sf : (qi == 2) ? -cf : sf;
        rope[2 * i] = cs; rope[2 * i + 1] = sn;
        { float* rope2 = (float*)(P->ws + WS_ROPE2); const int p = j >> 3, e = (j & 7) >> 1, o = j & 1;
          const size_t q = (((size_t)e * T + t) * 4 + p) * 4 + 2 * o; rope2[q] = cs; rope2[q + 1] = sn; }
    }
}


#define RESID_ALIGN true
#define STAGGER_US10 0
template <int PH> __device__ __forceinline__ void gemm_phase_of(KP P, int l, LAS unsigned char* lds, int G, int c, int i0 = 0, int ni = 1 << 30) {
    asm volatile("" : "+s"(l), "+s"(G), "+s"(c), "+s"(i0), "+s"(ni));
    const bool final_layer = (l == DEPTH - 1); const unsigned char* wb = wbase(P, l);
    unsigned char* ws = P->ws; const pg8::bf16_t* xb = (const pg8::bf16_t*)(ws + WS_XB); float* rss = (float*)(ws + WS_RSS);
    if constexpr (STAGGER_US10 > 0 && (PH == 0 || PH == 1 || PH == 4)) {
        if (otid() == 0) { const unsigned long long t0 = __builtin_amdgcn_s_memrealtime(), dt = (unsigned long long)(((unsigned)c >> 3) & 7u) * STAGGER_US10 * 10ull;
            while (__builtin_amdgcn_s_memrealtime() - t0 < dt) __builtin_amdgcn_s_sleep(8); }
        __syncthreads(); }
    pg8::StaticOrder S;
    if constexpr (PH == 0) { pg8::Gemm g{xb, (const pg8::bf16_t*)(wb + WS_WIN), M, NA, D, D}; S.init(M, NA, G, c); pg8::EpiRowScale E{{rss}, (pg8::bf16_t*)(ws + WS_BIG), NA};
        pg8::gemm_phase<pg8::EpiRowScale, pg8::StaticOrder, true, true>(lds, g, S, E); }
    if constexpr (PH == 1) { pg8::Gemm g{xb, (const pg8::bf16_t*)(wb + WS_WIN) + (size_t)NA * D, M, NG, D, D}; S.init(M, NG, G, c); S.i0 = i0; S.ni = ni; pg8::EpiGates E{{rss}, pg8::GateMap{(pg8::bf16_t*)(ws + WS_BIG), (pg8::bf16_t*)(ws + WS_GX)}};
        pg8::gemm_phase<pg8::EpiGates, pg8::StaticOrder, true, true>(lds, g, S, E); }
    if constexpr (PH == 2) { pg8::Gemm g{(const pg8::bf16_t*)(ws + WS_MIXO), (const pg8::bf16_t*)(wb + WS_WMIX), M, D, NMIX, NMIX}; S.init(M, D, G, c); pg8::EpiGateMix E{pg8::GateMap{(pg8::bf16_t*)(ws + WS_BIG), (pg8::bf16_t*)(ws + WS_GX)}, (pg8::bf16_t*)(ws + WS_BIG) + C_RW, NA};
        pg8::gemm_phase<pg8::EpiGateMix, pg8::StaticOrder, true, true>(lds, g, S, E); }
    if constexpr (PH == 3) { pg8::Gemm g{(const pg8::bf16_t*)(ws + WS_BIG) + C_RW, (const pg8::bf16_t*)(wb + WS_WOUT), M, D, D, NA}; S.init(M, D, G, c); pg8::EpiResid E{(pg8::bf16_t*)(ws + WS_XB), rss, nullptr};
        pg8::gemm_phase<pg8::EpiResid, pg8::StaticOrder, RESID_ALIGN, true>(lds, g, S, E); }
    if constexpr (PH == 4) { pg8::Gemm g{xb, (const pg8::bf16_t*)(wb + WS_WGU), M, FF2, D, D}; S.init(M, FF2, G, c); pg8::EpiSwiglu E{{rss}, (pg8::bf16_t*)(ws + WS_BIG), NA};
        pg8::gemm_phase<pg8::EpiSwiglu, pg8::StaticOrder, true, true>(lds, g, S, E); }
    if constexpr (PH == 5) { pg8::Gemm g{(const pg8::bf16_t*)(ws + WS_BIG), (const pg8::bf16_t*)(wb + WS_WDN), M, D, FF, NA}; S.init(M, D, G, c); pg8::EpiResid E{(pg8::bf16_t*)(ws + WS_XB), rss, final_layer ? P->out : nullptr};
        pg8::gemm_phase<pg8::EpiResid, pg8::StaticOrder, RESID_ALIGN, true>(lds, g, S, E); }
}

typedef float f32x16 __attribute__((ext_vector_type(16)));
typedef short bf16x8v __attribute__((ext_vector_type(8)));
constexpr int AT_KS = 144;
constexpr int AT_VS = 520;
constexpr int AT_KOFF = 0, AT_VOFF = 256 * AT_KS, AT_GOFF = AT_VOFF + 64 * AT_VS;
typedef float v2f_ __attribute__((ext_vector_type(2)));
typedef __bf16 v2bf_ __attribute__((ext_vector_type(2)));
__device__ __forceinline__ unsigned cvtpk(float lo, float hi) { const v2f_ x = {lo, hi}; return __builtin_bit_cast(unsigned, __builtin_convertvector(x, v2bf_)); }
#define LDS_BAR() do { asm volatile("s_waitcnt lgkmcnt(0)" ::: "memory"); __builtin_amdgcn_s_barrier(); asm volatile("" ::: "memory"); } while (0)
__device__ __forceinline__ void attn_phase(KP P, int l, LAS unsigned char* lds, int u0, int ustep, int uend) {
    const int tid = otid(), w = __builtin_amdgcn_readfirstlane(tid >> 6), lane = tid & 63, r32 = lane & 31, h = lane >> 5;
    const bf16* proj = (const bf16*)(P->ws + WS_BIG); bf16* mixo = (bf16*)(P->ws + WS_MIXO);
    const float* gq = P->in[I_QNG] + l * 64; const float* gk = P->in[I_KNG] + l * 64; const float* sinks = P->in[I_SINK] + l * 8;
    LAS float* gqs = (LAS float*)(lds + AT_GOFF);
    constexpr float LOG2E = 1.4426950408889634f;
    __syncthreads();
    if (tid < 64) { gqs[tid] = gq[tid] * (0.125f * LOG2E); gqs[64 + tid] = gk[tid]; }
    v4u kv[4], vv[4];
#define AT_LOAD(U) do { const int b_ = (U) >> 5, n_ = ((U) >> 1) & 15, kvh_ = (U) & 1, r_ = tid >> 1, hf_ = tid & 1; const size_t grow_ = (size_t)(b_ * T + n_ * 128 - 128 + r_) * NA; \
        _Pragma("unroll") for (int i = 0; i < 4; ++i) { kv[i] = (v4u){0u, 0u, 0u, 0u}; vv[i] = (v4u){0u, 0u, 0u, 0u}; } \
        if ((n_ > 0) || (r_ >= 128)) { _Pragma("unroll") for (int i = 0; i < 4; ++i) { kv[i] = *(const v4u*)(proj + grow_ + C_AK + kvh_ * 64 + hf_ * 32 + 8 * i); vv[i] = *(const v4u*)(proj + grow_ + C_AV + kvh_ * 64 + hf_ * 32 + 8 * i); } } } while (0)
    if (u0 < uend) AT_LOAD(u0);
    for (int unit = u0; unit < uend; unit += ustep) {
        const int b = unit >> 5, n = (unit >> 1) & 15, kvh = unit & 1;
        LDS_BAR();
        {
            const int r = tid >> 1, hf = tid & 1;
            float ss = 0.f;
#pragma unroll
            for (int i = 0; i < 4; ++i)
#pragma unroll
                for (int e = 0; e < 4; ++e) { const float k0 = bflo(kv[i][e]), k1 = bfhi(kv[i][e]); ss += k0 * k0 + k1 * k1; }
            ss += __shfl_xor(ss, 1);
            const float rs = rsqrtf(ss * (1.f / 64.f) + 1e-6f);
#pragma unroll
            for (int i = 0; i < 4; ++i) { v4u o;
#pragma unroll
                for (int e = 0; e < 4; ++e) { const int d = hf * 32 + 8 * i + 2 * e; o[e] = cvtpk(bflo(kv[i][e]) * rs * gqs[64 + d], bfhi(kv[i][e]) * rs * gqs[64 + d + 1]); }
                *(LAS v4u*)(lds + AT_KOFF + r * AT_KS + hf * 64 + 16 * i) = o; }
#pragma unroll
            for (int i = 0; i < 4; ++i)
#pragma unroll
                for (int e = 0; e < 4; ++e) { const int d = hf * 32 + 8 * i + 2 * e;
                    *(LAS unsigned short*)(lds + AT_VOFF + d * AT_VS + r * 2) = (unsigned short)(vv[i][e] & 0xffffu);
                    *(LAS unsigned short*)(lds + AT_VOFF + (d + 1) * AT_VS + r * 2) = (unsigned short)(vv[i][e] >> 16); }
        }
        LDS_BAR();
        if (unit + ustep < uend) AT_LOAD(unit + ustep);
#pragma unroll 1
        for (int gi = 0; gi < 2; ++gi) {
            const int g = w >> 1, sb = (w & 1) * 2 + gi, hq = kvh * 4 + g;
            const size_t qrow = (size_t)(b * T + n * 128 + 32 * sb + r32);
            v4u qr[4]; float ss = 0.f;
#pragma unroll
            for (int s = 0; s < 4; ++s) { qr[s] = *(const v4u*)(proj + qrow * NA + C_AQ + hq * 64 + 8 * h + 16 * s);
#pragma unroll
                for (int e = 0; e < 4; ++e) { const float q0 = bflo(qr[s][e]), q1 = bfhi(qr[s][e]); ss += q0 * q0 + q1 * q1; } }
            ss += __shfl_xor(ss, 32);
            const float rs = rsqrtf(ss * (1.f / 64.f) + 1e-6f);
            bf16x8v Qf[4];
#pragma unroll
            for (int s = 0; s < 4; ++s) { const v4f g0 = *(const LAS v4f*)(gqs + 8 * h + 16 * s), g1 = *(const LAS v4f*)(gqs + 8 * h + 16 * s + 4); v4u o;
                o[0] = cvtpk(bflo(qr[s][0]) * rs * g0[0], bfhi(qr[s][0]) * rs * g0[1]); o[1] = cvtpk(bflo(qr[s][1]) * rs * g0[2], bfhi(qr[s][1]) * rs * g0[3]);
                o[2] = cvtpk(bflo(qr[s][2]) * rs * g1[0], bfhi(qr[s][2]) * rs * g1[1]); o[3] = cvtpk(bflo(qr[s][3]) * rs * g1[2], bfhi(qr[s][3]) * rs * g1[3]);
                Qf[s] = __builtin_bit_cast(bf16x8v, o); }
            f32x16 S[5];
#pragma unroll
            for (int c5 = 0; c5 < 5; ++c5) { f32x16 acc;
#pragma unroll
                for (int i = 0; i < 16; ++i) acc[i] = 0.f;
#pragma unroll
                for (int s = 0; s < 4; ++s) { const bf16x8v kf = *(const LAS bf16x8v*)(lds + AT_KOFF + (32 * (sb + c5) + r32) * AT_KS + (8 * h + 16 * s) * 2);
                    acc = __builtin_amdgcn_mfma_f32_32x32x16_bf16(kf, Qf[s], acc, 0, 0, 0); }
                S[c5] = acc; }
            const int qi = 32 * sb + r32; float mx = -INFINITY;
#pragma unroll
            for (int c5 = 0; c5 < 5; ++c5)
#pragma unroll
                for (int i = 0; i < 16; ++i) { const int si = 32 * (sb + c5) + 8 * (i >> 2) + 4 * h + (i & 3);
                    bool ok = true; if (c5 == 0) ok = si > qi; if (c5 == 4) ok = si <= qi + 128; if (n == 0) ok = ok && (si >= 128);
                    const float v = ok ? S[c5][i] : -INFINITY; S[c5][i] = v; mx = fmaxf(mx, v); }
            mx = fmaxf(mx, __shfl_xor(mx, 32));
            const float sink = sinks[hq] * LOG2E; mx = fmaxf(mx, sink);
            float sum = 0.f;
#pragma unroll
            for (int c5 = 0; c5 < 5; ++c5)
#pragma unroll
                for (int i = 0; i < 16; ++i) { const float p = __builtin_amdgcn_exp2f(S[c5][i] - mx); S[c5][i] = p; sum += p; }
            sum += __shfl_xor(sum, 32);
            const float inv = __builtin_amdgcn_rcpf(sum + __builtin_amdgcn_exp2f(sink - mx));
            f32x16 O[2];
#pragma unroll
            for (int dt = 0; dt < 2; ++dt)
#pragma unroll
                for (int i = 0; i < 16; ++i) O[dt][i] = 0.f;
#pragma unroll
            for (int c5 = 0; c5 < 5; ++c5)
#pragma unroll
                for (int s = 0; s < 2; ++s) { v4u pw; pw[0] = cvtpk(S[c5][8 * s], S[c5][8 * s + 1]); pw[1] = cvtpk(S[c5][8 * s + 2], S[c5][8 * s + 3]); pw[2] = cvtpk(S[c5][8 * s + 4], S[c5][8 * s + 5]); pw[3] = cvtpk(S[c5][8 * s + 6], S[c5][8 * s + 7]);
                    const bf16x8v pf = __builtin_bit_cast(bf16x8v, pw);
#pragma unroll
                    for (int dt = 0; dt < 2; ++dt) { const LAS unsigned char* vp = lds + AT_VOFF + (32 * dt + r32) * AT_VS + (32 * (sb + c5) + 16 * s + 4 * h) * 2;
                        const v2u lo = *(const LAS v2u*)vp, hi = *(const LAS v2u*)(vp + 16); v4u vw; vw[0] = lo[0]; vw[1] = lo[1]; vw[2] = hi[0]; vw[3] = hi[1];
                        O[dt] = __builtin_amdgcn_mfma_f32_32x32x16_bf16(__builtin_bit_cast(bf16x8v, vw), pf, O[dt], 0, 0, 0); } }
#pragma unroll
            for (int dt = 0; dt < 2; ++dt)
#pragma unroll
                for (int q4 = 0; q4 < 4; ++q4) { v2u o; o[0] = cvtpk(O[dt][4 * q4] * inv, O[dt][4 * q4 + 1] * inv); o[1] = cvtpk(O[dt][4 * q4 + 2] * inv, O[dt][4 * q4 + 3] * inv);
                    *(v2u*)(mixo + qrow * NMIX + hq * 64 + 32 * dt + 8 * q4 + 4 * h) = o; }
        }
    }
    __syncthreads();
#undef AT_LOAD
}

constexpr int RT_KS = 144, RT_TS = 272;
constexpr int RT_KOFF = 0, RT_KTOFF = 128 * RT_KS, RT_VTOFF = RT_KTOFF + 64 * RT_TS, RT_ROFF = RT_VTOFF + 64 * RT_TS, RT_SOFF = RT_ROFF + 64 * RT_KS, RT_QOFF = RT_SOFF + 1024, RT_GOFF = RT_QOFF + 128 * RT_KS, RT_END = RT_GOFF + 128 * RT_KS;
static_assert(RT_END <= 131072, "retention LDS");
__device__ __forceinline__ void ret_unit(KP P, LAS unsigned char* lds, int b, int hh) {
    const int tid = otid(), w = __builtin_amdgcn_readfirstlane(tid >> 6), lane = tid & 63, r32 = lane & 31, h = lane >> 5;
    const bf16* proj = (const bf16*)(P->ws + WS_BIG); bf16* mixo = (bf16*)(P->ws + WS_MIXO); const float* rope2 = (const float*)(P->ws + WS_ROPE2);
    const float lg = log2f(1.0f - exp2f(-5.0f - (float)hh));
    const float g128 = exp2f(128.0f * lg);
    const int qg = w >> 1, dt = w & 1;
    f32x16 Racc;
#pragma unroll
    for (int i = 0; i < 16; ++i) Racc[i] = 0.f;
    __syncthreads();
    for (int i = tid; i < 64 * RT_KS / 4; i += 512) ((LAS unsigned*)(lds + RT_ROFF))[i] = 0u;
    v4u pk1, pk2, pv1, pv2, pq1, pq2, pg1, pg2; v4f prk[4];
#define RT_PREFETCH(N) do { const int row_ = tid >> 2, p_ = tid & 3; const size_t g_ = ((size_t)(b * T + (N) * 128) + row_) * NA + hh * 64 + 8 * p_; \
        pk1 = *(const v4u*)(proj + g_ + C_RK); pk2 = *(const v4u*)(proj + g_ + C_RK + 32); pv1 = *(const v4u*)(proj + g_ + C_RV); pv2 = *(const v4u*)(proj + g_ + C_RV + 32); \
        pq1 = *(const v4u*)(proj + g_ + C_RQ); pq2 = *(const v4u*)(proj + g_ + C_RQ + 32); pg1 = *(const v4u*)(proj + g_ + C_RG); pg2 = *(const v4u*)(proj + g_ + C_RG + 32); \
        _Pragma("unroll") for (int e_ = 0; e_ < 4; ++e_) prk[e_] = *(const v4f*)(rope2 + (((size_t)e_ * T + (N) * 128 + row_) * 4 + p_) * 4); } while (0)
    RT_PREFETCH(0);
#pragma unroll 1
    for (int n = 0; n < 16; ++n) {
        const size_t tok0 = (size_t)(b * T + n * 128);
        LDS_BAR();
        {
            const int row = tid >> 2, p = tid & 3;
            const v4u k1 = pk1, k2 = pk2, v1 = pv1, v2 = pv2, q1 = pq1, q2 = pq2;
            const float sc = 0.125f * exp2f(-(float)(row + 1) * lg);
            v4u w1, w2, x1, x2;
#pragma unroll
            for (int e = 0; e < 4; ++e) { const v4f cs = prk[e];
                { const float a1 = bflo(k1[e]), a2 = bflo(k2[e]), b1 = bfhi(k1[e]), b2 = bfhi(k2[e]);
                  w1[e] = cvtpk((a1 * cs[0] - a2 * cs[1]) * sc, (b1 * cs[2] - b2 * cs[3]) * sc); w2[e] = cvtpk((a2 * cs[0] + a1 * cs[1]) * sc, (b2 * cs[2] + b1 * cs[3]) * sc); }
                { const float a1 = bflo(q1[e]), a2 = bflo(q2[e]), b1 = bfhi(q1[e]), b2 = bfhi(q2[e]);
                  x1[e] = cvtpk(a1 * cs[0] - a2 * cs[1], b1 * cs[2] - b2 * cs[3]); x2[e] = cvtpk(a2 * cs[0] + a1 * cs[1], b2 * cs[2] + b1 * cs[3]); } }
            *(LAS v4u*)(lds + RT_KOFF + row * RT_KS + 16 * p) = w1; *(LAS v4u*)(lds + RT_KOFF + row * RT_KS + 64 + 16 * p) = w2;
            *(LAS v4u*)(lds + RT_QOFF + row * RT_KS + 16 * p) = x1; *(LAS v4u*)(lds + RT_QOFF + row * RT_KS + 64 + 16 * p) = x2;
            *(LAS v4u*)(lds + RT_GOFF + row * RT_KS + 16 * p) = pg1; *(LAS v4u*)(lds + RT_GOFF + row * RT_KS + 64 + 16 * p) = pg2;
#pragma unroll
            for (int e = 0; e < 4; ++e) { const int d = 8 * p + 2 * e;
                *(LAS unsigned short*)(lds + RT_KTOFF + d * RT_TS + row * 2) = (unsigned short)(w1[e] & 0xffffu); *(LAS unsigned short*)(lds + RT_KTOFF + (d + 1) * RT_TS + row * 2) = (unsigned short)(w1[e] >> 16);
                *(LAS unsigned short*)(lds + RT_KTOFF + (d + 32) * RT_TS + row * 2) = (unsigned short)(w2[e] & 0xffffu); *(LAS unsigned short*)(lds + RT_KTOFF + (d + 33) * RT_TS + row * 2) = (unsigned short)(w2[e] >> 16);
                *(LAS unsigned short*)(lds + RT_VTOFF + d * RT_TS + row * 2) = (unsigned short)(v1[e] & 0xffffu); *(LAS unsigned short*)(lds + RT_VTOFF + (d + 1) * RT_TS + row * 2) = (unsigned short)(v1[e] >> 16);
                *(LAS unsigned short*)(lds + RT_VTOFF + (d + 32) * RT_TS + row * 2) = (unsigned short)(v2[e] & 0xffffu); *(LAS unsigned short*)(lds + RT_VTOFF + (d + 33) * RT_TS + row * 2) = (unsigned short)(v2[e] >> 16); }
        }
        LDS_BAR();
        if (n + 1 < 16) RT_PREFETCH(n + 1);
        bf16x8v Qf[4];
        const size_t qtok = tok0 + 32 * qg + r32;
#pragma unroll
        for (int s = 0; s < 4; ++s) Qf[s] = *(const LAS bf16x8v*)(lds + RT_QOFF + (32 * qg + r32) * RT_KS + (8 * h + 16 * s) * 2);
        f32x16 O;
#pragma unroll
        for (int i = 0; i < 16; ++i) O[i] = 0.f;
#pragma unroll
        for (int s = 0; s < 4; ++s) { const bf16x8v rf = *(const LAS bf16x8v*)(lds + RT_ROFF + (32 * dt + r32) * RT_KS + (8 * h + 16 * s) * 2);
            O = __builtin_amdgcn_mfma_f32_32x32x16_bf16(rf, Qf[s], O, 0, 0, 0); }
#pragma unroll
        for (int c = 0; c < 4; ++c) { if (c <= qg) {
            f32x16 S;
#pragma unroll
            for (int i = 0; i < 16; ++i) S[i] = 0.f;
#pragma unroll
            for (int s = 0; s < 4; ++s) { const bf16x8v kf = *(const LAS bf16x8v*)(lds + RT_KOFF + (32 * c + r32) * RT_KS + (8 * h + 16 * s) * 2);
                S = __builtin_amdgcn_mfma_f32_32x32x16_bf16(kf, Qf[s], S, 0, 0, 0); }
            if (c == qg) {
#pragma unroll
                for (int i = 0; i < 16; ++i) { const int j = 8 * (i >> 2) + 4 * h + (i & 3); S[i] = (j <= r32) ? S[i] : 0.f; } }
#pragma unroll
            for (int s = 0; s < 2; ++s) { v4u pw; pw[0] = cvtpk(S[8 * s], S[8 * s + 1]); pw[1] = cvtpk(S[8 * s + 2], S[8 * s + 3]); pw[2] = cvtpk(S[8 * s + 4], S[8 * s + 5]); pw[3] = cvtpk(S[8 * s + 6], S[8 * s + 7]);
                const LAS unsigned char* vp = lds + RT_VTOFF + (32 * dt + r32) * RT_TS + (32 * c + 16 * s + 4 * h) * 2;
                const v2u lo = *(const LAS v2u*)vp, hi = *(const LAS v2u*)(vp + 16); v4u vw; vw[0] = lo[0]; vw[1] = lo[1]; vw[2] = hi[0]; vw[3] = hi[1];
                O = __builtin_amdgcn_mfma_f32_32x32x16_bf16(__builtin_bit_cast(bf16x8v, vw), __builtin_bit_cast(bf16x8v, pw), O, 0, 0, 0); } } }
        if (w < 4) { const int et = w >> 1, dtile = w & 1;
#pragma unroll
            for (int s = 0; s < 8; ++s) { const bf16x8v vf = *(const LAS bf16x8v*)(lds + RT_VTOFF + (32 * et + r32) * RT_TS + (16 * s + 8 * h) * 2);
                const bf16x8v kf = *(const LAS bf16x8v*)(lds + RT_KTOFF + (32 * dtile + r32) * RT_TS + (16 * s + 8 * h) * 2);
                Racc = __builtin_amdgcn_mfma_f32_32x32x16_bf16(vf, kf, Racc, 0, 0, 0); }
#pragma unroll
            for (int i = 0; i < 16; ++i) Racc[i] *= g128; }
        const float xi = exp2f((float)(32 * qg + r32 + 1) * lg); float ss = 0.f;
#pragma unroll
        for (int i = 0; i < 16; ++i) { O[i] *= xi; ss += O[i] * O[i]; }
        ss += __shfl_xor(ss, 32);
        LAS float* ssb = (LAS float*)(lds + RT_SOFF);
        if (h == 0) ssb[(qg * 2 + dt) * 32 + r32] = ss;
        LDS_BAR();
        const float rstd = rsqrtf((ss + ssb[(qg * 2 + (dt ^ 1)) * 32 + r32]) * (1.f / 64.f) + 1e-6f);
        if (w < 4) { const int et = w >> 1, dtile = w & 1;
#pragma unroll
            for (int i = 0; i < 16; ++i) { const int e = 32 * et + 8 * (i >> 2) + 4 * h + (i & 3); *(LAS unsigned short*)(lds + RT_ROFF + e * RT_KS + (32 * dtile + r32) * 2) = (unsigned short)f2bf(Racc[i]); } }
#pragma unroll
        for (int q4 = 0; q4 < 4; ++q4) { const int e0 = 32 * dt + 8 * q4 + 4 * h; const v2u gw = *(const LAS v2u*)(lds + RT_GOFF + (32 * qg + r32) * RT_KS + e0 * 2);
            const float g0 = bflo(gw[0]), g1 = bfhi(gw[0]), g2 = bflo(gw[1]), g3 = bfhi(gw[1]);
            v2u o; o[0] = cvtpk(O[4 * q4] * rstd * g0 * __builtin_amdgcn_rcpf(1.0f + __expf(-g0)), O[4 * q4 + 1] * rstd * g1 * __builtin_amdgcn_rcpf(1.0f + __expf(-g1)));
            o[1] = cvtpk(O[4 * q4 + 2] * rstd * g2 * __builtin_amdgcn_rcpf(1.0f + __expf(-g2)), O[4 * q4 + 3] * rstd * g3 * __builtin_amdgcn_rcpf(1.0f + __expf(-g3)));
            *(v2u*)(mixo + qtok * NMIX + 1024 + hh * 64 + e0) = o; }
    }
    __syncthreads();
#undef RT_PREFETCH
}
__device__ __forceinline__ void ret_phase(KP P, LAS unsigned char* lds, int vcu, int G) {
    for (int unit = vcu; unit < BATCH * 8; unit += G) ret_unit(P, lds, unit >> 3, unit & 7);
}

template <int CTRL> __device__ __forceinline__ float dppf(float x) { return __builtin_bit_cast(float, __builtin_amdgcn_mov_dpp(__builtin_bit_cast(int, x), CTRL, 0xf, 0xf, true)); }
constexpr int DPP_X1 = 0xB1, DPP_X2 = 0x4E, DPP_X7 = 0x141, DPP_X8 = 0x128;
__device__ __forceinline__ float sum8(float x) { x += dppf<DPP_X1>(x); x += dppf<DPP_X2>(x); x += dppf<DPP_X7>(x); return x; }
__device__ __forceinline__ float sum16(float x) { x = sum8(x); x += dppf<DPP_X8>(x); return x; }
#define PROBE_SCAN2 0
constexpr int RS_TT = 32;
constexpr int RS_W2T = 0, RS_A2T = 9216, RS_G2T = 18432, RS_XW = 35840, RS_XA = RS_XW + RS_TT * 144, RS_XG = RS_XA + RS_TT * 144, RS_F0 = RS_XG + RS_TT * 272;
constexpr int RS_FA = RS_TT * 64 * 4;
constexpr int RS_ZR = RS_F0, RS_ZK = RS_F0 + RS_FA, RS_ZV = RS_F0 + 2 * RS_FA, RS_WL = RS_F0 + 3 * RS_FA, RS_AL = RS_F0 + 4 * RS_FA, RS_GL = RS_F0 + 5 * RS_FA, RS_AV = RS_F0 + 6 * RS_FA, RS_YS = RS_F0 + 7 * RS_FA, RS_BS = RS_F0 + 8 * RS_FA;
constexpr int RS_MU = RS_BS + RS_TT * 4, RS_CST = RS_MU + 448 * 4;
static_assert(RS_CST + 7 * 256 <= 131072, "rwkv LDS");
constexpr int RS_NP = (RS_TT * 56 + 511) / 512;
typedef float v2f __attribute__((ext_vector_type(2)));
__device__ __forceinline__ void rwkv_unit(KP P, int l, LAS unsigned char* lds, int b, int hh) {
    const int tid = otid(), w = __builtin_amdgcn_readfirstlane(tid >> 6), lane = tid & 63, r32 = lane & 31, h2 = lane >> 5;
    const bf16* proj = (const bf16*)(P->ws + WS_BIG); bf16* mixo = (bf16*)(P->ws + WS_MIXO);
    const float* mu = P->in[I_MU] + l * RWC; const float* w0 = P->in[I_W0] + l * 512 + hh * 64; const float* a0 = P->in[I_A0] + l * 512 + hh * 64;
    const float* kkw = P->in[I_KK] + l * 512 + hh * 64; const float* kaw = P->in[I_KA] + l * 512 + hh * 64; const float* rkw = P->in[I_RK] + l * 512 + hh * 64;
    const float* lng = P->in[I_LNG] + l * 512 + hh * 64; const float* lnb = P->in[I_LNB] + l * 512 + hh * 64;
    __syncthreads();
    for (int i = tid; i < 64 * 64; i += 512) { const int c = i >> 6, j = i & 63;
        *(LAS unsigned short*)(lds + RS_W2T + j * 144 + c * 2) = (unsigned short)f2bf(P->in[I_W2][(size_t)l * 64 * 512 + c * 512 + hh * 64 + j]);
        *(LAS unsigned short*)(lds + RS_A2T + j * 144 + c * 2) = (unsigned short)f2bf(P->in[I_A2][(size_t)l * 64 * 512 + c * 512 + hh * 64 + j]); }
    for (int i = tid; i < 128 * 64; i += 512) { const int c = i >> 6, j = i & 63;
        *(LAS unsigned short*)(lds + RS_G2T + j * 272 + c * 2) = (unsigned short)f2bf(P->in[I_G2][(size_t)l * 128 * 512 + c * 512 + hh * 64 + j]); }
    for (int i = tid; i < 448; i += 512) { const int p = i >> 3, e = i & 7; int col; if (p < 24) col = (p >> 3) * 512 + hh * 64 + (p & 7) * 8; else col = 1536 + (p - 24) * 8; ((LAS float*)(lds + RS_MU))[i] = mu[col + e]; }
    if (tid < 448) { const int a = tid >> 6, j = tid & 63; const float* src = a == 0 ? w0 : a == 1 ? a0 : a == 2 ? kkw : a == 3 ? kaw : a == 4 ? rkw : a == 5 ? lng : lnb; ((LAS float*)(lds + RS_CST))[tid] = src[j]; }
    v2f S2[4];
#pragma unroll
    for (int i = 0; i < 4; ++i) S2[i] = (v2f){0.f, 0.f};
    v4u pc[RS_NP], pp[RS_NP];
#define RS_LOADPIECES(T0) do { _Pragma("unroll") for (int it = 0; it < RS_NP; ++it) { const int idx = tid + it * 512; pc[it] = (v4u){0u, 0u, 0u, 0u}; pp[it] = (v4u){0u, 0u, 0u, 0u}; \
        if (idx < RS_TT * 56) { const int p = idx / RS_TT, tt = idx % RS_TT, t = (T0) + tt; int col; if (p < 24) col = (p >> 3) * 512 + hh * 64 + (p & 7) * 8; else col = 1536 + (p - 24) * 8; \
            const size_t g = (size_t)(b * T + t) * NA + C_RW + col; pc[it] = *(const v4u*)(proj + g); if (t > 0) pp[it] = *(const v4u*)(proj + g - NA); } } } while (0)
    RS_LOADPIECES(0);
#pragma unroll 1
    for (int t0 = 0; t0 < T; t0 += RS_TT) {
        __syncthreads();
#pragma unroll
        for (int it = 0; it < RS_NP; ++it) { const int idx = tid + it * 512; if (idx < RS_TT * 56) { const int p = idx / RS_TT, tt = idx % RS_TT;
            const v4u hc = pc[it], hp = pp[it];
            const v4f m0 = *(const LAS v4f*)(lds + RS_MU + p * 32), m1 = *(const LAS v4f*)(lds + RS_MU + p * 32 + 16);
            float z[8];
#pragma unroll
            for (int e = 0; e < 4; ++e) { const float c0 = bflo(hc[e]), c1 = bfhi(hc[e]), p0 = bflo(hp[e]), p1 = bfhi(hp[e]); const float ma = e < 2 ? m0[2 * e] : m1[2 * e - 4], mb = e < 2 ? m0[2 * e + 1] : m1[2 * e - 3];
                z[2 * e] = c0 + ma * (p0 - c0); z[2 * e + 1] = c1 + mb * (p1 - c1); }
            if (p < 24) { LAS float* dst = (LAS float*)(lds + (p < 8 ? RS_ZR : (p < 16 ? RS_ZK : RS_ZV)) + (tt * 64 + (p & 7) * 8) * 4);
                *(LAS v4f*)dst = (v4f){z[0], z[1], z[2], z[3]}; *(LAS v4f*)(dst + 4) = (v4f){z[4], z[5], z[6], z[7]}; }
            else { v4u o;
                if (p < 32) {
#pragma unroll
                    for (int e = 0; e < 4; ++e) o[e] = cvtpk(1.0f - 2.0f * __builtin_amdgcn_rcpf(1.0f + __expf(2.0f * z[2 * e])), 1.0f - 2.0f * __builtin_amdgcn_rcpf(1.0f + __expf(2.0f * z[2 * e + 1])));
                    *(LAS v4u*)(lds + RS_XW + tt * 144 + (p - 24) * 16) = o; }
                else if (p < 40) {
#pragma unroll
                    for (int e = 0; e < 4; ++e) o[e] = cvtpk(z[2 * e], z[2 * e + 1]);
                    *(LAS v4u*)(lds + RS_XA + tt * 144 + (p - 32) * 16) = o; }
                else {
#pragma unroll
                    for (int e = 0; e < 4; ++e) o[e] = cvtpk(__builtin_amdgcn_rcpf(1.0f + __expf(-z[2 * e])), __builtin_amdgcn_rcpf(1.0f + __expf(-z[2 * e + 1])));
                    *(LAS v4u*)(lds + RS_XG + tt * 272 + (p - 40) * 16) = o; } }
        } }
        __syncthreads();
        if (w < 6) { const int which = w >> 1, jt = w & 1; f32x16 acc;
#pragma unroll
            for (int i = 0; i < 16; ++i) acc[i] = 0.f;
            if (which < 2) { const int wo = which == 0 ? RS_W2T : RS_A2T, xo = which == 0 ? RS_XW : RS_XA;
#pragma unroll
                for (int s = 0; s < 4; ++s) { const bf16x8v af = *(const LAS bf16x8v*)(lds + wo + (32 * jt + r32) * 144 + (16 * s + 8 * h2) * 2), bfr = *(const LAS bf16x8v*)(lds + xo + r32 * 144 + (16 * s + 8 * h2) * 2);
                    acc = __builtin_amdgcn_mfma_f32_32x32x16_bf16(af, bfr, acc, 0, 0, 0); } }
            else {
#pragma unroll
                for (int s = 0; s < 8; ++s) { const bf16x8v af = *(const LAS bf16x8v*)(lds + RS_G2T + (32 * jt + r32) * 272 + (16 * s + 8 * h2) * 2), bfr = *(const LAS bf16x8v*)(lds + RS_XG + r32 * 272 + (16 * s + 8 * h2) * 2);
                    acc = __builtin_amdgcn_mfma_f32_32x32x16_bf16(af, bfr, acc, 0, 0, 0); } }
            const int oo = which == 0 ? RS_WL : (which == 1 ? RS_AL : RS_GL);
#pragma unroll
            for (int q4 = 0; q4 < 4; ++q4) *(LAS v4f*)(lds + oo + (r32 * 64 + 32 * jt + 8 * q4 + 4 * h2) * 4) = (v4f){acc[4 * q4], acc[4 * q4 + 1], acc[4 * q4 + 2], acc[4 * q4 + 3]}; }
        __syncthreads();
        { const int tt = tid >> 4, j0 = (tid & 15) * 4; const int o4 = (tt * 64 + j0) * 4;
          const v4f wl = *(const LAS v4f*)(lds + RS_WL + o4), al = *(const LAS v4f*)(lds + RS_AL + o4), zk = *(const LAS v4f*)(lds + RS_ZK + o4), zr = *(const LAS v4f*)(lds + RS_ZR + o4);
          const v4f w0v = *(const LAS v4f*)(lds + RS_CST + j0 * 4), a0v = *(const LAS v4f*)(lds + RS_CST + 256 + j0 * 4), kkv = *(const LAS v4f*)(lds + RS_CST + 512 + j0 * 4), kav = *(const LAS v4f*)(lds + RS_CST + 768 + j0 * 4), rkv = *(const LAS v4f*)(lds + RS_CST + 1024 + j0 * 4);
          v4f dcy, alp, kk0, km; float ssq = 0.f, bsum = 0.f;
#pragma unroll
          for (int e = 0; e < 4; ++e) { const float x = -(wl[e] + w0v[e]); const float sp = fmaxf(x, 0.f) + __logf(1.0f + __expf(-fabsf(x)));
              dcy[e] = __expf(-__expf(-sp - 0.5f)); alp[e] = __builtin_amdgcn_rcpf(1.0f + __expf(-(al[e] + a0v[e])));
              kk0[e] = zk[e] * kkv[e]; ssq += kk0[e] * kk0[e]; km[e] = zk[e] * (1.0f + (alp[e] - 1.0f) * kav[e]); bsum += zr[e] * km[e] * rkv[e]; }
          ssq = sum16(ssq); bsum = sum16(bsum);
          const float inv = __builtin_amdgcn_rcpf(fmaxf(__builtin_amdgcn_sqrtf(ssq), 1e-12f));
          v4f avv, bvv;
#pragma unroll
          for (int e = 0; e < 4; ++e) { const float kk = kk0[e] * inv; avv[e] = -kk; bvv[e] = kk * alp[e]; }
          *(LAS v4f*)(lds + RS_WL + o4) = dcy; *(LAS v4f*)(lds + RS_AL + o4) = bvv; *(LAS v4f*)(lds + RS_AV + o4) = avv; *(LAS v4f*)(lds + RS_ZK + o4) = km;
          if ((tid & 15) == 0) *(LAS float*)(lds + RS_BS + tt * 4) = bsum; }
        __syncthreads();
        if (t0 + RS_TT < T) RS_LOADPIECES(t0 + RS_TT);
#if PROBE_SCAN2
        v2f Ssave[4];
#pragma unroll
        for (int i = 0; i < 4; ++i) Ssave[i] = S2[i];
        for (int rep_ = 0; rep_ < 2; ++rep_) { if (rep_ == 1) {
#pragma unroll
            for (int i = 0; i < 4; ++i) S2[i] = Ssave[i]; }
#endif
        { const int v_ = tid >> 3, ks = tid & 7; LAS unsigned char* sb = lds + ks * 32; LAS unsigned char* vb = lds + RS_ZV + v_ * 4; LAS unsigned char* yb = lds + RS_YS + v_ * 4;
#pragma unroll
          for (int tt = 0; tt < RS_TT; ++tt) { const int o8 = tt * 256;
              const v4f a0_ = *(const LAS v4f*)(sb + RS_AV + o8), a1_ = *(const LAS v4f*)(sb + RS_AV + o8 + 16);
              const v4f d0_ = *(const LAS v4f*)(sb + RS_WL + o8), d1_ = *(const LAS v4f*)(sb + RS_WL + o8 + 16);
              const v4f b0_ = *(const LAS v4f*)(sb + RS_AL + o8), b1_ = *(const LAS v4f*)(sb + RS_AL + o8 + 16);
              const v4f k0_ = *(const LAS v4f*)(sb + RS_ZK + o8), k1_ = *(const LAS v4f*)(sb + RS_ZK + o8 + 16);
              const v4f r0_ = *(const LAS v4f*)(sb + RS_ZR + o8), r1_ = *(const LAS v4f*)(sb + RS_ZR + o8 + 16);
              const float vv = *(const LAS float*)(vb + o8);
              v2f ac = S2[0] * a0_.xy; ac = __builtin_elementwise_fma(S2[1], a0_.zw, ac); ac = __builtin_elementwise_fma(S2[2], a1_.xy, ac); ac = __builtin_elementwise_fma(S2[3], a1_.zw, ac);
              const float sa = sum8(ac.x + ac.y); const v2f sa2 = (v2f){sa, sa}, vv2 = (v2f){vv, vv};
              S2[0] = __builtin_elementwise_fma(S2[0], d0_.xy, __builtin_elementwise_fma(k0_.xy, vv2, b0_.xy * sa2));
              S2[1] = __builtin_elementwise_fma(S2[1], d0_.zw, __builtin_elementwise_fma(k0_.zw, vv2, b0_.zw * sa2));
              S2[2] = __builtin_elementwise_fma(S2[2], d1_.xy, __builtin_elementwise_fma(k1_.xy, vv2, b1_.xy * sa2));
              S2[3] = __builtin_elementwise_fma(S2[3], d1_.zw, __builtin_elementwise_fma(k1_.zw, vv2, b1_.zw * sa2));
              v2f yc = S2[0] * r0_.xy; yc = __builtin_elementwise_fma(S2[1], r0_.zw, yc); yc = __builtin_elementwise_fma(S2[2], r1_.xy, yc); yc = __builtin_elementwise_fma(S2[3], r1_.zw, yc);
              const float y = sum8(yc.x + yc.y);
              if (ks == 0) *(LAS float*)(yb + o8) = y; } }
#if PROBE_SCAN2
        }
#endif
        __syncthreads();
        { const int tt = tid >> 4, v0 = (tid & 15) * 4; const int o4 = (tt * 64 + v0) * 4;
          const v4f y4 = *(const LAS v4f*)(lds + RS_YS + o4), zv = *(const LAS v4f*)(lds + RS_ZV + o4), gl = *(const LAS v4f*)(lds + RS_GL + o4);
          const float mean = sum16((y4[0] + y4[1]) + (y4[2] + y4[3])) * (1.f / 64.f);
          const v4f d = y4 - mean; const float var = sum16((d[0] * d[0] + d[1] * d[1]) + (d[2] * d[2] + d[3] * d[3])) * (1.f / 64.f);
          const float rstd = rsqrtf(var + 64e-5f), bs = *(const LAS float*)(lds + RS_BS + tt * 4);
          const v4f lg4 = *(const LAS v4f*)(lds + RS_CST + 1280 + v0 * 4), lb4 = *(const LAS v4f*)(lds + RS_CST + 1536 + v0 * 4);
          float o[4];
#pragma unroll
          for (int e = 0; e < 4; ++e) o[e] = (d[e] * rstd * lg4[e] + lb4[e] + bs * zv[e]) * gl[e];
          v2u ow; ow[0] = cvtpk(o[0], o[1]); ow[1] = cvtpk(o[2], o[3]);
          *(v2u*)(mixo + (size_t)(b * T + t0 + tt) * NMIX + 512 + hh * 64 + v0) = ow; }
    }
    __syncthreads();
#undef RS_LOADPIECES
}
__device__ __forceinline__ void rwkv_phase(KP P, int l, LAS unsigned char* lds, int vcu, int G) {
    for (int unit = vcu; unit < BATCH * 8; unit += G) rwkv_unit(P, l, lds, unit >> 3, unit & 7);
}

#define RC_BAR() do { asm volatile("s_waitcnt lgkmcnt(0)" ::: "memory"); __builtin_amdgcn_s_barrier(); asm volatile("" ::: "memory"); } while (0)
constexpr int RC_SL = 9216;
constexpr int RC_A = 0 * RC_SL, RC_B = 1 * RC_SL, RC_K = 2 * RC_SL, RC_R = 3 * RC_SL, RC_V = 4 * RC_SL, RC_G = 5 * RC_SL, RC_S = 6 * RC_SL;
constexpr int RC_XW = 7 * RC_SL, RC_XA = 8 * RC_SL, RC_XG = 9 * RC_SL, RC_WL = 11 * RC_SL, RC_AL = 13 * RC_SL, RC_LW = 14 * RC_SL;
constexpr int RC_DINV = RC_B, RC_DINVT = RC_K, RC_NT = 9 * RC_SL, RC_P = RC_B, RC_UT = RC_V, RC_BHT = RC_XW, RC_KHT = RC_XA, RC_VT = 9 * RC_SL, RC_LAB = 10 * RC_SL, RC_N = RC_LAB, RC_TINV = RC_LAB;
constexpr int RC_LABT = 11 * RC_SL, RC_N2 = RC_LABT, RC_RHST = RC_LABT, RC_LAK = 12 * RC_SL, RC_MRB = 13 * RC_SL, RC_MRK = RC_LW;
constexpr int RC_SM = RC_LW + 16384, RC_BS = RC_SM, RC_GC = RC_SM + 256, RC_PT = RC_SM + 512, RC_SSB = RC_PT + 2048, RC_DIAG = RC_SSB + 1024, RC_MU = RC_DIAG + 4096, RC_CST = RC_MU + 1792, RC_END = RC_CST + 1792, RC_MK = RC_MU + 768;
static_assert(RC_END <= 156928, "chunked rwkv LDS");
typedef float f32x4v_ __attribute__((ext_vector_type(4)));
template <int KSTEPS, int SA = 144, int SB = 144> __device__ __forceinline__ f32x16 rc_mm(f32x16 acc, const LAS unsigned char* A, int arow0, const LAS unsigned char* B, int brow0, int r32, int h, int kofs = 0) {
#pragma unroll
    for (int s = 0; s < KSTEPS; ++s) { const bf16x8v af = *(const LAS bf16x8v*)(A + (arow0 + r32) * SA + (kofs + 16 * s + 8 * h) * 2), bfr = *(const LAS bf16x8v*)(B + (brow0 + r32) * SB + (kofs + 16 * s + 8 * h) * 2);
        acc = __builtin_amdgcn_mfma_f32_32x32x16_bf16(af, bfr, acc, 0, 0, 0); }
    return acc;
}
__device__ __forceinline__ f32x16 rc_zero() { f32x16 z;
#pragma unroll
    for (int i = 0; i < 16; ++i) z[i] = 0.f;
    return z; }
template <int KSTEPS> __device__ __forceinline__ f32x16 rc_mm2(f32x16 acc, const LAS unsigned char* A, int arow0, const LAS unsigned char* B, int brow0, int r32, int h) {
    f32x16 a1 = rc_zero();
#pragma unroll
    for (int s = 0; s < KSTEPS; ++s) { const bf16x8v af = *(const LAS bf16x8v*)(A + (arow0 + r32) * 144 + (16 * s + 8 * h) * 2), bfr = *(const LAS bf16x8v*)(B + (brow0 + r32) * 144 + (16 * s + 8 * h) * 2);
        if (s & 1) a1 = __builtin_amdgcn_mfma_f32_32x32x16_bf16(af, bfr, a1, 0, 0, 0); else acc = __builtin_amdgcn_mfma_f32_32x32x16_bf16(af, bfr, acc, 0, 0, 0); }
#pragma unroll
    for (int i = 0; i < 16; ++i) acc[i] += a1[i];
    return acc;
}
__device__ __forceinline__ bf16x8v rc_frag_bd(const LAS unsigned char* cb, int row, int s, int h) {
    v4u z = (v4u){0u, 0u, 0u, 0u}; if ((row >> 4) == s) z = *(const LAS v4u*)(cb + (row >> 4) * 1024 + ((row & 15) * 16 + 8 * h) * 2); return __builtin_bit_cast(bf16x8v, z); }
template <bool BD_A> __device__ __forceinline__ f32x16 rc_mm_bd(f32x16 acc, const LAS unsigned char* A, int arow0, const LAS unsigned char* B, int brow0, int r32, int h) {
    f32x16 a1 = rc_zero();
#pragma unroll
    for (int s = 0; s < 4; ++s) { const bf16x8v af = BD_A ? rc_frag_bd(A, arow0 + r32, s, h) : *(const LAS bf16x8v*)(A + (arow0 + r32) * 144 + (16 * s + 8 * h) * 2);
        const bf16x8v bfr = BD_A ? *(const LAS bf16x8v*)(B + (brow0 + r32) * 144 + (16 * s + 8 * h) * 2) : rc_frag_bd(B, brow0 + r32, s, h);
        if (s & 1) a1 = __builtin_amdgcn_mfma_f32_32x32x16_bf16(af, bfr, a1, 0, 0, 0); else acc = __builtin_amdgcn_mfma_f32_32x32x16_bf16(af, bfr, acc, 0, 0, 0); }
#pragma unroll
    for (int i = 0; i < 16; ++i) acc[i] += a1[i];
    return acc;
}
__device__ __forceinline__ void rc_store_t(const f32x16& d, LAS unsigned char* O, int arow0, int brow0, int r32, int h) {
#pragma unroll
    for (int q4 = 0; q4 < 4; ++q4) { v2u o; o[0] = cvtpk(d[4 * q4], d[4 * q4 + 1]); o[1] = cvtpk(d[4 * q4 + 2], d[4 * q4 + 3]); *(LAS v2u*)(O + (brow0 + r32) * 144 + (arow0 + 8 * q4 + 4 * h) * 2) = o; }
}
__device__ __forceinline__ void rwkv_prepass(KP P, int l, int b, int j, int rows) {
    const int tid = otid(), p = tid & 31;
    const bf16* proj = (const bf16*)(P->ws + WS_BIG); bf16* zs = (bf16*)((unsigned char*)P->out + OUT_ZS);
    const v4f* mup = (const v4f*)(P->in[I_MU] + l * RWC + 1536 + 8 * p); const v4f m0 = mup[0], m1 = mup[1];
    const float be = p < 8 ? -2.f : -1.f, al = p < 8 ? 2.f : 1.f, ga = p < 8 ? -1.f : 0.f; const bool plain = (p >= 8 && p < 16);
#pragma unroll 4
    for (int r = tid >> 5; r < rows; r += 16) { const int t = j * rows + r; const size_t g = (size_t)(b * T + t) * NA + C_RW + 1536 + 8 * p;
        const v4u hc = *(const v4u*)(proj + g); v4u hp = (v4u){0u, 0u, 0u, 0u}; if (t > 0) hp = *(const v4u*)(proj + g - NA);
        v4u o;
#pragma unroll
        for (int e = 0; e < 4; ++e) { const float c0 = bflo(hc[e]), c1 = bfhi(hc[e]), p0 = bflo(hp[e]), p1 = bfhi(hp[e]); const float ma = e < 2 ? m0[2 * e] : m1[2 * e - 4], mb = e < 2 ? m0[2 * e + 1] : m1[2 * e - 3];
            const float z0 = c0 + ma * (p0 - c0), z1 = c1 + mb * (p1 - c1);
            const float s0 = al * __builtin_amdgcn_rcpf(1.0f + __expf(be * z0)) + ga, s1 = al * __builtin_amdgcn_rcpf(1.0f + __expf(be * z1)) + ga;
            o[e] = cvtpk(plain ? z0 : s0, plain ? z1 : s1); }
        *(v4u*)(zs + (size_t)(b * T + t) * 256 + 8 * p) = o; }
}
__device__ __forceinline__ void rwkvc_unit(KP P, int l, LAS unsigned char* lds, int b, int hh) {
    const int tid = otid(), w = __builtin_amdgcn_readfirstlane(tid >> 6), lane = tid & 63, r32 = lane & 31, h = lane >> 5;
    const bf16* proj = (const bf16*)(P->ws + WS_BIG); bf16* mixo = (bf16*)(P->ws + WS_MIXO);
    const float* mu = P->in[I_MU] + l * RWC; const float* w0 = P->in[I_W0] + l * 512 + hh * 64; const float* a0 = P->in[I_A0] + l * 512 + hh * 64;
    const float* kkw = P->in[I_KK] + l * 512 + hh * 64; const float* kaw = P->in[I_KA] + l * 512 + hh * 64; const float* rkw = P->in[I_RK] + l * 512 + hh * 64;
    const float* lng = P->in[I_LNG] + l * 512 + hh * 64; const float* lnb = P->in[I_LNB] + l * 512 + hh * 64;
    __syncthreads();
    if (tid < 192) { const int p = tid >> 3, e = tid & 7; ((LAS float*)(lds + RC_MU))[tid] = mu[(p >> 3) * 512 + hh * 64 + (p & 7) * 8 + e]; }
    if (tid < 448) { const int a = tid >> 6, j = tid & 63; const float* src = a == 0 ? w0 : a == 1 ? a0 : a == 2 ? kkw : a == 3 ? kaw : a == 4 ? rkw : a == 5 ? lng : lnb; ((LAS float*)(lds + RC_CST))[tid] = src[j]; }
    bf16x8v wf[8];
    { const int jt = w & 1, j = hh * 64 + 32 * jt + r32;
#pragma unroll
      for (int s = 0; s < 8; ++s) { unsigned short e[8];
#pragma unroll
          for (int i = 0; i < 8; ++i) { float x; if (w < 4) { const int c = 16 * (s & 3) + 8 * h + i; x = (s < 4 ? P->in[I_W2] : P->in[I_A2])[(size_t)l * 64 * 512 + c * 512 + j]; } else { const int c = 16 * s + 8 * h + i; x = P->in[I_G2][(size_t)l * 128 * 512 + c * 512 + j]; }
              e[i] = (unsigned short)f2bf(x); }
          v4u pk; pk[0] = e[0] | ((unsigned)e[1] << 16); pk[1] = e[2] | ((unsigned)e[3] << 16); pk[2] = e[4] | ((unsigned)e[5] << 16); pk[3] = e[6] | ((unsigned)e[7] << 16);
          wf[s] = __builtin_bit_cast(bf16x8v, pk); } }
    if (tid < 64) { unsigned mkAB = 0u, mkC = 0u;
#pragma unroll
        for (int i = 0; i < 16; ++i) { const int m = 8 * (i >> 2) + 4 * h + (i & 3), n = r32;
            mkAB |= (((m < n) && ((n >> 4) != (m >> 4))) ? 1u : 0u) << i; mkAB |= ((m < n) ? 1u : 0u) << (16 + i); mkC |= ((m <= n) ? 1u : 0u) << i; }
        v2u mv; mv[0] = mkAB; mv[1] = mkC; *(LAS v2u*)(lds + RC_MK + tid * 8) = mv; }
    f32x16 Sacc = rc_zero();
    v4u pc[3], pp[3], zc[4];
    const bf16* zs = (const bf16*)((const unsigned char*)P->out + OUT_ZS);
#define RC_LOADPIECES(T0) do { _Pragma("unroll") for (int it = 0; it < 3; ++it) { const int q_ = it * 8 + (tid >> 6), tt = 8 * (q_ / 3) + ((tid & 63) >> 3), t = (T0) + tt; \
            const size_t g = (size_t)(b * T + t) * NA + C_RW + (q_ % 3) * 512 + hh * 64 + (tid & 7) * 8; pc[it] = *(const v4u*)(proj + g); pp[it] = (v4u){0u, 0u, 0u, 0u}; if (t > 0) pp[it] = *(const v4u*)(proj + g - NA); } \
        _Pragma("unroll") for (int it = 0; it < 4; ++it) { const int q2 = it * 8 + (tid >> 6), tt = 8 * (q2 >> 2) + ((tid & 63) >> 3); zc[it] = *(const v4u*)(zs + (size_t)(b * T + (T0) + tt) * 256 + (8 * (q2 & 3) + (tid & 7)) * 8); } } while (0)
    RC_LOADPIECES(0);
#pragma unroll 1
    for (int t0 = 0; t0 < T; t0 += 64) {
        f32x16 xacc, yacc;
        RC_BAR();
        { const int tid = otid(), w = __builtin_amdgcn_readfirstlane(tid >> 6), lane = tid & 63, r32 = lane & 31, h = lane >> 5; (void)w; (void)lane; (void)r32; (void)h;
        if (w < 4) rc_store_t(Sacc, lds + RC_S, 32 * (w >> 1), 32 * (w & 1), r32, h);
#pragma unroll
        for (int it = 0; it < 3; ++it) { const int q_ = it * 8 + (tid >> 6), g = q_ % 3, p = 8 * g + (tid & 7), tt = 8 * (q_ / 3) + ((tid & 63) >> 3);
            const v4u hc = pc[it], hp = pp[it];
            const v4f m0 = *(const LAS v4f*)(lds + RC_MU + p * 32), m1 = *(const LAS v4f*)(lds + RC_MU + p * 32 + 16);
            v4u o;
#pragma unroll
            for (int e = 0; e < 4; ++e) { const float c0 = bflo(hc[e]), c1 = bfhi(hc[e]), p0 = bflo(hp[e]), p1 = bfhi(hp[e]); const float ma = e < 2 ? m0[2 * e] : m1[2 * e - 4], mb = e < 2 ? m0[2 * e + 1] : m1[2 * e - 3];
                o[e] = cvtpk(c0 + ma * (p0 - c0), c1 + mb * (p1 - c1)); }
            *(LAS v4u*)(lds + (g == 0 ? RC_R : (g == 1 ? RC_K : RC_V)) + tt * 144 + (tid & 7) * 16) = o; }
#pragma unroll
        for (int it = 0; it < 4; ++it) { const int q2 = it * 8 + (tid >> 6), qu = q2 & 3, tt = 8 * (q2 >> 2) + ((tid & 63) >> 3), pl = tid & 7;
            const int dst = qu == 0 ? RC_XW + tt * 144 + pl * 16 : (qu == 1 ? RC_XA + tt * 144 + pl * 16 : RC_XG + tt * 272 + ((qu - 2) * 8 + pl) * 16);
            *(LAS v4u*)(lds + dst) = zc[it]; }
        }
        RC_BAR();
        { const int tid = otid(), w = __builtin_amdgcn_readfirstlane(tid >> 6), lane = tid & 63, r32 = lane & 31, h = lane >> 5; (void)w; (void)lane; (void)r32; (void)h;
        { const int tt = (w >> 1) & 1, jt = w & 1;
          if (w < 4) { f32x16 aw = rc_zero(), aa = rc_zero();
#pragma unroll
              for (int s = 0; s < 4; ++s) { const bf16x8v xw = *(const LAS bf16x8v*)(lds + RC_XW + (32 * tt + r32) * 144 + (16 * s + 8 * h) * 2), xa = *(const LAS bf16x8v*)(lds + RC_XA + (32 * tt + r32) * 144 + (16 * s + 8 * h) * 2);
                  aw = __builtin_amdgcn_mfma_f32_32x32x16_bf16(wf[s], xw, aw, 0, 0, 0); aa = __builtin_amdgcn_mfma_f32_32x32x16_bf16(wf[4 + s], xa, aa, 0, 0, 0); }
#pragma unroll
              for (int q4 = 0; q4 < 4; ++q4) *(LAS v4f*)(lds + RC_WL + ((32 * tt + r32) * 64 + 32 * jt + 8 * q4 + 4 * h) * 4) = (v4f){aw[4 * q4], aw[4 * q4 + 1], aw[4 * q4 + 2], aw[4 * q4 + 3]};
              rc_store_t(aa, lds + RC_AL, 32 * jt, 32 * tt, r32, h); }
          else { f32x16 ag = rc_zero();
#pragma unroll
              for (int s = 0; s < 8; ++s) { const bf16x8v xg = *(const LAS bf16x8v*)(lds + RC_XG + (32 * tt + r32) * 272 + (16 * s + 8 * h) * 2); ag = __builtin_amdgcn_mfma_f32_32x32x16_bf16(wf[s], xg, ag, 0, 0, 0); }
              rc_store_t(ag, lds + RC_G, 32 * jt, 32 * tt, r32, h); } }
        }
        RC_BAR();
        { const int tid = otid(), w = __builtin_amdgcn_readfirstlane(tid >> 6), lane = tid & 63, r32 = lane & 31, h = lane >> 5; (void)w; (void)lane; (void)r32; (void)h;
        { const int t = tid >> 3, j0 = (tid & 7) * 8; const int ob = t * 144 + j0 * 2;
          const v4f wl0 = *(const LAS v4f*)(lds + RC_WL + (t * 64 + j0) * 4), wl1 = *(const LAS v4f*)(lds + RC_WL + (t * 64 + j0 + 4) * 4);
          const v4u alw = *(const LAS v4u*)(lds + RC_AL + ob), kw = *(const LAS v4u*)(lds + RC_K + ob), rw = *(const LAS v4u*)(lds + RC_R + ob);
          float lw[8], alp[8], kk0[8], km[8]; float ssq = 0.f, bsum = 0.f;
          v4f cst[5][2];
#pragma unroll
          for (int a = 0; a < 5; ++a) { cst[a][0] = *(const LAS v4f*)(lds + RC_CST + a * 256 + j0 * 4); cst[a][1] = *(const LAS v4f*)(lds + RC_CST + a * 256 + j0 * 4 + 16); }
#pragma unroll
          for (int e = 0; e < 8; ++e) { const float wl = e < 4 ? wl0[e & 3] : wl1[e & 3]; const float cw0 = cst[0][e >> 2][e & 3], ca0 = cst[1][e >> 2][e & 3];
              const float ckk = cst[2][e >> 2][e & 3], cka = cst[3][e >> 2][e & 3], crk = cst[4][e >> 2][e & 3];
              const float al = (e & 1) ? bfhi(alw[e >> 1]) : bflo(alw[e >> 1]), kr = (e & 1) ? bfhi(kw[e >> 1]) : bflo(kw[e >> 1]), rr = (e & 1) ? bfhi(rw[e >> 1]) : bflo(rw[e >> 1]);
              lw[e] = -0.60653066f * __builtin_amdgcn_rcpf(1.0f + __expf(-(wl + cw0)));
              alp[e] = __builtin_amdgcn_rcpf(1.0f + __expf(-(al + ca0)));
              kk0[e] = kr * ckk; ssq += kk0[e] * kk0[e]; km[e] = kr * (1.0f + (alp[e] - 1.0f) * cka); bsum += rr * km[e] * crk; }
          ssq = sum8(ssq); bsum = sum8(bsum);
          const float inv = __builtin_amdgcn_rcpf(fmaxf(__builtin_amdgcn_sqrtf(ssq), 1e-12f));
          v4u ao, bo, ko;
#pragma unroll
          for (int e = 0; e < 4; ++e) { const float ka = kk0[2 * e] * inv, kb = kk0[2 * e + 1] * inv; ao[e] = cvtpk(-ka, -kb); bo[e] = cvtpk(ka * alp[2 * e], kb * alp[2 * e + 1]); ko[e] = cvtpk(km[2 * e], km[2 * e + 1]); }
          *(LAS v4u*)(lds + RC_A + ob) = ao; *(LAS v4u*)(lds + RC_B + ob) = bo; *(LAS v4u*)(lds + RC_K + ob) = ko;
          *(LAS v4f*)(lds + RC_LW + (t * 64 + j0) * 4) = (v4f){lw[0], lw[1], lw[2], lw[3]}; *(LAS v4f*)(lds + RC_LW + (t * 64 + j0 + 4) * 4) = (v4f){lw[4], lw[5], lw[6], lw[7]};
          if ((tid & 7) == 0) *(LAS float*)(lds + RC_BS + t * 4) = bsum; }
        }
        RC_BAR();
        { const int tid = otid(), w = __builtin_amdgcn_readfirstlane(tid >> 6), lane = tid & 63, r32 = lane & 31, h = lane >> 5; (void)w; (void)lane; (void)r32; (void)h;
        { const int k = tid & 63, tq = tid >> 6; float c[8]; float run = 0.f;
#pragma unroll
          for (int i = 0; i < 8; ++i) { run += *(const LAS float*)(lds + RC_LW + ((8 * tq + i) * 64 + k) * 4); c[i] = run; }
          *(LAS float*)(lds + RC_PT + (tq * 64 + k) * 4) = run;
          RC_BAR();
          float base = 0.f;
#pragma unroll
          for (int q = 0; q < 7; ++q) { const float pv = *(const LAS float*)(lds + RC_PT + (q * 64 + k) * 4); base += (q < tq) ? pv : 0.f; }
#pragma unroll
          for (int i = 0; i < 8; ++i) *(LAS float*)(lds + RC_LW + ((8 * tq + i) * 64 + k) * 4) = c[i] + base;
          if (tq == 7) *(LAS float*)(lds + RC_GC + k * 4) = __expf(c[7] + base); }
        { const int kk = tid >> 3, tg = tid & 7;
#pragma unroll
          for (int i = 0; i < 8; ++i) { const int t = tg + 8 * i; *(LAS unsigned short*)(lds + RC_VT + kk * 144 + t * 2) = *(const LAS unsigned short*)(lds + RC_V + t * 144 + kk * 2); } }
        }
        RC_BAR();
        { const int tid = otid(), w = __builtin_amdgcn_readfirstlane(tid >> 6), lane = tid & 63, r32 = lane & 31, h = lane >> 5; (void)w; (void)lane; (void)r32; (void)h;
        { const int t = tid >> 3, j0 = (tid & 7) * 8; const int ob = t * 144 + j0 * 2;
          const v4f c0 = *(const LAS v4f*)(lds + RC_LW + (t * 64 + j0) * 4), c1 = *(const LAS v4f*)(lds + RC_LW + (t * 64 + j0 + 4) * 4);
          v4f p0 = (v4f){0.f, 0.f, 0.f, 0.f}, p1 = p0; if (t > 0) { p0 = *(const LAS v4f*)(lds + RC_LW + ((t - 1) * 64 + j0) * 4); p1 = *(const LAS v4f*)(lds + RC_LW + ((t - 1) * 64 + j0 + 4) * 4); }
          const v4u aw = *(const LAS v4u*)(lds + RC_A + ob), bw = *(const LAS v4u*)(lds + RC_B + ob), kw = *(const LAS v4u*)(lds + RC_K + ob), rw = *(const LAS v4u*)(lds + RC_R + ob);
          v4u ao, bo, ko, ro;
#pragma unroll
          for (int e = 0; e < 4; ++e) { const float cA = e < 2 ? c0[2 * e] : c1[2 * e - 4], cB = e < 2 ? c0[2 * e + 1] : c1[2 * e - 3], pA = e < 2 ? p0[2 * e] : p1[2 * e - 4], pB = e < 2 ? p0[2 * e + 1] : p1[2 * e - 3];
              const float e1a = __expf(cA), e1b = __expf(cB), e0a = __expf(pA), e0b = __expf(pB), eia = __builtin_amdgcn_rcpf(e1a), eib = __builtin_amdgcn_rcpf(e1b);
              ao[e] = cvtpk(bflo(aw[e]) * e0a, bfhi(aw[e]) * e0b); ro[e] = cvtpk(bflo(rw[e]) * e1a, bfhi(rw[e]) * e1b);
              bo[e] = cvtpk(bflo(bw[e]) * eia, bfhi(bw[e]) * eib); ko[e] = cvtpk(bflo(kw[e]) * eia, bfhi(kw[e]) * eib); }
          *(LAS v4u*)(lds + RC_A + ob) = ao; *(LAS v4u*)(lds + RC_B + ob) = bo; *(LAS v4u*)(lds + RC_K + ob) = ko; *(LAS v4u*)(lds + RC_R + ob) = ro; }
        }
        RC_BAR();
        { const int tid = otid(), w = __builtin_amdgcn_readfirstlane(tid >> 6), lane = tid & 63, r32 = lane & 31, h = lane >> 5; (void)w; (void)lane; (void)r32; (void)h;
        if (w == 0 || w == 3) { const int tq = w == 0 ? 0 : 1; f32x16 d = rc_zero(); d = rc_mm2<4>(d, lds + RC_B, 32 * tq, lds + RC_A, 32 * tq, r32, h);
            const int n = 32 * tq + r32;
#pragma unroll
            for (int i = 0; i < 16; ++i) { const int m = 32 * tq + 8 * (i >> 2) + 4 * h + (i & 3); if ((m >> 4) == (n >> 4)) *(LAS float*)(lds + RC_DIAG + ((n >> 4) * 256 + (m & 15) * 16 + (n & 15)) * 4) = (m < n) ? d[i] : 0.f; }
            asm volatile("s_waitcnt lgkmcnt(0)" ::: "memory");
            if (lane < 32) { const int blk = 2 * tq + (lane >> 4), c = lane & 15; float x[16];
#pragma unroll
                for (int t = 0; t < 16; ++t) x[t] = (t == c) ? 1.f : 0.f;
#pragma unroll
                for (int j = 0; j < 15; ++j) {
#pragma unroll
                    for (int q = (j + 1) >> 2; q < 4; ++q) { const v4f l4 = *(const LAS v4f*)(lds + RC_DIAG + (blk * 256 + j * 16 + 4 * q) * 4);
#pragma unroll
                        for (int e = 0; e < 4; ++e) { const int t = 4 * q + e; if (t > j) x[t] += l4[e] * x[j]; } } }
                asm volatile("s_waitcnt lgkmcnt(0)" ::: "memory");
                LAS unsigned char* cb = lds + RC_DIAG + blk * 1024;
#pragma unroll
                for (int t = 0; t < 16; ++t) *(LAS unsigned short*)(cb + (t * 16 + c) * 2) = (unsigned short)f2bf(x[t]);
                v4u o0, o1;
#pragma unroll
                for (int e = 0; e < 4; ++e) { o0[e] = cvtpk(x[2 * e], x[2 * e + 1]); o1[e] = cvtpk(x[8 + 2 * e], x[9 + 2 * e]); }
                *(LAS v4u*)(cb + 512 + c * 32) = o0; *(LAS v4u*)(cb + 512 + c * 32 + 16) = o1; } }
        else { const int slot = w < 3 ? w - 1 : w - 2;
#pragma unroll 1
            for (int kq = 0; kq < 3; ++kq) { const int q = (slot == 4 && kq == 2) ? 15 : slot + 6 * kq; if (q >= 16 || (slot == 3 && kq == 2)) break;
                const int blk = 1 + (q >> 2), ta = (q >> 1) & 1, tb = q & 1;
                const int ao = blk == 1 ? RC_B : blk == 2 ? RC_K : blk == 3 ? RC_B : RC_K, bo = blk < 3 ? RC_A : RC_R;
                const int oo = blk == 1 ? RC_LAB : blk == 2 ? RC_LAK : blk == 3 ? RC_MRB : RC_MRK;
                f32x16 d = rc_zero();
                const bool dead = ta > tb;
                if (!dead) d = rc_mm2<4>(d, lds + ao, 32 * ta, lds + bo, 32 * tb, r32, h);
                { unsigned mk = 0xffffu; if (ta == tb) { const v2u mv = *(const LAS v2u*)(lds + RC_MK + lane * 8); mk = blk == 1 ? (mv[0] & 0xffffu) : (blk == 2 ? (mv[0] >> 16) : mv[1]); }
#pragma unroll
                  for (int i = 0; i < 16; ++i) d[i] = ((mk >> i) & 1u) ? d[i] : 0.f; }
                rc_store_t(d, lds + oo, 32 * ta, 32 * tb, r32, h); } }
        }
        RC_BAR();
        { const int tid = otid(), w = __builtin_amdgcn_readfirstlane(tid >> 6), lane = tid & 63, r32 = lane & 31, h = lane >> 5; (void)w; (void)lane; (void)r32; (void)h;
        if (w < 4) { const int l16 = lane & 15, q = lane >> 4, v0 = 16 * w;
            bf16x8v sf[2], vf[2];
#pragma unroll
            for (int ks = 0; ks < 2; ++ks) { sf[ks] = *(const LAS bf16x8v*)(lds + RC_S + (v0 + l16) * 144 + (32 * ks + 8 * q) * 2); vf[ks] = *(const LAS bf16x8v*)(lds + RC_VT + (v0 + l16) * 144 + (32 * ks + 8 * q) * 2); }
            f32x4v_ acc[4];
#pragma unroll
            for (int i = 0; i < 4; ++i) { acc[i] = (f32x4v_){0.f, 0.f, 0.f, 0.f};
#pragma unroll
                for (int ks = 0; ks < 2; ++ks) { const bf16x8v a = *(const LAS bf16x8v*)(lds + RC_A + (16 * i + l16) * 144 + (32 * ks + 8 * q) * 2); acc[i] = __builtin_amdgcn_mfma_f32_16x16x32_bf16(a, sf[ks], acc[i], 0, 0, 0); }
#pragma unroll
                for (int js = 0; js <= (i >> 1); ++js) { const bf16x8v a = *(const LAS bf16x8v*)(lds + RC_LAK + (16 * i + l16) * 144 + (32 * js + 8 * q) * 2); acc[i] = __builtin_amdgcn_mfma_f32_16x16x32_bf16(a, vf[js], acc[i], 0, 0, 0); } }
            unsigned ub[4][2];
#pragma unroll
            for (int i = 0; i < 4; ++i) {
#pragma unroll
                for (int jp = 0; jp < i; jp += 2) { const v2u lo = *(const LAS v2u*)(lds + RC_LAB + (16 * i + l16) * 144 + (16 * jp + 4 * q) * 2); v2u hi = (v2u){0u, 0u}; if (jp + 1 < i) hi = *(const LAS v2u*)(lds + RC_LAB + (16 * i + l16) * 144 + (16 * (jp + 1) + 4 * q) * 2);
                    v4u aw, bw; aw[0] = lo[0]; aw[1] = lo[1]; aw[2] = hi[0]; aw[3] = hi[1]; bw[0] = ub[jp][0]; bw[1] = ub[jp][1]; bw[2] = (jp + 1 < i) ? ub[jp + 1][0] : 0u; bw[3] = (jp + 1 < i) ? ub[jp + 1][1] : 0u;
                    acc[i] = __builtin_amdgcn_mfma_f32_16x16x32_bf16(__builtin_bit_cast(bf16x8v, aw), __builtin_bit_cast(bf16x8v, bw), acc[i], 0, 0, 0); }
                const v2u dv = *(const LAS v2u*)(lds + RC_DIAG + i * 1024 + (l16 * 16 + 4 * q) * 2);
                v4u aw, bw; aw[0] = dv[0]; aw[1] = dv[1]; aw[2] = 0u; aw[3] = 0u; bw[0] = cvtpk(acc[i][0], acc[i][1]); bw[1] = cvtpk(acc[i][2], acc[i][3]); bw[2] = 0u; bw[3] = 0u;
                const f32x4v_ u = __builtin_amdgcn_mfma_f32_16x16x32_bf16(__builtin_bit_cast(bf16x8v, aw), __builtin_bit_cast(bf16x8v, bw), (f32x4v_){0.f, 0.f, 0.f, 0.f}, 0, 0, 0);
                ub[i][0] = cvtpk(u[0], u[1]); ub[i][1] = cvtpk(u[2], u[3]);
                v2u uo; uo[0] = ub[i][0]; uo[1] = ub[i][1]; *(LAS v2u*)(lds + RC_UT + (v0 + l16) * 144 + (16 * i + 4 * q) * 2) = uo; } }
        else { const int t4 = tid - 256, k = t4 >> 2, tg = t4 & 3; const float gc = *(const LAS float*)(lds + RC_GC + k * 4);
#pragma unroll
            for (int i = 0; i < 16; ++i) { const int t = tg + 4 * i;
                const float bt = bf2f(*(const LAS unsigned short*)(lds + RC_B + t * 144 + k * 2)), kt = bf2f(*(const LAS unsigned short*)(lds + RC_K + t * 144 + k * 2));
                *(LAS unsigned short*)(lds + RC_BHT + k * 144 + t * 2) = (unsigned short)f2bf(bt * gc); *(LAS unsigned short*)(lds + RC_KHT + k * 144 + t * 2) = (unsigned short)f2bf(kt * gc); } }
        if (t0 + 64 < T) RC_LOADPIECES(t0 + 64);
        }
        RC_BAR();
        { const int tid = otid(), w = __builtin_amdgcn_readfirstlane(tid >> 6), lane = tid & 63, r32 = lane & 31, h = lane >> 5; (void)w; (void)lane; (void)r32; (void)h;
        yacc = rc_zero();
        { const int ta = (w >> 1) & 1, tb = w & 1;
          if (w < 4) {
#pragma unroll
              for (int i = 0; i < 16; ++i) Sacc[i] *= *(const LAS float*)(lds + RC_GC + (32 * ta + 8 * (i >> 2) + 4 * h + (i & 3)) * 4);
              Sacc = rc_mm2<4>(Sacc, lds + RC_BHT, 32 * ta, lds + RC_UT, 32 * tb, r32, h); Sacc = rc_mm2<4>(Sacc, lds + RC_KHT, 32 * ta, lds + RC_VT, 32 * tb, r32, h); }
          else { yacc = rc_mm2<4>(yacc, lds + RC_S, 32 * ta, lds + RC_R, 32 * tb, r32, h); yacc = rc_mm2<4>(yacc, lds + RC_UT, 32 * ta, lds + RC_MRB, 32 * tb, r32, h); yacc = rc_mm2<4>(yacc, lds + RC_VT, 32 * ta, lds + RC_MRK, 32 * tb, r32, h);
              float s1 = 0.f, s2 = 0.f;
#pragma unroll
              for (int i = 0; i < 16; ++i) { s1 += yacc[i]; s2 += yacc[i] * yacc[i]; }
              s1 += __shfl_xor(s1, 32); s2 += __shfl_xor(s2, 32);
              if (h == 0) { *(LAS float*)(lds + RC_SSB + ((w - 4) * 32 + r32) * 8) = s1; *(LAS float*)(lds + RC_SSB + ((w - 4) * 32 + r32) * 8 + 4) = s2; } } }
        }
        RC_BAR();
        { const int tid = otid(), w = __builtin_amdgcn_readfirstlane(tid >> 6), lane = tid & 63, r32 = lane & 31, h = lane >> 5; (void)w; (void)lane; (void)r32; (void)h;
        if (w >= 4) { const int ta = (w >> 1) & 1, tb = w & 1, t = 32 * tb + r32;
            const float a1 = *(const LAS float*)(lds + RC_SSB + ((w - 4) * 32 + r32) * 8), a2 = *(const LAS float*)(lds + RC_SSB + ((w - 4) * 32 + r32) * 8 + 4);
            const float b1 = *(const LAS float*)(lds + RC_SSB + (((w - 4) ^ 2) * 32 + r32) * 8), b2 = *(const LAS float*)(lds + RC_SSB + (((w - 4) ^ 2) * 32 + r32) * 8 + 4);
            const float mean = (a1 + b1) * (1.f / 64.f), var = fmaxf((a2 + b2) * (1.f / 64.f) - mean * mean, 0.f), rstd = rsqrtf(var + 64e-5f), bs = *(const LAS float*)(lds + RC_BS + t * 4);
#pragma unroll
            for (int q4 = 0; q4 < 4; ++q4) { const int v0 = 32 * ta + 8 * q4 + 4 * h; const v2u gw = *(const LAS v2u*)(lds + RC_G + t * 144 + v0 * 2);
                const v4f lg4 = *(const LAS v4f*)(lds + RC_CST + 1280 + v0 * 4), lb4 = *(const LAS v4f*)(lds + RC_CST + 1536 + v0 * 4); float o[4];
#pragma unroll
                for (int e = 0; e < 4; ++e) { const float vv = bf2f(*(const LAS unsigned short*)(lds + RC_VT + (v0 + e) * 144 + t * 2)); const float g = (e & 1) ? bfhi(gw[e >> 1]) : bflo(gw[e >> 1]);
                    o[e] = ((yacc[4 * q4 + e] - mean) * rstd * lg4[e] + lb4[e] + bs * vv) * g; }
                v2u ow; ow[0] = cvtpk(o[0], o[1]); ow[1] = cvtpk(o[2], o[3]);
                *(v2u*)(mixo + (size_t)(b * T + t0 + t) * NMIX + 512 + hh * 64 + v0) = ow; } }

        }
    }
    __syncthreads();
#undef RC_LOADPIECES
}
__device__ __forceinline__ void rwkvc_phase(KP P, int l, LAS unsigned char* lds, int vcu, int G) {
    for (int unit = vcu; unit < BATCH * 8; unit += G) rwkvc_unit(P, l, lds, unit >> 3, unit & 7);
}

#define XB_TMO      128
#define XB_XCNT(j)  (256  + 64 * (j))
#define XB_XSUB(j)  (1280 + 64 * (j))
#define XB_XGEN(j)  (2304 + 64 * (j))
#define XB_TOP      3328
#define XB_TOPGEN   3392
#define XCD_BAR_WORDS 3456
#define XB_SPIN_CAP (1u << 18)
__device__ __forceinline__ unsigned xb_ld(unsigned* p)              { return __hip_atomic_load(p, __ATOMIC_RELAXED, __HIP_MEMORY_SCOPE_AGENT); }
__device__ __forceinline__ unsigned xb_add(unsigned* p, unsigned v) { return __hip_atomic_fetch_add(p, v, __ATOMIC_RELAXED, __HIP_MEMORY_SCOPE_AGENT); }
__device__ __forceinline__ unsigned xb_xcc_id() { return (unsigned)__builtin_amdgcn_s_getreg((3 << 11) | 20) & 0xFu; }
#define XB_SPIN(cond, bar) do { unsigned _sp = 0; while (cond) { __builtin_amdgcn_s_sleep(1); \
    if ((++_sp & 255u) == 0u) { if (xb_ld(&(bar)[XB_TMO])) break; if (_sp > XB_SPIN_CAP) { atomicAdd(&(bar)[XB_TMO], 1u); break; } } } } while (0)
struct XcdBarrier {
    unsigned* bar; unsigned x;
    volatile LAS unsigned* st;
    unsigned n;
};
__device__ __forceinline__ XcdBarrier xcd_barrier_post(unsigned* bar, volatile LAS unsigned* st, unsigned n) {
    XcdBarrier b; b.bar = bar; b.x = xb_xcc_id(); b.st = st; b.n = n;
    if (threadIdx.x == 0) (void)xb_add(&bar[XB_XCNT(b.x)], 1u);
    return b;
}
__device__ __forceinline__ void xcd_barrier_complete(unsigned* bar, unsigned x, unsigned G, unsigned& nloc, unsigned& nx) {
    unsigned sum, cnt, mine, sp = 0u;
    for (;;) {
        sum = 0u; cnt = 0u; mine = 0u;
#pragma unroll
        for (unsigned j = 0; j < 16; ++j) { const unsigned c = xb_ld(&bar[XB_XCNT(j)]); sum += c; cnt += (c > 0u) ? 1u : 0u; mine = (j == x) ? c : mine; }
        if (sum == G) break;
        __builtin_amdgcn_s_sleep(1);
        if ((++sp & 255u) == 0u) { if (xb_ld(&bar[XB_TMO])) break; if (sp > XB_SPIN_CAP) { atomicAdd(&bar[XB_TMO], 1u); break; } }
    }
    nloc = mine > 0u ? mine : 1u; nx = cnt > 0u ? cnt : 1u;
}
template <bool LOCAL> __device__ __forceinline__ void xcd_barrier(const XcdBarrier& b) {
    asm volatile("s_waitcnt vmcnt(0)" ::: "memory");
    __syncthreads();
    if (threadIdx.x == 0) {
        unsigned* bar = b.bar;
        __builtin_amdgcn_s_waitcnt(0);
        unsigned nloc = b.st[0], nx = b.st[1];
        if (nloc == 0u) { xcd_barrier_complete(bar, b.x, b.n, nloc, nx); b.st[0] = nloc; b.st[1] = nx; }
        const bool one = LOCAL && nx == 1u;
        const unsigned old = xb_add(&bar[XB_XSUB(b.x)], 1u);
        const unsigned gen = old / nloc;
        if (old + 1u == (gen + 1u) * nloc) {
            if (!one) { __builtin_amdgcn_fence(__ATOMIC_RELEASE, "agent");
                        asm volatile("s_waitcnt vmcnt(0)" ::: "memory"); }
            const unsigned og = xb_add(&bar[XB_TOP], 1u);
            const unsigned tg = og / nx;
            if (og + 1u == (tg + 1u) * nx) xb_add(&bar[XB_TOPGEN], 1u);
            else XB_SPIN(xb_ld(&bar[XB_TOPGEN]) == tg, bar);
            if (!one) __builtin_amdgcn_fence(__ATOMIC_ACQUIRE, "agent");
            else asm volatile("buffer_inv sc0" ::: "memory");
            xb_add(&bar[XB_XGEN(b.x)], 1u);
            asm volatile("s_waitcnt vmcnt(0)" ::: "memory");
        } else {
            XB_SPIN(xb_ld(&bar[XB_XGEN(b.x)]) == gen, bar);
            if (!one) __builtin_amdgcn_fence(__ATOMIC_ACQUIRE, "agent");
            else asm volatile("buffer_inv sc0" ::: "memory");
            asm volatile("s_waitcnt vmcnt(0)" ::: "memory");
        }
    }
    __syncthreads();
}

constexpr int CW_BAR = 4096;
constexpr int MISC_OFF = 156928;
constexpr int CW_HB = 8192;
constexpr int CW_SEQ = 8192 + 512;
constexpr int CW_WDONE = 8192 + 1024;
constexpr int CW_GBAR = 65536;
__device__ __forceinline__ void half_barrier(unsigned* ctl, int cw, unsigned target) {
    asm volatile("s_waitcnt vmcnt(0) lgkmcnt(0)" ::: "memory");
    __syncthreads();
    if (threadIdx.x == 0) {
        (void)xb_add(&ctl[cw], 1u);
        unsigned sp = 0;
        while (xb_ld(&ctl[cw]) < target) { __builtin_amdgcn_s_sleep(2);
            if ((++sp & 255u) == 0u) { if (xb_ld(&ctl[CW_BAR + XB_TMO])) break; if (sp > XB_SPIN_CAP) { atomicAdd(&ctl[CW_BAR + XB_TMO], 1u); break; } } }
        asm volatile("" ::: "memory");
    }
    __syncthreads();
}
__device__ __forceinline__ void half_wait(unsigned* ctl, int cw, unsigned target) {
    if (threadIdx.x == 0) { unsigned sp = 0;
        while (xb_ld(&ctl[cw]) < target) { __builtin_amdgcn_s_sleep(2);
            if ((++sp & 255u) == 0u) { if (xb_ld(&ctl[CW_BAR + XB_TMO])) break; if (sp > XB_SPIN_CAP) { atomicAdd(&ctl[CW_BAR + XB_TMO], 1u); break; } } }
        asm volatile("" ::: "memory"); }
    __syncthreads();
}
__device__ __forceinline__ void pub_barrier(unsigned* ctl, int cw, unsigned target, bool one) {
    asm volatile("s_waitcnt vmcnt(0)" ::: "memory");
    __syncthreads();
    if (threadIdx.x == 0) {
        if (!one) { __builtin_amdgcn_fence(__ATOMIC_RELEASE, "agent"); asm volatile("s_waitcnt vmcnt(0)" ::: "memory"); }
        (void)xb_add(&ctl[cw], 1u);
        unsigned sp = 0;
        while (xb_ld(&ctl[cw]) < target) { __builtin_amdgcn_s_sleep(1);
            if ((++sp & 255u) == 0u) { if (xb_ld(&ctl[CW_BAR + XB_TMO])) break; if (sp > XB_SPIN_CAP) { atomicAdd(&ctl[CW_BAR + XB_TMO], 1u); break; } } }
        if (!one) __builtin_amdgcn_fence(__ATOMIC_ACQUIRE, "agent"); else asm volatile("buffer_inv sc0" ::: "memory");
        asm volatile("s_waitcnt vmcnt(0)" ::: "memory");
    }
    __syncthreads();
}
#ifndef NAIVE_ATTN
#define NAIVE_ATTN 0
#endif
#ifndef NAIVE_RET
#define NAIVE_RET 0
#endif
#ifndef NAIVE_RWKV
#define NAIVE_RWKV 0
#endif
#define RWKV_CHUNKED 1
#define GROUP_LOCAL 1
#define PROBE_H 0
#define P1B_FIRST 1
#define ATT_FIRST 1
#ifndef REP_RWKV
#define REP_RWKV 1
#endif
#ifndef REP_ATTN
#define REP_ATTN 1
#endif
#ifndef REP_RET
#define REP_RET 1
#endif
#ifndef REP_G0
#define REP_G0 1
#endif
#ifndef REP_G1
#define REP_G1 1
#endif
#ifndef REP_G2
#define REP_G2 1
#endif
#ifndef REP_G4
#define REP_G4 1
#endif
__global__ void __launch_bounds__(512, 2) k_mega(Params Pv) {
    KP P = (KP)__builtin_amdgcn_kernarg_segment_ptr();
#define PFRESH() asm volatile("" : "+s"(P))
    extern __shared__ __attribute__((aligned(16))) unsigned char lds_[];
    LAS unsigned char* lds = (LAS unsigned char*)lds_;
    const int tid = threadIdx.x, G = gridDim.x, bx = blockIdx.x, vcu = (G % 8 == 0) ? (bx % 8) * (G / 8) + bx / 8 : bx;
    volatile LAS unsigned* MISC = (volatile LAS unsigned*)(lds + MISC_OFF);
    for (int u = tid; u < (LDS_BYTES - MISC_OFF) / 4; u += 512) ((LAS unsigned*)(lds + MISC_OFF))[u] = 0u;
    __syncthreads();
    const int GS = G / 8, grp = vcu / GS, rk = vcu % GS, GSH = GS / 2;
    XcdBarrier bar = xcd_barrier_post((unsigned*)(P->ws + WS_CTL) + CW_BAR, MISC + 8, (unsigned)G);
    { XcdBarrier gb0 = xcd_barrier_post((unsigned*)(P->ws + WS_CTL) + CW_GBAR + 4096 * grp, MISC + 12, (unsigned)GS); (void)gb0; }
#define GRID_BAR() do { asm volatile("" : "+s"(bar.x)); xcd_barrier<false>(bar); } while (0)
#define GROUP_BAR() do { int g_ = grp; asm volatile("" : "+s"(g_)); XcdBarrier gb_; gb_.bar = (unsigned*)(P->ws + WS_CTL) + CW_GBAR + 4096 * g_; gb_.x = xb_xcc_id(); gb_.st = MISC + 12; gb_.n = (unsigned)GS; xcd_barrier<GROUP_LOCAL != 0>(gb_); } while (0)
    PFRESH(); phase_x0(P, vcu, G);
    PFRESH(); phase_wconv_all(P, lds, vcu, G);
    GRID_BAR();
    for (int l = 0; l < DEPTH; ++l) {
        PFRESH(); gemm_phase_of<0>(P, l, lds, G, bx);
        GROUP_BAR();
        PFRESH();
#if PROBE_H
        const unsigned long long th0_ = __builtin_amdgcn_s_memrealtime();
#endif
        { unsigned* ctl = (unsigned*)(P->ws + WS_CTL); const int cw = CW_HB + 64 * grp;
          const bool loc = GROUP_LOCAL && MISC[13] == 1u;
          if (rk < GSH) { attn_phase(P, l, lds, 64 * grp + rk, GSH, 64 * grp + GSH * ATT_FIRST); half_barrier(ctl, cw, 0u); PFRESH();
                          { const int npb = GSH / 2; rwkv_prepass(P, l, 2 * grp + rk / npb, rk % npb, T / npb); }
                          pub_barrier(ctl, CW_SEQ + 64 * grp, (unsigned)GSH * (unsigned)(l + 1), loc); PFRESH();
#if PROBE_H == 3
                          if (tid == 0 && grp == 0 && rk == 0) { unsigned long long* ts_ = (unsigned long long*)(P->ws + WS_CTL + 65536); *ts_ += __builtin_amdgcn_s_memrealtime() - th0_; }
#endif
                          for (int unit = 16 * grp + rk; unit < 16 * grp + 16; unit += GSH) rwkvc_unit(P, l, lds, unit >> 3, unit & 7);
                          if (P1B_FIRST > 0) { half_wait(ctl, cw, (unsigned)GS * (unsigned)(l + 1)); PFRESH(); gemm_phase_of<1>(P, l, lds, 8 * GSH, 8 * rk + grp, 12 - P1B_FIRST, P1B_FIRST); } }
          else { const int r2 = rk - GSH;
                 attn_phase(P, l, lds, 64 * grp + GSH * ATT_FIRST + r2, GS - GSH, 64 * grp + 64); __syncthreads();
#if PROBE_H == 4 || PROBE_H == 5
                 const unsigned long long tr0_ = __builtin_amdgcn_s_memrealtime();
#endif
#if PROBE_H == 5
                 if (tid == 0 && grp == 0 && rk == GSH) { unsigned long long* ts_ = (unsigned long long*)(P->ws + WS_CTL + 65536); *ts_ += tr0_ - th0_; }
#endif
                 for (int unit = 16 * grp + r2; unit < 16 * grp + 16; unit += GS - GSH) ret_unit(P, lds, unit >> 3, unit & 7);
#if PROBE_H == 4
                 if (tid == 0 && grp == 0 && rk == GSH) { unsigned long long* ts_ = (unsigned long long*)(P->ws + WS_CTL + 65536); *ts_ += __builtin_amdgcn_s_memrealtime() - tr0_; }
#endif
                 half_barrier(ctl, cw, (unsigned)GS * (unsigned)(l + 1));
                 PFRESH(); gemm_phase_of<1>(P, l, lds, 8 * (GS - GSH), 8 * r2 + grp, 0, 12 - P1B_FIRST); } }
#if PROBE_H
        if (PROBE_H < 3 && tid == 0 && grp == 0 && rk == (PROBE_H == 1 ? 0 : GSH)) { unsigned long long* ts_ = (unsigned long long*)(P->ws + WS_CTL + 65536); *ts_ += __builtin_amdgcn_s_memrealtime() - th0_; }
#endif
        GROUP_BAR();
        if (l == DEPTH - 1) { if (tid == 0) (void)xb_add((unsigned*)(P->ws + WS_CTL) + CW_WDONE, 1u); }
        PFRESH(); gemm_phase_of<2>(P, l, lds, G, bx);
        GROUP_BAR();
        PFRESH(); gemm_phase_of<3>(P, l, lds, G, bx);
        GROUP_BAR();
        PFRESH(); gemm_phase_of<4>(P, l, lds, G, bx);
        GROUP_BAR();
        if (l == DEPTH - 1) {
            unsigned* ctl = (unsigned*)(P->ws + WS_CTL);
            if (tid == 0) { unsigned sp = 0; while (xb_ld(&ctl[CW_WDONE]) < (unsigned)G) { __builtin_amdgcn_s_sleep(8);
                if ((++sp & 255u) == 0u) { if (xb_ld(&ctl[CW_BAR + XB_TMO])) break; if (sp > XB_SPIN_CAP) { atomicAdd(&ctl[CW_BAR + XB_TMO], 1u); break; } } } }
            __syncthreads(); }
        PFRESH(); gemm_phase_of<5>(P, l, lds, G, bx);
        if (l < DEPTH - 1) GROUP_BAR();
    }
#if PROBE_H
    if (grp == 0 && rk == 0 && tid == 0) { const unsigned long long tt_ = __hip_atomic_load((unsigned long long*)(P->ws + WS_CTL + 65536), __ATOMIC_RELAXED, __HIP_MEMORY_SCOPE_AGENT) * 4ull; const unsigned long long t0_ = __builtin_amdgcn_s_memrealtime(); while (__builtin_amdgcn_s_memrealtime() - t0_ < tt_) __builtin_amdgcn_s_sleep(8); }
#endif
#if PROBE_T
    if (vcu == 0 && tid == 0) { const unsigned long long tt_ = *(volatile unsigned long long*)(P->ws + WS_CTL + 65536) * 8ull; const unsigned long long t0_ = __builtin_amdgcn_s_memrealtime(); while (__builtin_amdgcn_s_memrealtime() - t0_ < tt_) __builtin_amdgcn_s_sleep(8); }
#endif
}

extern "C" void kernel_launch(void* const* d_in, const int* in_sizes, int n_in, void* d_out, int out_size, void* d_ws, size_t ws_size, hipStream_t stream) {
    static int grid = 0;
    if (grid == 0) {
        if (n_in != 25 || out_size != M * D || ws_size < WS_END) { fprintf(stderr, "kernel_launch: unexpected shapes (n_in %d, out %d, ws %zu)\n", n_in, out_size, ws_size); grid = -1; return; }
        int dev = 0, cus = 0, per_cu = 0; if (hipGetDevice(&dev) != hipSuccess || hipDeviceGetAttribute(&cus, hipDeviceAttributeMultiprocessorCount, dev) != hipSuccess) { grid = -1; return; }
        if (hipFuncSetAttribute((const void*)k_mega, hipFuncAttributeMaxDynamicSharedMemorySize, LDS_BYTES) != hipSuccess) { fprintf(stderr, "kernel_launch: hipFuncSetAttribute failed\n"); grid = -1; return; }
        if (hipOccupancyMaxActiveBlocksPerMultiprocessor(&per_cu, (const void*)k_mega, 512, LDS_BYTES) != hipSuccess || per_cu < 1) fprintf(stderr, "kernel_launch: occupancy query reports %d workgroups per CU\n", per_cu);
        (void)hipGetLastError();
        grid = cus - cus % 16;
        if (grid < 16) { grid = -1; return; }
    }
    if (grid < 0) return;
    Params p; memset(&p, 0, sizeof(p));
    for (int i = 0; i < 25; ++i) p.in[i] = (const float*)d_in[i];
    p.out = (float*)d_out; p.ws = (unsigned char*)d_ws;
    (void)hipMemsetAsync((char*)d_ws + WS_CTL, 0, CTL_BYTES, stream);
    hipLaunchKernelGGL(k_mega, dim3(grid), dim3(512), LDS_BYTES, stream, p);
}
```

```cpp
#include <hip/hip_runtime.h>
#include <cstdio>
#include <cstdint>
#include <cstring>

constexpr int D = 1024, BATCH = 16, T = 2048, DEPTH = 4, M = BATCH * T;
constexpr int HD = 64;
constexpr int NA = 4608;
constexpr int NG = 3072;
constexpr int INW = NA + NG;
constexpr int C_AQ = 0, C_AK = 512, C_AV = 640, C_RW = 768, C_RQ = 2560, C_RK = 3072, C_RV = 3584, C_RG = 4096;
constexpr int RWC = 1792;
constexpr int FF = 2816, FF2 = 2 * FF;
constexpr int NMIX = 1536;

constexpr size_t MiB = 1u << 20;
constexpr size_t WS_CTL = 0, CTL_BYTES = 1 * MiB;
constexpr size_t WS_WIN = 1 * MiB;
constexpr size_t WS_WMIX = WS_WIN + (size_t)INW * D * 2;
constexpr size_t WS_WOUT = WS_WMIX + (size_t)D * NMIX * 2;
constexpr size_t WS_WGU = WS_WOUT + (size_t)D * D * 2;
constexpr size_t WS_WDN = WS_WGU + (size_t)FF2 * D * 2;
constexpr size_t WS_XB = 38 * MiB;
constexpr size_t WS_MIXO = 102 * MiB;
constexpr size_t WS_BIG = 198 * MiB;
constexpr size_t WS_MIXED = WS_BIG + 192 * MiB;
constexpr size_t WS_RSS = 486 * MiB;
constexpr size_t WS_ROPE = 488 * MiB;
constexpr size_t WS_ROPE2 = WS_ROPE + 512 * 1024;
constexpr size_t WS_GX = 489 * MiB;
constexpr size_t WS_END = 505 * MiB;
static_assert(WS_WDN + (size_t)D * FF * 2 <= WS_XB && WS_WDN + (size_t)D * FF * 2 - WS_WIN <= 37 * MiB && 3 * 37 * MiB <= (size_t)M * D * 4, "weights fit");
static_assert(WS_BIG + (size_t)M * NA * 2 <= WS_RSS, "big region fits");

#define GAS __attribute__((address_space(1)))
#define LAS __attribute__((address_space(3)))
typedef unsigned short bf16;
typedef unsigned v4u __attribute__((ext_vector_type(4)));
typedef unsigned v2u __attribute__((ext_vector_type(2)));
typedef float v4f __attribute__((ext_vector_type(4)));
__device__ __forceinline__ unsigned f2bf(float f) { unsigned u = __builtin_bit_cast(unsigned, f); return (u + 0x7fffu + ((u >> 16) & 1u)) >> 16; }
__device__ __forceinline__ unsigned pk2(float lo, float hi) { return f2bf(lo) | (f2bf(hi) << 16); }
__device__ __forceinline__ float bf2f(unsigned short b) { return __builtin_bit_cast(float, (unsigned)b << 16); }
__device__ __forceinline__ float bflo(unsigned w) { return __builtin_bit_cast(float, w << 16); }
__device__ __forceinline__ float bfhi(unsigned w) { return __builtin_bit_cast(float, w & 0xffff0000u); }
__device__ __forceinline__ float wave_sum(float v) {
#pragma unroll
    for (int o = 1; o < 64; o <<= 1) v += __shfl_xor(v, o);
    return v;
}
__device__ __forceinline__ float wave_max(float v) {
#pragma unroll
    for (int o = 1; o < 64; o <<= 1) v = fmaxf(v, __shfl_xor(v, o));
    return v;
}
__device__ __forceinline__ float sigmoidf_(float x) { return 1.f / (1.f + __expf(-x)); }

__device__ __forceinline__ int otid() { int t = threadIdx.x; asm volatile("" : "+v"(t)); return t; }

struct Params {
    const float* in[25];
    float* out;
    unsigned char* ws;
    int layer; int pad;
};
typedef const __attribute__((address_space(4))) Params* KP;
constexpr size_t WL_STRIDE = 37 * MiB;
__device__ __forceinline__ unsigned char* wbase(KP P, int l) { return l == DEPTH - 1 ? P->ws : (unsigned char*)P->out + (size_t)l * WL_STRIDE - WS_WIN; }
constexpr size_t OUT_ZS = (DEPTH - 1) * WL_STRIDE;
static_assert(OUT_ZS + (size_t)M * 256 * 2 <= (size_t)M * D * 4, "zs fits in d_out");
enum { I_X = 0, I_N1G, I_WIN, I_QNG, I_KNG, I_SINK, I_WAO, I_MU, I_W0, I_W2, I_A0, I_A2, I_G2, I_KK, I_KA, I_RK, I_LNG, I_LNB, I_WRO, I_WTO, I_WOUT, I_N2G, I_WG, I_WU, I_WD };


namespace pg8 {
#define PG8_LAS __attribute__((address_space(3)))
typedef unsigned short bf16_t;
typedef short bf16x8 __attribute__((ext_vector_type(8)));
typedef float f32x4 __attribute__((ext_vector_type(4)));
typedef unsigned u32x4 __attribute__((ext_vector_type(4)));
constexpr int BM = 256, BK = 64, HALF = 128, HTB = HALF * BK * 2  , STAGE_BYTES = 8 * HTB, NXCD = 8, WGM = 8;

__host__ __device__ __forceinline__ int lds_byte(int r, int c) { const int st = (r >> 4) * 2 + (c >> 5), rr = r & 15, cc = c & 31, ob = rr * 64 + cc * 2; return st * 1024 + (ob ^ (((ob >> 9) & 1) << 5)); }
__host__ __device__ __forceinline__ void stage_rc(int b, int& R, int& C) { const int st = b / 1024, sb = b % 1024, swz = sb ^ (((sb >> 9) & 1) << 5); R = (st >> 1) * 16 + swz / 64; C = (st & 1) * 32 + (swz % 64) / 2; }
__host__ __device__ __forceinline__ int perm32(int rho) { const int n = rho >> 4, i = rho & 15; return 8 * (i >> 2) + 4 * n + (i & 3); }

struct Unit { int pm, pn; };
struct Gemm { const bf16_t* A; const bf16_t* Bt; int M, N, K, lda; };

struct StaticOrder {
    int nM, nN, nwg, G, c, i0, ni;
    __host__ __device__ void init(int M, int N, int G_, int c_) { nM = M / BM; nN = N / BM; nwg = nM * nN; G = G_; c = c_; i0 = 0; ni = 1 << 30; }
    __host__ __device__ bool next(int i, Unit& u) const {
        if (i >= ni) return false;
        const long L = (long)(i0 + i) * G + c; if (L >= nwg) return false;
        int wgid = (int)L; { const int q = nwg / NXCD, r = nwg % NXCD, xcd = wgid % NXCD, off = wgid / NXCD; wgid = (xcd < r ? xcd * (q + 1) : r * (q + 1) + (xcd - r) * q) + off; }
        const int nig = WGM * nN, gid = wgid / nig, fm = gid * WGM, gsz = (nM - fm) < WGM ? (nM - fm) : WGM;
        u.pm = fm + ((wgid % nig) % gsz); u.pn = (wgid % nig) / gsz; return true;
    }
    __device__ __forceinline__ void a_ready(const Unit&) const {}
    __device__ __forceinline__ void done(const Unit&) const {}
};


typedef float f32x2_ __attribute__((ext_vector_type(2))); typedef __bf16 bf16x2_ __attribute__((ext_vector_type(2)));
__device__ __forceinline__ unsigned cvt_pk_bf16(float lo, float hi) { const f32x2_ x = {lo, hi}; return __builtin_bit_cast(unsigned, __builtin_convertvector(x, bf16x2_)); }
__device__ __forceinline__ float clampg(float x) { return __builtin_amdgcn_fmed3f(x, -30.0f, 30.0f); }
__device__ __forceinline__ float row_rstd(const float* rss, int row) {
    const f32x4* p = (const f32x4*)(rss + (size_t)row * 16);
    const f32x4 a = p[0], b = p[1], c = p[2], d = p[3];
    const float s = (((a.x + a.y) + (a.z + a.w)) + ((b.x + b.y) + (b.z + b.w))) + (((c.x + c.y) + (c.z + c.w)) + ((d.x + d.y) + (d.z + d.w)));
    return rsqrtf(s * (1.0f / 1024.0f) + 1e-6f);
}
struct RowTab {
    const float* rss;
    __device__ __forceinline__ void tab_load(const Unit& u, int tid, f32x4& a, f32x4& b) const { const f32x4* p = (const f32x4*)(rss + ((size_t)u.pm * BM + (tid >> 1)) * 16 + (tid & 1) * 8); a = p[0]; b = p[1]; }
    __device__ __forceinline__ void tab_dma(const Unit& u, PG8_LAS unsigned char* stg, int wid, int lane) const {
#pragma unroll
        for (int i = 0; i < 2; ++i) __builtin_amdgcn_global_load_lds((const unsigned*)((const char*)(rss + (size_t)u.pm * BM * 16) + (wid * 2 + i) * 1024 + lane * 16), (PG8_LAS unsigned*)(stg + (wid * 2 + i) * 1024), 16, 0, 0); }
    __device__ __forceinline__ void tab_store_lds(PG8_LAS float* tab, const PG8_LAS unsigned char* stg, int tid) const {
        const PG8_LAS f32x4* p = (const PG8_LAS f32x4*)(stg + (tid >> 1) * 64 + (tid & 1) * 32); const f32x4 a = p[0], b = p[1]; tab_store(tab, tid, a, b); }
    __device__ __forceinline__ void tab_store(PG8_LAS float* tab, int tid, const f32x4& a, const f32x4& b) const {
        float s = ((a.x + a.y) + (a.z + a.w)) + ((b.x + b.y) + (b.z + b.w)); s += __shfl_xor(s, 1);
        if ((tid & 1) == 0) tab[tid >> 1] = rsqrtf(s * (1.0f / 1024.0f) + 1e-6f); }
};
struct EpiRowScale : RowTab {
    static constexpr bool PERM = true, AFTER_DRAIN = false, ROWTAB = true, ACCINIT = false; static constexpr int KSEG = 0;
    bf16_t* O; int ldc;
    __device__ __forceinline__ void operator()(const f32x4 (&acc)[2][2][4][2], const Unit& u, int wr, int wc, int fr, int fq, const PG8_LAS float* tab) const {
        const int row0 = u.pm * BM + wr * 64 + fr, col0 = u.pn * BM + wc * 32 + 8 * fq;
#pragma unroll
        for (int ai = 0; ai < 2; ++ai)
#pragma unroll
            for (int m = 0; m < 4; ++m) { const int row = row0 + ai * HALF + m * 16; const float rs = tab[wr * 64 + fr + ai * HALF + m * 16]; bf16_t* rowp = O + (size_t)row * ldc + col0;
#pragma unroll
                for (int bj = 0; bj < 2; ++bj) { const f32x4 v0 = acc[ai][bj][m][0] * rs, v1 = acc[ai][bj][m][1] * rs;
                    u32x4 w; w.x = cvt_pk_bf16(v0[0], v0[1]); w.y = cvt_pk_bf16(v0[2], v0[3]); w.z = cvt_pk_bf16(v1[0], v1[1]); w.w = cvt_pk_bf16(v1[2], v1[3]);
                    *(u32x4*)(rowp + bj * HALF) = w; } }
    }
};
struct GateMap { bf16_t* proj; bf16_t* gx;
    __device__ __forceinline__ bf16_t* tile(int gt, int& ld) const { if (gt < 11) { ld = 4608; return proj + (gt < 3 ? gt * 256 : 2560 + (gt - 3) * 256); } ld = 256; return gx; } };
struct EpiGates : RowTab {
    static constexpr bool PERM = true, AFTER_DRAIN = false, ROWTAB = true, ACCINIT = false; static constexpr int KSEG = 0;
    GateMap gm;
    __device__ __forceinline__ void operator()(const f32x4 (&acc)[2][2][4][2], const Unit& u, int wr, int wc, int fr, int fq, const PG8_LAS float* tab) const {
        int ld; bf16_t* base = gm.tile(u.pn, ld); const int row0 = u.pm * BM + wr * 64 + fr, col0 = wc * 32 + 8 * fq;
#pragma unroll
        for (int ai = 0; ai < 2; ++ai)
#pragma unroll
            for (int m = 0; m < 4; ++m) { const int row = row0 + ai * HALF + m * 16; const float rs = tab[wr * 64 + fr + ai * HALF + m * 16]; bf16_t* rowp = base + (size_t)row * ld + col0;
#pragma unroll
                for (int bj = 0; bj < 2; ++bj) { const f32x4 v0 = acc[ai][bj][m][0] * rs, v1 = acc[ai][bj][m][1] * rs;
                    u32x4 w; w.x = cvt_pk_bf16(v0[0], v0[1]); w.y = cvt_pk_bf16(v0[2], v0[3]); w.z = cvt_pk_bf16(v1[0], v1[1]); w.w = cvt_pk_bf16(v1[2], v1[3]);
                    *(u32x4*)(rowp + bj * HALF) = w; } }
    }
};
struct EpiSwiglu : RowTab {
    static constexpr bool PERM = true, AFTER_DRAIN = false, ROWTAB = true, ACCINIT = false; static constexpr int KSEG = 0;
    bf16_t* O; int ldc;
    __device__ __forceinline__ void operator()(const f32x4 (&acc)[2][2][4][2], const Unit& u, int wr, int wc, int fr, int fq, const PG8_LAS float* tab) const {
        const int row0 = u.pm * BM + wr * 64 + fr, col0 = u.pn * HALF + wc * 32 + 8 * fq;
#pragma unroll
        for (int ai = 0; ai < 2; ++ai)
#pragma unroll
            for (int m = 0; m < 4; ++m) { const int row = row0 + ai * HALF + m * 16; const float rs = tab[wr * 64 + fr + ai * HALF + m * 16]; bf16_t* rowp = O + (size_t)row * ldc + col0;
                float o[8];
#pragma unroll
                for (int n = 0; n < 2; ++n)
#pragma unroll
                    for (int j = 0; j < 4; ++j) { const float g = acc[ai][0][m][n][j] * rs, up = acc[ai][1][m][n][j] * rs; o[4 * n + j] = g * up * __builtin_amdgcn_rcpf(1.0f + __expf(-g)); }
                u32x4 w; w.x = cvt_pk_bf16(o[0], o[1]); w.y = cvt_pk_bf16(o[2], o[3]); w.z = cvt_pk_bf16(o[4], o[5]); w.w = cvt_pk_bf16(o[6], o[7]);
                *(u32x4*)rowp = w; }
    }
};
struct EpiResid {
    static constexpr bool PERM = true, AFTER_DRAIN = false, ROWTAB = false, ACCINIT = true; static constexpr int KSEG = 0;
    bf16_t* XB; float* rss; float* OUT;
    __device__ __forceinline__ void init(f32x4 (&acc)[2][2][4][2], const Unit& u, int wr, int wc, int fr, int fq) const {
        const int row0 = u.pm * BM + wr * 64 + fr, col0 = u.pn * BM + wc * 32 + 8 * fq;
#pragma unroll
        for (int ai = 0; ai < 2; ++ai) { u32x4 xin[4][2];
#pragma unroll
            for (int m = 0; m < 4; ++m)
#pragma unroll
                for (int bj = 0; bj < 2; ++bj) xin[m][bj] = *(const u32x4*)(XB + (size_t)(row0 + ai * HALF + m * 16) * 1024 + col0 + bj * HALF);
#pragma unroll
            for (int m = 0; m < 4; ++m)
#pragma unroll
                for (int bj = 0; bj < 2; ++bj)
#pragma unroll
                    for (int q = 0; q < 4; ++q) { const unsigned w = xin[m][bj][q]; acc[ai][bj][m][q >> 1][(q & 1) * 2] = __builtin_bit_cast(float, w << 16); acc[ai][bj][m][q >> 1][(q & 1) * 2 + 1] = __builtin_bit_cast(float, w & 0xffff0000u); } }
    }
    __device__ __forceinline__ void operator()(const f32x4 (&acc)[2][2][4][2], const Unit& u, int wr, int wc, int fr, int fq) const {
        const int row0 = u.pm * BM + wr * 64 + fr, col0 = u.pn * BM + wc * 32 + 8 * fq;
#pragma unroll
        for (int g = 0; g < 8; ++g) { const int ai = g >> 2, m = g & 3; const int row = row0 + ai * HALF + m * 16; const size_t off = (size_t)row * 1024 + col0; float ss = 0.f;
#pragma unroll
            for (int bj = 0; bj < 2; ++bj) { const f32x4 x0 = acc[ai][bj][m][0], x1 = acc[ai][bj][m][1];
                ss += ((x0[0] * x0[0] + x0[1] * x0[1]) + (x0[2] * x0[2] + x0[3] * x0[3])) + ((x1[0] * x1[0] + x1[1] * x1[1]) + (x1[2] * x1[2] + x1[3] * x1[3]));
                u32x4 w; w.x = cvt_pk_bf16(x0[0], x0[1]); w.y = cvt_pk_bf16(x0[2], x0[3]); w.z = cvt_pk_bf16(x1[0], x1[1]); w.w = cvt_pk_bf16(x1[2], x1[3]);
                *(u32x4*)(XB + off + bj * HALF) = w;
                if (OUT) { *(f32x4*)(OUT + off + bj * HALF) = x0; *(f32x4*)(OUT + off + bj * HALF + 4) = x1; } }
            ss += __shfl_xor(ss, 16); ss += __shfl_xor(ss, 32);
            if (fq == 0) rss[(size_t)row * 16 + u.pn * 4 + wc] = ss; }
    }
};
struct EpiGateMix {
    static constexpr bool PERM = true, AFTER_DRAIN = false, ROWTAB = false, ACCINIT = false; static constexpr int KSEG = 8;
    GateMap gm; bf16_t* O; int ldo;
    static constexpr int PF = 4;
    __device__ __forceinline__ void seg(f32x4 (&acc)[2][2][4][2], const Unit& u, int s, int wr, int wc, int fr, int fq) const {
        const int row0 = u.pm * BM + wr * 64 + fr, col0 = wc * 32 + 8 * fq; int ldl, ldh; const bf16_t* bl = gm.tile((s - 1) * 4 + u.pn, ldl); const bf16_t* bh = gm.tile(s * 4 + u.pn, ldh);
        u32x4 lo[PF][2], hi[PF][2];
#pragma unroll
        for (int g = 0; g < PF; ++g) { const size_t rown = (size_t)(row0 + (g >> 2) * HALF + (g & 3) * 16);
#pragma unroll
            for (int bj = 0; bj < 2; ++bj) { lo[g][bj] = *(const u32x4*)(bl + rown * ldl + col0 + bj * HALF); hi[g][bj] = *(const u32x4*)(bh + rown * ldh + col0 + bj * HALF); } }
#pragma unroll
        for (int g = 0; g < 8; ++g) { const int ai = g >> 2, m = g & 3, sl = g % PF;
#pragma unroll
            for (int bj = 0; bj < 2; ++bj)
#pragma unroll
                for (int q = 0; q < 4; ++q) { const unsigned wl = lo[sl][bj][q], wh = hi[sl][bj][q];
                    const float l0 = clampg(__builtin_bit_cast(float, wl << 16)), l1 = clampg(__builtin_bit_cast(float, wl & 0xffff0000u)), h0 = clampg(__builtin_bit_cast(float, wh << 16)), h1 = clampg(__builtin_bit_cast(float, wh & 0xffff0000u));
                    const float r0 = (1.0f + __expf(-h0)) * __builtin_amdgcn_rcpf(1.0f + __expf(-l0)), r1 = (1.0f + __expf(-h1)) * __builtin_amdgcn_rcpf(1.0f + __expf(-l1));
                    acc[ai][bj][m][q >> 1][(q & 1) * 2] *= r0; acc[ai][bj][m][q >> 1][(q & 1) * 2 + 1] *= r1; }
            if (g + PF < 8) { const size_t rown = (size_t)(row0 + ((g + PF) >> 2) * HALF + ((g + PF) & 3) * 16);
#pragma unroll
                for (int bj = 0; bj < 2; ++bj) { lo[sl][bj] = *(const u32x4*)(bl + rown * ldl + col0 + bj * HALF); hi[sl][bj] = *(const u32x4*)(bh + rown * ldh + col0 + bj * HALF); } } }
    }
    __device__ __forceinline__ void operator()(const f32x4 (&acc)[2][2][4][2], const Unit& u, int wr, int wc, int fr, int fq) const {
        const int row0 = u.pm * BM + wr * 64 + fr, col0 = wc * 32 + 8 * fq; int ldg; const bf16_t* bg = gm.tile(8 + u.pn, ldg);
        u32x4 gc[PF][2];
#pragma unroll
        for (int g = 0; g < PF; ++g) { const size_t rown = (size_t)(row0 + (g >> 2) * HALF + (g & 3) * 16);
#pragma unroll
            for (int bj = 0; bj < 2; ++bj) gc[g][bj] = *(const u32x4*)(bg + rown * ldg + col0 + bj * HALF); }
#pragma unroll
        for (int gi = 0; gi < 8; ++gi) { const int ai = gi >> 2, m = gi & 3, sl = gi % PF; const int row = row0 + ai * HALF + m * 16; bf16_t* rowp = O + (size_t)row * ldo + u.pn * BM + col0;
#pragma unroll
            for (int bj = 0; bj < 2; ++bj) { const u32x4 g = gc[sl][bj]; float o[8];
#pragma unroll
                for (int q = 0; q < 4; ++q) { const unsigned w = g[q]; const float g0 = clampg(__builtin_bit_cast(float, w << 16)), g1 = clampg(__builtin_bit_cast(float, w & 0xffff0000u));
                    o[2 * q] = acc[ai][bj][m][q >> 1][(q & 1) * 2] * __builtin_amdgcn_rcpf(1.0f + __expf(-g0)); o[2 * q + 1] = acc[ai][bj][m][q >> 1][(q & 1) * 2 + 1] * __builtin_amdgcn_rcpf(1.0f + __expf(-g1)); }
                u32x4 w; w.x = cvt_pk_bf16(o[0], o[1]); w.y = cvt_pk_bf16(o[2], o[3]); w.z = cvt_pk_bf16(o[4], o[5]); w.w = cvt_pk_bf16(o[6], o[7]);
                *(u32x4*)(rowp + bj * HALF) = w; }
            if (gi + PF < 8) { const size_t rown = (size_t)(row0 + ((gi + PF) >> 2) * HALF + ((gi + PF) & 3) * 16);
#pragma unroll
                for (int bj = 0; bj < 2; ++bj) gc[sl][bj] = *(const u32x4*)(bg + rown * ldg + col0 + bj * HALF); } }
    }
};


template <class Epi, class Sched, bool ALIGN_EPI = false, bool SP2 = false>
__device__ __forceinline__ void gemm_phase(PG8_LAS unsigned char* lds, const Gemm g, const Sched& S, const Epi& E) {
    int tid_ = threadIdx.x; asm volatile("" : "+v"(tid_));
    const int tid = tid_, wid = __builtin_amdgcn_readfirstlane(tid >> 6), lane = tid & 63, wr = wid >> 2, wc = wid & 3, fr = lane & 15, fq = lane >> 4;
    const int K = g.K, nt = K / BK;
    unsigned voffA[2], voffB[2];
#pragma unroll
    for (int i = 0; i < 2; ++i) { int R, C; stage_rc(tid * 16 + i * 8192, R, C); const int Rb = Epi::PERM ? ((R & ~31) + perm32(R & 31)) : R;
        voffA[i] = (unsigned)(R * g.lda + C) * 2u; voffB[i] = (unsigned)(Rb * K + C) * 2u; }
    const size_t kstep = (size_t)(BK * 2);
    const size_t hstepB = (size_t)HALF * K * 2, hstepA = (size_t)HALF * g.lda * 2;
    const size_t tstepB = 2 * hstepB, tstepA = 2 * hstepA;
    const unsigned ldsw = (unsigned)wid * 1024u;
    const int aoff = lds_byte(wr * 64 + fr, fq * 8), boff = lds_byte(wc * 32 + fr, fq * 8);
#define PG8_SA(b, h) (((b) * 2 + (h)) * HTB)
#define PG8_SB(b, h) ((4 + (b) * 2 + (h)) * HTB)
#define PG8_STAGE(bufoff, gbase, voff) do { _Pragma("unroll") for (int _i = 0; _i < 2; ++_i) \
        __builtin_amdgcn_global_load_lds((const unsigned*)((const char*)(gbase) + (voff)[_i]), (PG8_LAS unsigned*)(lds + (bufoff) + ldsw + _i * 8192), 16, 0, 0); } while (0)
#define PG8_LDA(dst, b, h) do { _Pragma("unroll") for (int m = 0; m < 4; ++m) _Pragma("unroll") for (int k = 0; k < 2; ++k) dst[m][k] = *(const PG8_LAS bf16x8*)(lds + PG8_SA(b, h) + aoff + m * 2048 + k * 1024); } while (0)
#define PG8_LDB(dst, b, h) do { _Pragma("unroll") for (int n = 0; n < 2; ++n) _Pragma("unroll") for (int k = 0; k < 2; ++k) dst[n][k] = *(const PG8_LAS bf16x8*)(lds + PG8_SB(b, h) + boff + n * 2048 + k * 1024); } while (0)
#define PG8_MMA(ai, bj, At, Bt) do { __builtin_amdgcn_s_setprio(1); _Pragma("unroll") for (int m = 0; m < 4; ++m) _Pragma("unroll") for (int n = 0; n < 2; ++n) _Pragma("unroll") for (int k = 0; k < 2; ++k) \
        acc[ai][bj][m][n] = __builtin_amdgcn_mfma_f32_16x16x32_bf16(Bt[n][k], At[m][k], acc[ai][bj][m][n], 0, 0, 0); __builtin_amdgcn_s_setprio(0); } while (0)
#define PG8_WAIT_V(n) asm volatile("s_waitcnt vmcnt(" #n ")" ::: "memory")
#define PG8_WAIT_L(n) asm volatile("s_waitcnt lgkmcnt(" #n ")" ::: "memory")
#define PG8_BAR __builtin_amdgcn_s_barrier()
#define PG8_SCHED __builtin_amdgcn_sched_barrier(0)
    Unit cur, nxt; int ui = 0;
    if (!S.next(0, cur)) return;
    f32x4 rt0 = (f32x4){0.f, 0.f, 0.f, 0.f}, rt1 = rt0;
    if constexpr (Epi::ROWTAB) { E.tab_load(cur, tid, rt0, rt1); E.tab_store((PG8_LAS float*)(lds + STAGE_BYTES), tid, rt0, rt1); }
    f32x4 acc[2][2][4][2];
#pragma unroll
    for (int a = 0; a < 2; ++a)
#pragma unroll
        for (int b = 0; b < 2; ++b)
#pragma unroll
            for (int m = 0; m < 4; ++m)
#pragma unroll
                for (int n = 0; n < 2; ++n) acc[a][b][m][n] = (f32x4){0.f, 0.f, 0.f, 0.f};
    if constexpr (Epi::ACCINIT) E.init(acc, cur, wr, wc, fr, fq);
    bf16x8 At[4][2], B0[2][2], B1[2][2];
    const char* cA = (const char*)g.A + (size_t)cur.pm * tstepA; const char* cB = (const char*)g.Bt + (size_t)cur.pn * tstepB;
    S.a_ready(cur);
    if constexpr (SP2) {
        PG8_STAGE(PG8_SB(0, 0), cB, voffB); PG8_STAGE(PG8_SB(0, 1), cB + hstepB, voffB); PG8_STAGE(PG8_SA(0, 0), cA, voffA); PG8_STAGE(PG8_SA(0, 1), cA + hstepA, voffA);
        if (wr == 1) PG8_BAR;
        PG8_WAIT_V(2); PG8_BAR;
        PG8_STAGE(PG8_SB(1, 0), cB + kstep, voffB); PG8_STAGE(PG8_SA(1, 0), cA + kstep, voffA); PG8_STAGE(PG8_SB(1, 1), cB + hstepB + kstep, voffB);
        PG8_WAIT_V(6); PG8_BAR;
    } else {
        PG8_STAGE(PG8_SB(0, 0), cB, voffB); PG8_STAGE(PG8_SA(0, 0), cA, voffA); PG8_STAGE(PG8_SB(0, 1), cB + hstepB, voffB); PG8_STAGE(PG8_SA(0, 1), cA + hstepA, voffA);
        if (wr == 1) PG8_BAR;
        PG8_WAIT_V(4); PG8_BAR;
        PG8_STAGE(PG8_SB(1, 0), cB + kstep, voffB); PG8_STAGE(PG8_SA(1, 0), cA + kstep, voffA); PG8_STAGE(PG8_SB(1, 1), cB + hstepB + kstep, voffB);
        PG8_WAIT_V(6); PG8_BAR;
    }
    for (;;) {
        const bool has_next = S.next(ui + 1, nxt);
        const char* nA = has_next ? (const char*)g.A + (size_t)nxt.pm * tstepA : cA; const char* nB = has_next ? (const char*)g.Bt + (size_t)nxt.pn * tstepB : cB;
        for (int t = 0; t < nt; t += 2) {
            const bool last = (t == nt - 2);
            const char* a1 = cA + (size_t)(t + 1) * kstep;
            const char* a2 = last ? nA : cA + (size_t)(t + 2) * kstep; const char* b2 = last ? nB : cB + (size_t)(t + 2) * kstep;
            const char* a3 = a2 + kstep; const char* b3 = b2 + kstep;
            if (last && has_next) S.a_ready(nxt);
            if constexpr (Epi::ROWTAB) { if (has_next) { if (t == nt - 4) E.tab_dma(nxt, lds + STAGE_BYTES + 2048, wid, lane);
                                                         if (last) E.tab_store_lds((PG8_LAS float*)(lds + STAGE_BYTES + ((ui + 1) & 1) * 1024), lds + STAGE_BYTES + 2048, tid); } }
            if constexpr (Epi::KSEG > 0) { if (t != 0 && (t % Epi::KSEG) == 0) {
                if constexpr (ALIGN_EPI) { if (wr == 0) PG8_BAR; }
                E.seg(acc, cur, t / Epi::KSEG, wr, wc, fr, fq);
                if constexpr (ALIGN_EPI) { if (wr == 1) PG8_BAR; } } }
            if constexpr (SP2) {
            PG8_LDB(B0, 0, 0); PG8_LDB(B1, 0, 1); PG8_SCHED; PG8_LDA(At, 0, 0); PG8_STAGE(PG8_SA(1, 1), a1 + hstepA, voffA);
            PG8_WAIT_V(8); PG8_WAIT_L(0); PG8_BAR; PG8_MMA(0, 0, At, B0); PG8_MMA(0, 1, At, B1); PG8_BAR; PG8_SCHED;
            PG8_LDA(At, 0, 1); PG8_STAGE(PG8_SB(0, 0), b2, voffB); PG8_STAGE(PG8_SB(0, 1), b2 + hstepB, voffB); PG8_STAGE(PG8_SA(0, 0), a2, voffA);
            PG8_WAIT_V(8); PG8_WAIT_L(0); PG8_BAR; PG8_MMA(1, 0, At, B0); PG8_MMA(1, 1, At, B1); PG8_BAR; PG8_SCHED;
            PG8_LDB(B0, 1, 0); PG8_LDB(B1, 1, 1); PG8_SCHED; PG8_LDA(At, 1, 0); PG8_STAGE(PG8_SA(0, 1), a2 + hstepA, voffA);
            PG8_WAIT_V(8); PG8_WAIT_L(0); PG8_BAR; PG8_MMA(0, 0, At, B0); PG8_MMA(0, 1, At, B1); PG8_BAR; PG8_SCHED;
            PG8_LDA(At, 1, 1); PG8_STAGE(PG8_SB(1, 0), b3, voffB); PG8_STAGE(PG8_SB(1, 1), b3 + hstepB, voffB); PG8_STAGE(PG8_SA(1, 0), a3, voffA);
            PG8_WAIT_V(8); PG8_WAIT_L(0); PG8_BAR; PG8_MMA(1, 0, At, B0); PG8_MMA(1, 1, At, B1); PG8_BAR; PG8_SCHED;
            } else {
            PG8_LDB(B0, 0, 0); PG8_SCHED; PG8_LDA(At, 0, 0); PG8_STAGE(PG8_SA(1, 1), a1 + hstepA, voffA);
            PG8_WAIT_L(8); PG8_BAR; PG8_WAIT_L(0); PG8_MMA(0, 0, At, B0); PG8_BAR; PG8_SCHED;
            PG8_LDB(B1, 0, 1); PG8_STAGE(PG8_SB(0, 0), b2, voffB);
            PG8_BAR; PG8_WAIT_L(0); PG8_MMA(0, 1, At, B1); PG8_BAR;
            PG8_LDA(At, 0, 1); PG8_STAGE(PG8_SA(0, 0), a2, voffA);
            PG8_BAR; PG8_WAIT_L(0); PG8_MMA(1, 0, At, B0); PG8_BAR; PG8_SCHED;
            PG8_STAGE(PG8_SB(0, 1), b2 + hstepB, voffB);
            PG8_WAIT_V(6); PG8_BAR; PG8_MMA(1, 1, At, B1); PG8_BAR;
            PG8_LDB(B0, 1, 0); PG8_SCHED; PG8_LDA(At, 1, 0); PG8_STAGE(PG8_SA(0, 1), a2 + hstepA, voffA);
            PG8_WAIT_L(8); PG8_BAR; PG8_WAIT_L(0); PG8_MMA(0, 0, At, B0); PG8_BAR; PG8_SCHED;
            PG8_LDB(B1, 1, 1); PG8_STAGE(PG8_SB(1, 0), b3, voffB);
            PG8_BAR; PG8_WAIT_L(0); PG8_MMA(0, 1, At, B1); PG8_BAR;
            PG8_LDA(At, 1, 1); PG8_STAGE(PG8_SA(1, 0), a3, voffA);
            PG8_BAR; PG8_WAIT_L(0); PG8_MMA(1, 0, At, B0); PG8_BAR; PG8_SCHED;
            PG8_STAGE(PG8_SB(1, 1), b3 + hstepB, voffB);
            PG8_WAIT_V(6); PG8_BAR; PG8_MMA(1, 1, At, B1); PG8_BAR;
            }
        }
        if constexpr (ALIGN_EPI) { if (wr == 0) PG8_BAR; }
        if constexpr (!Epi::AFTER_DRAIN) { if constexpr (Epi::ROWTAB) E(acc, cur, wr, wc, fr, fq, (const PG8_LAS float*)(lds + STAGE_BYTES + (ui & 1) * 1024)); else E(acc, cur, wr, wc, fr, fq); S.done(cur); }
        if (!has_next) break;
#pragma unroll
        for (int a = 0; a < 2; ++a)
#pragma unroll
            for (int b = 0; b < 2; ++b)
#pragma unroll
                for (int m = 0; m < 4; ++m)
#pragma unroll
                    for (int n = 0; n < 2; ++n) acc[a][b][m][n] = (f32x4){0.f, 0.f, 0.f, 0.f};
        if constexpr (Epi::ACCINIT) E.init(acc, nxt, wr, wc, fr, fq);
        cur = nxt; cA = nA; cB = nB; ++ui;
        if constexpr (ALIGN_EPI) { if (wr == 1) PG8_BAR; }
    }
    PG8_WAIT_V(0);
    if constexpr (!ALIGN_EPI) { if (wr == 0) PG8_BAR; }
    PG8_BAR;
    if constexpr (Epi::AFTER_DRAIN) { E.fused(acc, cur, wr, wc, fr, fq, lds, wid, lane); S.done(cur); }
#undef PG8_SA
#undef PG8_SB
#undef PG8_STAGE
#undef PG8_LDA
#undef PG8_LDB
#undef PG8_MMA
#undef PG8_WAIT_V
#undef PG8_WAIT_L
#undef PG8_BAR
#undef PG8_SCHED
}
}


#define LDS_WAIT() asm volatile("s_waitcnt lgkmcnt(0)" ::: "memory")
constexpr int NWAVES = 8;
constexpr int LDS_BYTES = 157696;

struct WItem { const float* W; const float* scale; bf16* WT; int ldw, k0, n0, ldt, drow0, dcol0; };
constexpr int WI_IN = 16 * 240, WI_MIX = 3 * 8 * 32, WI_OUT = 16 * 32, WI_G = 16 * 88, WI_DN = 44 * 32;
constexpr int WI_TOTAL = WI_IN + WI_MIX + WI_OUT + 2 * WI_G + WI_DN;
__device__ __forceinline__ void witem_desc(KP P, int gi, WItem& d) {
    const int l = gi / WI_TOTAL; int it = gi - l * WI_TOTAL;
    unsigned char* ws = wbase(P, l);
    if (it < WI_IN) { const int kb = it / 240, nb = it % 240; d.W = P->in[I_WIN] + (size_t)l * D * INW; d.ldw = INW; d.k0 = 64 * kb; d.n0 = 32 * nb; d.scale = P->in[I_N1G] + l * D; d.WT = (bf16*)(ws + WS_WIN); d.ldt = D; d.drow0 = 32 * nb; d.dcol0 = 64 * kb; return; }
    it -= WI_IN;
    if (it < WI_MIX) { const int br = it / 256, r = it % 256, kb = r / 32, nb = r % 32; d.W = P->in[br == 0 ? I_WAO : (br == 1 ? I_WRO : I_WTO)] + (size_t)l * 512 * D;
        d.ldw = D; d.k0 = 64 * kb; d.n0 = 32 * nb; d.scale = nullptr; d.WT = (bf16*)(ws + WS_WMIX); d.ldt = NMIX; d.drow0 = 32 * nb; d.dcol0 = br * 512 + 64 * kb; return; }
    it -= WI_MIX;
    if (it < WI_OUT) { const int kb = it / 32, nb = it % 32; d.W = P->in[I_WOUT] + (size_t)l * D * D; d.ldw = D; d.k0 = 64 * kb; d.n0 = 32 * nb; d.scale = nullptr; d.WT = (bf16*)(ws + WS_WOUT); d.ldt = D; d.drow0 = 32 * nb; d.dcol0 = 64 * kb; return; }
    it -= WI_OUT;
    if (it < 2 * WI_G) { const int up = it / WI_G, r = it % WI_G, kb = r / 88, nb = r % 88, n0 = 32 * nb;
        d.W = P->in[up ? I_WU : I_WG] + (size_t)l * D * FF; d.ldw = FF; d.k0 = 64 * kb; d.n0 = n0; d.scale = P->in[I_N2G] + l * D; d.WT = (bf16*)(ws + WS_WGU); d.ldt = D; d.drow0 = (n0 / 128) * 256 + up * 128 + (n0 % 128); d.dcol0 = 64 * kb; return; }
    it -= 2 * WI_G;
    { const int kb = it / 32, nb = it % 32; d.W = P->in[I_WD] + (size_t)l * FF * D; d.ldw = D; d.k0 = 64 * kb; d.n0 = 32 * nb; d.scale = nullptr; d.WT = (bf16*)(ws + WS_WDN); d.ldt = FF; d.drow0 = 32 * nb; d.dcol0 = 64 * kb; }
}
__device__ __forceinline__ void witem_load(const WItem& d, int lane, v4f (&r)[8], v4f (&sc)[2]) {
    const float* src = d.W + (size_t)(d.k0 + (lane >> 3)) * d.ldw + d.n0 + 4 * (lane & 7);
#pragma unroll
    for (int i = 0; i < 8; ++i) r[i] = *(const v4f*)(src + (size_t)(8 * i) * d.ldw);
    sc[0] = (v4f){1.f, 1.f, 1.f, 1.f}; sc[1] = sc[0];
    if (d.scale) { const v4f* sp = (const v4f*)(d.scale + d.k0 + 8 * (lane & 7)); sc[0] = sp[0]; sc[1] = sp[1]; }
}
__device__ __forceinline__ void witem_store(const WItem& d, int lane, const v4f (&r)[8], const v4f (&sc)[2], LAS float* scr) {
    { LAS float* w = scr + (lane >> 3) * 33 + 4 * (lane & 7);
#pragma unroll
      for (int i = 0; i < 8; ++i) { w[(8 * i) * 33 + 0] = r[i].x; w[(8 * i) * 33 + 1] = r[i].y; w[(8 * i) * 33 + 2] = r[i].z; w[(8 * i) * 33 + 3] = r[i].w; } }
    LDS_WAIT(); asm volatile("" ::: "memory");
    const int c = lane & 7;
#pragma unroll
    for (int j = 0; j < 4; ++j) { const int n = (lane >> 3) + 8 * j; const LAS float* s = scr + (8 * c) * 33 + n;
        v4u o; o.x = pk2(s[0 * 33] * sc[0].x, s[1 * 33] * sc[0].y); o.y = pk2(s[2 * 33] * sc[0].z, s[3 * 33] * sc[0].w); o.z = pk2(s[4 * 33] * sc[1].x, s[5 * 33] * sc[1].y); o.w = pk2(s[6 * 33] * sc[1].z, s[7 * 33] * sc[1].w);
        *(v4u*)(d.WT + (size_t)(d.drow0 + n) * d.ldt + d.dcol0 + 8 * c) = o; }
    LDS_WAIT(); asm volatile("" ::: "memory");
}
__device__ __forceinline__ void phase_wconv_all(KP P, LAS unsigned char* lds, int vcu, int G) {
    const int otid_ = otid();
    const int wave = __builtin_amdgcn_readfirstlane(otid_ >> 6), lane = otid_ & 63;
    LAS float* scr = (LAS float*)(lds + wave * 16384);
    const int step = G * NWAVES, total = DEPTH * WI_TOTAL;
    int gi = vcu * NWAVES + wave;
    if (gi >= total) return;
    WItem cur, nxt; v4f rc[8], rn[8], sc[2], sn[2];
    witem_desc(P, gi, cur); witem_load(cur, lane, rc, sc);
#pragma unroll 1
    for (;;) {
        const int gn = gi + step; const bool has_next = gn < total;
        if (has_next) { witem_desc(P, gn, nxt); witem_load(nxt, lane, rn, sn); }
        witem_store(cur, lane, rc, sc, scr);
        if (!has_next) break;
        cur = nxt; gi = gn;
#pragma unroll
        for (int i = 0; i < 8; ++i) rc[i] = rn[i];
        sc[0] = sn[0]; sc[1] = sn[1];
    }
}
__device__ __forceinline__ void phase_x0(KP P, int vcu, int G) {
    const int otid_ = otid();
    const int wave = __builtin_amdgcn_readfirstlane(otid_ >> 6), lane = otid_ & 63;
    const float* x = P->in[I_X]; bf16* xb = (bf16*)(P->ws + WS_XB); float* rss = (float*)(P->ws + WS_RSS);
    for (int m0 = vcu * NWAVES + wave; m0 < M; m0 += 2 * G * NWAVES) {
        v4f v[2][4];
#pragma unroll
        for (int q = 0; q < 2; ++q) { const int m = m0 + q * G * NWAVES; const v4f* xr = (const v4f*)(x + (size_t)(m < M ? m : m0) * D) + lane;
#pragma unroll
            for (int j = 0; j < 4; ++j) v[q][j] = xr[64 * j]; }
#pragma unroll
        for (int q = 0; q < 2; ++q) { const int m = m0 + q * G * NWAVES; if (m < M) { unsigned long long* o8 = (unsigned long long*)(xb + (size_t)m * D) + lane; float s = 0.f;
#pragma unroll
            for (int j = 0; j < 4; ++j) s += (v[q][j].x * v[q][j].x + v[q][j].y * v[q][j].y) + (v[q][j].z * v[q][j].z + v[q][j].w * v[q][j].w);
            s = wave_sum(s);
#pragma unroll
            for (int j = 0; j < 4; ++j) { o8[64 * j] = (unsigned long long)pk2(v[q][j].x, v[q][j].y) | ((unsigned long long)pk2(v[q][j].z, v[q][j].w) << 32); }
            if (lane < 16) rss[(size_t)m * 16 + lane] = lane == 0 ? s : 0.f; } }
    }
    float* rope = (float*)(P->ws + WS_ROPE);
    for (int i = (vcu * NWAVES + wave) * 64 + lane; i < T * 32; i += G * NWAVES * 64) {
        const int t = i >> 5, j = i & 31; const float inv_freq = (float)exp(-((double)j / 32.0) * 9.210340371976184); const float ang = (float)t * inv_freq;
        const double xa = (double)ang, qd = rint(xa * 0.6366197723675814), fd = xa - qd * 1.5707963267948966; const int qi = (int)qd & 3;
        const float ff = (float)fd, f2 = ff * ff;
        const float sf = ff * (1.0f + f2 * (-1.6666667e-1f + f2 * (8.3333333e-3f + f2 * (-1.9841270e-4f + f2 * 2.7557319e-6f))));
        const float cf = 1.0f + f2 * (-0.5f + f2 * (4.1666667e-2f + f2 * (-1.3888889e-3f + f2 * (2.4801587e-5f + f2 * -2.7557319e-7f))));
        const float sn = (qi == 0) ? sf : (qi == 1) ? cf : (qi == 2) ? -sf : -cf, cs = (qi == 0) ? cf : (qi == 1) ? -sf : (qi == 2) ? -cf : sf;
        rope[2 * i] = cs; rope[2 * i + 1] = sn;
        { float* rope2 = (float*)(P->ws + WS_ROPE2); const int p = j >> 3, e = (j & 7) >> 1, o = j & 1;
          const size_t q = (((size_t)e * T + t) * 4 + p) * 4 + 2 * o; rope2[q] = cs; rope2[q + 1] = sn; }
    }
}


#define RESID_ALIGN true
#define STAGGER_US10 0
template <int PH> __device__ __forceinline__ void gemm_phase_of(KP P, int l, LAS unsigned char* lds, int G, int c, int i0 = 0, int ni = 1 << 30) {
    asm volatile("" : "+s"(l), "+s"(G), "+s"(c), "+s"(i0), "+s"(ni));
    const bool final_layer = (l == DEPTH - 1); const unsigned char* wb = wbase(P, l);
    unsigned char* ws = P->ws; const pg8::bf16_t* xb = (const pg8::bf16_t*)(ws + WS_XB); float* rss = (float*)(ws + WS_RSS);
    if constexpr (STAGGER_US10 > 0 && (PH == 0 || PH == 1 || PH == 4)) {
        if (otid() == 0) { const unsigned long long t0 = __builtin_amdgcn_s_memrealtime(), dt = (unsigned long long)(((unsigned)c >> 3) & 7u) * STAGGER_US10 * 10ull;
            while (__builtin_amdgcn_s_memrealtime() - t0 < dt) __builtin_amdgcn_s_sleep(8); }
        __syncthreads(); }
    pg8::StaticOrder S;
    if constexpr (PH == 0) { pg8::Gemm g{xb, (const pg8::bf16_t*)(wb + WS_WIN), M, NA, D, D}; S.init(M, NA, G, c); pg8::EpiRowScale E{{rss}, (pg8::bf16_t*)(ws + WS_BIG), NA};
        pg8::gemm_phase<pg8::EpiRowScale, pg8::StaticOrder, true, true>(lds, g, S, E); }
    if constexpr (PH == 1) { pg8::Gemm g{xb, (const pg8::bf16_t*)(wb + WS_WIN) + (size_t)NA * D, M, NG, D, D}; S.init(M, NG, G, c); S.i0 = i0; S.ni = ni; pg8::EpiGates E{{rss}, pg8::GateMap{(pg8::bf16_t*)(ws + WS_BIG), (pg8::bf16_t*)(ws + WS_GX)}};
        pg8::gemm_phase<pg8::EpiGates, pg8::StaticOrder, true, true>(lds, g, S, E); }
    if constexpr (PH == 2) { pg8::Gemm g{(const pg8::bf16_t*)(ws + WS_MIXO), (const pg8::bf16_t*)(wb + WS_WMIX), M, D, NMIX, NMIX}; S.init(M, D, G, c); pg8::EpiGateMix E{pg8::GateMap{(pg8::bf16_t*)(ws + WS_BIG), (pg8::bf16_t*)(ws + WS_GX)}, (pg8::bf16_t*)(ws + WS_BIG) + C_RW, NA};
        pg8::gemm_phase<pg8::EpiGateMix, pg8::StaticOrder, true, true>(lds, g, S, E); }
    if constexpr (PH == 3) { pg8::Gemm g{(const pg8::bf16_t*)(ws + WS_BIG) + C_RW, (const pg8::bf16_t*)(wb + WS_WOUT), M, D, D, NA}; S.init(M, D, G, c); pg8::EpiResid E{(pg8::bf16_t*)(ws + WS_XB), rss, nullptr};
        pg8::gemm_phase<pg8::EpiResid, pg8::StaticOrder, RESID_ALIGN, true>(lds, g, S, E); }
    if constexpr (PH == 4) { pg8::Gemm g{xb, (const pg8::bf16_t*)(wb + WS_WGU), M, FF2, D, D}; S.init(M, FF2, G, c); pg8::EpiSwiglu E{{rss}, (pg8::bf16_t*)(ws + WS_BIG), NA};
        pg8::gemm_phase<pg8::EpiSwiglu, pg8::StaticOrder, true, true>(lds, g, S, E); }
    if constexpr (PH == 5) { pg8::Gemm g{(const pg8::bf16_t*)(ws + WS_BIG), (const pg8::bf16_t*)(wb + WS_WDN), M, D, FF, NA}; S.init(M, D, G, c); pg8::EpiResid E{(pg8::bf16_t*)(ws + WS_XB), rss, final_layer ? P->out : nullptr};
        pg8::gemm_phase<pg8::EpiResid, pg8::StaticOrder, RESID_ALIGN, true>(lds, g, S, E); }
}

typedef float f32x16 __attribute__((ext_vector_type(16)));
typedef short bf16x8v __attribute__((ext_vector_type(8)));
constexpr int AT_KS = 144;
constexpr int AT_VS = 144;
constexpr int AT_KOFF = 0, AT_VOFF = 256 * AT_KS, AT_GOFF = AT_VOFF + 256 * AT_VS;
typedef short s16x4a_ __attribute__((ext_vector_type(4)));
typedef float v2f_ __attribute__((ext_vector_type(2)));
typedef __bf16 v2bf_ __attribute__((ext_vector_type(2)));
__device__ __forceinline__ unsigned cvtpk(float lo, float hi) { const v2f_ x = {lo, hi}; return __builtin_bit_cast(unsigned, __builtin_convertvector(x, v2bf_)); }
#define LDS_BAR() do { asm volatile("s_waitcnt lgkmcnt(0)" ::: "memory"); __builtin_amdgcn_s_barrier(); asm volatile("" ::: "memory"); } while (0)
__device__ __forceinline__ void attn_phase(KP P, int l, LAS unsigned char* lds, int u0, int ustep, int uend) {
    const int tid = otid(), w = __builtin_amdgcn_readfirstlane(tid >> 6), lane = tid & 63, r32 = lane & 31, h = lane >> 5;
    const bf16* proj = (const bf16*)(P->ws + WS_BIG); bf16* mixo = (bf16*)(P->ws + WS_MIXO);
    const float* gq = P->in[I_QNG] + l * 64; const float* gk = P->in[I_KNG] + l * 64; const float* sinks = P->in[I_SINK] + l * 8;
    LAS float* gqs = (LAS float*)(lds + AT_GOFF);
    constexpr float LOG2E = 1.4426950408889634f;
    __syncthreads();
    if (tid < 64) { gqs[tid] = gq[tid] * (0.125f * LOG2E); gqs[64 + tid] = gk[tid]; }
    v4u kv[4], vv[4];
#define AT_LOAD(U) do { const int b_ = (U) >> 5, n_ = ((U) >> 1) & 15, kvh_ = (U) & 1, r_ = tid >> 1, hf_ = tid & 1; const size_t grow_ = (size_t)(b_ * T + n_ * 128 - 128 + r_) * NA; \
        _Pragma("unroll") for (int i = 0; i < 4; ++i) { kv[i] = (v4u){0u, 0u, 0u, 0u}; vv[i] = (v4u){0u, 0u, 0u, 0u}; } \
        if ((n_ > 0) || (r_ >= 128)) { _Pragma("unroll") for (int i = 0; i < 4; ++i) { kv[i] = *(const v4u*)(proj + grow_ + C_AK + kvh_ * 64 + hf_ * 32 + 8 * i); vv[i] = *(const v4u*)(proj + grow_ + C_AV + kvh_ * 64 + hf_ * 32 + 8 * i); } } } while (0)
    if (u0 < uend) AT_LOAD(u0);
    for (int unit = u0; unit < uend; unit += ustep) {
        const int b = unit >> 5, n = (unit >> 1) & 15, kvh = unit & 1;
        LDS_BAR();
        {
            const int r = tid >> 1, hf = tid & 1;
            float ss = 0.f;
#pragma unroll
            for (int i = 0; i < 4; ++i)
#pragma unroll
                for (int e = 0; e < 4; ++e) { const float k0 = bflo(kv[i][e]), k1 = bfhi(kv[i][e]); ss += k0 * k0 + k1 * k1; }
            ss += __shfl_xor(ss, 1);
            const float rs = rsqrtf(ss * (1.f / 64.f) + 1e-6f);
#pragma unroll
            for (int i = 0; i < 4; ++i) { v4u o;
#pragma unroll
                for (int e = 0; e < 4; ++e) { const int d = hf * 32 + 8 * i + 2 * e; o[e] = cvtpk(bflo(kv[i][e]) * rs * gqs[64 + d], bfhi(kv[i][e]) * rs * gqs[64 + d + 1]); }
                *(LAS v4u*)(lds + AT_KOFF + r * AT_KS + hf * 64 + 16 * i) = o; }
#pragma unroll
            for (int i = 0; i < 4; ++i) *(LAS v4u*)(lds + AT_VOFF + r * AT_VS + hf * 64 + 16 * i) = vv[i];
        }
        LDS_BAR();
        if (unit + ustep < uend) AT_LOAD(unit + ustep);
#pragma unroll 1
        for (int gi = 0; gi < 2; ++gi) {
            const int g = w >> 1, sb = (w & 1) * 2 + gi, hq = kvh * 4 + g;
            const size_t qrow = (size_t)(b * T + n * 128 + 32 * sb + r32);
            v4u qr[4]; float ss = 0.f;
#pragma unroll
            for (int s = 0; s < 4; ++s) { qr[s] = *(const v4u*)(proj + qrow * NA + C_AQ + hq * 64 + 8 * h + 16 * s);
#pragma unroll
                for (int e = 0; e < 4; ++e) { const float q0 = bflo(qr[s][e]), q1 = bfhi(qr[s][e]); ss += q0 * q0 + q1 * q1; } }
            ss += __shfl_xor(ss, 32);
            const float rs = rsqrtf(ss * (1.f / 64.f) + 1e-6f);
            bf16x8v Qf[4];
#pragma unroll
            for (int s = 0; s < 4; ++s) { const v4f g0 = *(const LAS v4f*)(gqs + 8 * h + 16 * s), g1 = *(const LAS v4f*)(gqs + 8 * h + 16 * s + 4); v4u o;
                o[0] = cvtpk(bflo(qr[s][0]) * rs * g0[0], bfhi(qr[s][0]) * rs * g0[1]); o[1] = cvtpk(bflo(qr[s][1]) * rs * g0[2], bfhi(qr[s][1]) * rs * g0[3]);
                o[2] = cvtpk(bflo(qr[s][2]) * rs * g1[0], bfhi(qr[s][2]) * rs * g1[1]); o[3] = cvtpk(bflo(qr[s][3]) * rs * g1[2], bfhi(qr[s][3]) * rs * g1[3]);
                Qf[s] = __builtin_bit_cast(bf16x8v, o); }
            f32x16 S[5];
#pragma unroll
            for (int c5 = 0; c5 < 5; ++c5) { f32x16 acc;
#pragma unroll
                for (int i = 0; i < 16; ++i) acc[i] = 0.f;
#pragma unroll
                for (int s = 0; s < 4; ++s) { const bf16x8v kf = *(const LAS bf16x8v*)(lds + AT_KOFF + (32 * (sb + c5) + r32) * AT_KS + (8 * h + 16 * s) * 2);
                    acc = __builtin_amdgcn_mfma_f32_32x32x16_bf16(kf, Qf[s], acc, 0, 0, 0); }
                S[c5] = acc; }
            const int qi = 32 * sb + r32; float mx = -INFINITY;
#pragma unroll
            for (int c5 = 0; c5 < 5; ++c5)
#pragma unroll
                for (int i = 0; i < 16; ++i) { const int si = 32 * (sb + c5) + 8 * (i >> 2) + 4 * h + (i & 3);
                    bool ok = true; if (c5 == 0) ok = si > qi; if (c5 == 4) ok = si <= qi + 128; if (n == 0) ok = ok && (si >= 128);
                    const float v = ok ? S[c5][i] : -INFINITY; S[c5][i] = v; mx = fmaxf(mx, v); }
            mx = fmaxf(mx, __shfl_xor(mx, 32));
            const float sink = sinks[hq] * LOG2E; mx = fmaxf(mx, sink);
            float sum = 0.f;
#pragma unroll
            for (int c5 = 0; c5 < 5; ++c5)
#pragma unroll
                for (int i = 0; i < 16; ++i) { const float p = __builtin_amdgcn_exp2f(S[c5][i] - mx); S[c5][i] = p; sum += p; }
            sum += __shfl_xor(sum, 32);
            const float inv = __builtin_amdgcn_rcpf(sum + __builtin_amdgcn_exp2f(sink - mx));
            f32x16 O[2];
#pragma unroll
            for (int dt = 0; dt < 2; ++dt)
#pragma unroll
                for (int i = 0; i < 16; ++i) O[dt][i] = 0.f;
#pragma unroll
            for (int c5 = 0; c5 < 5; ++c5)
#pragma unroll
                for (int s = 0; s < 2; ++s) { v4u pw; pw[0] = cvtpk(S[c5][8 * s], S[c5][8 * s + 1]); pw[1] = cvtpk(S[c5][8 * s + 2], S[c5][8 * s + 3]); pw[2] = cvtpk(S[c5][8 * s + 4], S[c5][8 * s + 5]); pw[3] = cvtpk(S[c5][8 * s + 6], S[c5][8 * s + 7]);
                    const bf16x8v pf = __builtin_bit_cast(bf16x8v, pw);
#pragma unroll
                    for (int dt = 0; dt < 2; ++dt) {
                        const LAS unsigned char* vp = lds + AT_VOFF + (32 * (sb + c5) + 16 * s + 4 * h + ((lane & 15) >> 2)) * AT_VS + (32 * dt + 16 * ((lane >> 4) & 1) + 4 * (lane & 3)) * 2;
                        const s16x4a_ lo = __builtin_amdgcn_ds_read_tr16_b64_v4i16((LAS s16x4a_*)vp), hi = __builtin_amdgcn_ds_read_tr16_b64_v4i16((LAS s16x4a_*)(vp + 8 * AT_VS));
                        O[dt] = __builtin_amdgcn_mfma_f32_32x32x16_bf16(__builtin_shufflevector(lo, hi, 0, 1, 2, 3, 4, 5, 6, 7), pf, O[dt], 0, 0, 0); } }
#pragma unroll
            for (int dt = 0; dt < 2; ++dt)
#pragma unroll
                for (int q4 = 0; q4 < 4; ++q4) { v2u o; o[0] = cvtpk(O[dt][4 * q4] * inv, O[dt][4 * q4 + 1] * inv); o[1] = cvtpk(O[dt][4 * q4 + 2] * inv, O[dt][4 * q4 + 3] * inv);
                    *(v2u*)(mixo + qrow * NMIX + hq * 64 + 32 * dt + 8 * q4 + 4 * h) = o; }
        }
    }
    __syncthreads();
#undef AT_LOAD
}

constexpr int RT_KS = 144;
constexpr int RT_KOFF = 0, RT_VOFF = 128 * RT_KS, RT_ROFF = RT_VOFF + 128 * RT_KS, RT_SOFF = RT_ROFF + 64 * RT_KS, RT_QOFF = RT_SOFF + 1024, RT_GOFF = RT_QOFF + 128 * RT_KS, RT_END = RT_GOFF + 128 * RT_KS;
typedef short s16x4r_ __attribute__((ext_vector_type(4)));
__device__ __forceinline__ bf16x8v rt_frag_tr(const LAS unsigned char* M, int kA, int kB, int c0, int lane) {
    const int g = lane >> 4, i = lane & 15; const int cb = (c0 + 16 * (g & 1) + 4 * (i & 3)) * 2 + (i >> 2) * RT_KS;
    const s16x4r_ a = __builtin_amdgcn_ds_read_tr16_b64_v4i16((LAS s16x4r_*)(M + kA * RT_KS + cb)), b = __builtin_amdgcn_ds_read_tr16_b64_v4i16((LAS s16x4r_*)(M + kB * RT_KS + cb));
    return __builtin_shufflevector(a, b, 0, 1, 2, 3, 4, 5, 6, 7); }
static_assert(RT_END <= 131072, "retention LDS");
__device__ __forceinline__ void ret_unit(KP P, LAS unsigned char* lds, int b, int hh) {
    const int tid = otid(), w = __builtin_amdgcn_readfirstlane(tid >> 6), lane = tid & 63, r32 = lane & 31, h = lane >> 5;
    const bf16* proj = (const bf16*)(P->ws + WS_BIG); bf16* mixo = (bf16*)(P->ws + WS_MIXO); const float* rope2 = (const float*)(P->ws + WS_ROPE2);
    const float lg = log2f(1.0f - exp2f(-5.0f - (float)hh));
    const float g128 = exp2f(128.0f * lg);
    const int qg = w >> 1, dt = w & 1;
    f32x16 Racc;
#pragma unroll
    for (int i = 0; i < 16; ++i) Racc[i] = 0.f;
    __syncthreads();
    for (int i = tid; i < 64 * RT_KS / 4; i += 512) ((LAS unsigned*)(lds + RT_ROFF))[i] = 0u;
    v4u pk1, pk2, pv1, pv2, pq1, pq2, pg1, pg2; v4f prk[4];
#define RT_PREFETCH(N) do { const int row_ = tid >> 2, p_ = tid & 3; const size_t g_ = ((size_t)(b * T + (N) * 128) + row_) * NA + hh * 64 + 8 * p_; \
        pk1 = *(const v4u*)(proj + g_ + C_RK); pk2 = *(const v4u*)(proj + g_ + C_RK + 32); pv1 = *(const v4u*)(proj + g_ + C_RV); pv2 = *(const v4u*)(proj + g_ + C_RV + 32); \
        pq1 = *(const v4u*)(proj + g_ + C_RQ); pq2 = *(const v4u*)(proj + g_ + C_RQ + 32); pg1 = *(const v4u*)(proj + g_ + C_RG); pg2 = *(const v4u*)(proj + g_ + C_RG + 32); \
        _Pragma("unroll") for (int e_ = 0; e_ < 4; ++e_) prk[e_] = *(const v4f*)(rope2 + (((size_t)e_ * T + (N) * 128 + row_) * 4 + p_) * 4); } while (0)
    RT_PREFETCH(0);
#pragma unroll 1
    for (int n = 0; n < 16; ++n) {
        const size_t tok0 = (size_t)(b * T + n * 128);
        LDS_BAR();
        {
            const int row = tid >> 2, p = tid & 3;
            const v4u k1 = pk1, k2 = pk2, v1 = pv1, v2 = pv2, q1 = pq1, q2 = pq2;
            const float sc = 0.125f * exp2f(-(float)(row + 1) * lg);
            v4u w1, w2, x1, x2;
#pragma unroll
            for (int e = 0; e < 4; ++e) { const v4f cs = prk[e];
                { const float a1 = bflo(k1[e]), a2 = bflo(k2[e]), b1 = bfhi(k1[e]), b2 = bfhi(k2[e]);
                  w1[e] = cvtpk((a1 * cs[0] - a2 * cs[1]) * sc, (b1 * cs[2] - b2 * cs[3]) * sc); w2[e] = cvtpk((a2 * cs[0] + a1 * cs[1]) * sc, (b2 * cs[2] + b1 * cs[3]) * sc); }
                { const float a1 = bflo(q1[e]), a2 = bflo(q2[e]), b1 = bfhi(q1[e]), b2 = bfhi(q2[e]);
                  x1[e] = cvtpk(a1 * cs[0] - a2 * cs[1], b1 * cs[2] - b2 * cs[3]); x2[e] = cvtpk(a2 * cs[0] + a1 * cs[1], b2 * cs[2] + b1 * cs[3]); } }
            *(LAS v4u*)(lds + RT_KOFF + row * RT_KS + 16 * p) = w1; *(LAS v4u*)(lds + RT_KOFF + row * RT_KS + 64 + 16 * p) = w2;
            *(LAS v4u*)(lds + RT_QOFF + row * RT_KS + 16 * p) = x1; *(LAS v4u*)(lds + RT_QOFF + row * RT_KS + 64 + 16 * p) = x2;
            *(LAS v4u*)(lds + RT_GOFF + row * RT_KS + 16 * p) = pg1; *(LAS v4u*)(lds + RT_GOFF + row * RT_KS + 64 + 16 * p) = pg2;
            *(LAS v4u*)(lds + RT_VOFF + row * RT_KS + 16 * p) = v1; *(LAS v4u*)(lds + RT_VOFF + row * RT_KS + 64 + 16 * p) = v2;
        }
        LDS_BAR();
        if (n + 1 < 16) RT_PREFETCH(n + 1);
        bf16x8v Qf[4];
        const size_t qtok = tok0 + 32 * qg + r32;
#pragma unroll
        for (int s = 0; s < 4; ++s) Qf[s] = *(const LAS bf16x8v*)(lds + RT_QOFF + (32 * qg + r32) * RT_KS + (8 * h + 16 * s) * 2);
        f32x16 O;
#pragma unroll
        for (int i = 0; i < 16; ++i) O[i] = 0.f;
#pragma unroll
        for (int s = 0; s < 4; ++s) { const bf16x8v rf = *(const LAS bf16x8v*)(lds + RT_ROFF + (32 * dt + r32) * RT_KS + (8 * h + 16 * s) * 2);
            O = __builtin_amdgcn_mfma_f32_32x32x16_bf16(rf, Qf[s], O, 0, 0, 0); }
#define RT_APPLY(S_, c_) do { if ((c_) == qg) { _Pragma("unroll") for (int i = 0; i < 16; ++i) { const int j = 8 * (i >> 2) + 4 * h + (i & 3); S_[i] = (j <= r32) ? S_[i] : 0.f; } }     \
            _Pragma("unroll") for (int s = 0; s < 2; ++s) { v4u pw; pw[0] = cvtpk(S_[8 * s], S_[8 * s + 1]); pw[1] = cvtpk(S_[8 * s + 2], S_[8 * s + 3]); pw[2] = cvtpk(S_[8 * s + 4], S_[8 * s + 5]); pw[3] = cvtpk(S_[8 * s + 6], S_[8 * s + 7]); \
                const bf16x8v vfr = rt_frag_tr(lds + RT_VOFF, 32 * (c_) + 16 * s + 4 * h, 32 * (c_) + 16 * s + 4 * h + 8, 32 * dt, lane);        \
                O = __builtin_amdgcn_mfma_f32_32x32x16_bf16(vfr, __builtin_bit_cast(bf16x8v, pw), O, 0, 0, 0); } } while (0)
#pragma unroll
        for (int cp = 0; cp < 4; cp += 2) { if (cp <= qg) {
            f32x16 S0, S1;
#pragma unroll
            for (int i = 0; i < 16; ++i) { S0[i] = 0.f; S1[i] = 0.f; }
            if (cp + 1 <= qg) { bf16x8v k0[4], k1[4];
#pragma unroll
                for (int s = 0; s < 4; ++s) { k0[s] = *(const LAS bf16x8v*)(lds + RT_KOFF + (32 * cp + r32) * RT_KS + (8 * h + 16 * s) * 2); k1[s] = *(const LAS bf16x8v*)(lds + RT_KOFF + (32 * (cp + 1) + r32) * RT_KS + (8 * h + 16 * s) * 2); }
#pragma unroll
                for (int s = 0; s < 4; ++s) { S0 = __builtin_amdgcn_mfma_f32_32x32x16_bf16(k0[s], Qf[s], S0, 0, 0, 0); S1 = __builtin_amdgcn_mfma_f32_32x32x16_bf16(k1[s], Qf[s], S1, 0, 0, 0); }
                RT_APPLY(S0, cp); RT_APPLY(S1, cp + 1); }
            else {
#pragma unroll
                for (int s = 0; s < 4; ++s) { const bf16x8v kf = *(const LAS bf16x8v*)(lds + RT_KOFF + (32 * cp + r32) * RT_KS + (8 * h + 16 * s) * 2);
                    S0 = __builtin_amdgcn_mfma_f32_32x32x16_bf16(kf, Qf[s], S0, 0, 0, 0); }
                RT_APPLY(S0, cp); } } }
#undef RT_APPLY
        if (w < 4) { const int et = w >> 1, dtile = w & 1;
#pragma unroll
            for (int s = 0; s < 8; ++s) { const bf16x8v vf = rt_frag_tr(lds + RT_VOFF, 16 * s + 8 * h, 16 * s + 8 * h + 4, 32 * et, lane);
                const bf16x8v kf = rt_frag_tr(lds + RT_KOFF, 16 * s + 8 * h, 16 * s + 8 * h + 4, 32 * dtile, lane);
                Racc = __builtin_amdgcn_mfma_f32_32x32x16_bf16(vf, kf, Racc, 0, 0, 0); }
#pragma unroll
            for (int i = 0; i < 16; ++i) Racc[i] *= g128; }
        const float xi = exp2f((float)(32 * qg + r32 + 1) * lg); float ss = 0.f;
#pragma unroll
        for (int i = 0; i < 16; ++i) { O[i] *= xi; ss += O[i] * O[i]; }
        ss += __shfl_xor(ss, 32);
        LAS float* ssb = (LAS float*)(lds + RT_SOFF);
        if (h == 0) ssb[(qg * 2 + dt) * 32 + r32] = ss;
        LDS_BAR();
        const float rstd = rsqrtf((ss + ssb[(qg * 2 + (dt ^ 1)) * 32 + r32]) * (1.f / 64.f) + 1e-6f);
        if (w < 4) { const int et = w >> 1, dtile = w & 1;
#pragma unroll
            for (int i = 0; i < 16; ++i) { const int e = 32 * et + 8 * (i >> 2) + 4 * h + (i & 3); *(LAS unsigned short*)(lds + RT_ROFF + e * RT_KS + (32 * dtile + r32) * 2) = (unsigned short)f2bf(Racc[i]); } }
#pragma unroll
        for (int q4 = 0; q4 < 4; ++q4) { const int e0 = 32 * dt + 8 * q4 + 4 * h; const v2u gw = *(const LAS v2u*)(lds + RT_GOFF + (32 * qg + r32) * RT_KS + e0 * 2);
            const float g0 = bflo(gw[0]), g1 = bfhi(gw[0]), g2 = bflo(gw[1]), g3 = bfhi(gw[1]);
            v2u o; o[0] = cvtpk(O[4 * q4] * rstd * g0 * __builtin_amdgcn_rcpf(1.0f + __expf(-g0)), O[4 * q4 + 1] * rstd * g1 * __builtin_amdgcn_rcpf(1.0f + __expf(-g1)));
            o[1] = cvtpk(O[4 * q4 + 2] * rstd * g2 * __builtin_amdgcn_rcpf(1.0f + __expf(-g2)), O[4 * q4 + 3] * rstd * g3 * __builtin_amdgcn_rcpf(1.0f + __expf(-g3)));
            *(v2u*)(mixo + qtok * NMIX + 1024 + hh * 64 + e0) = o; }
    }
    __syncthreads();
#undef RT_PREFETCH
}
__device__ __forceinline__ void ret_phase(KP P, LAS unsigned char* lds, int vcu, int G) {
    for (int unit = vcu; unit < BATCH * 8; unit += G) ret_unit(P, lds, unit >> 3, unit & 7);
}

template <int CTRL> __device__ __forceinline__ float dppf(float x) { return __builtin_bit_cast(float, __builtin_amdgcn_mov_dpp(__builtin_bit_cast(int, x), CTRL, 0xf, 0xf, true)); }
constexpr int DPP_X1 = 0xB1, DPP_X2 = 0x4E, DPP_X7 = 0x141, DPP_X8 = 0x128;
__device__ __forceinline__ float sum8(float x) { x += dppf<DPP_X1>(x); x += dppf<DPP_X2>(x); x += dppf<DPP_X7>(x); return x; }
__device__ __forceinline__ float sum16(float x) { x = sum8(x); x += dppf<DPP_X8>(x); return x; }
#define PROBE_SCAN2 0
constexpr int RS_TT = 32;
constexpr int RS_W2T = 0, RS_A2T = 9216, RS_G2T = 18432, RS_XW = 35840, RS_XA = RS_XW + RS_TT * 144, RS_XG = RS_XA + RS_TT * 144, RS_F0 = RS_XG + RS_TT * 272;
constexpr int RS_FA = RS_TT * 64 * 4;
constexpr int RS_ZR = RS_F0, RS_ZK = RS_F0 + RS_FA, RS_ZV = RS_F0 + 2 * RS_FA, RS_WL = RS_F0 + 3 * RS_FA, RS_AL = RS_F0 + 4 * RS_FA, RS_GL = RS_F0 + 5 * RS_FA, RS_AV = RS_F0 + 6 * RS_FA, RS_YS = RS_F0 + 7 * RS_FA, RS_BS = RS_F0 + 8 * RS_FA;
constexpr int RS_MU = RS_BS + RS_TT * 4, RS_CST = RS_MU + 448 * 4;
static_assert(RS_CST + 7 * 256 <= 131072, "rwkv LDS");
constexpr int RS_NP = (RS_TT * 56 + 511) / 512;
typedef float v2f __attribute__((ext_vector_type(2)));
__device__ __forceinline__ void rwkv_unit(KP P, int l, LAS unsigned char* lds, int b, int hh) {
    const int tid = otid(), w = __builtin_amdgcn_readfirstlane(tid >> 6), lane = tid & 63, r32 = lane & 31, h2 = lane >> 5;
    const bf16* proj = (const bf16*)(P->ws + WS_BIG); bf16* mixo = (bf16*)(P->ws + WS_MIXO);
    const float* mu = P->in[I_MU] + l * RWC; const float* w0 = P->in[I_W0] + l * 512 + hh * 64; const float* a0 = P->in[I_A0] + l * 512 + hh * 64;
    const float* kkw = P->in[I_KK] + l * 512 + hh * 64; const float* kaw = P->in[I_KA] + l * 512 + hh * 64; const float* rkw = P->in[I_RK] + l * 512 + hh * 64;
    const float* lng = P->in[I_LNG] + l * 512 + hh * 64; const float* lnb = P->in[I_LNB] + l * 512 + hh * 64;
    __syncthreads();
    for (int i = tid; i < 64 * 64; i += 512) { const int c = i >> 6, j = i & 63;
        *(LAS unsigned short*)(lds + RS_W2T + j * 144 + c * 2) = (unsigned short)f2bf(P->in[I_W2][(size_t)l * 64 * 512 + c * 512 + hh * 64 + j]);
        *(LAS unsigned short*)(lds + RS_A2T + j * 144 + c * 2) = (unsigned short)f2bf(P->in[I_A2][(size_t)l * 64 * 512 + c * 512 + hh * 64 + j]); }
    for (int i = tid; i < 128 * 64; i += 512) { const int c = i >> 6, j = i & 63;
        *(LAS unsigned short*)(lds + RS_G2T + j * 272 + c * 2) = (unsigned short)f2bf(P->in[I_G2][(size_t)l * 128 * 512 + c * 512 + hh * 64 + j]); }
    for (int i = tid; i < 448; i += 512) { const int p = i >> 3, e = i & 7; int col; if (p < 24) col = (p >> 3) * 512 + hh * 64 + (p & 7) * 8; else col = 1536 + (p - 24) * 8; ((LAS float*)(lds + RS_MU))[i] = mu[col + e]; }
    if (tid < 448) { const int a = tid >> 6, j = tid & 63; const float* src = a == 0 ? w0 : a == 1 ? a0 : a == 2 ? kkw : a == 3 ? kaw : a == 4 ? rkw : a == 5 ? lng : lnb; ((LAS float*)(lds + RS_CST))[tid] = src[j]; }
    v2f S2[4];
#pragma unroll
    for (int i = 0; i < 4; ++i) S2[i] = (v2f){0.f, 0.f};
    v4u pc[RS_NP], pp[RS_NP];
#define RS_LOADPIECES(T0) do { _Pragma("unroll") for (int it = 0; it < RS_NP; ++it) { const int idx = tid + it * 512; pc[it] = (v4u){0u, 0u, 0u, 0u}; pp[it] = (v4u){0u, 0u, 0u, 0u}; \
        if (idx < RS_TT * 56) { const int p = idx / RS_TT, tt = idx % RS_TT, t = (T0) + tt; int col; if (p < 24) col = (p >> 3) * 512 + hh * 64 + (p & 7) * 8; else col = 1536 + (p - 24) * 8; \
            const size_t g = (size_t)(b * T + t) * NA + C_RW + col; pc[it] = *(const v4u*)(proj + g); if (t > 0) pp[it] = *(const v4u*)(proj + g - NA); } } } while (0)
    RS_LOADPIECES(0);
#pragma unroll 1
    for (int t0 = 0; t0 < T; t0 += RS_TT) {
        __syncthreads();
#pragma unroll
        for (int it = 0; it < RS_NP; ++it) { const int idx = tid + it * 512; if (idx < RS_TT * 56) { const int p = idx / RS_TT, tt = idx % RS_TT;
            const v4u hc = pc[it], hp = pp[it];
            const v4f m0 = *(const LAS v4f*)(lds + RS_MU + p * 32), m1 = *(const LAS v4f*)(lds + RS_MU + p * 32 + 16);
            float z[8];
#pragma unroll
            for (int e = 0; e < 4; ++e) { const float c0 = bflo(hc[e]), c1 = bfhi(hc[e]), p0 = bflo(hp[e]), p1 = bfhi(hp[e]); const float ma = e < 2 ? m0[2 * e] : m1[2 * e - 4], mb = e < 2 ? m0[2 * e + 1] : m1[2 * e - 3];
                z[2 * e] = c0 + ma * (p0 - c0); z[2 * e + 1] = c1 + mb * (p1 - c1); }
            if (p < 24) { LAS float* dst = (LAS float*)(lds + (p < 8 ? RS_ZR : (p < 16 ? RS_ZK : RS_ZV)) + (tt * 64 + (p & 7) * 8) * 4);
                *(LAS v4f*)dst = (v4f){z[0], z[1], z[2], z[3]}; *(LAS v4f*)(dst + 4) = (v4f){z[4], z[5], z[6], z[7]}; }
            else { v4u o;
                if (p < 32) {
#pragma unroll
                    for (int e = 0; e < 4; ++e) o[e] = cvtpk(1.0f - 2.0f * __builtin_amdgcn_rcpf(1.0f + __expf(2.0f * z[2 * e])), 1.0f - 2.0f * __builtin_amdgcn_rcpf(1.0f + __expf(2.0f * z[2 * e + 1])));
                    *(LAS v4u*)(lds + RS_XW + tt * 144 + (p - 24) * 16) = o; }
                else if (p < 40) {
#pragma unroll
                    for (int e = 0; e < 4; ++e) o[e] = cvtpk(z[2 * e], z[2 * e + 1]);
                    *(LAS v4u*)(lds + RS_XA + tt * 144 + (p - 32) * 16) = o; }
                else {
#pragma unroll
                    for (int e = 0; e < 4; ++e) o[e] = cvtpk(__builtin_amdgcn_rcpf(1.0f + __expf(-z[2 * e])), __builtin_amdgcn_rcpf(1.0f + __expf(-z[2 * e + 1])));
                    *(LAS v4u*)(lds + RS_XG + tt * 272 + (p - 40) * 16) = o; } }
        } }
        __syncthreads();
        if (w < 6) { const int which = w >> 1, jt = w & 1; f32x16 acc;
#pragma unroll
            for (int i = 0; i < 16; ++i) acc[i] = 0.f;
            if (which < 2) { const int wo = which == 0 ? RS_W2T : RS_A2T, xo = which == 0 ? RS_XW : RS_XA;
#pragma unroll
                for (int s = 0; s < 4; ++s) { const bf16x8v af = *(const LAS bf16x8v*)(lds + wo + (32 * jt + r32) * 144 + (16 * s + 8 * h2) * 2), bfr = *(const LAS bf16x8v*)(lds + xo + r32 * 144 + (16 * s + 8 * h2) * 2);
                    acc = __builtin_amdgcn_mfma_f32_32x32x16_bf16(af, bfr, acc, 0, 0, 0); } }
            else {
#pragma unroll
                for (int s = 0; s < 8; ++s) { const bf16x8v af = *(const LAS bf16x8v*)(lds + RS_G2T + (32 * jt + r32) * 272 + (16 * s + 8 * h2) * 2), bfr = *(const LAS bf16x8v*)(lds + RS_XG + r32 * 272 + (16 * s + 8 * h2) * 2);
                    acc = __builtin_amdgcn_mfma_f32_32x32x16_bf16(af, bfr, acc, 0, 0, 0); } }
            const int oo = which == 0 ? RS_WL : (which == 1 ? RS_AL : RS_GL);
#pragma unroll
            for (int q4 = 0; q4 < 4; ++q4) *(LAS v4f*)(lds + oo + (r32 * 64 + 32 * jt + 8 * q4 + 4 * h2) * 4) = (v4f){acc[4 * q4], acc[4 * q4 + 1], acc[4 * q4 + 2], acc[4 * q4 + 3]}; }
        __syncthreads();
        { const int tt = tid >> 4, j0 = (tid & 15) * 4; const int o4 = (tt * 64 + j0) * 4;
          const v4f wl = *(const LAS v4f*)(lds + RS_WL + o4), al = *(const LAS v4f*)(lds + RS_AL + o4), zk = *(const LAS v4f*)(lds + RS_ZK + o4), zr = *(const LAS v4f*)(lds + RS_ZR + o4);
          const v4f w0v = *(const LAS v4f*)(lds + RS_CST + j0 * 4), a0v = *(const LAS v4f*)(lds + RS_CST + 256 + j0 * 4), kkv = *(const LAS v4f*)(lds + RS_CST + 512 + j0 * 4), kav = *(const LAS v4f*)(lds + RS_CST + 768 + j0 * 4), rkv = *(const LAS v4f*)(lds + RS_CST + 1024 + j0 * 4);
          v4f dcy, alp, kk0, km; float ssq = 0.f, bsum = 0.f;
#pragma unroll
          for (int e = 0; e < 4; ++e) { const float x = -(wl[e] + w0v[e]); const float sp = fmaxf(x, 0.f) + __logf(1.0f + __expf(-fabsf(x)));
              dcy[e] = __expf(-__expf(-sp - 0.5f)); alp[e] = __builtin_amdgcn_rcpf(1.0f + __expf(-(al[e] + a0v[e])));
              kk0[e] = zk[e] * kkv[e]; ssq += kk0[e] * kk0[e]; km[e] = zk[e] * (1.0f + (alp[e] - 1.0f) * kav[e]); bsum += zr[e] * km[e] * rkv[e]; }
          ssq = sum16(ssq); bsum = sum16(bsum);
          const float inv = __builtin_amdgcn_rcpf(fmaxf(__builtin_amdgcn_sqrtf(ssq), 1e-12f));
          v4f avv, bvv;
#pragma unroll
          for (int e = 0; e < 4; ++e) { const float kk = kk0[e] * inv; avv[e] = -kk; bvv[e] = kk * alp[e]; }
          *(LAS v4f*)(lds + RS_WL + o4) = dcy; *(LAS v4f*)(lds + RS_AL + o4) = bvv; *(LAS v4f*)(lds + RS_AV + o4) = avv; *(LAS v4f*)(lds + RS_ZK + o4) = km;
          if ((tid & 15) == 0) *(LAS float*)(lds + RS_BS + tt * 4) = bsum; }
        __syncthreads();
        if (t0 + RS_TT < T) RS_LOADPIECES(t0 + RS_TT);
#if PROBE_SCAN2
        v2f Ssave[4];
#pragma unroll
        for (int i = 0; i < 4; ++i) Ssave[i] = S2[i];
        for (int rep_ = 0; rep_ < 2; ++rep_) { if (rep_ == 1) {
#pragma unroll
            for (int i = 0; i < 4; ++i) S2[i] = Ssave[i]; }
#endif
        { const int v_ = tid >> 3, ks = tid & 7; LAS unsigned char* sb = lds + ks * 32; LAS unsigned char* vb = lds + RS_ZV + v_ * 4; LAS unsigned char* yb = lds + RS_YS + v_ * 4;
#pragma unroll
          for (int tt = 0; tt < RS_TT; ++tt) { const int o8 = tt * 256;
              const v4f a0_ = *(const LAS v4f*)(sb + RS_AV + o8), a1_ = *(const LAS v4f*)(sb + RS_AV + o8 + 16);
              const v4f d0_ = *(const LAS v4f*)(sb + RS_WL + o8), d1_ = *(const LAS v4f*)(sb + RS_WL + o8 + 16);
              const v4f b0_ = *(const LAS v4f*)(sb + RS_AL + o8), b1_ = *(const LAS v4f*)(sb + RS_AL + o8 + 16);
              const v4f k0_ = *(const LAS v4f*)(sb + RS_ZK + o8), k1_ = *(const LAS v4f*)(sb + RS_ZK + o8 + 16);
              const v4f r0_ = *(const LAS v4f*)(sb + RS_ZR + o8), r1_ = *(const LAS v4f*)(sb + RS_ZR + o8 + 16);
              const float vv = *(const LAS float*)(vb + o8);
              v2f ac = S2[0] * a0_.xy; ac = __builtin_elementwise_fma(S2[1], a0_.zw, ac); ac = __builtin_elementwise_fma(S2[2], a1_.xy, ac); ac = __builtin_elementwise_fma(S2[3], a1_.zw, ac);
              const float sa = sum8(ac.x + ac.y); const v2f sa2 = (v2f){sa, sa}, vv2 = (v2f){vv, vv};
              S2[0] = __builtin_elementwise_fma(S2[0], d0_.xy, __builtin_elementwise_fma(k0_.xy, vv2, b0_.xy * sa2));
              S2[1] = __builtin_elementwise_fma(S2[1], d0_.zw, __builtin_elementwise_fma(k0_.zw, vv2, b0_.zw * sa2));
              S2[2] = __builtin_elementwise_fma(S2[2], d1_.xy, __builtin_elementwise_fma(k1_.xy, vv2, b1_.xy * sa2));
              S2[3] = __builtin_elementwise_fma(S2[3], d1_.zw, __builtin_elementwise_fma(k1_.zw, vv2, b1_.zw * sa2));
              v2f yc = S2[0] * r0_.xy; yc = __builtin_elementwise_fma(S2[1], r0_.zw, yc); yc = __builtin_elementwise_fma(S2[2], r1_.xy, yc); yc = __builtin_elementwise_fma(S2[3], r1_.zw, yc);
              const float y = sum8(yc.x + yc.y);
              if (ks == 0) *(LAS float*)(yb + o8) = y; } }
#if PROBE_SCAN2
        }
#endif
        __syncthreads();
        { const int tt = tid >> 4, v0 = (tid & 15) * 4; const int o4 = (tt * 64 + v0) * 4;
          const v4f y4 = *(const LAS v4f*)(lds + RS_YS + o4), zv = *(const LAS v4f*)(lds + RS_ZV + o4), gl = *(const LAS v4f*)(lds + RS_GL + o4);
          const float mean = sum16((y4[0] + y4[1]) + (y4[2] + y4[3])) * (1.f / 64.f);
          const v4f d = y4 - mean; const float var = sum16((d[0] * d[0] + d[1] * d[1]) + (d[2] * d[2] + d[3] * d[3])) * (1.f / 64.f);
          const float rstd = rsqrtf(var + 64e-5f), bs = *(const LAS float*)(lds + RS_BS + tt * 4);
          const v4f lg4 = *(const LAS v4f*)(lds + RS_CST + 1280 + v0 * 4), lb4 = *(const LAS v4f*)(lds + RS_CST + 1536 + v0 * 4);
          float o[4];
#pragma unroll
          for (int e = 0; e < 4; ++e) o[e] = (d[e] * rstd * lg4[e] + lb4[e] + bs * zv[e]) * gl[e];
          v2u ow; ow[0] = cvtpk(o[0], o[1]); ow[1] = cvtpk(o[2], o[3]);
          *(v2u*)(mixo + (size_t)(b * T + t0 + tt) * NMIX + 512 + hh * 64 + v0) = ow; }
    }
    __syncthreads();
#undef RS_LOADPIECES
}
__device__ __forceinline__ void rwkv_phase(KP P, int l, LAS unsigned char* lds, int vcu, int G) {
    for (int unit = vcu; unit < BATCH * 8; unit += G) rwkv_unit(P, l, lds, unit >> 3, unit & 7);
}

#define RC_STATIC_PRIO 1
#define RC_BAR() do { asm volatile("s_waitcnt lgkmcnt(0)" ::: "memory"); __builtin_amdgcn_s_barrier(); asm volatile("" ::: "memory"); } while (0)
constexpr int RC_SL = 9216;
constexpr int RC_A = 0 * RC_SL, RC_B = 1 * RC_SL, RC_K = 2 * RC_SL, RC_R = 3 * RC_SL, RC_V = 4 * RC_SL, RC_G = 5 * RC_SL, RC_S = 6 * RC_SL;
constexpr int RC_XW = 7 * RC_SL, RC_XA = 8 * RC_SL, RC_XG = 9 * RC_SL, RC_WL = 11 * RC_SL, RC_AL = 13 * RC_SL, RC_LW = 14 * RC_SL;
constexpr int RC_DINV = RC_B, RC_DINVT = RC_K, RC_NT = 9 * RC_SL, RC_P = RC_B, RC_UT = 9 * RC_SL, RC_BHT = RC_XW, RC_KHT = RC_XA, RC_VT = 9 * RC_SL, RC_LAB = 10 * RC_SL, RC_N = RC_LAB, RC_TINV = RC_LAB;
constexpr int RC_LABT = 11 * RC_SL, RC_N2 = RC_LABT, RC_RHST = RC_LABT, RC_LAK = 12 * RC_SL, RC_MRB = 13 * RC_SL, RC_MRK = RC_LW;
constexpr int RC_SM = RC_LW + 16384, RC_BS = RC_SM, RC_GC = RC_SM + 256, RC_PT = RC_SM + 512, RC_SSB = RC_PT + 2048, RC_DIAG = RC_SSB + 1024, RC_MU = RC_DIAG + 4096, RC_CST = RC_MU + 1792, RC_END = RC_CST + 1792, RC_MK = RC_MU + 768;
static_assert(RC_END <= 156928, "chunked rwkv LDS");
typedef float f32x4v_ __attribute__((ext_vector_type(4)));
template <int KSTEPS, int SA = 144, int SB = 144> __device__ __forceinline__ f32x16 rc_mm(f32x16 acc, const LAS unsigned char* A, int arow0, const LAS unsigned char* B, int brow0, int r32, int h, int kofs = 0) {
#pragma unroll
    for (int s = 0; s < KSTEPS; ++s) { const bf16x8v af = *(const LAS bf16x8v*)(A + (arow0 + r32) * SA + (kofs + 16 * s + 8 * h) * 2), bfr = *(const LAS bf16x8v*)(B + (brow0 + r32) * SB + (kofs + 16 * s + 8 * h) * 2);
        acc = __builtin_amdgcn_mfma_f32_32x32x16_bf16(af, bfr, acc, 0, 0, 0); }
    return acc;
}
__device__ __forceinline__ f32x16 rc_zero() { f32x16 z;
#pragma unroll
    for (int i = 0; i < 16; ++i) z[i] = 0.f;
    return z; }
template <int KSTEPS> __device__ __forceinline__ f32x16 rc_mm2(f32x16 acc, const LAS unsigned char* A, int arow0, const LAS unsigned char* B, int brow0, int r32, int h) {
    f32x16 a1 = rc_zero(); bf16x8v af[KSTEPS], bfr[KSTEPS];
#pragma unroll
    for (int s = 0; s < KSTEPS; ++s) { af[s] = *(const LAS bf16x8v*)(A + (arow0 + r32) * 144 + (16 * s + 8 * h) * 2); bfr[s] = *(const LAS bf16x8v*)(B + (brow0 + r32) * 144 + (16 * s + 8 * h) * 2); }
    asm volatile("s_waitcnt lgkmcnt(0)" ::: "memory"); __builtin_amdgcn_sched_barrier(0);
#pragma unroll
    for (int s = 0; s < KSTEPS; ++s) { if (s & 1) a1 = __builtin_amdgcn_mfma_f32_32x32x16_bf16(af[s], bfr[s], a1, 0, 0, 0); else acc = __builtin_amdgcn_mfma_f32_32x32x16_bf16(af[s], bfr[s], acc, 0, 0, 0); }
#pragma unroll
    for (int i = 0; i < 16; ++i) acc[i] += a1[i];
    return acc;
}
typedef short s16x4_ __attribute__((ext_vector_type(4)));
__device__ __forceinline__ bf16x8v rc_frag_tr32(const LAS unsigned char* M, int k0, int c0, int lane) {
    const int g = lane >> 4, i = lane & 15; const LAS unsigned char* p = M + (k0 + 8 * (g >> 1) + (i >> 2)) * 144 + (c0 + 16 * (g & 1) + 4 * (i & 3)) * 2;
    const s16x4_ a = __builtin_amdgcn_ds_read_tr16_b64_v4i16((LAS s16x4_*)p), b = __builtin_amdgcn_ds_read_tr16_b64_v4i16((LAS s16x4_*)(p + 4 * 144));
    return __builtin_shufflevector(a, b, 0, 1, 2, 3, 4, 5, 6, 7); }
__device__ __forceinline__ bf16x8v rc_frag_tr16(const LAS unsigned char* M, int k0, int c0, int lane) {
    const int q = lane >> 4, i = lane & 15; const LAS unsigned char* p = M + (k0 + 8 * q + (i >> 2)) * 144 + (c0 + 4 * (i & 3)) * 2;
    const s16x4_ a = __builtin_amdgcn_ds_read_tr16_b64_v4i16((LAS s16x4_*)p), b = __builtin_amdgcn_ds_read_tr16_b64_v4i16((LAS s16x4_*)(p + 4 * 144));
    return __builtin_shufflevector(a, b, 0, 1, 2, 3, 4, 5, 6, 7); }
template <bool TA, bool TB> __device__ __forceinline__ f32x16 rc_mm2t(f32x16 acc, const LAS unsigned char* A, int a0, const LAS unsigned char* B, int b0, int r32, int h, int lane) {
    f32x16 a1 = rc_zero(); bf16x8v af[4], bfr[4];
#pragma unroll
    for (int s = 0; s < 4; ++s) { af[s] = TA ? rc_frag_tr32(A, 16 * s, a0, lane) : *(const LAS bf16x8v*)(A + (a0 + r32) * 144 + (16 * s + 8 * h) * 2);
                                  bfr[s] = TB ? rc_frag_tr32(B, 16 * s, b0, lane) : *(const LAS bf16x8v*)(B + (b0 + r32) * 144 + (16 * s + 8 * h) * 2); }
    asm volatile("s_waitcnt lgkmcnt(0)" ::: "memory"); __builtin_amdgcn_sched_barrier(0);
#pragma unroll
    for (int s = 0; s < 4; ++s) { if (s & 1) a1 = __builtin_amdgcn_mfma_f32_32x32x16_bf16(af[s], bfr[s], a1, 0, 0, 0); else acc = __builtin_amdgcn_mfma_f32_32x32x16_bf16(af[s], bfr[s], acc, 0, 0, 0); }
#pragma unroll
    for (int i = 0; i < 16; ++i) acc[i] += a1[i];
    return acc;
}
__device__ __forceinline__ bf16x8v rc_frag_bd(const LAS unsigned char* cb, int row, int s, int h) {
    v4u z = (v4u){0u, 0u, 0u, 0u}; if ((row >> 4) == s) z = *(const LAS v4u*)(cb + (row >> 4) * 1024 + ((row & 15) * 16 + 8 * h) * 2); return __builtin_bit_cast(bf16x8v, z); }
template <bool BD_A> __device__ __forceinline__ f32x16 rc_mm_bd(f32x16 acc, const LAS unsigned char* A, int arow0, const LAS unsigned char* B, int brow0, int r32, int h) {
    f32x16 a1 = rc_zero();
#pragma unroll
    for (int s = 0; s < 4; ++s) { const bf16x8v af = BD_A ? rc_frag_bd(A, arow0 + r32, s, h) : *(const LAS bf16x8v*)(A + (arow0 + r32) * 144 + (16 * s + 8 * h) * 2);
        const bf16x8v bfr = BD_A ? *(const LAS bf16x8v*)(B + (brow0 + r32) * 144 + (16 * s + 8 * h) * 2) : rc_frag_bd(B, brow0 + r32, s, h);
        if (s & 1) a1 = __builtin_amdgcn_mfma_f32_32x32x16_bf16(af, bfr, a1, 0, 0, 0); else acc = __builtin_amdgcn_mfma_f32_32x32x16_bf16(af, bfr, acc, 0, 0, 0); }
#pragma unroll
    for (int i = 0; i < 16; ++i) acc[i] += a1[i];
    return acc;
}
__device__ __forceinline__ void rc_store_t(const f32x16& d, LAS unsigned char* O, int arow0, int brow0, int r32, int h) {
#pragma unroll
    for (int q4 = 0; q4 < 4; ++q4) { v2u o; o[0] = cvtpk(d[4 * q4], d[4 * q4 + 1]); o[1] = cvtpk(d[4 * q4 + 2], d[4 * q4 + 3]); *(LAS v2u*)(O + (brow0 + r32) * 144 + (arow0 + 8 * q4 + 4 * h) * 2) = o; }
}
__device__ __forceinline__ void rwkv_prepass(KP P, int l, int b, int j, int rows) {
    const int tid = otid(), p = tid & 31;
    const bf16* proj = (const bf16*)(P->ws + WS_BIG); bf16* zs = (bf16*)((unsigned char*)P->out + OUT_ZS);
    const v4f* mup = (const v4f*)(P->in[I_MU] + l * RWC + 1536 + 8 * p); const v4f m0 = mup[0], m1 = mup[1];
    const float be = p < 8 ? -2.f : -1.f, al = p < 8 ? 2.f : 1.f, ga = p < 8 ? -1.f : 0.f; const bool plain = (p >= 8 && p < 16);
#pragma unroll 4
    for (int r = tid >> 5; r < rows; r += 16) { const int t = j * rows + r; const size_t g = (size_t)(b * T + t) * NA + C_RW + 1536 + 8 * p;
        const v4u hc = *(const v4u*)(proj + g); v4u hp = (v4u){0u, 0u, 0u, 0u}; if (t > 0) hp = *(const v4u*)(proj + g - NA);
        v4u o;
#pragma unroll
        for (int e = 0; e < 4; ++e) { const float c0 = bflo(hc[e]), c1 = bfhi(hc[e]), p0 = bflo(hp[e]), p1 = bfhi(hp[e]); const float ma = e < 2 ? m0[2 * e] : m1[2 * e - 4], mb = e < 2 ? m0[2 * e + 1] : m1[2 * e - 3];
            const float z0 = c0 + ma * (p0 - c0), z1 = c1 + mb * (p1 - c1);
            const float s0 = al * __builtin_amdgcn_rcpf(1.0f + __expf(be * z0)) + ga, s1 = al * __builtin_amdgcn_rcpf(1.0f + __expf(be * z1)) + ga;
            o[e] = cvtpk(plain ? z0 : s0, plain ? z1 : s1); }
        *(v4u*)(zs + (size_t)(b * T + t) * 256 + 8 * p) = o; }
}
__device__ __forceinline__ void rwkvc_unit(KP P, int l, LAS unsigned char* lds, int b, int hh) {
    const int tid = otid(), w = __builtin_amdgcn_readfirstlane(tid >> 6), lane = tid & 63, r32 = lane & 31, h = lane >> 5;
    const bf16* proj = (const bf16*)(P->ws + WS_BIG); bf16* mixo = (bf16*)(P->ws + WS_MIXO);
    const float* mu = P->in[I_MU] + l * RWC; const float* w0 = P->in[I_W0] + l * 512 + hh * 64; const float* a0 = P->in[I_A0] + l * 512 + hh * 64;
    const float* kkw = P->in[I_KK] + l * 512 + hh * 64; const float* kaw = P->in[I_KA] + l * 512 + hh * 64; const float* rkw = P->in[I_RK] + l * 512 + hh * 64;
    const float* lng = P->in[I_LNG] + l * 512 + hh * 64; const float* lnb = P->in[I_LNB] + l * 512 + hh * 64;
    __syncthreads();
    if (tid < 192) { const int p = tid >> 3, e = tid & 7; ((LAS float*)(lds + RC_MU))[tid] = mu[(p >> 3) * 512 + hh * 64 + (p & 7) * 8 + e]; }
    if (tid < 448) { const int a = tid >> 6, j = tid & 63; const float* src = a == 0 ? w0 : a == 1 ? a0 : a == 2 ? kkw : a == 3 ? kaw : a == 4 ? rkw : a == 5 ? lng : lnb; ((LAS float*)(lds + RC_CST))[tid] = src[j]; }
    bf16x8v wf[8];
    { const int jt = w & 1, j = hh * 64 + 32 * jt + r32;
#pragma unroll
      for (int s = 0; s < 8; ++s) { unsigned short e[8];
#pragma unroll
          for (int i = 0; i < 8; ++i) { float x; if (w < 4) { const int c = 16 * (s & 3) + 8 * h + i; x = (s < 4 ? P->in[I_W2] : P->in[I_A2])[(size_t)l * 64 * 512 + c * 512 + j]; } else { const int c = 16 * s + 8 * h + i; x = P->in[I_G2][(size_t)l * 128 * 512 + c * 512 + j]; }
              e[i] = (unsigned short)f2bf(x); }
          v4u pk; pk[0] = e[0] | ((unsigned)e[1] << 16); pk[1] = e[2] | ((unsigned)e[3] << 16); pk[2] = e[4] | ((unsigned)e[5] << 16); pk[3] = e[6] | ((unsigned)e[7] << 16);
          wf[s] = __builtin_bit_cast(bf16x8v, pk); } }
    if (tid < 64) { unsigned mkAB = 0u, mkC = 0u;
#pragma unroll
        for (int i = 0; i < 16; ++i) { const int m = 8 * (i >> 2) + 4 * h + (i & 3), n = r32;
            mkAB |= (((m < n) && ((n >> 4) != (m >> 4))) ? 1u : 0u) << i; mkAB |= ((m < n) ? 1u : 0u) << (16 + i); mkC |= ((m <= n) ? 1u : 0u) << i; }
        v2u mv; mv[0] = mkAB; mv[1] = mkC; *(LAS v2u*)(lds + RC_MK + tid * 8) = mv; }
    f32x16 Sacc = rc_zero();
    v4u pc[3], pp[3], zc[4];
    const bf16* zs = (const bf16*)((const unsigned char*)P->out + OUT_ZS);
#define RC_LOADPIECES(T0) do { const int tt_ = 8 * (tid >> 6) + ((tid & 63) >> 3), t_ = (T0) + tt_;        \
        const bf16* pb_ = proj + (size_t)(b * T + t_) * NA + C_RW + hh * 64 + (tid & 7) * 8; const bf16* zb_ = zs + (size_t)(b * T + t_) * 256 + (tid & 7) * 8; \
        _Pragma("unroll") for (int g_ = 0; g_ < 3; ++g_) { pc[g_] = *(const v4u*)(pb_ + g_ * 512); pp[g_] = (v4u){0u, 0u, 0u, 0u}; if (t_ > 0) pp[g_] = *(const v4u*)(pb_ + g_ * 512 - NA); } \
        _Pragma("unroll") for (int it = 0; it < 4; ++it) zc[it] = *(const v4u*)(zb_ + it * 64); } while (0)
    RC_LOADPIECES(0);
    if (RC_STATIC_PRIO && w >= 4) __builtin_amdgcn_s_setprio(1);
#pragma unroll 1
    for (int t0 = 0; t0 < T; t0 += 64) {
        f32x16 xacc, yacc;
        RC_BAR();
        { const int tid = otid(), w = __builtin_amdgcn_readfirstlane(tid >> 6), lane = tid & 63, r32 = lane & 31, h = lane >> 5; (void)w; (void)lane; (void)r32; (void)h;
        if (w < 4) rc_store_t(Sacc, lds + RC_S, 32 * (w >> 1), 32 * (w & 1), r32, h);
        { const int tt = 8 * (tid >> 6) + ((tid & 63) >> 3), pl = tid & 7;
#pragma unroll
        for (int g = 0; g < 3; ++g) { const int p = 8 * g + pl;
            const v4u hc = pc[g], hp = pp[g];
            const v4f m0 = *(const LAS v4f*)(lds + RC_MU + p * 32), m1 = *(const LAS v4f*)(lds + RC_MU + p * 32 + 16);
            v4u o;
#pragma unroll
            for (int e = 0; e < 4; ++e) { const float c0 = bflo(hc[e]), c1 = bfhi(hc[e]), p0 = bflo(hp[e]), p1 = bfhi(hp[e]); const float ma = e < 2 ? m0[2 * e] : m1[2 * e - 4], mb = e < 2 ? m0[2 * e + 1] : m1[2 * e - 3];
                o[e] = cvtpk(c0 + ma * (p0 - c0), c1 + mb * (p1 - c1)); }
            *(LAS v4u*)(lds + (g == 0 ? RC_R : (g == 1 ? RC_K : RC_V)) + tt * 144 + pl * 16) = o; }
#pragma unroll
        for (int it = 0; it < 4; ++it) { const int dst = it == 0 ? RC_XW + tt * 144 + pl * 16 : (it == 1 ? RC_XA + tt * 144 + pl * 16 : RC_XG + tt * 272 + ((it - 2) * 8 + pl) * 16);
            *(LAS v4u*)(lds + dst) = zc[it]; } }
        }
        RC_BAR();
        { const int tid = otid(), w = __builtin_amdgcn_readfirstlane(tid >> 6), lane = tid & 63, r32 = lane & 31, h = lane >> 5; (void)w; (void)lane; (void)r32; (void)h;
        { const int tt = (w >> 1) & 1, jt = w & 1;
          if (w < 4) { f32x16 aw = rc_zero(), aa = rc_zero();
#pragma unroll
              for (int s = 0; s < 4; ++s) { const bf16x8v xw = *(const LAS bf16x8v*)(lds + RC_XW + (32 * tt + r32) * 144 + (16 * s + 8 * h) * 2), xa = *(const LAS bf16x8v*)(lds + RC_XA + (32 * tt + r32) * 144 + (16 * s + 8 * h) * 2);
                  aw = __builtin_amdgcn_mfma_f32_32x32x16_bf16(wf[s], xw, aw, 0, 0, 0); aa = __builtin_amdgcn_mfma_f32_32x32x16_bf16(wf[4 + s], xa, aa, 0, 0, 0); }
#pragma unroll
              for (int q4 = 0; q4 < 4; ++q4) *(LAS v4f*)(lds + RC_WL + ((32 * tt + r32) * 64 + 32 * jt + 8 * q4 + 4 * h) * 4) = (v4f){aw[4 * q4], aw[4 * q4 + 1], aw[4 * q4 + 2], aw[4 * q4 + 3]};
              rc_store_t(aa, lds + RC_AL, 32 * jt, 32 * tt, r32, h); }
          else { f32x16 ag = rc_zero();
#pragma unroll
              for (int s = 0; s < 8; ++s) { const bf16x8v xg = *(const LAS bf16x8v*)(lds + RC_XG + (32 * tt + r32) * 272 + (16 * s + 8 * h) * 2); ag = __builtin_amdgcn_mfma_f32_32x32x16_bf16(wf[s], xg, ag, 0, 0, 0); }
              rc_store_t(ag, lds + RC_G, 32 * jt, 32 * tt, r32, h); } }
        }
        RC_BAR();
        { const int tid = otid(), w = __builtin_amdgcn_readfirstlane(tid >> 6), lane = tid & 63, r32 = lane & 31, h = lane >> 5; (void)w; (void)lane; (void)r32; (void)h;
        { const int t = tid >> 3, j0 = (tid & 7) * 8; const int ob = t * 144 + j0 * 2;
          const v4f wl0 = *(const LAS v4f*)(lds + RC_WL + (t * 64 + j0) * 4), wl1 = *(const LAS v4f*)(lds + RC_WL + (t * 64 + j0 + 4) * 4);
          const v4u alw = *(const LAS v4u*)(lds + RC_AL + ob), kw = *(const LAS v4u*)(lds + RC_K + ob), rw = *(const LAS v4u*)(lds + RC_R + ob);
          float lw[8], alp[8], kk0[8], km[8]; float ssq = 0.f, bsum = 0.f;
          v4f cst[5][2];
#pragma unroll
          for (int a = 0; a < 5; ++a) { cst[a][0] = *(const LAS v4f*)(lds + RC_CST + a * 256 + j0 * 4); cst[a][1] = *(const LAS v4f*)(lds + RC_CST + a * 256 + j0 * 4 + 16); }
#pragma unroll
          for (int e = 0; e < 8; ++e) { const float wl = e < 4 ? wl0[e & 3] : wl1[e & 3]; const float cw0 = cst[0][e >> 2][e & 3], ca0 = cst[1][e >> 2][e & 3];
              const float ckk = cst[2][e >> 2][e & 3], cka = cst[3][e >> 2][e & 3], crk = cst[4][e >> 2][e & 3];
              const float al = (e & 1) ? bfhi(alw[e >> 1]) : bflo(alw[e >> 1]), kr = (e & 1) ? bfhi(kw[e >> 1]) : bflo(kw[e >> 1]), rr = (e & 1) ? bfhi(rw[e >> 1]) : bflo(rw[e >> 1]);
              lw[e] = -0.60653066f * __builtin_amdgcn_rcpf(1.0f + __expf(-(wl + cw0)));
              alp[e] = __builtin_amdgcn_rcpf(1.0f + __expf(-(al + ca0)));
              kk0[e] = kr * ckk; ssq += kk0[e] * kk0[e]; km[e] = kr * (1.0f + (alp[e] - 1.0f) * cka); bsum += rr * km[e] * crk; }
          ssq = sum8(ssq); bsum = sum8(bsum);
          const float inv = __builtin_amdgcn_rcpf(fmaxf(__builtin_amdgcn_sqrtf(ssq), 1e-12f));
          v4u ao, bo, ko;
#pragma unroll
          for (int e = 0; e < 4; ++e) { const float ka = kk0[2 * e] * inv, kb = kk0[2 * e + 1] * inv; ao[e] = cvtpk(-ka, -kb); bo[e] = cvtpk(ka * alp[2 * e], kb * alp[2 * e + 1]); ko[e] = cvtpk(km[2 * e], km[2 * e + 1]); }
          *(LAS v4u*)(lds + RC_A + ob) = ao; *(LAS v4u*)(lds + RC_B + ob) = bo; *(LAS v4u*)(lds + RC_K + ob) = ko;
          *(LAS v4f*)(lds + RC_LW + (t * 64 + j0) * 4) = (v4f){lw[0], lw[1], lw[2], lw[3]}; *(LAS v4f*)(lds + RC_LW + (t * 64 + j0 + 4) * 4) = (v4f){lw[4], lw[5], lw[6], lw[7]};
          if ((tid & 7) == 0) *(LAS float*)(lds + RC_BS + t * 4) = bsum; }
        }
        RC_BAR();
        { const int tid = otid(), w = __builtin_amdgcn_readfirstlane(tid >> 6), lane = tid & 63, r32 = lane & 31, h = lane >> 5; (void)w; (void)lane; (void)r32; (void)h;
        { const int k = tid & 63, tq = tid >> 6; float c[8]; float run = 0.f;
#pragma unroll
          for (int i = 0; i < 8; ++i) { run += *(const LAS float*)(lds + RC_LW + ((8 * tq + i) * 64 + k) * 4); c[i] = run; }
          *(LAS float*)(lds + RC_PT + (tq * 64 + k) * 4) = run;
          RC_BAR();
          float base = 0.f;
#pragma unroll
          for (int q = 0; q < 7; ++q) { const float pv = *(const LAS float*)(lds + RC_PT + (q * 64 + k) * 4); base += (q < tq) ? pv : 0.f; }
#pragma unroll
          for (int i = 0; i < 8; ++i) *(LAS float*)(lds + RC_LW + ((8 * tq + i) * 64 + k) * 4) = c[i] + base;
          if (tq == 7) *(LAS float*)(lds + RC_GC + k * 4) = __expf(c[7] + base); }
        }
        RC_BAR();
        { const int tid = otid(), w = __builtin_amdgcn_readfirstlane(tid >> 6), lane = tid & 63, r32 = lane & 31, h = lane >> 5; (void)w; (void)lane; (void)r32; (void)h;
        { const int t = tid >> 3, j0 = (tid & 7) * 8; const int ob = t * 144 + j0 * 2;
          const v4f c0 = *(const LAS v4f*)(lds + RC_LW + (t * 64 + j0) * 4), c1 = *(const LAS v4f*)(lds + RC_LW + (t * 64 + j0 + 4) * 4);
          v4f p0 = (v4f){0.f, 0.f, 0.f, 0.f}, p1 = p0; if (t > 0) { p0 = *(const LAS v4f*)(lds + RC_LW + ((t - 1) * 64 + j0) * 4); p1 = *(const LAS v4f*)(lds + RC_LW + ((t - 1) * 64 + j0 + 4) * 4); }
          const v4u aw = *(const LAS v4u*)(lds + RC_A + ob), bw = *(const LAS v4u*)(lds + RC_B + ob), kw = *(const LAS v4u*)(lds + RC_K + ob), rw = *(const LAS v4u*)(lds + RC_R + ob);
          v4u ao, bo, ko, ro;
#pragma unroll
          for (int e = 0; e < 4; ++e) { const float cA = e < 2 ? c0[2 * e] : c1[2 * e - 4], cB = e < 2 ? c0[2 * e + 1] : c1[2 * e - 3], pA = e < 2 ? p0[2 * e] : p1[2 * e - 4], pB = e < 2 ? p0[2 * e + 1] : p1[2 * e - 3];
              const float e1a = __expf(cA), e1b = __expf(cB), e0a = __expf(pA), e0b = __expf(pB), eia = __builtin_amdgcn_rcpf(e1a), eib = __builtin_amdgcn_rcpf(e1b);
              ao[e] = cvtpk(bflo(aw[e]) * e0a, bfhi(aw[e]) * e0b); ro[e] = cvtpk(bflo(rw[e]) * e1a, bfhi(rw[e]) * e1b);
              bo[e] = cvtpk(bflo(bw[e]) * eia, bfhi(bw[e]) * eib); ko[e] = cvtpk(bflo(kw[e]) * eia, bfhi(kw[e]) * eib); }
          *(LAS v4u*)(lds + RC_A + ob) = ao; *(LAS v4u*)(lds + RC_B + ob) = bo; *(LAS v4u*)(lds + RC_K + ob) = ko; *(LAS v4u*)(lds + RC_R + ob) = ro; }
        }
        RC_BAR();
        { const int tid = otid(), w = __builtin_amdgcn_readfirstlane(tid >> 6), lane = tid & 63, r32 = lane & 31, h = lane >> 5; (void)w; (void)lane; (void)r32; (void)h;
        if (w == 0 || w == 3) { const int tq = w == 0 ? 0 : 1; f32x16 d = rc_zero(); d = rc_mm2<4>(d, lds + RC_B, 32 * tq, lds + RC_A, 32 * tq, r32, h);
            const int n = 32 * tq + r32;
#pragma unroll
            for (int i = 0; i < 16; ++i) { const int m = 32 * tq + 8 * (i >> 2) + 4 * h + (i & 3); if ((m >> 4) == (n >> 4)) *(LAS float*)(lds + RC_DIAG + ((n >> 4) * 256 + (m & 15) * 16 + (n & 15)) * 4) = (m < n) ? d[i] : 0.f; }
            asm volatile("s_waitcnt lgkmcnt(0)" ::: "memory");
            if (lane < 32) { const int blk = 2 * tq + (lane >> 4), c = lane & 15; float x[16];
#pragma unroll
                for (int t = 0; t < 16; ++t) x[t] = (t == c) ? 1.f : 0.f;
#pragma unroll
                for (int j = 0; j < 15; ++j) {
#pragma unroll
                    for (int q = (j + 1) >> 2; q < 4; ++q) { const v4f l4 = *(const LAS v4f*)(lds + RC_DIAG + (blk * 256 + j * 16 + 4 * q) * 4);
#pragma unroll
                        for (int e = 0; e < 4; ++e) { const int t = 4 * q + e; if (t > j) x[t] += l4[e] * x[j]; } } }
                asm volatile("s_waitcnt lgkmcnt(0)" ::: "memory");
                LAS unsigned char* cb = lds + RC_DIAG + blk * 1024;
#pragma unroll
                for (int t = 0; t < 16; ++t) *(LAS unsigned short*)(cb + (t * 16 + c) * 2) = (unsigned short)f2bf(x[t]);
                v4u o0, o1;
#pragma unroll
                for (int e = 0; e < 4; ++e) { o0[e] = cvtpk(x[2 * e], x[2 * e + 1]); o1[e] = cvtpk(x[8 + 2 * e], x[9 + 2 * e]); }
                *(LAS v4u*)(cb + 512 + c * 32) = o0; *(LAS v4u*)(cb + 512 + c * 32 + 16) = o1; } }
        else { const int slot = w < 3 ? w - 1 : w - 2;
#pragma unroll 1
            for (int kq = 0; kq < 3; ++kq) { const int q = (slot == 4 && kq == 2) ? 15 : slot + 6 * kq; if (q >= 16 || (slot == 3 && kq == 2)) break;
                const int blk = 1 + (q >> 2), ta = (q >> 1) & 1, tb = q & 1;
                const int ao = blk == 1 ? RC_B : blk == 2 ? RC_K : blk == 3 ? RC_B : RC_K, bo = blk < 3 ? RC_A : RC_R;
                const int oo = blk == 1 ? RC_LAB : blk == 2 ? RC_LAK : blk == 3 ? RC_MRB : RC_MRK;
                f32x16 d = rc_zero();
                const bool dead = ta > tb;
                if (!dead) d = rc_mm2<4>(d, lds + ao, 32 * ta, lds + bo, 32 * tb, r32, h);
                { unsigned mk = 0xffffu; if (ta == tb) { const v2u mv = *(const LAS v2u*)(lds + RC_MK + lane * 8); mk = blk == 1 ? (mv[0] & 0xffffu) : (blk == 2 ? (mv[0] >> 16) : mv[1]); }
#pragma unroll
                  for (int i = 0; i < 16; ++i) d[i] = ((mk >> i) & 1u) ? d[i] : 0.f; }
                rc_store_t(d, lds + oo, 32 * ta, 32 * tb, r32, h); } }
        }
        RC_BAR();
        { const int tid = otid(), w = __builtin_amdgcn_readfirstlane(tid >> 6), lane = tid & 63, r32 = lane & 31, h = lane >> 5; (void)w; (void)lane; (void)r32; (void)h;
        if (w < 4) { const int l16 = lane & 15, q = lane >> 4, v0 = 16 * w;
            bf16x8v sf[2], vf[2];
#pragma unroll
            for (int ks = 0; ks < 2; ++ks) { sf[ks] = *(const LAS bf16x8v*)(lds + RC_S + (v0 + l16) * 144 + (32 * ks + 8 * q) * 2); vf[ks] = rc_frag_tr16(lds + RC_V, 32 * ks, v0, lane); }
            bf16x8v af[4][2], lf[4][2]; v2u lb[4][3], dv[4];
#pragma unroll
            for (int i = 0; i < 4; ++i) {
#pragma unroll
                for (int ks = 0; ks < 2; ++ks) { af[i][ks] = *(const LAS bf16x8v*)(lds + RC_A + (16 * i + l16) * 144 + (32 * ks + 8 * q) * 2); if (ks <= (i >> 1)) lf[i][ks] = *(const LAS bf16x8v*)(lds + RC_LAK + (16 * i + l16) * 144 + (32 * ks + 8 * q) * 2); }
#pragma unroll
                for (int j = 0; j < 3; ++j) if (j < i) lb[i][j] = *(const LAS v2u*)(lds + RC_LAB + (16 * i + l16) * 144 + (16 * j + 4 * q) * 2);
                dv[i] = *(const LAS v2u*)(lds + RC_DIAG + i * 1024 + (l16 * 16 + 4 * q) * 2); }
            asm volatile("s_waitcnt lgkmcnt(0)" ::: "memory"); __builtin_amdgcn_sched_barrier(0);
            f32x4v_ acc[4];
#pragma unroll
            for (int i = 0; i < 4; ++i) { acc[i] = (f32x4v_){0.f, 0.f, 0.f, 0.f};
#pragma unroll
                for (int ks = 0; ks < 2; ++ks) acc[i] = __builtin_amdgcn_mfma_f32_16x16x32_bf16(af[i][ks], sf[ks], acc[i], 0, 0, 0);
#pragma unroll
                for (int js = 0; js <= (i >> 1); ++js) acc[i] = __builtin_amdgcn_mfma_f32_16x16x32_bf16(lf[i][js], vf[js], acc[i], 0, 0, 0); }
            unsigned ub[4][2];
#pragma unroll
            for (int i = 0; i < 4; ++i) {
#pragma unroll
                for (int jp = 0; jp < i; jp += 2) { const v2u lo = lb[i][jp]; v2u hi = (v2u){0u, 0u}; if (jp + 1 < i) hi = lb[i][jp + 1 < 3 ? jp + 1 : 2];
                    v4u aw, bw; aw[0] = lo[0]; aw[1] = lo[1]; aw[2] = hi[0]; aw[3] = hi[1]; bw[0] = ub[jp][0]; bw[1] = ub[jp][1]; bw[2] = (jp + 1 < i) ? ub[jp + 1][0] : 0u; bw[3] = (jp + 1 < i) ? ub[jp + 1][1] : 0u;
                    acc[i] = __builtin_amdgcn_mfma_f32_16x16x32_bf16(__builtin_bit_cast(bf16x8v, aw), __builtin_bit_cast(bf16x8v, bw), acc[i], 0, 0, 0); }
                v4u aw, bw; aw[0] = dv[i][0]; aw[1] = dv[i][1]; aw[2] = 0u; aw[3] = 0u; bw[0] = cvtpk(acc[i][0], acc[i][1]); bw[1] = cvtpk(acc[i][2], acc[i][3]); bw[2] = 0u; bw[3] = 0u;
                const f32x4v_ u = __builtin_amdgcn_mfma_f32_16x16x32_bf16(__builtin_bit_cast(bf16x8v, aw), __builtin_bit_cast(bf16x8v, bw), (f32x4v_){0.f, 0.f, 0.f, 0.f}, 0, 0, 0);
                ub[i][0] = cvtpk(u[0], u[1]); ub[i][1] = cvtpk(u[2], u[3]);
                v2u uo; uo[0] = ub[i][0]; uo[1] = ub[i][1]; *(LAS v2u*)(lds + RC_UT + (v0 + l16) * 144 + (16 * i + 4 * q) * 2) = uo; } }
        else { const int ta = (w >> 1) & 1, tb = w & 1;
            yacc = rc_zero(); yacc = rc_mm2<4>(yacc, lds + RC_S, 32 * ta, lds + RC_R, 32 * tb, r32, h); yacc = rc_mm2t<true, false>(yacc, lds + RC_V, 32 * ta, lds + RC_MRK, 32 * tb, r32, h, lane); }
        if (t0 + 64 < T) RC_LOADPIECES(t0 + 64);
        }
        RC_BAR();
        { const int tid = otid(), w = __builtin_amdgcn_readfirstlane(tid >> 6), lane = tid & 63, r32 = lane & 31, h = lane >> 5; (void)w; (void)lane; (void)r32; (void)h;
        { const int ta = (w >> 1) & 1, tb = w & 1;
          if (w < 4) { f32x16 d = rc_zero();
              d = rc_mm2t<true, false>(d, lds + RC_B, 32 * ta, lds + RC_UT, 32 * tb, r32, h, lane); d = rc_mm2t<true, true>(d, lds + RC_K, 32 * ta, lds + RC_V, 32 * tb, r32, h, lane);
#pragma unroll
              for (int i = 0; i < 16; ++i) Sacc[i] = (Sacc[i] + d[i]) * *(const LAS float*)(lds + RC_GC + (32 * ta + 8 * (i >> 2) + 4 * h + (i & 3)) * 4); }
          else { yacc = rc_mm2<4>(yacc, lds + RC_UT, 32 * ta, lds + RC_MRB, 32 * tb, r32, h);
              float s1 = 0.f, s2 = 0.f;
#pragma unroll
              for (int i = 0; i < 16; ++i) { s1 += yacc[i]; s2 += yacc[i] * yacc[i]; }
              s1 += __shfl_xor(s1, 32); s2 += __shfl_xor(s2, 32);
              if (h == 0) { *(LAS float*)(lds + RC_SSB + ((w - 4) * 32 + r32) * 8) = s1; *(LAS float*)(lds + RC_SSB + ((w - 4) * 32 + r32) * 8 + 4) = s2; } } }
        }
        RC_BAR();
        { const int tid = otid(), w = __builtin_amdgcn_readfirstlane(tid >> 6), lane = tid & 63, r32 = lane & 31, h = lane >> 5; (void)w; (void)lane; (void)r32; (void)h;
        if (w >= 4) { const int ta = (w >> 1) & 1, tb = w & 1, t = 32 * tb + r32;
            const float a1 = *(const LAS float*)(lds + RC_SSB + ((w - 4) * 32 + r32) * 8), a2 = *(const LAS float*)(lds + RC_SSB + ((w - 4) * 32 + r32) * 8 + 4);
            const float b1 = *(const LAS float*)(lds + RC_SSB + (((w - 4) ^ 2) * 32 + r32) * 8), b2 = *(const LAS float*)(lds + RC_SSB + (((w - 4) ^ 2) * 32 + r32) * 8 + 4);
            const float mean = (a1 + b1) * (1.f / 64.f), var = fmaxf((a2 + b2) * (1.f / 64.f) - mean * mean, 0.f), rstd = rsqrtf(var + 64e-5f), bs = *(const LAS float*)(lds + RC_BS + t * 4);
#pragma unroll
            for (int q4 = 0; q4 < 4; ++q4) { const int v0 = 32 * ta + 8 * q4 + 4 * h; const v2u gw = *(const LAS v2u*)(lds + RC_G + t * 144 + v0 * 2);
                const v4f lg4 = *(const LAS v4f*)(lds + RC_CST + 1280 + v0 * 4), lb4 = *(const LAS v4f*)(lds + RC_CST + 1536 + v0 * 4); float o[4];
                const v2u vw = *(const LAS v2u*)(lds + RC_V + t * 144 + v0 * 2);
#pragma unroll
                for (int e = 0; e < 4; ++e) { const float vv = (e & 1) ? bfhi(vw[e >> 1]) : bflo(vw[e >> 1]); const float g = (e & 1) ? bfhi(gw[e >> 1]) : bflo(gw[e >> 1]);
                    o[e] = ((yacc[4 * q4 + e] - mean) * rstd * lg4[e] + lb4[e] + bs * vv) * g; }
                v2u ow; ow[0] = cvtpk(o[0], o[1]); ow[1] = cvtpk(o[2], o[3]);
                *(v2u*)(mixo + (size_t)(b * T + t0 + t) * NMIX + 512 + hh * 64 + v0) = ow; } }

        }
    }
    if (RC_STATIC_PRIO) __builtin_amdgcn_s_setprio(0);
    __syncthreads();
#undef RC_LOADPIECES
}
__device__ __forceinline__ void rwkvc_phase(KP P, int l, LAS unsigned char* lds, int vcu, int G) {
    for (int unit = vcu; unit < BATCH * 8; unit += G) rwkvc_unit(P, l, lds, unit >> 3, unit & 7);
}

#define XB_TMO      128
#define XB_XCNT(j)  (256  + 64 * (j))
#define XB_XSUB(j)  (1280 + 64 * (j))
#define XB_XGEN(j)  (2304 + 64 * (j))
#define XB_TOP      3328
#define XB_TOPGEN   3392
#define XCD_BAR_WORDS 3456
#define XB_SPIN_CAP (1u << 18)
__device__ __forceinline__ unsigned xb_ld(unsigned* p)              { return __hip_atomic_load(p, __ATOMIC_RELAXED, __HIP_MEMORY_SCOPE_AGENT); }
__device__ __forceinline__ unsigned xb_add(unsigned* p, unsigned v) { return __hip_atomic_fetch_add(p, v, __ATOMIC_RELAXED, __HIP_MEMORY_SCOPE_AGENT); }
__device__ __forceinline__ unsigned xb_xcc_id() { return (unsigned)__builtin_amdgcn_s_getreg((3 << 11) | 20) & 0xFu; }
#define XB_SPIN(cond, bar) do { unsigned _sp = 0; while (cond) { __builtin_amdgcn_s_sleep(1); \
    if ((++_sp & 255u) == 0u) { if (xb_ld(&(bar)[XB_TMO])) break; if (_sp > XB_SPIN_CAP) { atomicAdd(&(bar)[XB_TMO], 1u); break; } } } } while (0)
struct XcdBarrier {
    unsigned* bar; unsigned x;
    volatile LAS unsigned* st;
    unsigned n;
};
__device__ __forceinline__ XcdBarrier xcd_barrier_post(unsigned* bar, volatile LAS unsigned* st, unsigned n) {
    XcdBarrier b; b.bar = bar; b.x = xb_xcc_id(); b.st = st; b.n = n;
    if (threadIdx.x == 0) (void)xb_add(&bar[XB_XCNT(b.x)], 1u);
    return b;
}
__device__ __forceinline__ void xcd_barrier_complete(unsigned* bar, unsigned x, unsigned G, unsigned& nloc, unsigned& nx) {
    unsigned sum, cnt, mine, sp = 0u;
    for (;;) {
        sum = 0u; cnt = 0u; mine = 0u;
#pragma unroll
        for (unsigned j = 0; j < 16; ++j) { const unsigned c = xb_ld(&bar[XB_XCNT(j)]); sum += c; cnt += (c > 0u) ? 1u : 0u; mine = (j == x) ? c : mine; }
        if (sum == G) break;
        __builtin_amdgcn_s_sleep(1);
        if ((++sp & 255u) == 0u) { if (xb_ld(&bar[XB_TMO])) break; if (sp > XB_SPIN_CAP) { atomicAdd(&bar[XB_TMO], 1u); break; } }
    }
    nloc = mine > 0u ? mine : 1u; nx = cnt > 0u ? cnt : 1u;
}
template <bool LOCAL> __device__ __forceinline__ void xcd_barrier(const XcdBarrier& b) {
    asm volatile("s_waitcnt vmcnt(0)" ::: "memory");
    __syncthreads();
    if (threadIdx.x == 0) {
        unsigned* bar = b.bar;
        __builtin_amdgcn_s_waitcnt(0);
        unsigned nloc = b.st[0], nx = b.st[1];
        if (nloc == 0u) { xcd_barrier_complete(bar, b.x, b.n, nloc, nx); b.st[0] = nloc; b.st[1] = nx; }
        const bool one = LOCAL && nx == 1u;
        const unsigned old = xb_add(&bar[XB_XSUB(b.x)], 1u);
        const unsigned gen = old / nloc;
        if (one) {
            asm volatile("buffer_inv sc1" ::: "memory");
            if (old + 1u == (gen + 1u) * nloc) (void)xb_add(&bar[XB_XGEN(b.x)], 1u);
            else XB_SPIN(xb_ld(&bar[XB_XGEN(b.x)]) == gen, bar);
            asm volatile("s_waitcnt vmcnt(0)" ::: "memory");
        } else
        if (old + 1u == (gen + 1u) * nloc) {
            if (!one) { __builtin_amdgcn_fence(__ATOMIC_RELEASE, "agent");
                        asm volatile("s_waitcnt vmcnt(0)" ::: "memory"); }
            const unsigned og = xb_add(&bar[XB_TOP], 1u);
            const unsigned tg = og / nx;
            if (og + 1u == (tg + 1u) * nx) xb_add(&bar[XB_TOPGEN], 1u);
            else XB_SPIN(xb_ld(&bar[XB_TOPGEN]) == tg, bar);
            __builtin_amdgcn_fence(__ATOMIC_ACQUIRE, "agent");
            xb_add(&bar[XB_XGEN(b.x)], 1u);
            asm volatile("s_waitcnt vmcnt(0)" ::: "memory");
        } else {
            XB_SPIN(xb_ld(&bar[XB_XGEN(b.x)]) == gen, bar);
            __builtin_amdgcn_fence(__ATOMIC_ACQUIRE, "agent");
            asm volatile("s_waitcnt vmcnt(0)" ::: "memory");
        }
    }
    __syncthreads();
}

constexpr int CW_BAR = 4096;
constexpr int MISC_OFF = 156928;
constexpr int CW_HB = 8192;
constexpr int CW_SEQ = 8192 + 512;
constexpr int CW_WDONE = 8192 + 1024;
constexpr int CW_GBAR = 65536;
__device__ __forceinline__ void half_barrier(unsigned* ctl, int cw, unsigned target) {
    asm volatile("s_waitcnt vmcnt(0) lgkmcnt(0)" ::: "memory");
    __syncthreads();
    if (threadIdx.x == 0) {
        (void)xb_add(&ctl[cw], 1u);
        unsigned sp = 0;
        while (xb_ld(&ctl[cw]) < target) { __builtin_amdgcn_s_sleep(2);
            if ((++sp & 255u) == 0u) { if (xb_ld(&ctl[CW_BAR + XB_TMO])) break; if (sp > XB_SPIN_CAP) { atomicAdd(&ctl[CW_BAR + XB_TMO], 1u); break; } } }
        asm volatile("" ::: "memory");
    }
    __syncthreads();
}
__device__ __forceinline__ void half_wait(unsigned* ctl, int cw, unsigned target) {
    if (threadIdx.x == 0) { unsigned sp = 0;
        while (xb_ld(&ctl[cw]) < target) { __builtin_amdgcn_s_sleep(2);
            if ((++sp & 255u) == 0u) { if (xb_ld(&ctl[CW_BAR + XB_TMO])) break; if (sp > XB_SPIN_CAP) { atomicAdd(&ctl[CW_BAR + XB_TMO], 1u); break; } } }
        asm volatile("" ::: "memory"); }
    __syncthreads();
}
__device__ __forceinline__ void pub_barrier(unsigned* ctl, int cw, unsigned target, bool one) {
    asm volatile("s_waitcnt vmcnt(0)" ::: "memory");
    __syncthreads();
    if (threadIdx.x == 0) {
        if (!one) { __builtin_amdgcn_fence(__ATOMIC_RELEASE, "agent"); asm volatile("s_waitcnt vmcnt(0)" ::: "memory"); }
        (void)xb_add(&ctl[cw], 1u);
        if (one) asm volatile("buffer_inv sc1" ::: "memory");
        unsigned sp = 0;
        while (xb_ld(&ctl[cw]) < target) { __builtin_amdgcn_s_sleep(1);
            if ((++sp & 255u) == 0u) { if (xb_ld(&ctl[CW_BAR + XB_TMO])) break; if (sp > XB_SPIN_CAP) { atomicAdd(&ctl[CW_BAR + XB_TMO], 1u); break; } } }
        if (!one) __builtin_amdgcn_fence(__ATOMIC_ACQUIRE, "agent");
        asm volatile("s_waitcnt vmcnt(0)" ::: "memory");
    }
    __syncthreads();
}
#ifndef NAIVE_ATTN
#define NAIVE_ATTN 0
#endif
#ifndef NAIVE_RET
#define NAIVE_RET 0
#endif
#ifndef NAIVE_RWKV
#define NAIVE_RWKV 0
#endif
#define RWKV_CHUNKED 1
#define GROUP_LOCAL 1
#define PROBE_H 0
#define PROBE_G 0
#define P1B_FIRST 2
#define ATT_FIRST 0
#ifndef REP_RWKV
#define REP_RWKV 1
#endif
#ifndef REP_ATTN
#define REP_ATTN 1
#endif
#ifndef REP_RET
#define REP_RET 1
#endif
#ifndef REP_G0
#define REP_G0 1
#endif
#ifndef REP_G1
#define REP_G1 1
#endif
#ifndef REP_G2
#define REP_G2 1
#endif
#ifndef REP_G4
#define REP_G4 1
#endif
__global__ void __launch_bounds__(512, 2) k_mega(Params Pv) {
    KP P = (KP)__builtin_amdgcn_kernarg_segment_ptr();
#define PFRESH() asm volatile("" : "+s"(P))
    extern __shared__ __attribute__((aligned(16))) unsigned char lds_[];
    LAS unsigned char* lds = (LAS unsigned char*)lds_;
    const int tid = threadIdx.x, G = gridDim.x, bx = blockIdx.x, vcu = (G % 8 == 0) ? (bx % 8) * (G / 8) + bx / 8 : bx;
    volatile LAS unsigned* MISC = (volatile LAS unsigned*)(lds + MISC_OFF);
    for (int u = tid; u < (LDS_BYTES - MISC_OFF) / 4; u += 512) ((LAS unsigned*)(lds + MISC_OFF))[u] = 0u;
    __syncthreads();
    const int GS = G / 8, grp = vcu / GS, rk = vcu % GS, GSH = GS / 2;
    XcdBarrier bar = xcd_barrier_post((unsigned*)(P->ws + WS_CTL) + CW_BAR, MISC + 8, (unsigned)G);
    { XcdBarrier gb0 = xcd_barrier_post((unsigned*)(P->ws + WS_CTL) + CW_GBAR + 4096 * grp, MISC + 12, (unsigned)GS); (void)gb0; }
#define GRID_BAR() do { asm volatile("" : "+s"(bar.x)); xcd_barrier<false>(bar); } while (0)
#define GROUP_BAR() do { int g_ = grp; asm volatile("" : "+s"(g_)); XcdBarrier gb_; gb_.bar = (unsigned*)(P->ws + WS_CTL) + CW_GBAR + 4096 * g_; gb_.x = xb_xcc_id(); gb_.st = MISC + 12; gb_.n = (unsigned)GS; xcd_barrier<GROUP_LOCAL != 0>(gb_); } while (0)
    PFRESH(); phase_x0(P, vcu, G);
    PFRESH(); phase_wconv_all(P, lds, vcu, G);
    GRID_BAR();
    for (int l = 0; l < DEPTH; ++l) {
        PFRESH(); gemm_phase_of<0>(P, l, lds, G, bx);
        GROUP_BAR();
        PFRESH();
#if PROBE_H
        const unsigned long long th0_ = __builtin_amdgcn_s_memrealtime();
#endif
        { unsigned* ctl = (unsigned*)(P->ws + WS_CTL); const int cw = CW_HB + 64 * grp;
          const bool loc = GROUP_LOCAL && MISC[13] == 1u;
          if (rk < GSH) { attn_phase(P, l, lds, 64 * grp + rk, GSH, 64 * grp + GSH * ATT_FIRST); half_barrier(ctl, cw, 0u); PFRESH();
                          { const int npb = GSH / 2; rwkv_prepass(P, l, 2 * grp + rk / npb, rk % npb, T / npb); }
                          pub_barrier(ctl, CW_SEQ + 64 * grp, (unsigned)GSH * (unsigned)(l + 1), loc); PFRESH();
#if PROBE_H == 3
                          if (tid == 0 && grp == 0 && rk == 0) { unsigned long long* ts_ = (unsigned long long*)(P->ws + WS_CTL + 65536); *ts_ += __builtin_amdgcn_s_memrealtime() - th0_; }
#endif
                          for (int unit = 16 * grp + rk; unit < 16 * grp + 16; unit += GSH) rwkvc_unit(P, l, lds, unit >> 3, unit & 7);
                          if (P1B_FIRST > 0) { half_wait(ctl, cw, (unsigned)GS * (unsigned)(l + 1)); PFRESH(); gemm_phase_of<1>(P, l, lds, 8 * GSH, 8 * rk + grp, 12 - P1B_FIRST, P1B_FIRST); } }
          else { const int r2 = rk - GSH;
                 attn_phase(P, l, lds, 64 * grp + GSH * ATT_FIRST + r2, GS - GSH, 64 * grp + 64); __syncthreads();
#if PROBE_H == 4 || PROBE_H == 5
                 const unsigned long long tr0_ = __builtin_amdgcn_s_memrealtime();
#endif
#if PROBE_H == 5
                 if (tid == 0 && grp == 0 && rk == GSH) { unsigned long long* ts_ = (unsigned long long*)(P->ws + WS_CTL + 65536); *ts_ += tr0_ - th0_; }
#endif
                 for (int unit = 16 * grp + r2; unit < 16 * grp + 16; unit += GS - GSH) ret_unit(P, lds, unit >> 3, unit & 7);
#if PROBE_H == 4
                 if (tid == 0 && grp == 0 && rk == GSH) { unsigned long long* ts_ = (unsigned long long*)(P->ws + WS_CTL + 65536); *ts_ += __builtin_amdgcn_s_memrealtime() - tr0_; }
#endif
                 half_barrier(ctl, cw, (unsigned)GS * (unsigned)(l + 1));
                 PFRESH(); gemm_phase_of<1>(P, l, lds, 8 * (GS - GSH), 8 * r2 + grp, 0, 12 - P1B_FIRST); } }
#if PROBE_H
        if (PROBE_H < 3 && tid == 0 && grp == 0 && rk == (PROBE_H == 1 ? 0 : GSH)) { unsigned long long* ts_ = (unsigned long long*)(P->ws + WS_CTL + 65536); *ts_ += __builtin_amdgcn_s_memrealtime() - th0_; }
#endif
        GROUP_BAR();
        if (l == DEPTH - 1) { if (tid == 0) (void)xb_add((unsigned*)(P->ws + WS_CTL) + CW_WDONE, 1u); }
        PFRESH(); gemm_phase_of<2>(P, l, lds, G, bx);
        GROUP_BAR();
        PFRESH(); gemm_phase_of<3>(P, l, lds, G, bx);
        GROUP_BAR();
        PFRESH(); gemm_phase_of<4>(P, l, lds, G, bx);
        GROUP_BAR();
        if (l == DEPTH - 1) {
            unsigned* ctl = (unsigned*)(P->ws + WS_CTL);
            if (tid == 0) { unsigned sp = 0; while (xb_ld(&ctl[CW_WDONE]) < (unsigned)G) { __builtin_amdgcn_s_sleep(8);
                if ((++sp & 255u) == 0u) { if (xb_ld(&ctl[CW_BAR + XB_TMO])) break; if (sp > XB_SPIN_CAP) { atomicAdd(&ctl[CW_BAR + XB_TMO], 1u); break; } } } }
            __syncthreads(); }
        PFRESH(); gemm_phase_of<5>(P, l, lds, G, bx);
        if (l < DEPTH - 1) GROUP_BAR();
    }
#if PROBE_G
    if (grp == PROBE_G - 1 && rk == 0 && tid == 0) { const unsigned long long t0_ = __builtin_amdgcn_s_memrealtime(); while (__builtin_amdgcn_s_memrealtime() - t0_ < 30000ull) __builtin_amdgcn_s_sleep(8); }
#endif
#if PROBE_H
    if (grp == 0 && rk == 0 && tid == 0) { const unsigned long long tt_ = __hip_atomic_load((unsigned long long*)(P->ws + WS_CTL + 65536), __ATOMIC_RELAXED, __HIP_MEMORY_SCOPE_AGENT) * 4ull; const unsigned long long t0_ = __builtin_amdgcn_s_memrealtime(); while (__builtin_amdgcn_s_memrealtime() - t0_ < tt_) __builtin_amdgcn_s_sleep(8); }
#endif
#if PROBE_T
    if (vcu == 0 && tid == 0) { const unsigned long long tt_ = *(volatile unsigned long long*)(P->ws + WS_CTL + 65536) * 8ull; const unsigned long long t0_ = __builtin_amdgcn_s_memrealtime(); while (__builtin_amdgcn_s_memrealtime() - t0_ < tt_) __builtin_amdgcn_s_sleep(8); }
#endif
}

extern "C" void kernel_launch(void* const* d_in, const int* in_sizes, int n_in, void* d_out, int out_size, void* d_ws, size_t ws_size, hipStream_t stream) {
    static int grid = 0;
    if (grid == 0) {
        if (n_in != 25 || out_size != M * D || ws_size < WS_END) { fprintf(stderr, "kernel_launch: unexpected shapes (n_in %d, out %d, ws %zu)\n", n_in, out_size, ws_size); grid = -1; return; }
        int dev = 0, cus = 0, per_cu = 0; if (hipGetDevice(&dev) != hipSuccess || hipDeviceGetAttribute(&cus, hipDeviceAttributeMultiprocessorCount, dev) != hipSuccess) { grid = -1; return; }
        if (hipFuncSetAttribute((const void*)k_mega, hipFuncAttributeMaxDynamicSharedMemorySize, LDS_BYTES) != hipSuccess) { fprintf(stderr, "kernel_launch: hipFuncSetAttribute failed\n"); grid = -1; return; }
        if (hipOccupancyMaxActiveBlocksPerMultiprocessor(&per_cu, (const void*)k_mega, 512, LDS_BYTES) != hipSuccess || per_cu < 1) fprintf(stderr, "kernel_launch: occupancy query reports %d workgroups per CU\n", per_cu);
        (void)hipGetLastError();
        grid = cus - cus % 16;
        if (grid < 16) { grid = -1; return; }
    }
    if (grid < 0) return;
    Params p; memset(&p, 0, sizeof(p));
    for (int i = 0; i < 25; ++i) p.in[i] = (const float*)d_in[i];
    p.out = (float*)d_out; p.ws = (unsigned char*)d_ws;
    (void)hipMemsetAsync((char*)d_ws + WS_CTL, 0, CTL_BYTES, stream);
    hipLaunchKernelGGL(k_mega, dim3(grid), dim3(512), LDS_BYTES, stream, p);
}
```
